# Optimizing an MI355X kernel written in HIP

```python
import math
import jax
import jax.numpy as jnp
from jax import lax
import numpy as np

D_MODEL = 1024
BATCH = 4
SEQ = 4096
DEPTH = 2

RWKV_HEADS = 8
RWKV_HEAD_DIM = 64
RWKV_WIDTH = RWKV_HEADS * RWKV_HEAD_DIM
DECAY_LORA = 64
ICLR_LORA = 64
VRES_LORA = 32
GATE_LORA = 128
RWKV_GN_EPS = 64e-5
MLA_HEADS = 8
QK_NOPE_DIM = 64
QK_ROPE_DIM = 32
MLA_QK_DIM = QK_NOPE_DIM + QK_ROPE_DIM
MLA_V_DIM = 64
MLA_WIDTH = MLA_HEADS * MLA_V_DIM
Q_LORA_RANK = 256
KV_LORA_RANK = 128
ROPE_THETA = 10000.0
Q_BLOCK = 128
GDN_HEADS = 8
GDN_K_DIM = 64
GDN_V_DIM = 64
GDN_WIDTH = GDN_HEADS * GDN_V_DIM
GDN_QKV = 2 * GDN_HEADS * GDN_K_DIM + GDN_HEADS * GDN_V_DIM
GDN_CONV = 4
GDN_CHUNK = 64
N_BRANCH = 3
FF_DENSE = 2816
N_EXPERTS = 8
TOP_K = 2
FF_EXPERT = 3584
MOE_BLOCK = 128
PLE_DIM = 256
NORM_EPS = 1e-6

RWKV_IN_SIZES = (RWKV_WIDTH, RWKV_WIDTH, RWKV_WIDTH, DECAY_LORA, ICLR_LORA, GATE_LORA)
MLA_IN_SIZES = (Q_LORA_RANK, KV_LORA_RANK, QK_ROPE_DIM)
GDN_IN_SIZES = (GDN_QKV, GDN_HEADS, GDN_HEADS, GDN_WIDTH)
RWKV_IN = sum(RWKV_IN_SIZES)
MLA_IN = sum(MLA_IN_SIZES)
GDN_IN = sum(GDN_IN_SIZES)
GATE_IN = N_BRANCH * D_MODEL
N_IN = RWKV_IN + MLA_IN + GDN_IN + GATE_IN

kernel_name = 'hybrid_rwkv7_mla_gdn_moe_block'


def rms_norm(x, g, eps=NORM_EPS):
    xf = x.astype(jnp.float32)
    y = xf * lax.rsqrt(jnp.mean(jnp.square(xf), axis=-1, keepdims=True) + eps)
    return (y * g.astype(jnp.float32)).astype(x.dtype)


def l2_normalize(x, eps=1e-12):
    xf = x.astype(jnp.float32)
    return xf * lax.rsqrt(jnp.sum(jnp.square(xf), axis=-1, keepdims=True) + eps)


def split_cols(z, sizes):
    return jnp.split(z, [int(c) for c in np.cumsum(sizes)[:-1]], axis=-1)


def heads(t, n):
    return t.reshape(t.shape[:-1] + (n, t.shape[-1] // n))


def token_shift(z):
    return jnp.pad(z, ((0, 0), (1, 0), (0, 0)))[:, :-1]


def rope_tables(positions):
    inv_freq = 1.0 / (ROPE_THETA ** (jnp.arange(0, QK_ROPE_DIM, 2, dtype=jnp.float32) / QK_ROPE_DIM))
    ang = positions.astype(jnp.float32)[..., None] * inv_freq
    return jnp.cos(ang)[:, :, None, :], jnp.sin(ang)[:, :, None, :]


def apply_rope(x, cos, sin):
    x1, x2 = jnp.split(x.astype(jnp.float32), 2, axis=-1)
    return jnp.concatenate([x1 * cos - x2 * sin, x2 * cos + x1 * sin], axis=-1).astype(x.dtype)


def rwkv7_recurrence(r, w, k, v, a, b):
    bsz, _, h, n = r.shape

    def step(state, xs):
        r_t, w_t, k_t, v_t, a_t, b_t = xs
        sa = jnp.einsum('bhij,bhj->bhi', state, a_t)
        state = (state * w_t[:, :, None, :] + sa[..., None] * b_t[:, :, None, :]
                 + v_t[..., None] * k_t[:, :, None, :])
        return state, jnp.einsum('bhij,bhj->bhi', state, r_t)

    xs = tuple(jnp.moveaxis(t, 1, 0) for t in (r, w, k, v, a, b))
    _, y = lax.scan(step, jnp.zeros((bsz, h, n, n), jnp.float32), xs)
    return jnp.moveaxis(y, 0, 1)


def rwkv7_branch(z, u, v_first, vres, mu, w0, w_up, a0, a_up, g_up, k_k, k_a, r_k, ln_g, ln_b):
    b, s, _ = z.shape
    z = z + (token_shift(z) - z) * mu
    r, k, v, w_lo, a_lo, g_lo = split_cols(z, RWKV_IN_SIZES)
    log_w = -jax.nn.softplus(-(w0 + jnp.tanh(w_lo) @ w_up)) - 0.5
    decay = jnp.exp(-jnp.exp(log_w.astype(jnp.float32)))
    iclr = jax.nn.sigmoid(a0 + a_lo @ a_up)
    gate = jax.nn.sigmoid(g_lo) @ g_up
    if vres is None:
        v_first = v
    else:
        v_mu, v_down, v_up, v_bias = vres
        xv = u + (token_shift(u) - u) * v_mu
        v = v + (v_first - v) * jax.nn.sigmoid(v_bias + (xv @ v_down) @ v_up)
    kk = l2_normalize(heads(k * k_k, RWKV_HEADS))
    k = k * (1.0 + (iclr - 1.0) * k_a)
    rh, kh, vh, ah, wh = (heads(t, RWKV_HEADS).astype(jnp.float32) for t in (r, k, v, iclr, decay))
    y = rwkv7_recurrence(rh, wh, kh, vh, -kk, kk * ah)
    mean = jnp.mean(y, axis=-1, keepdims=True)
    var = jnp.mean(jnp.square(y - mean), axis=-1, keepdims=True)
    y = ((y - mean) * lax.rsqrt(var + RWKV_GN_EPS)).reshape(b, s, RWKV_WIDTH) * ln_g + ln_b
    bonus = jnp.sum(rh * kh * r_k, axis=-1, keepdims=True) * vh
    y = y + bonus.reshape(b, s, RWKV_WIDTH)
    return (y * gate).astype(z.dtype), v_first


def causal_block_attention(q, k, v, scale):
    seq = q.shape[1]
    outs = []
    for start in range(0, seq, Q_BLOCK):
        stop = start + Q_BLOCK
        s = jnp.einsum('bqhd,bkhd->bhqk', q[:, start:stop], k[:, :stop]).astype(jnp.float32) * scale
        mask = (start + jnp.arange(Q_BLOCK))[:, None] >= jnp.arange(stop)[None, :]
        prob = jax.nn.softmax(jnp.where(mask, s, -jnp.inf), axis=-1)
        outs.append(jnp.einsum('bhqk,bkhd->bqhd', prob.astype(v.dtype), v[:, :stop]))
    return jnp.concatenate(outs, axis=1)


def mla_branch(z, cos, sin, q_norm_g, kv_norm_g, w_uq, w_ukv, qk_g_q, qk_g_k):
    b, s, _ = z.shape
    c_q, c_kv, k_pe = split_cols(z, MLA_IN_SIZES)
    q = heads(rms_norm(c_q, q_norm_g) @ w_uq, MLA_HEADS)
    kv = heads(rms_norm(c_kv, kv_norm_g) @ w_ukv, MLA_HEADS)
    k_nope, v = kv[..., :QK_NOPE_DIM], kv[..., QK_NOPE_DIM:]
    k_pe = jnp.broadcast_to(k_pe[:, :, None, :], k_nope.shape[:-1] + (QK_ROPE_DIM,))
    k = jnp.concatenate([k_nope, k_pe], axis=-1)
    q = rms_norm(q, qk_g_q)
    k = rms_norm(k, qk_g_k)
    q = jnp.concatenate([q[..., :QK_NOPE_DIM], apply_rope(q[..., QK_NOPE_DIM:], cos, sin)], axis=-1)
    k = jnp.concatenate([k[..., :QK_NOPE_DIM], apply_rope(k[..., QK_NOPE_DIM:], cos, sin)], axis=-1)
    o = causal_block_attention(q, k, v, MLA_QK_DIM ** -0.5)
    return o.reshape(b, s, MLA_WIDTH)


def causal_depthwise_conv(x, w):
    xp = jnp.pad(x, ((0, 0), (GDN_CONV - 1, 0), (0, 0)))
    return lax.conv_general_dilated(xp, w[:, None, :].astype(x.dtype), (1,), 'VALID',
                                    dimension_numbers=('NWC', 'WIO', 'NWC'),
                                    feature_group_count=x.shape[-1])


def chunk_gated_delta_rule(q, k, v, g, beta):
    b, s, h, dk = q.shape
    dv = v.shape[-1]
    c = GDN_CHUNK
    n = s // c

    def chunks(t):
        return jnp.moveaxis(t.reshape((b, n, c, h) + t.shape[3:]), 3, 2)

    q, k, v, g, beta = (chunks(t) for t in (q, k, v, g, beta))
    gc = jnp.cumsum(g, axis=-1)
    causal = jnp.tril(jnp.ones((c, c), dtype=bool))
    strict = jnp.tril(jnp.ones((c, c), dtype=bool), -1)
    gamma = jnp.exp(jnp.where(causal, gc[..., :, None] - gc[..., None, :], -jnp.inf))
    kb = k * beta[..., None]
    m = jnp.where(strict, jnp.einsum('bnhid,bnhjd->bnhij', kb, k) * gamma, 0.0) + jnp.eye(c, dtype=jnp.float32)
    rhs = jnp.concatenate([v * beta[..., None], kb * jnp.exp(gc)[..., None]], axis=-1)
    sol = lax.linalg.triangular_solve(m, rhs, left_side=True, lower=True, unit_diagonal=True)
    u_c, w_c = sol[..., :dv], sol[..., dv:]
    a_in = jnp.einsum('bnhid,bnhjd->bnhij', q, k) * gamma
    q_dec = q * jnp.exp(gc)[..., None]
    k_dec = k * jnp.exp(gc[..., -1:] - gc)[..., None]
    chunk_dec = jnp.exp(gc[..., -1])

    def step(state, xs):
        u_i, w_i, a_i, qd_i, kd_i, d_i = xs
        v_new = u_i - jnp.einsum('bhck,bhkv->bhcv', w_i, state)
        o_i = jnp.einsum('bhck,bhkv->bhcv', qd_i, state) + jnp.einsum('bhcj,bhjv->bhcv', a_i, v_new)
        state = state * d_i[..., None, None] + jnp.einsum('bhck,bhcv->bhkv', kd_i, v_new)
        return state, o_i

    xs = tuple(jnp.moveaxis(t, 1, 0) for t in (u_c, w_c, a_in, q_dec, k_dec, chunk_dec))
    _, o = lax.scan(step, jnp.zeros((b, h, dk, dv), jnp.float32), xs)
    return jnp.moveaxis(o, 0, 1).swapaxes(2, 3).reshape(b, s, h, dv)


def gdn_branch(z, conv_w, a_log, dt_bias, norm_g):
    b, s, _ = z.shape
    qkv, b_logit, a_logit, gate = split_cols(z, GDN_IN_SIZES)
    qkv = jax.nn.silu(causal_depthwise_conv(qkv, conv_w))
    q, k, v = split_cols(qkv, (GDN_HEADS * GDN_K_DIM, GDN_HEADS * GDN_K_DIM, GDN_HEADS * GDN_V_DIM))
    q = l2_normalize(heads(q, GDN_HEADS)) * (GDN_K_DIM ** -0.5)
    k = l2_normalize(heads(k, GDN_HEADS))
    v = heads(v, GDN_HEADS).astype(jnp.float32)
    beta = jax.nn.sigmoid(b_logit.astype(jnp.float32))
    g = -jnp.exp(a_log.astype(jnp.float32)) * jax.nn.softplus(a_logit.astype(jnp.float32) + dt_bias)
    o = chunk_gated_delta_rule(q, k, v, g, beta)
    o = rms_norm(o, norm_g) * jax.nn.silu(heads(gate, GDN_HEADS).astype(jnp.float32))
    return o.reshape(b, s, GDN_WIDTH).astype(z.dtype)


def swiglu(x, w_gate, w_up, w_down):
    return (jax.nn.silu(x @ w_gate) * (x @ w_up)) @ w_down


def moe_swiglu(x2d, w_router, w_gate, w_up, w_down):
    n_tok, d = x2d.shape
    n_assign = n_tok * TOP_K
    n_blocks = -(-(n_assign + N_EXPERTS * (MOE_BLOCK - 1)) // MOE_BLOCK)
    logits = jnp.dot(x2d, w_router).astype(jnp.float32)
    top_logits, top_e = lax.top_k(logits, TOP_K)
    top_w = jax.nn.softmax(top_logits, axis=-1).reshape(-1)
    flat_e = top_e.reshape(-1)
    order = jnp.argsort(flat_e)
    e_sorted = flat_e[order]
    tok_sorted = order // TOP_K
    w_sorted = top_w[order]
    counts = jnp.bincount(flat_e, length=N_EXPERTS)
    padded = (counts + MOE_BLOCK - 1) // MOE_BLOCK * MOE_BLOCK
    pad_end = jnp.cumsum(padded)
    rank = jnp.arange(n_assign) - (jnp.cumsum(counts) - counts)[e_sorted]
    dest = (pad_end - padded)[e_sorted] + rank
    rows = jnp.zeros((n_blocks * MOE_BLOCK, d), x2d.dtype).at[dest].set(x2d[tok_sorted])
    block_e = jnp.minimum(jnp.searchsorted(pad_end, jnp.arange(n_blocks) * MOE_BLOCK, side='right'), N_EXPERTS - 1)

    def expert_block(args):
        xb, e = args
        return (jax.nn.silu(xb @ w_gate[e]) * (xb @ w_up[e])) @ w_down[e]

    y_rows = lax.map(expert_block, (rows.reshape(n_blocks, MOE_BLOCK, d), block_e)).reshape(n_blocks * MOE_BLOCK, d)
    y = jax.ops.segment_sum(y_rows[dest] * w_sorted[:, None], tok_sorted, num_segments=n_tok)
    return y.astype(x2d.dtype)


def setup_inputs(seed: int = 0) -> dict:
    key = jax.random.key(seed)
    ks = iter(jax.random.split(key, 64))
    f32 = jnp.float32
    L = DEPTH
    LD = (DEPTH + 1) // 2
    LM = DEPTH // 2
    LV = DEPTH - 1

    def nrm(shape, scale):
        return jax.random.normal(next(ks), shape, f32) * scale

    def unif(shape, lo, hi):
        return jax.random.uniform(next(ks), shape, f32, lo, hi)

    def gain(shape):
        return 1.0 + nrm(shape, 0.02)

    x = nrm((BATCH, SEQ, D_MODEL), 1.0)
    p = nrm((DEPTH, BATCH, SEQ, PLE_DIM), 1.0)
    positions = (jnp.arange(SEQ, dtype=jnp.int32)[None, :]
                 + jax.random.randint(next(ks), (BATCH, 1), 0, 1024, dtype=jnp.int32))
    dt = jnp.exp(unif((L, GDN_HEADS), math.log(1e-3), math.log(1e-1)))
    gdn_dt_bias = dt + jnp.log(-jnp.expm1(-dt))
    return {
        'x': x,
        'p': p,
        'positions': positions,
        'norm_mix_g': gain((L, D_MODEL)),
        'w_in': nrm((L, D_MODEL, N_IN), D_MODEL ** -0.5),
        'rwkv_mu': unif((L, RWKV_IN), 0.0, 1.0),
        'rwkv_w0': unif((L, RWKV_WIDTH), -6.0, 1.0),
        'rwkv_w_up': nrm((L, DECAY_LORA, RWKV_WIDTH), DECAY_LORA ** -0.5),
        'rwkv_a0': unif((L, RWKV_WIDTH), -1.0, 1.0),
        'rwkv_a_up': nrm((L, ICLR_LORA, RWKV_WIDTH), ICLR_LORA ** -0.5),
        'rwkv_g_up': nrm((L, GATE_LORA, RWKV_WIDTH), GATE_LORA ** -0.5),
        'rwkv_k_k': 0.85 + nrm((L, RWKV_WIDTH), 0.05),
        'rwkv_k_a': 1.0 + nrm((L, RWKV_WIDTH), 0.05),
        'rwkv_r_k': nrm((L, RWKV_HEADS, RWKV_HEAD_DIM), 0.1),
        'rwkv_ln_g': gain((L, RWKV_WIDTH)),
        'rwkv_ln_b': nrm((L, RWKV_WIDTH), 0.02),
        'vres_mu': unif((LV, D_MODEL), 0.0, 1.0),
        'vres_down': nrm((LV, D_MODEL, VRES_LORA), D_MODEL ** -0.5),
        'vres_up': nrm((LV, VRES_LORA, RWKV_WIDTH), VRES_LORA ** -0.5),
        'vres_b': 1.0 + nrm((LV, RWKV_WIDTH), 0.1),
        'mla_q_norm_g': gain((L, Q_LORA_RANK)),
        'mla_kv_norm_g': gain((L, KV_LORA_RANK)),
        'mla_w_uq': nrm((L, Q_LORA_RANK, MLA_HEADS * MLA_QK_DIM), Q_LORA_RANK ** -0.5),
        'mla_w_ukv': nrm((L, KV_LORA_RANK, MLA_HEADS * (QK_NOPE_DIM + MLA_V_DIM)), KV_LORA_RANK ** -0.5),
        'mla_qk_norm_q': gain((L, MLA_QK_DIM)),
        'mla_qk_norm_k': gain((L, MLA_QK_DIM)),
        'gdn_conv_w': nrm((L, GDN_CONV, GDN_QKV), GDN_CONV ** -0.5),
        'gdn_a_log': jnp.log(unif((L, GDN_HEADS), 1.0, 16.0)),
        'gdn_dt_bias': gdn_dt_bias,
        'gdn_norm_g': gain((L, GDN_V_DIM)),
        'w_br_rwkv': nrm((L, RWKV_WIDTH, D_MODEL), RWKV_WIDTH ** -0.5),
        'w_br_mla': nrm((L, MLA_WIDTH, D_MODEL), MLA_WIDTH ** -0.5),
        'w_br_gdn': nrm((L, GDN_WIDTH, D_MODEL), GDN_WIDTH ** -0.5),
        'w_out': nrm((L, D_MODEL, D_MODEL), D_MODEL ** -0.5),
        'norm_ffn_g': gain((L, D_MODEL)),
        'ffn_wg': nrm((LD, D_MODEL, FF_DENSE), D_MODEL ** -0.5),
        'ffn_wu': nrm((LD, D_MODEL, FF_DENSE), D_MODEL ** -0.5),
        'ffn_wd': nrm((LD, FF_DENSE, D_MODEL), FF_DENSE ** -0.5),
        'moe_router': nrm((LM, D_MODEL, N_EXPERTS), D_MODEL ** -0.5),
        'moe_wg': nrm((LM, N_EXPERTS, D_MODEL, FF_EXPERT), D_MODEL ** -0.5),
        'moe_wu': nrm((LM, N_EXPERTS, D_MODEL, FF_EXPERT), D_MODEL ** -0.5),
        'moe_wd': nrm((LM, N_EXPERTS, FF_EXPERT, D_MODEL), FF_EXPERT ** -0.5),
        'ple_proj': nrm((L, PLE_DIM, D_MODEL), PLE_DIM ** -0.5),
        'ple_gate': nrm((L, D_MODEL, D_MODEL), D_MODEL ** -0.5),
        'ple_norm_g': gain((L, D_MODEL)),
    }


def reference(x, p, positions, norm_mix_g, w_in, rwkv_mu, rwkv_w0, rwkv_w_up, rwkv_a0, rwkv_a_up,
              rwkv_g_up, rwkv_k_k, rwkv_k_a, rwkv_r_k, rwkv_ln_g, rwkv_ln_b, vres_mu, vres_down,
              vres_up, vres_b, mla_q_norm_g, mla_kv_norm_g, mla_w_uq, mla_w_ukv, mla_qk_norm_q,
              mla_qk_norm_k, gdn_conv_w, gdn_a_log, gdn_dt_bias, gdn_norm_g, w_br_rwkv, w_br_mla,
              w_br_gdn, w_out, norm_ffn_g, ffn_wg, ffn_wu, ffn_wd, moe_router, moe_wg, moe_wu, moe_wd,
              ple_proj, ple_gate, ple_norm_g):
    b, s, d = x.shape
    cos, sin = rope_tables(positions)
    h = x
    v_first = None
    for i in range(DEPTH):
        u = rms_norm(h, norm_mix_g[i])
        z = u @ w_in[i]
        z_rwkv, z_mla, z_gdn, z_gate = split_cols(z, (RWKV_IN, MLA_IN, GDN_IN, GATE_IN))
        vres = None if i == 0 else (vres_mu[i - 1], vres_down[i - 1], vres_up[i - 1], vres_b[i - 1])
        o_a, v_first = rwkv7_branch(z_rwkv, u, v_first, vres, rwkv_mu[i], rwkv_w0[i], rwkv_w_up[i],
                                    rwkv_a0[i], rwkv_a_up[i], rwkv_g_up[i], rwkv_k_k[i], rwkv_k_a[i],
                                    rwkv_r_k[i], rwkv_ln_g[i], rwkv_ln_b[i])
        o_b = mla_branch(z_mla, cos, sin, mla_q_norm_g[i], mla_kv_norm_g[i], mla_w_uq[i], mla_w_ukv[i],
                         mla_qk_norm_q[i], mla_qk_norm_k[i])
        o_c = gdn_branch(z_gdn, gdn_conv_w[i], gdn_a_log[i], gdn_dt_bias[i], gdn_norm_g[i])
        g_a, g_b, g_c = jnp.split(jax.nn.sigmoid(z_gate), N_BRANCH, axis=-1)
        merged = (g_a * (o_a @ w_br_rwkv[i]) + g_b * (o_b @ w_br_mla[i])
                  + g_c * (o_c @ w_br_gdn[i]))
        h = h + merged @ w_out[i]
        u2 = rms_norm(h, norm_ffn_g[i])
        if i % 2 == 0:
            f = swiglu(u2, ffn_wg[i // 2], ffn_wu[i // 2], ffn_wd[i // 2])
        else:
            f = moe_swiglu(u2.reshape(b * s, d), moe_router[i // 2], moe_wg[i // 2],
                           moe_wu[i // 2], moe_wd[i // 2]).reshape(b, s, d)
        h = h + f
        e = rms_norm(p[i] @ ple_proj[i], ple_norm_g[i])
        h = h + jax.nn.sigmoid(h @ ple_gate[i]) * e
    return h
```

```cpp
#include <hip/hip_runtime.h>
#include <cstdio>
#include <cstdint>
__device__ __forceinline__ int otid() { int t = threadIdx.x; asm volatile("" : "+v"(t)); return t; }
__device__ __forceinline__ int obid() { int t = blockIdx.x; asm volatile("" : "+s"(t)); return t; }
__device__ __forceinline__ int ogrid() { int t = gridDim.x; asm volatile("" : "+s"(t)); return t; }
namespace pg8 {
#define PG8_LAS __attribute__((address_space(3)))
typedef unsigned short bf16_t;
typedef short bf16x8 __attribute__((ext_vector_type(8)));
typedef float f32x4 __attribute__((ext_vector_type(4)));
typedef unsigned u32x4 __attribute__((ext_vector_type(4)));
typedef unsigned u32x2 __attribute__((ext_vector_type(2)));
constexpr int BM = 256, BK = 64, HALF = 128, HTB = HALF * BK * 2, STAGE_BYTES = 8 * HTB, NXCD = 8, WGM = 8;

__host__ __device__ __forceinline__ int lds_byte(int r, int c) { const int st = (r >> 4) * 2 + (c >> 5), rr = r & 15, cc = c & 31, ob = rr * 64 + cc * 2; return st * 1024 + (ob ^ (((ob >> 9) & 1) << 5)); }
__host__ __device__ __forceinline__ void stage_rc(int b, int& R, int& C) { const int st = b / 1024, sb = b % 1024, swz = sb ^ (((sb >> 9) & 1) << 5); R = (st >> 1) * 16 + swz / 64; C = (st & 1) * 32 + (swz % 64) / 2; }
__host__ __device__ __forceinline__ int perm32(int rho) { const int n = rho >> 4, i = rho & 15; return 8 * (i >> 2) + 4 * n + (i & 3); }

struct Unit { int pm, pn, pb; };
struct Gemm { const bf16_t* A; const bf16_t* Bt; int K, lda, ldb; };

struct StaticOrder {
    int nM, nN, nwg, G, c, pm0; const int* blk_e;
    __device__ void init(int nM_, int nN_, int G_, int c_, int pm0_ = 0, const int* blk_e_ = nullptr) { nM = nM_; nN = nN_; nwg = nM * nN; G = G_; c = c_; pm0 = pm0_; blk_e = blk_e_; }
    __device__ bool next(int i, Unit& u) const {
        const long L = (long)i * G + c; if (L >= nwg) return false;
        int wgid = (int)L; { const int q = nwg / NXCD, r = nwg % NXCD, xcd = wgid % NXCD, off = wgid / NXCD; wgid = (xcd < r ? xcd * (q + 1) : r * (q + 1) + (xcd - r) * q) + off; }
        const int nig = WGM * nN, gid = wgid / nig, fm = gid * WGM, gsz = (nM - fm) < WGM ? (nM - fm) : WGM;
        u.pm = pm0 + fm + ((wgid % nig) % gsz); u.pn = (wgid % nig) / gsz;
        u.pb = blk_e ? (__builtin_amdgcn_readfirstlane(blk_e[u.pm]) * nN + u.pn) : u.pn;
        return true;
    }
};

__device__ __forceinline__ unsigned cvt_pk_bf16(float lo, float hi) { unsigned r; asm volatile("v_cvt_pk_bf16_f32 %0, %1, %2" : "=v"(r) : "v"(lo), "v"(hi)); return r; }

template <class Epi, class Sched>
__device__ __forceinline__ void gemm_phase(PG8_LAS unsigned char* lds, const Gemm g, const Sched& S, const Epi& E) {
    const int tid = otid(), wid = __builtin_amdgcn_readfirstlane(tid >> 6), lane = tid & 63, wr = wid >> 2, wc = wid & 3, fr = lane & 15, fq = lane >> 4;
    const int K = g.K, nt = K / BK;
    unsigned voffA[2], voffB[2];
#pragma unroll
    for (int i = 0; i < 2; ++i) { int R, C; stage_rc(tid * 16 + i * 8192, R, C); const int Rb = Epi::PERM ? ((R & ~31) + perm32(R & 31)) : R;
        voffA[i] = (unsigned)(R * g.lda + C) * 2u; voffB[i] = (unsigned)(Rb * g.ldb + C) * 2u; }
    const size_t kstep = (size_t)(BK * 2);
    const size_t hA = (size_t)HALF * g.lda * 2, hB = (size_t)HALF * g.ldb * 2;
    const size_t tA = 2 * hA, tB = 2 * hB;
    const unsigned ldsw = (unsigned)wid * 1024u;
    const int aoff = lds_byte(wr * 64 + fr, fq * 8), boff = lds_byte(wc * 32 + fr, fq * 8);
#define PG8_SA(b, h) (((b) * 2 + (h)) * HTB)
#define PG8_SB(b, h) ((4 + (b) * 2 + (h)) * HTB)
#define PG8_STAGE(bufoff, gbase, voff) do { _Pragma("unroll") for (int _i = 0; _i < 2; ++_i) \
        __builtin_amdgcn_global_load_lds((const unsigned*)((const char*)(gbase) + (voff)[_i]), (PG8_LAS unsigned*)(lds + (bufoff) + ldsw + _i * 8192), 16, 0, 0); } while (0)
#define PG8_LDA(dst, b, h) do { _Pragma("unroll") for (int m = 0; m < 4; ++m) _Pragma("unroll") for (int k = 0; k < 2; ++k) dst[m][k] = *(const PG8_LAS bf16x8*)(lds + PG8_SA(b, h) + aoff + m * 2048 + k * 1024); } while (0)
#define PG8_LDB(dst, b, h) do { _Pragma("unroll") for (int n = 0; n < 2; ++n) _Pragma("unroll") for (int k = 0; k < 2; ++k) dst[n][k] = *(const PG8_LAS bf16x8*)(lds + PG8_SB(b, h) + boff + n * 2048 + k * 1024); } while (0)
#define PG8_MMA(ai, bj, At, Bt) do { __builtin_amdgcn_s_setprio(1); _Pragma("unroll") for (int m = 0; m < 4; ++m) _Pragma("unroll") for (int n = 0; n < 2; ++n) _Pragma("unroll") for (int k = 0; k < 2; ++k) \
        acc[ai][bj][m][n] = __builtin_amdgcn_mfma_f32_16x16x32_bf16(Bt[n][k], At[m][k], acc[ai][bj][m][n], 0, 0, 0); __builtin_amdgcn_s_setprio(0); } while (0)
#define PG8_WAIT_V(n) asm volatile("s_waitcnt vmcnt(" #n ")" ::: "memory")
#define PG8_WAIT_L(n) asm volatile("s_waitcnt lgkmcnt(" #n ")" ::: "memory")
#define PG8_BAR __builtin_amdgcn_s_barrier()
#define PG8_SCHED __builtin_amdgcn_sched_barrier(0)
    Unit cur, nxt; int ui = 0;
    if (!S.next(0, cur)) return;
    f32x4 acc[2][2][4][2];
#pragma unroll
    for (int a = 0; a < 2; ++a)
#pragma unroll
        for (int b = 0; b < 2; ++b)
#pragma unroll
            for (int m = 0; m < 4; ++m)
#pragma unroll
                for (int n = 0; n < 2; ++n) acc[a][b][m][n] = (f32x4){0.f, 0.f, 0.f, 0.f};
    bf16x8 At[4][2], B0[2][2], B1[2][2];
    const char* cA = (const char*)g.A + (size_t)cur.pm * tA; const char* cB = (const char*)g.Bt + (size_t)cur.pb * tB;
    PG8_STAGE(PG8_SB(0, 0), cB, voffB); PG8_STAGE(PG8_SB(0, 1), cB + hB, voffB); PG8_STAGE(PG8_SA(0, 0), cA, voffA); PG8_STAGE(PG8_SA(0, 1), cA + hA, voffA);
    if (wr == 1) PG8_BAR;
    PG8_WAIT_V(2); PG8_BAR;
    PG8_STAGE(PG8_SB(1, 0), cB + kstep, voffB); PG8_STAGE(PG8_SA(1, 0), cA + kstep, voffA); PG8_STAGE(PG8_SB(1, 1), cB + hB + kstep, voffB);
    PG8_WAIT_V(6); PG8_BAR;
    for (;;) {
        const bool has_next = S.next(ui + 1, nxt);
        const char* nA = has_next ? (const char*)g.A + (size_t)nxt.pm * tA : cA; const char* nB = has_next ? (const char*)g.Bt + (size_t)nxt.pb * tB : cB;
        for (int t = 0; t < nt; t += 2) {
            const bool last = (t == nt - 2);
            const char* a1 = cA + (size_t)(t + 1) * kstep;
            const char* a2 = last ? nA : cA + (size_t)(t + 2) * kstep; const char* b2 = last ? nB : cB + (size_t)(t + 2) * kstep;
            const char* a3 = a2 + kstep; const char* b3 = b2 + kstep;
            PG8_LDB(B0, 0, 0); PG8_LDB(B1, 0, 1); PG8_SCHED; PG8_LDA(At, 0, 0); PG8_STAGE(PG8_SA(1, 1), a1 + hA, voffA);
            PG8_WAIT_V(8); PG8_WAIT_L(0); PG8_BAR; PG8_MMA(0, 0, At, B0); PG8_MMA(0, 1, At, B1); PG8_BAR; PG8_SCHED;
            PG8_LDA(At, 0, 1); PG8_STAGE(PG8_SB(0, 0), b2, voffB); PG8_STAGE(PG8_SB(0, 1), b2 + hB, voffB); PG8_STAGE(PG8_SA(0, 0), a2, voffA);
            PG8_WAIT_V(8); PG8_WAIT_L(0); PG8_BAR; PG8_MMA(1, 0, At, B0); PG8_MMA(1, 1, At, B1); PG8_BAR; PG8_SCHED;
            PG8_LDB(B0, 1, 0); PG8_LDB(B1, 1, 1); PG8_SCHED; PG8_LDA(At, 1, 0); PG8_STAGE(PG8_SA(0, 1), a2 + hA, voffA);
            PG8_WAIT_V(8); PG8_WAIT_L(0); PG8_BAR; PG8_MMA(0, 0, At, B0); PG8_MMA(0, 1, At, B1); PG8_BAR; PG8_SCHED;
            PG8_LDA(At, 1, 1); PG8_STAGE(PG8_SB(1, 0), b3, voffB); PG8_STAGE(PG8_SB(1, 1), b3 + hB, voffB); PG8_STAGE(PG8_SA(1, 0), a3, voffA);
            PG8_WAIT_V(8); PG8_WAIT_L(0); PG8_BAR; PG8_MMA(1, 0, At, B0); PG8_MMA(1, 1, At, B1); PG8_BAR; PG8_SCHED;
        }
        if (wr == 0) PG8_BAR;
        E(acc, cur, wr, wc, fr, fq);
        if (!has_next) break;
#pragma unroll
        for (int a = 0; a < 2; ++a)
#pragma unroll
            for (int b = 0; b < 2; ++b)
#pragma unroll
                for (int m = 0; m < 4; ++m)
#pragma unroll
                    for (int n = 0; n < 2; ++n) acc[a][b][m][n] = (f32x4){0.f, 0.f, 0.f, 0.f};
        cur = nxt; cA = nA; cB = nB; ++ui;
        if (wr == 1) PG8_BAR;
    }
    PG8_WAIT_V(0);
    PG8_BAR;
#undef PG8_SA
#undef PG8_SB
#undef PG8_STAGE
#undef PG8_LDA
#undef PG8_LDB
#undef PG8_MMA
#undef PG8_WAIT_V
#undef PG8_WAIT_L
#undef PG8_BAR
#undef PG8_SCHED
}
}
#define GAS __attribute__((address_space(1)))
#define LAS __attribute__((address_space(3)))
typedef unsigned short bf16;
typedef float f32x4 __attribute__((ext_vector_type(4)));
typedef float f32x2 __attribute__((ext_vector_type(2)));
typedef float f32x16 __attribute__((ext_vector_type(16)));
typedef short bf16x8 __attribute__((ext_vector_type(8)));
typedef unsigned u32x4 __attribute__((ext_vector_type(4)));
typedef unsigned u32x2 __attribute__((ext_vector_type(2)));

constexpr int NB = 4, SEQ = 4096, T = NB * SEQ, D = 1024, NL = 2;
constexpr int NH = 8, HD = 64, HW = 512;
constexpr int N_IN = 7344, FFD = 2816, FFE = 3584, NE = 8, PLE = 256;
constexpr int N1 = 4352, NZR = 1792, NZQ = 1536, NZG = 512, NZM = 512, NGATE = 3072;
constexpr int K2 = 512, N2 = 1792, K3 = 384, N3 = 2048;
constexpr int QKD = 96;
constexpr int NBLK_MAX = 136, HALF_BLK = 68;
constexpr float NORM_EPS = 1e-6f;
constexpr int NTH = 512, NWV = 8;

constexpr size_t MiB = 1u << 20;
constexpr size_t WS_CTL = 0;
constexpr size_t WS_W = 2 * MiB;
constexpr size_t WS_HB = 73 * MiB;
constexpr size_t WS_PB = 105 * MiB;
constexpr size_t WS_VF = 121 * MiB;
constexpr size_t WS_S = 137 * MiB;
constexpr size_t WS_END = 553 * MiB;
constexpr size_t S_ZR = WS_S + 0 * MiB, S_ZQ = WS_S + 56 * MiB, S_ZG = WS_S + 104 * MiB, S_ZM = WS_S + 120 * MiB;
constexpr size_t S_A2 = WS_S + 136 * MiB, S_L2 = WS_S + 148 * MiB;
constexpr size_t S_QRAW = WS_S + 212 * MiB, S_KVRAW = WS_S + 236 * MiB, S_Q = WS_S + 268 * MiB, S_K = WS_S + 292 * MiB, S_VT = WS_S + 316 * MiB, S_OB = WS_S + 332 * MiB;
constexpr size_t S_RR = WS_S + 212 * MiB, S_RK = WS_S + 228 * MiB, S_RV = WS_S + 244 * MiB, S_RA = WS_S + 260 * MiB, S_RB = WS_S + 276 * MiB, S_RW = WS_S + 292 * MiB, S_RG = WS_S + 348 * MiB;
constexpr size_t S_GQ = WS_S + 364 * MiB, S_GK = WS_S + 380 * MiB, S_GV = WS_S + 396 * MiB, S_GAL = WS_S + 412 * MiB, S_GBE = WS_S + 412 * MiB + 524288;
constexpr size_t S_YA = WS_S + 148 * MiB, S_YC = WS_S + 164 * MiB, S_OA = WS_S + 180 * MiB, S_OC = WS_S + 196 * MiB;
constexpr size_t S_ZS = WS_S + 212 * MiB, S_M = WS_S + 348 * MiB;
constexpr size_t S_ACT = WS_S + 0 * MiB;
constexpr size_t S_MWGU = WS_S + 0 * MiB;
constexpr size_t S_MWD = WS_S + 112 * MiB;
constexpr size_t S_XG = WS_S + 168 * MiB;
constexpr size_t S_MACT = WS_S + 237 * MiB;
constexpr size_t S_E = WS_S + 358 * MiB;
constexpr size_t S_SSP0 = WS_S + 413 * MiB, S_SSP1 = WS_S + 414 * MiB, S_SSP2 = WS_S + 415 * MiB;
static_assert(S_SSP2 + MiB <= WS_END, "ws map");
static_assert(S_E + 32 * MiB <= WS_END, "ws map");
static_assert(S_MACT + (size_t)HALF_BLK * 256 * FFE * 2 <= S_E, "ws map");
static_assert(S_XG + (size_t)NBLK_MAX * 256 * D * 2 <= S_MACT, "ws map");
static_assert(S_GBE + 524288 <= WS_END, "ws map");

constexpr size_t WL = 41 * MiB;
constexpr size_t W_IN = 0, W_GATE = 9 * MiB, W_2 = 15 * MiB, W_3 = 17 * MiB, W_BRA = 19 * MiB, W_BRB = 20 * MiB, W_BRC = 21 * MiB, W_OUT = 22 * MiB;
constexpr size_t W_FGU = 24 * MiB, W_FD = 35 * MiB;
constexpr size_t W_PLE = 65 * MiB, WPL = 2 * MiB + 524288, W_PP = 0, W_PG = 524288;
static_assert(W_FD + (size_t)D * FFD * 2 <= WL && W_PLE + 2 * WPL <= 71 * MiB, "w map");
constexpr size_t WS_HB2 = WS_W;
constexpr size_t CTL_ZERO = 512 * 1024;
constexpr size_t C_BAR = 0;
constexpr size_t C_MOE = 16384;
constexpr size_t C_SS = 65536;
constexpr size_t C_RSQ = 512 * 1024, C_RSKV = C_RSQ + 65536;
constexpr size_t C_SEL = C_RSKV + 65536;
constexpr size_t C_WTS = C_SEL + 131072;
constexpr size_t C_RANK = C_WTS + 131072;
constexpr size_t C_DEST = C_RANK + 131072;
constexpr size_t C_RSX = C_DEST + 131072;
constexpr size_t C_BLKE = C_RSX + 139264;
constexpr size_t C_RS1 = C_BLKE + 1024;
static_assert(C_RS1 + 65536 <= 2 * MiB, "ctl map");

__device__ __forceinline__ float bf2f(unsigned v) { return __uint_as_float(v << 16); }
__device__ __forceinline__ unsigned f2bf(float f) { unsigned u = __float_as_uint(f); return (u + 0x7fffu + ((u >> 16) & 1u)) >> 16; }
__device__ __forceinline__ unsigned pk2(float lo, float hi) { return f2bf(lo) | (f2bf(hi) << 16); }
__device__ __forceinline__ float wave_sum(float v) {
#pragma unroll
    for (int o = 1; o < 64; o <<= 1) v += __shfl_xor(v, o);
    return v;
}
__device__ __forceinline__ float sigmoidf_(float x) { return 1.f / (1.f + __expf(-x)); }
__device__ __forceinline__ float siluf_(float x) { return x / (1.f + __expf(-x)); }
__device__ __forceinline__ float softplusf_(float x) { return fmaxf(x, 0.f) + log1pf(__expf(-fabsf(x))); }

struct Args { const void* in[45]; float* out; unsigned char* ws; int layer; int pad; };
typedef const void* gptr_t;
typedef const __attribute__((address_space(4))) gptr_t* kin_t;
struct PArgs { kin_t in; float* out; unsigned char* ws; };
__device__ __forceinline__ PArgs make_pargs(const Args& a) {
    PArgs p; p.in = (kin_t)__builtin_amdgcn_kernarg_segment_ptr(); p.out = a.out; p.ws = a.ws;
    asm volatile("" : "+s"(p.in), "+s"(p.out), "+s"(p.ws)); return p; }
#define INF(i) ((const float*)a.in[i])
#define EPI_ARGS const pg8::f32x4 (&acc)[2][2][4][2], const pg8::Unit& u, int wr, int wc, int fr, int fq
#define EPI_ROWS _Pragma("unroll") for (int ai = 0; ai < 2; ++ai) _Pragma("unroll") for (int m = 0; m < 4; ++m)
__device__ __forceinline__ u32x4 pack8(const f32x4 v0, const f32x4 v1) { u32x4 w; w.x = pg8::cvt_pk_bf16(v0[0], v0[1]); w.y = pg8::cvt_pk_bf16(v0[2], v0[3]); w.z = pg8::cvt_pk_bf16(v1[0], v1[1]); w.w = pg8::cvt_pk_bf16(v1[2], v1[3]); return w; }
__device__ __forceinline__ void unpack8(const u32x4 w, float (&f)[8]) { f[0] = bf2f(w.x & 0xffffu); f[1] = bf2f(w.x >> 16); f[2] = bf2f(w.y & 0xffffu); f[3] = bf2f(w.y >> 16); f[4] = bf2f(w.z & 0xffffu); f[5] = bf2f(w.z >> 16); f[6] = bf2f(w.w & 0xffffu); f[7] = bf2f(w.w >> 16); }

__device__ __forceinline__ float rowscale16(const float* ssp, int r) { const f32x4* p = (const f32x4*)(ssp + (size_t)r * 16); const f32x4 a = p[0], b = p[1], c = p[2], d = p[3];
    const float s = ((a[0] + a[1]) + (a[2] + a[3])) + ((b[0] + b[1]) + (b[2] + b[3])) + ((c[0] + c[1]) + (c[2] + c[3])) + ((d[0] + d[1]) + (d[2] + d[3])); return rsqrtf(s * (1.f / D) + NORM_EPS); }
struct EpiInProj {
    static constexpr bool PERM = true;
    bf16 *zr, *zq, *zg, *zm; const float* ss;
    __device__ __forceinline__ void operator()(EPI_ARGS) const {
        bf16* O; int ld, ct; const int pn = u.pn;
        if (pn < 7) { O = zr; ld = NZR; ct = pn * 256; } else if (pn < 13) { O = zq; ld = NZQ; ct = (pn - 7) * 256; } else if (pn < 15) { O = zg; ld = NZG; ct = (pn - 13) * 256; } else { O = zm; ld = NZM; ct = (pn - 15) * 256; }
        const int row0 = u.pm * 256 + wr * 64 + fr, col0 = ct + wc * 32 + 8 * fq;
        EPI_ROWS { const int r = row0 + ai * 128 + m * 16; const float s = rowscale16(ss, r); bf16* rowp = O + (size_t)r * ld + col0;
#pragma unroll
            for (int bj = 0; bj < 2; ++bj) *(u32x4*)(rowp + bj * 128) = pack8(acc[ai][bj][m][0] * s, acc[ai][bj][m][1] * s); }
    }
};
struct EpiGate {
    static constexpr bool PERM = true;
    bf16* O; const float* ss;
    __device__ __forceinline__ void operator()(EPI_ARGS) const {
        const int row0 = u.pm * 256 + wr * 64 + fr, col0 = u.pn * 256 + wc * 32 + 8 * fq;
        EPI_ROWS { const int r = row0 + ai * 128 + m * 16; const float s = rowscale16(ss, r); bf16* rowp = O + (size_t)r * NGATE + col0;
#pragma unroll
            for (int bj = 0; bj < 2; ++bj) { f32x4 v0 = acc[ai][bj][m][0] * s, v1 = acc[ai][bj][m][1] * s;
#pragma unroll
                for (int j = 0; j < 4; ++j) { v0[j] = sigmoidf_(v0[j]); v1[j] = sigmoidf_(v1[j]); }
                *(u32x4*)(rowp + bj * 128) = pack8(v0, v1); } }
    }
};
struct EpiMla {
    static constexpr bool PERM = true;
    bf16 *qraw, *kvraw; const float *rsq, *rskv;
    __device__ __forceinline__ void operator()(EPI_ARGS) const {
        const bool isq = u.pn < 3; bf16* O = isq ? qraw : kvraw; const int ld = isq ? 768 : 1024, ct = isq ? u.pn * 256 : (u.pn - 3) * 256; const float* rs = isq ? rsq : rskv;
        const int row0 = u.pm * 256 + wr * 64 + fr, col0 = ct + wc * 32 + 8 * fq;
        EPI_ROWS { const int r = row0 + ai * 128 + m * 16; const float s = rs[r]; bf16* rowp = O + (size_t)r * ld + col0;
#pragma unroll
            for (int bj = 0; bj < 2; ++bj) *(u32x4*)(rowp + bj * 128) = pack8(acc[ai][bj][m][0] * s, acc[ai][bj][m][1] * s); }
    }
};
struct EpiPlain {
    static constexpr bool PERM = true;
    bf16* O; int ld;
    __device__ __forceinline__ void operator()(EPI_ARGS) const {
        const int row0 = u.pm * 256 + wr * 64 + fr, col0 = u.pn * 256 + wc * 32 + 8 * fq;
        EPI_ROWS { const int r = row0 + ai * 128 + m * 16; bf16* rowp = O + (size_t)r * ld + col0;
#pragma unroll
            for (int bj = 0; bj < 2; ++bj) *(u32x4*)(rowp + bj * 128) = pack8(acc[ai][bj][m][0], acc[ai][bj][m][1]); }
    }
};
template <bool FIRST> struct EpiMerge {
    static constexpr bool PERM = true;
    bf16* M; const bf16* zs; int br;
    __device__ __forceinline__ void operator()(EPI_ARGS) const {
        const int row0 = u.pm * 256 + wr * 64 + fr, col0 = u.pn * 256 + wc * 32 + 8 * fq;
        EPI_ROWS { const int r = row0 + ai * 128 + m * 16;
#pragma unroll
            for (int bj = 0; bj < 2; ++bj) { const int c = col0 + bj * 128; float g[8], o[8]; unpack8(*(const u32x4*)(zs + (size_t)r * NGATE + br * 1024 + c), g);
                if (!FIRST) unpack8(*(const u32x4*)(M + (size_t)r * D + c), o);
                f32x4 v0, v1;
#pragma unroll
                for (int j = 0; j < 4; ++j) { v0[j] = g[j] * acc[ai][bj][m][0][j] + (FIRST ? 0.f : o[j]); v1[j] = g[4 + j] * acc[ai][bj][m][1][j] + (FIRST ? 0.f : o[4 + j]); }
                *(u32x4*)(M + (size_t)r * D + c) = pack8(v0, v1); } }
    }
};
struct EpiResid {
    static constexpr bool PERM = false;
    float* out; bf16* hb; float* ss;
    __device__ __forceinline__ void operator()(EPI_ARGS) const {
        const int row0 = u.pm * 256 + wr * 64 + fr, col0 = u.pn * 256 + wc * 32 + 4 * fq;
        EPI_ROWS { const int r = row0 + ai * 128 + m * 16; float sq = 0.f;
#pragma unroll
            for (int bj = 0; bj < 2; ++bj)
#pragma unroll
                for (int n = 0; n < 2; ++n) { const size_t off = (size_t)r * D + col0 + bj * 128 + n * 16; f32x4 h = *(const f32x4*)(out + off); h += acc[ai][bj][m][n]; *(f32x4*)(out + off) = h;
                    u32x2 w; w.x = pg8::cvt_pk_bf16(h[0], h[1]); w.y = pg8::cvt_pk_bf16(h[2], h[3]); *(u32x2*)(hb + off) = w; sq += (h[0] * h[0] + h[1] * h[1]) + (h[2] * h[2] + h[3] * h[3]); }
            if (ss) { sq += __shfl_xor(sq, 16); sq += __shfl_xor(sq, 32); if (fq == 0) ss[(size_t)r * 16 + u.pn * 4 + wc] = sq; } }
    }
};
template <bool MOE> struct EpiSwiglu {
    static constexpr bool PERM = true;
    bf16* O; int ld; const float* rs;
    __device__ __forceinline__ void operator()(EPI_ARGS) const {
        const int row0 = u.pm * 256 + wr * 64 + fr, col0 = u.pn * 128 + wc * 32 + 8 * fq;
        EPI_ROWS { const int r = row0 + ai * 128 + m * 16; const float s = MOE ? rs[r] : rowscale16(rs, r);
            f32x4 v0, v1;
#pragma unroll
            for (int j = 0; j < 4; ++j) { v0[j] = siluf_(acc[ai][0][m][0][j] * s) * (acc[ai][1][m][0][j] * s); v1[j] = siluf_(acc[ai][0][m][1][j] * s) * (acc[ai][1][m][1][j] * s); }
            *(u32x4*)(O + (size_t)r * ld + col0) = pack8(v0, v1); }
    }
};
struct EpiPleProj {
    static constexpr bool PERM = true;
    bf16* O; float* sse;
    __device__ __forceinline__ void operator()(EPI_ARGS) const {
        const int row0 = u.pm * 256 + wr * 64 + fr, col0 = u.pn * 256 + wc * 32 + 8 * fq;
        EPI_ROWS { const int r = row0 + ai * 128 + m * 16; float sq = 0.f;
#pragma unroll
            for (int bj = 0; bj < 2; ++bj) { const f32x4 v0 = acc[ai][bj][m][0], v1 = acc[ai][bj][m][1]; *(u32x4*)(O + (size_t)r * D + col0 + bj * 128) = pack8(v0, v1);
                sq += (v0[0] * v0[0] + v0[1] * v0[1]) + (v0[2] * v0[2] + v0[3] * v0[3]) + (v1[0] * v1[0] + v1[1] * v1[1]) + (v1[2] * v1[2] + v1[3] * v1[3]); }
            sq += __shfl_xor(sq, 16); sq += __shfl_xor(sq, 32); if (fq == 0) sse[(size_t)r * 16 + u.pn * 4 + wc] = sq; }
    }
};
struct EpiPleGate {
    static constexpr bool PERM = false;
    float* out; bf16* hb; const bf16* E; const float* sse; const float* png; float* ssn;
    __device__ __forceinline__ void operator()(EPI_ARGS) const {
        const int row0 = u.pm * 256 + wr * 64 + fr, col0 = u.pn * 256 + wc * 32 + 4 * fq;
        EPI_ROWS { const int r = row0 + ai * 128 + m * 16; float sq = 0.f; const float se = rowscale16(sse, r);
#pragma unroll
            for (int bj = 0; bj < 2; ++bj)
#pragma unroll
                for (int n = 0; n < 2; ++n) { const int c = col0 + bj * 128 + n * 16; const size_t off = (size_t)r * D + c; f32x4 h = *(const f32x4*)(out + off);
                    const u32x2 ew = *(const u32x2*)(E + off); const f32x4 g = *(const f32x4*)(png + c);
                    const float e0 = bf2f(ew.x & 0xffffu), e1 = bf2f(ew.x >> 16), e2 = bf2f(ew.y & 0xffffu), e3 = bf2f(ew.y >> 16);
                    const f32x4 a4 = acc[ai][bj][m][n];
                    h[0] += sigmoidf_(a4[0]) * (e0 * se * g[0]); h[1] += sigmoidf_(a4[1]) * (e1 * se * g[1]); h[2] += sigmoidf_(a4[2]) * (e2 * se * g[2]); h[3] += sigmoidf_(a4[3]) * (e3 * se * g[3]);
                    *(f32x4*)(out + off) = h; if (hb) { u32x2 w; w.x = pg8::cvt_pk_bf16(h[0], h[1]); w.y = pg8::cvt_pk_bf16(h[2], h[3]); *(u32x2*)(hb + off) = w; }
                    sq += (h[0] * h[0] + h[1] * h[1]) + (h[2] * h[2] + h[3] * h[3]); }
            if (ssn) { sq += __shfl_xor(sq, 16); sq += __shfl_xor(sq, 32); if (fq == 0) ssn[(size_t)r * 16 + u.pn * 4 + wc] = sq; } }
    }
};
struct TJob { int src, src_off, K, ldn, n0, ncnt; int dst_off, dst_ld, dst_k0, dst_row0, rowmode; int gain, gain_off, gain2, gain2_off, g2mode; };
#define WOFF(l, o) ((int)((l) * WL + (o)))
#define LAYER_JOBS(l) \
    {4, (l) * D * N_IN, D, N_IN, 0, 1792, WOFF(l, W_IN), D, 0, 0, 0, 3, (l) * D, -1, 0, 0}, \
    {4, (l) * D * N_IN, D, N_IN, 2208, 1536, WOFF(l, W_IN), D, 0, 1792, 0, 3, (l) * D, -1, 0, 0}, \
    {4, (l) * D * N_IN, D, N_IN, 3760, 512, WOFF(l, W_IN), D, 0, 3328, 0, 3, (l) * D, -1, 0, 0}, \
    {4, (l) * D * N_IN, D, N_IN, 1792, 416, WOFF(l, W_IN), D, 0, 3840, 0, 3, (l) * D, -1, 0, 0}, \
    {4, (l) * D * N_IN, D, N_IN, 3744, 16, WOFF(l, W_IN), D, 0, 3840 + 416, 0, 3, (l) * D, -1, 0, 0}, \
    {4, (l) * D * N_IN, D, N_IN, 4272, 3072, WOFF(l, W_GATE), D, 0, 0, 0, 3, (l) * D, -1, 0, 0}, \
    {7, (l) * 64 * 512, 64, 512, 0, 512, WOFF(l, W_3), K3, 0, 0, 0, -1, 0, -1, 0, 0}, \
    {9, (l) * 64 * 512, 64, 512, 0, 512, WOFF(l, W_3), K3, 64, 512, 0, -1, 0, -1, 0, 0}, \
    {10, (l) * 128 * 512, 128, 512, 0, 512, WOFF(l, W_3), K3, 128, 1024, 0, -1, 0, -1, 0, 0}, \
    {22, (l) * 256 * 768, 256, 768, 0, 768, WOFF(l, W_2), K2, 0, 0, 0, 20, (l) * 256, -1, 0, 0}, \
    {23, (l) * 128 * 1024, 128, 1024, 0, 1024, WOFF(l, W_2), K2, 256, 768, 0, 21, (l) * 128, -1, 0, 0}, \
    {30, (l) * 512 * 1024, 512, 1024, 0, 1024, WOFF(l, W_BRA), 512, 0, 0, 0, -1, 0, -1, 0, 0}, \
    {31, (l) * 512 * 1024, 512, 1024, 0, 1024, WOFF(l, W_BRB), 512, 0, 0, 0, -1, 0, -1, 0, 0}, \
    {32, (l) * 512 * 1024, 512, 1024, 0, 1024, WOFF(l, W_BRC), 512, 0, 0, 0, -1, 0, -1, 0, 0}, \
    {33, (l) * D * D, D, D, 0, D, WOFF(l, W_OUT), D, 0, 0, 0, -1, 0, -1, 0, 0}, \
    {42, (l) * PLE * D, PLE, D, 0, D, (int)(W_PLE + (l) * WPL + W_PP), PLE, 0, 0, 0, -1, 0, -1, 0, 0}, \
    {43, (l) * D * D, D, D, 0, D, (int)(W_PLE + (l) * WPL + W_PG), D, 0, 0, 0, -1, 0, -1, 0, 0}
__constant__ TJob g_jobs[] = {
    LAYER_JOBS(0), LAYER_JOBS(1),
    {17, 0, D, 32, 0, 32, WOFF(1, W_IN), D, 0, 3840 + 432, 0, 3, 1 * D, 16, 0, 1},
    {17, 0, D, 32, 0, 32, WOFF(1, W_IN), D, 0, 3840 + 464, 0, 3, 1 * D, 16, 0, 2},
    {18, 0, 32, 512, 0, 512, WOFF(1, W_3), K3, 256, 1536, 0, -1, 0, -1, 0, 0},
    {35, 0, D, FFD, 0, FFD, (int)W_FGU, D, 0, 0, 1, 34, 0, -1, 0, 0},
    {36, 0, D, FFD, 0, FFD, (int)W_FGU, D, 0, 0, 2, 34, 0, -1, 0, 0},
    {37, 0, FFD, D, 0, D, (int)W_FD, FFD, 0, 0, 0, -1, 0, -1, 0, 0},
};
constexpr int NJOBS = sizeof(g_jobs) / sizeof(TJob);

__device__ __forceinline__ void transpose_item(const PArgs& a, const TJob& j, bf16* dstbase, LAS float* scr, int item, int lane) {
    const float* W = INF(j.src) + j.src_off;
    const float* G1 = j.gain >= 0 ? INF(j.gain) + j.gain_off : nullptr;
    const float* G2 = j.gain2 >= 0 ? INF(j.gain2) + j.gain2_off : nullptr;
    const int nblk = (j.ncnt + 31) / 32, kb = item / nblk, nb = item % nblk, k0 = 64 * kb, nl0 = 32 * nb;
    const int nl = nl0 + (lane & 31);
#pragma unroll 8
    for (int i = 0; i < 32; ++i) { const int kk = 2 * i + (lane >> 5), k = k0 + kk; float v = 0.f;
        if (k < j.K && nl < j.ncnt) { v = W[(size_t)k * j.ldn + j.n0 + nl]; if (G1) v *= G1[k]; if (G2) { const float g2 = G2[k]; v *= (j.g2mode == 1) ? (1.f - g2) : g2; } }
        scr[kk * 33 + (lane & 31)] = v; }
    asm volatile("s_waitcnt lgkmcnt(0)" ::: "memory");
    const int c = lane & 7;
    if (k0 + 8 * c < j.K) {
#pragma unroll
        for (int q = 0; q < 4; ++q) { const int nloc = (lane >> 3) + 8 * q, n = nl0 + nloc; if (n < j.ncnt) { const LAS float* s = scr + (8 * c) * 33 + nloc;
            u32x4 o; o.x = pk2(s[0 * 33], s[1 * 33]); o.y = pk2(s[2 * 33], s[3 * 33]); o.z = pk2(s[4 * 33], s[5 * 33]); o.w = pk2(s[6 * 33], s[7 * 33]);
            const int row = j.dst_row0 + (j.rowmode == 0 ? n : (n / 128) * 256 + (n % 128) + (j.rowmode == 2 ? 128 : 0));
            *(u32x4*)(dstbase + (size_t)row * j.dst_ld + j.dst_k0 + k0 + 8 * c) = o; } }
    }
    asm volatile("s_waitcnt lgkmcnt(0)" ::: "memory");
}

__device__ __forceinline__ void phase_prologue(const PArgs& a, LAS unsigned char* lds) {
    const int bidx_ = obid();
    const int tid = otid(), lane = tid & 63, wave = __builtin_amdgcn_readfirstlane(tid >> 6), G = ogrid();
    const int gw = bidx_ * NWV + wave, NGW = G * NWV;
    LAS float* scr = (LAS float*)(lds + wave * 16384);
    for (int ji = 0; ji < NJOBS; ++ji) { const TJob j = g_jobs[ji]; const int nit = ((j.K + 63) / 64) * ((j.ncnt + 31) / 32);
        bf16* dstbase = (bf16*)(a.ws + WS_W + j.dst_off);
        for (int it = gw; it < nit; it += NGW) transpose_item(a, j, dstbase, scr, it, lane); }
    const float* x = INF(0); bf16* hb = (bf16*)(a.ws + WS_HB); float* ss0 = (float*)(a.ws + S_SSP0);
    for (int m = gw; m < T; m += NGW) { const f32x4* xr = (const f32x4*)(x + (size_t)m * D) + lane; f32x4* orow = (f32x4*)(a.out + (size_t)m * D) + lane; u32x2* hrow = (u32x2*)(hb + (size_t)m * D) + lane;
        float s = 0.f;
#pragma unroll
        for (int q = 0; q < 4; ++q) { const f32x4 v = xr[64 * q]; orow[64 * q] = v; u32x2 w; w.x = pk2(v[0], v[1]); w.y = pk2(v[2], v[3]); hrow[64 * q] = w; s += (v[0] * v[0] + v[1] * v[1]) + (v[2] * v[2] + v[3] * v[3]); }
        s = wave_sum(s); if (lane < 16) ss0[(size_t)m * 16 + lane] = lane == 0 ? s : 0.f; }
    const f32x4* p4 = (const f32x4*)INF(1); u32x2* pb = (u32x2*)(a.ws + WS_PB);
    for (size_t i = (size_t)bidx_ * NTH + tid; i < (size_t)NL * T * PLE / 4; i += (size_t)G * NTH) { const f32x4 v = p4[i]; u32x2 w; w.x = pk2(v[0], v[1]); w.y = pk2(v[2], v[3]); pb[i] = w; }
}

__device__ __forceinline__ void phase_moe_cvt(const PArgs& a, LAS unsigned char* lds) {
    const int bidx_ = obid();
    const int tid = otid(), lane = tid & 63, wave = __builtin_amdgcn_readfirstlane(tid >> 6), G = ogrid();
    const int gw = bidx_ * NWV + wave, NGW = G * NWV;
    LAS float* scr = (LAS float*)(lds + wave * 16384);
    constexpr int IT_GU = (D / 64) * (FFE / 32), IT_D = (FFE / 64) * (D / 32);
    constexpr int PER_E = 2 * IT_GU + IT_D;
    for (int it = gw; it < NE * PER_E; it += NGW) { const int e = it / PER_E; int r = it % PER_E;
        TJob j; j.gain2 = -1; j.gain2_off = 0; j.g2mode = 0; j.n0 = 0; j.dst_k0 = 0;
        if (r < 2 * IT_GU) { const int up = r >= IT_GU; if (up) r -= IT_GU; j.src = up ? 40 : 39; j.src_off = e * D * FFE; j.K = D; j.ldn = FFE; j.ncnt = FFE; j.dst_ld = D; j.dst_row0 = e * 2 * FFE; j.rowmode = up ? 2 : 1; j.gain = 34; j.gain_off = D;
            transpose_item(a, j, (bf16*)(a.ws + S_MWGU), scr, r, lane); }
        else { r -= 2 * IT_GU; j.src = 41; j.src_off = e * FFE * D; j.K = FFE; j.ldn = D; j.ncnt = D; j.dst_ld = FFE; j.dst_row0 = e * D; j.rowmode = 0; j.gain = -1; j.gain_off = 0;
            transpose_item(a, j, (bf16*)(a.ws + S_MWD), scr, r, lane); } }
}
__device__ __forceinline__ void phase_pre(const PArgs& a, int l) {
    const int bidx_ = obid();
    const int tid = otid(), lane = tid & 63, wave = tid >> 6, G = ogrid();
    const bf16* zr = (const bf16*)(a.ws + S_ZR); const bf16* zm = (const bf16*)(a.ws + S_ZM); bf16* A2 = (bf16*)(a.ws + S_A2);
    float* rsq = (float*)(a.ws + WS_CTL + C_RSQ); float* rskv = (float*)(a.ws + WS_CTL + C_RSKV);
    constexpr int TT = 8;
    const float mu = tid < 256 ? INF(5)[l * 1792 + 1536 + tid] : 0.f;
    for (int g = bidx_; g < T / TT; g += G) { const int t0 = g * TT;
        if (tid < 256) { const int col = 1536 + tid; float v[TT + 1];
            v[0] = (t0 % SEQ == 0) ? 0.f : bf2f(zr[(size_t)(t0 - 1) * NZR + col]);
#pragma unroll
            for (int i = 0; i < TT; ++i) v[i + 1] = bf2f(zr[(size_t)(t0 + i) * NZR + col]);
#pragma unroll
            for (int i = 0; i < TT; ++i) { float x = v[i + 1] + (v[i] - v[i + 1]) * mu; if (tid < 64) x = tanhf(x); else if (tid >= 128) x = sigmoidf_(x); A2[(size_t)(t0 + i) * K3 + tid] = (bf16)f2bf(x); }
        } else if (tid < 288) { const int jx = tid - 256; float c1[TT], c2[TT + 1];
            c2[0] = (t0 % SEQ == 0) ? 0.f : bf2f(zm[(size_t)(t0 - 1) * NZM + 464 + jx]);
#pragma unroll
            for (int i = 0; i < TT; ++i) { c1[i] = bf2f(zm[(size_t)(t0 + i) * NZM + 432 + jx]); c2[i + 1] = bf2f(zm[(size_t)(t0 + i) * NZM + 464 + jx]); }
#pragma unroll
            for (int i = 0; i < TT; ++i) A2[(size_t)(t0 + i) * K3 + tid] = (bf16)f2bf(c1[i] + c2[i]);
        } else if (tid < 384) {
#pragma unroll
            for (int i = 0; i < TT; ++i) A2[(size_t)(t0 + i) * K3 + tid] = 0;
        } else if (wave == 6) { float s[TT];
#pragma unroll
            for (int i = 0; i < TT; ++i) { const u32x2 w = *(const u32x2*)(zm + (size_t)(t0 + i) * NZM + lane * 4); const float f0 = bf2f(w.x & 0xffffu), f1 = bf2f(w.x >> 16), f2 = bf2f(w.y & 0xffffu), f3 = bf2f(w.y >> 16); s[i] = f0 * f0 + f1 * f1 + f2 * f2 + f3 * f3; }
#pragma unroll
            for (int i = 0; i < TT; ++i) { const float q = wave_sum(s[i]); if (lane == 0) rsq[t0 + i] = rsqrtf(q * (1.f / 256.f) + NORM_EPS); }
        } else { float s[TT];
#pragma unroll
            for (int i = 0; i < TT; ++i) { const unsigned w = *(const unsigned*)(zm + (size_t)(t0 + i) * NZM + 256 + lane * 2); const float f0 = bf2f(w & 0xffffu), f1 = bf2f(w >> 16); s[i] = f0 * f0 + f1 * f1; }
#pragma unroll
            for (int i = 0; i < TT; ++i) { const float q = wave_sum(s[i]); if (lane == 0) rskv[t0 + i] = rsqrtf(q * (1.f / 128.f) + NORM_EPS); }
        }
    }
}

__device__ __forceinline__ void phase_mla_post(const PArgs& a, int l, LAS unsigned char* lds) {
    const int bidx_ = obid();
    const int tid = otid(), lane = tid & 63, h = tid >> 6, G = ogrid();
    const bf16* qraw = (const bf16*)(a.ws + S_QRAW); const bf16* kvraw = (const bf16*)(a.ws + S_KVRAW); const bf16* zm = (const bf16*)(a.ws + S_ZM);
    bf16* Q = (bf16*)(a.ws + S_Q); bf16* Kk = (bf16*)(a.ws + S_K); bf16* Vt = (bf16*)(a.ws + S_VT);
    const int* pos = (const int*)a.in[2];
    LAS bf16* vt = (LAS bf16*)lds;
    const float* gq = INF(24) + l * QKD; const float* gk = INF(25) + l * QKD;
    const float gq0 = gq[lane], gk0 = gk[lane], gq1 = lane < 32 ? gq[64 + lane] : 0.f, gk1 = lane < 32 ? gk[64 + lane] : 0.f;
    const float invf = exp2f(-(float)(lane & 15) * (13.287712379549449f / 16.f));
    const float qscale = 0.10206207261596577f * 1.4426950408889634f;
    for (int tile = bidx_; tile < T / 64; tile += G) { const int t0 = tile * 64, b = t0 / SEQ, s0 = t0 % SEQ;
        for (int i0 = 0; i0 < 64; i0 += 4) {
            float q0[4], q1[4], k0[4], k1[4], ang[4]; unsigned short vv[4];
#pragma unroll
            for (int ii = 0; ii < 4; ++ii) { const int t = t0 + i0 + ii;
                q0[ii] = bf2f(qraw[(size_t)t * 768 + h * 96 + lane]); q1[ii] = lane < 32 ? bf2f(qraw[(size_t)t * 768 + h * 96 + 64 + lane]) : 0.f;
                k0[ii] = bf2f(kvraw[(size_t)t * 1024 + h * 128 + lane]); k1[ii] = lane < 32 ? bf2f(zm[(size_t)t * NZM + 384 + lane]) : 0.f;
                vv[ii] = kvraw[(size_t)t * 1024 + h * 128 + 64 + lane]; ang[ii] = (float)pos[t] * invf; }
#pragma unroll
            for (int ii = 0; ii < 4; ++ii) { const int i = i0 + ii;
                const float sq = wave_sum(q0[ii] * q0[ii] + q1[ii] * q1[ii]), sk = wave_sum(k0[ii] * k0[ii] + k1[ii] * k1[ii]);
                const float rq = rsqrtf(sq * (1.f / QKD) + NORM_EPS), rk = rsqrtf(sk * (1.f / QKD) + NORM_EPS);
                const float qn0 = q0[ii] * rq * gq0, qn1 = q1[ii] * rq * gq1, kn0 = k0[ii] * rk * gk0, kn1 = k1[ii] * rk * gk1;
                const double rev = (double)ang[ii] * 0.15915494309189535; const float fr = (float)(rev - rint(rev));
                const float sn = __builtin_amdgcn_sinf(fr), cs = __builtin_amdgcn_cosf(fr);
                const float qp = __shfl_xor(qn1, 16), kp = __shfl_xor(kn1, 16);
                const float qr = (lane < 16) ? (qn1 * cs - qp * sn) : (qn1 * cs + qp * sn);
                const float kr = (lane < 16) ? (kn1 * cs - kp * sn) : (kn1 * cs + kp * sn);
                const size_t ro = ((size_t)(b * NH + h) * SEQ + s0 + i) * QKD;
                Q[ro + lane] = (bf16)f2bf(qn0 * qscale); Kk[ro + lane] = (bf16)f2bf(kn0);
                if (lane < 32) { Q[ro + 64 + lane] = (bf16)f2bf(qr * qscale); Kk[ro + 64 + lane] = (bf16)f2bf(kr); }
                vt[(h * 64 + lane) * 72 + i] = vv[ii]; }
        }
        __syncthreads();
        { const int row = tid; const LAS u32x4* src = (const LAS u32x4*)(vt + row * 72); u32x4* dst = (u32x4*)(Vt + ((size_t)(b * NH) * 64 + row) * SEQ + s0);
#pragma unroll
          for (int q = 0; q < 8; ++q) dst[q] = src[q]; }
        __syncthreads();
    }
}

__device__ __forceinline__ void phase_rwkv_post(const PArgs& a, int l) {
    const int bidx_ = obid();
    const int tid = otid(), G = ogrid(), c = tid;
    const bf16* zr = (const bf16*)(a.ws + S_ZR); const bf16* L2 = (const bf16*)(a.ws + S_L2); bf16* vf = (bf16*)(a.ws + WS_VF);
    bf16* RR = (bf16*)(a.ws + S_RR); bf16* RK = (bf16*)(a.ws + S_RK); bf16* RV = (bf16*)(a.ws + S_RV); bf16* RA = (bf16*)(a.ws + S_RA); bf16* RB = (bf16*)(a.ws + S_RB); float* RW = (float*)(a.ws + S_RW); bf16* RG = (bf16*)(a.ws + S_RG);
    const float mur = INF(5)[l * 1792 + c], muk = INF(5)[l * 1792 + 512 + c], muv = INF(5)[l * 1792 + 1024 + c];
    const float w0 = INF(6)[l * 512 + c], a0 = INF(8)[l * 512 + c], kkc = INF(11)[l * 512 + c], kac = INF(12)[l * 512 + c];
    const float vb = l > 0 ? INF(19)[(l - 1) * 512 + c] : 0.f;
    constexpr int TT = 4;
    for (int g = bidx_; g < T / TT; g += G) { const int t0 = g * TT; float zr_[TT + 1], zk_[TT + 1], zv_[TT + 1], lw[TT], la[TT], lg[TT], lv[TT], vfi[TT];
        const bool first = (t0 % SEQ == 0);
        zr_[0] = first ? 0.f : bf2f(zr[(size_t)(t0 - 1) * NZR + c]); zk_[0] = first ? 0.f : bf2f(zr[(size_t)(t0 - 1) * NZR + 512 + c]); zv_[0] = first ? 0.f : bf2f(zr[(size_t)(t0 - 1) * NZR + 1024 + c]);
#pragma unroll
        for (int i = 0; i < TT; ++i) { const size_t t = t0 + i; zr_[i + 1] = bf2f(zr[t * NZR + c]); zk_[i + 1] = bf2f(zr[t * NZR + 512 + c]); zv_[i + 1] = bf2f(zr[t * NZR + 1024 + c]);
            lw[i] = bf2f(L2[t * N3 + c]); la[i] = bf2f(L2[t * N3 + 512 + c]); lg[i] = bf2f(L2[t * N3 + 1024 + c]); lv[i] = l > 0 ? bf2f(L2[t * N3 + 1536 + c]) : 0.f; vfi[i] = l > 0 ? bf2f(vf[t * HW + c]) : 0.f; }
#pragma unroll
        for (int i = 0; i < TT; ++i) { const size_t t = t0 + i;
            const float r = zr_[i + 1] + (zr_[i] - zr_[i + 1]) * mur; const float k = zk_[i + 1] + (zk_[i] - zk_[i + 1]) * muk; float v = zv_[i + 1] + (zv_[i] - zv_[i + 1]) * muv;
            const float logw = -softplusf_(-(w0 + lw[i])) - 0.5f; const float decay = __expf(-__expf(logw));
            const float iclr = sigmoidf_(a0 + la[i]);
            if (l == 0) vf[t * HW + c] = (bf16)f2bf(v); else v = v + (vfi[i] - v) * sigmoidf_(vb + lv[i]);
            const float kkr = k * kkc; const float ssq = wave_sum(kkr * kkr); const float kk = kkr * rsqrtf(ssq + 1e-12f);
            const float kp = k * (1.f + (iclr - 1.f) * kac);
            RR[t * HW + c] = (bf16)f2bf(r); RK[t * HW + c] = (bf16)f2bf(kp); RV[t * HW + c] = (bf16)f2bf(v); RA[t * HW + c] = (bf16)f2bf(-kk); RB[t * HW + c] = (bf16)f2bf(kk * iclr); RW[t * HW + c] = decay; RG[t * HW + c] = (bf16)f2bf(lg[i]); }
    }
}

__device__ __forceinline__ void phase_gdn_prep(const PArgs& a, int l) {
    const int bidx_ = obid();
    const int tid = otid(), lane = tid & 63, h = tid >> 6, G = ogrid(), c = tid;
    const bf16* zq = (const bf16*)(a.ws + S_ZQ); const bf16* zm = (const bf16*)(a.ws + S_ZM);
    bf16* GQ = (bf16*)(a.ws + S_GQ); bf16* GK = (bf16*)(a.ws + S_GK); bf16* GV = (bf16*)(a.ws + S_GV); float* GAL = (float*)(a.ws + S_GAL); float* GBE = (float*)(a.ws + S_GBE);
    const float* cw = INF(26) + l * 4 * NZQ;
    float wq[4], wk[4], wv[4];
#pragma unroll
    for (int j = 0; j < 4; ++j) { wq[j] = cw[j * NZQ + c]; wk[j] = cw[j * NZQ + 512 + c]; wv[j] = cw[j * NZQ + 1024 + c]; }
    const float alog = INF(27)[l * 8 + h], dtb = INF(28)[l * 8 + h];
    constexpr int TT = 4;
    for (int g = bidx_; g < T / TT; g += G) { const int t0 = g * TT; float xq[TT + 3], xk[TT + 3], xv[TT + 3];
        const bool first = (t0 % SEQ == 0);
#pragma unroll
        for (int i = 0; i < TT + 3; ++i) { const int t = t0 - 3 + i; const bool ok = (i >= 3) || !first; const size_t tt = ok ? t : t0;
            const float q_ = bf2f(zq[tt * NZQ + c]), k_ = bf2f(zq[tt * NZQ + 512 + c]), v_ = bf2f(zq[tt * NZQ + 1024 + c]); xq[i] = ok ? q_ : 0.f; xk[i] = ok ? k_ : 0.f; xv[i] = ok ? v_ : 0.f; }
#pragma unroll
        for (int i = 0; i < TT; ++i) { const size_t t = t0 + i;
            float q = 0.f, k = 0.f, v = 0.f;
#pragma unroll
            for (int j = 0; j < 4; ++j) { q += wq[j] * xq[i + j]; k += wk[j] * xk[i + j]; v += wv[j] * xv[i + j]; }
            q = siluf_(q); k = siluf_(k); v = siluf_(v);
            const float sq = wave_sum(q * q), sk = wave_sum(k * k);
            q = q * rsqrtf(sq + 1e-12f) * 0.125f; k = k * rsqrtf(sk + 1e-12f);
            GQ[t * HW + c] = (bf16)f2bf(q); GK[t * HW + c] = (bf16)f2bf(k); GV[t * HW + c] = (bf16)f2bf(v);
            if (lane == 0) { const float bl = bf2f(zm[t * NZM + 416 + h]), al = bf2f(zm[t * NZM + 424 + h]); GBE[t * 8 + h] = sigmoidf_(bl); GAL[t * 8 + h] = __expf(-__expf(alog) * softplusf_(al + dtb)); } }
    }
}

__device__ __forceinline__ void phase_finish(const PArgs& a, int l) {
    const int bidx_ = obid();
    const int tid = otid(), lane = tid & 63, h = tid >> 6, G = ogrid(), c = tid;
    const bf16* YA = (const bf16*)(a.ws + S_YA); const bf16* YC = (const bf16*)(a.ws + S_YC); const bf16* RR = (const bf16*)(a.ws + S_RR); const bf16* RK = (const bf16*)(a.ws + S_RK); const bf16* RV = (const bf16*)(a.ws + S_RV); const bf16* RG = (const bf16*)(a.ws + S_RG);
    const bf16* zg = (const bf16*)(a.ws + S_ZG); bf16* OA = (bf16*)(a.ws + S_OA); bf16* OC = (bf16*)(a.ws + S_OC);
    const float rkc = INF(13)[l * 512 + c], lng = INF(14)[l * 512 + c], lnb = INF(15)[l * 512 + c], gng = INF(29)[l * 64 + lane];
    constexpr int TT = 4;
    for (int g = bidx_; g < T / TT; g += G) { const int t0 = g * TT; float ya[TT], yc[TT], r[TT], k[TT], v[TT], gt[TT], gg[TT];
#pragma unroll
        for (int i = 0; i < TT; ++i) { const size_t o = (size_t)(t0 + i) * HW + c; ya[i] = bf2f(YA[o]); yc[i] = bf2f(YC[o]); r[i] = bf2f(RR[o]); k[i] = bf2f(RK[o]); v[i] = bf2f(RV[o]); gt[i] = bf2f(RG[o]); gg[i] = bf2f(zg[o]); }
#pragma unroll
        for (int i = 0; i < TT; ++i) { const size_t o = (size_t)(t0 + i) * HW + c;
            const float mean = wave_sum(ya[i]) * (1.f / 64.f); const float d = ya[i] - mean; const float var = wave_sum(d * d) * (1.f / 64.f);
            const float bon = wave_sum(r[i] * k[i] * rkc) * v[i];
            const float y = d * rsqrtf(var + 64e-5f) * lng + lnb + bon;
            OA[o] = (bf16)f2bf(y * gt[i]);
            const float ms = wave_sum(yc[i] * yc[i]) * (1.f / 64.f);
            OC[o] = (bf16)f2bf(yc[i] * rsqrtf(ms + NORM_EPS) * gng * siluf_(gg[i])); }
    }
}
constexpr int AT_KP = 208, AT_VP = 136, AT_KB = 64 * AT_KP, AT_BUF = AT_KB + 64 * AT_VP;
__device__ __forceinline__ void attn_unit(const bf16* Q, const bf16* K, const bf16* Vt, bf16* OB, LAS unsigned char* lds, int b, int h, int qb) {
    const int tid = otid(), lane = tid & 63, wave = __builtin_amdgcn_readfirstlane(tid >> 6), ql = lane & 31, hh = lane >> 5;
    const int qrow0 = qb * 256 + wave * 32;
    const size_t bh = (size_t)(b * NH + h);
    bf16x8 qf[6];
    { const bf16* qp = Q + (bh * SEQ + qrow0 + ql) * QKD + 8 * hh;
#pragma unroll
      for (int s = 0; s < 6; ++s) qf[s] = *(const bf16x8*)(qp + 16 * s); }
    f32x16 o0, o1;
#pragma unroll
    for (int r = 0; r < 16; ++r) { o0[r] = 0.f; o1[r] = 0.f; }
    float mrun = -1e30f, lsum = 0.f;
    const int nkt = 4 * qb + 4;
    const unsigned char* Kb = (const unsigned char*)(K + bh * SEQ * QKD);
    const unsigned char* Vb = (const unsigned char*)(Vt + bh * 64 * SEQ);
    const int kr0 = tid / 12, kc0 = tid % 12, id1 = tid + 512, kr1 = id1 / 12, kc1 = id1 % 12; const bool k1v = id1 < 768;
    const int vr = tid >> 3, vc = tid & 7;
    u32x4 rk0, rk1, rv;
#define AT_LOAD(kt) do { const size_t key0 = (size_t)(kt) * 64; rk0 = *(const u32x4*)(Kb + (key0 + kr0) * (QKD * 2) + kc0 * 16); if (k1v) rk1 = *(const u32x4*)(Kb + (key0 + kr1) * (QKD * 2) + kc1 * 16); \
        rv = *(const u32x4*)(Vb + ((size_t)vr * SEQ + key0) * 2 + vc * 16); } while (0)
#define AT_STORE(buf) do { LAS unsigned char* bp = lds + (buf) * AT_BUF; *(LAS u32x4*)(bp + kr0 * AT_KP + kc0 * 16) = rk0; if (k1v) *(LAS u32x4*)(bp + kr1 * AT_KP + kc1 * 16) = rk1; \
        LAS u32x2* vp = (LAS u32x2*)(bp + AT_KB + vr * AT_VP + vc * 16); vp[0] = (u32x2){rv.x, rv.y}; vp[1] = (u32x2){rv.z, rv.w}; } while (0)
    AT_LOAD(0); AT_STORE(0);
    __syncthreads();
    for (int kt = 0; kt < nkt; ++kt) {
        if (kt + 1 < nkt) AT_LOAD(kt + 1);
        if (64 * kt <= qrow0 + 31) {
            const LAS unsigned char* kb = lds + (kt & 1) * AT_BUF; const LAS unsigned char* vb = kb + AT_KB;
            f32x16 s0, s1;
#pragma unroll
            for (int r = 0; r < 16; ++r) { s0[r] = 0.f; s1[r] = 0.f; }
#pragma unroll
            for (int s = 0; s < 6; ++s) { const bf16x8 kf0 = *(const LAS bf16x8*)(kb + ql * AT_KP + (16 * s + 8 * hh) * 2), kf1 = *(const LAS bf16x8*)(kb + (32 + ql) * AT_KP + (16 * s + 8 * hh) * 2);
                s0 = __builtin_amdgcn_mfma_f32_32x32x16_bf16(kf0, qf[s], s0, 0, 0, 0); s1 = __builtin_amdgcn_mfma_f32_32x32x16_bf16(kf1, qf[s], s1, 0, 0, 0); }
            if (64 * kt + 63 > qrow0) { const int qi = qrow0 + ql, kbase = 64 * kt + 4 * hh;
#pragma unroll
                for (int r = 0; r < 16; ++r) { const int key = kbase + (r & 3) + 8 * (r >> 2); if (key > qi) s0[r] = -1e30f; if (key + 32 > qi) s1[r] = -1e30f; } }
            float mx = s0[0];
#pragma unroll
            for (int r = 1; r < 16; ++r) mx = fmaxf(mx, s0[r]);
#pragma unroll
            for (int r = 0; r < 16; ++r) mx = fmaxf(mx, s1[r]);
            mx = fmaxf(mx, __shfl_xor(mx, 32));
            const float mnew = fmaxf(mrun, mx), alpha = exp2f(mrun - mnew); mrun = mnew;
            float ps = 0.f;
#pragma unroll
            for (int r = 0; r < 16; ++r) { s0[r] = exp2f(s0[r] - mnew); s1[r] = exp2f(s1[r] - mnew); ps += s0[r] + s1[r]; }
            lsum = lsum * alpha + ps;
#pragma unroll
            for (int r = 0; r < 16; ++r) { o0[r] *= alpha; o1[r] *= alpha; }
#pragma unroll
            for (int sub = 0; sub < 2; ++sub)
#pragma unroll
                for (int s2 = 0; s2 < 2; ++s2) {
                    union { u32x4 u; bf16x8 v; } pf;
                    if (sub == 0) { pf.u.x = pg8::cvt_pk_bf16(s0[8 * s2 + 0], s0[8 * s2 + 1]); pf.u.y = pg8::cvt_pk_bf16(s0[8 * s2 + 2], s0[8 * s2 + 3]); pf.u.z = pg8::cvt_pk_bf16(s0[8 * s2 + 4], s0[8 * s2 + 5]); pf.u.w = pg8::cvt_pk_bf16(s0[8 * s2 + 6], s0[8 * s2 + 7]); }
                    else { pf.u.x = pg8::cvt_pk_bf16(s1[8 * s2 + 0], s1[8 * s2 + 1]); pf.u.y = pg8::cvt_pk_bf16(s1[8 * s2 + 2], s1[8 * s2 + 3]); pf.u.z = pg8::cvt_pk_bf16(s1[8 * s2 + 4], s1[8 * s2 + 5]); pf.u.w = pg8::cvt_pk_bf16(s1[8 * s2 + 6], s1[8 * s2 + 7]); }
                    const int kofs = (sub * 32 + 16 * s2 + 4 * hh) * 2;
                    union { u32x4 u; bf16x8 v; } va, vb2;
                    { const u32x2 lo = *(const LAS u32x2*)(vb + ql * AT_VP + kofs), hi = *(const LAS u32x2*)(vb + ql * AT_VP + kofs + 16); va.u = (u32x4){lo.x, lo.y, hi.x, hi.y}; }
                    { const u32x2 lo = *(const LAS u32x2*)(vb + (32 + ql) * AT_VP + kofs), hi = *(const LAS u32x2*)(vb + (32 + ql) * AT_VP + kofs + 16); vb2.u = (u32x4){lo.x, lo.y, hi.x, hi.y}; }
                    o0 = __builtin_amdgcn_mfma_f32_32x32x16_bf16(va.v, pf.v, o0, 0, 0, 0); o1 = __builtin_amdgcn_mfma_f32_32x32x16_bf16(vb2.v, pf.v, o1, 0, 0, 0);
                }
        }
        if (kt + 1 < nkt) AT_STORE((kt + 1) & 1);
        __syncthreads();
    }
#undef AT_LOAD
#undef AT_STORE
    const float ltot = lsum + __shfl_xor(lsum, 32), inv = 1.f / ltot;
    bf16* op = OB + ((size_t)b * SEQ + qrow0 + ql) * HW + h * 64 + 4 * hh;
#pragma unroll
    for (int g = 0; g < 4; ++g) { u32x2 w0, w1; w0.x = pg8::cvt_pk_bf16(o0[4 * g] * inv, o0[4 * g + 1] * inv); w0.y = pg8::cvt_pk_bf16(o0[4 * g + 2] * inv, o0[4 * g + 3] * inv);
        w1.x = pg8::cvt_pk_bf16(o1[4 * g] * inv, o1[4 * g + 1] * inv); w1.y = pg8::cvt_pk_bf16(o1[4 * g + 2] * inv, o1[4 * g + 3] * inv);
        *(u32x2*)(op + 8 * g) = w0; *(u32x2*)(op + 32 + 8 * g) = w1; }
}
__device__ __forceinline__ void phase_attn(const PArgs& a, LAS unsigned char* lds) {
    const int bidx_ = obid();
    const bf16* Q = (const bf16*)(a.ws + S_Q); const bf16* K = (const bf16*)(a.ws + S_K); const bf16* Vt = (const bf16*)(a.ws + S_VT); bf16* OB = (bf16*)(a.ws + S_OB);
    for (int pi = bidx_; pi < NB * NH * 8; pi += ogrid()) { const int bh = pi >> 3, j = pi & 7;
        attn_unit(Q, K, Vt, OB, lds, bh >> 3, bh & 7, 15 - j);
        attn_unit(Q, K, Vt, OB, lds, bh >> 3, bh & 7, j); }
}

constexpr int SC_STEPS = 16, SC_ROW = 5 * 64 + 16, SC_BUF = SC_STEPS * SC_ROW * 4;
__device__ __forceinline__ void scan_task(const PArgs& a, int task, LAS unsigned char* wlds) {
    const int lane = otid() & 63, i = lane >> 2, jq = lane & 3;
    const bool gdn = task >= 128; const int tt = gdn ? task - 128 : task; const int b = tt >> 5, h = (tt >> 2) & 7, rg = tt & 3;
    const bf16 *PR, *PK, *PV, *PA, *PB; const float* PW; const float *PAL, *PBE; bf16* Y;
    if (!gdn) { PR = (const bf16*)(a.ws + S_RR); PK = (const bf16*)(a.ws + S_RK); PV = (const bf16*)(a.ws + S_RV); PA = (const bf16*)(a.ws + S_RA); PB = (const bf16*)(a.ws + S_RB); PW = (const float*)(a.ws + S_RW); PAL = nullptr; PBE = nullptr; Y = (bf16*)(a.ws + S_YA); }
    else { PR = (const bf16*)(a.ws + S_GQ); PK = (const bf16*)(a.ws + S_GK); PV = (const bf16*)(a.ws + S_GV); PA = nullptr; PB = nullptr; PW = nullptr; PAL = (const float*)(a.ws + S_GAL); PBE = (const float*)(a.ws + S_GBE); Y = (bf16*)(a.ws + S_YC); }
    const size_t row0 = (size_t)b * SEQ; const int col0 = h * 64;
    const int bs = lane >> 3, be = 8 * (lane & 7);
    u32x4 gr[2], gk[2], ga[2], gb[2], gv; f32x4 gw[4]; float gal[2], gbe[2];
#define SC_LOAD(c) do { const size_t t0_ = row0 + (size_t)(c) * SC_STEPS; \
        _Pragma("unroll") for (int q = 0; q < 2; ++q) { const size_t o_ = (t0_ + bs + 8 * q) * HW + col0 + be; gr[q] = *(const u32x4*)(PR + o_); gk[q] = *(const u32x4*)(PK + o_); \
            if (!gdn) { ga[q] = *(const u32x4*)(PA + o_); gb[q] = *(const u32x4*)(PB + o_); } else { gal[q] = PAL[(t0_ + bs + 8 * q) * 8 + h]; gbe[q] = PBE[(t0_ + bs + 8 * q) * 8 + h]; } } \
        if (!gdn) { _Pragma("unroll") for (int q = 0; q < 4; ++q) gw[q] = *(const f32x4*)(PW + (t0_ + (lane >> 4) + 4 * q) * HW + col0 + 4 * (lane & 15)); } \
        if (lane < 32) gv = *(const u32x4*)(PV + (t0_ + (lane >> 1)) * HW + col0 + rg * 16 + (lane & 1) * 8); } while (0)
#define SC_STORE(buf) do { LAS float* B_ = (LAS float*)(wlds + (buf) * SC_BUF); \
        _Pragma("unroll") for (int q = 0; q < 2; ++q) { LAS float* R_ = B_ + (bs + 8 * q) * SC_ROW; float fr_[8], fk_[8]; unpack8(gr[q], fr_); unpack8(gk[q], fk_); \
            if (!gdn) { float fa_[8], fb_[8]; unpack8(ga[q], fa_); unpack8(gb[q], fb_); \
                *(LAS f32x4*)(R_ + 0 + be) = (f32x4){fa_[0], fa_[1], fa_[2], fa_[3]}; *(LAS f32x4*)(R_ + 0 + be + 4) = (f32x4){fa_[4], fa_[5], fa_[6], fa_[7]}; \
                *(LAS f32x4*)(R_ + 128 + be) = (f32x4){fb_[0], fb_[1], fb_[2], fb_[3]}; *(LAS f32x4*)(R_ + 128 + be + 4) = (f32x4){fb_[4], fb_[5], fb_[6], fb_[7]}; \
                *(LAS f32x4*)(R_ + 192 + be) = (f32x4){fk_[0], fk_[1], fk_[2], fk_[3]}; *(LAS f32x4*)(R_ + 192 + be + 4) = (f32x4){fk_[4], fk_[5], fk_[6], fk_[7]}; } \
            else { const float al_ = gal[q], be_ = gbe[q], nab_ = -al_ * be_; \
                *(LAS f32x4*)(R_ + 0 + be) = (f32x4){fk_[0], fk_[1], fk_[2], fk_[3]}; *(LAS f32x4*)(R_ + 0 + be + 4) = (f32x4){fk_[4], fk_[5], fk_[6], fk_[7]}; \
                *(LAS f32x4*)(R_ + 64 + be) = (f32x4){al_, al_, al_, al_}; *(LAS f32x4*)(R_ + 64 + be + 4) = (f32x4){al_, al_, al_, al_}; \
                *(LAS f32x4*)(R_ + 128 + be) = (f32x4){fk_[0] * nab_, fk_[1] * nab_, fk_[2] * nab_, fk_[3] * nab_}; *(LAS f32x4*)(R_ + 128 + be + 4) = (f32x4){fk_[4] * nab_, fk_[5] * nab_, fk_[6] * nab_, fk_[7] * nab_}; \
                *(LAS f32x4*)(R_ + 192 + be) = (f32x4){fk_[0] * be_, fk_[1] * be_, fk_[2] * be_, fk_[3] * be_}; *(LAS f32x4*)(R_ + 192 + be + 4) = (f32x4){fk_[4] * be_, fk_[5] * be_, fk_[6] * be_, fk_[7] * be_}; } \
            *(LAS f32x4*)(R_ + 256 + be) = (f32x4){fr_[0], fr_[1], fr_[2], fr_[3]}; *(LAS f32x4*)(R_ + 256 + be + 4) = (f32x4){fr_[4], fr_[5], fr_[6], fr_[7]}; } \
        if (!gdn) { _Pragma("unroll") for (int q = 0; q < 4; ++q) *(LAS f32x4*)(B_ + ((lane >> 4) + 4 * q) * SC_ROW + 64 + 4 * (lane & 15)) = gw[q]; } \
        if (lane < 32) { float fv_[8]; unpack8(gv, fv_); LAS float* V_ = B_ + (lane >> 1) * SC_ROW + 320 + (lane & 1) * 8; *(LAS f32x4*)(V_) = (f32x4){fv_[0], fv_[1], fv_[2], fv_[3]}; *(LAS f32x4*)(V_ + 4) = (f32x4){fv_[4], fv_[5], fv_[6], fv_[7]}; } } while (0)
    float st[16];
#pragma unroll
    for (int q = 0; q < 16; ++q) st[q] = 0.f;
    SC_LOAD(0); SC_STORE(0);
    constexpr int NCH = SEQ / SC_STEPS;
    for (int c = 0; c < NCH; ++c) {
        if (c + 1 < NCH) SC_LOAD(c + 1);
        const LAS float* B_ = (const LAS float*)(wlds + (c & 1) * SC_BUF);
        for (int s = 0; s < SC_STEPS; ++s) { const LAS float* R_ = B_ + s * SC_ROW + 16 * jq;
            float va[16], vw[16], vb[16], vk[16], vr[16];
#pragma unroll
            for (int q = 0; q < 4; ++q) { const f32x4 x0 = *(const LAS f32x4*)(R_ + 4 * q), x1 = *(const LAS f32x4*)(R_ + 64 + 4 * q), x2 = *(const LAS f32x4*)(R_ + 128 + 4 * q), x3 = *(const LAS f32x4*)(R_ + 192 + 4 * q), x4 = *(const LAS f32x4*)(R_ + 256 + 4 * q);
#pragma unroll
                for (int e = 0; e < 4; ++e) { va[4 * q + e] = x0[e]; vw[4 * q + e] = x1[e]; vb[4 * q + e] = x2[e]; vk[4 * q + e] = x3[e]; vr[4 * q + e] = x4[e]; } }
            const float vi = B_[s * SC_ROW + 320 + i];
            float sa = 0.f;
#pragma unroll
            for (int q = 0; q < 16; ++q) sa += st[q] * va[q];
            sa += __shfl_xor(sa, 1); sa += __shfl_xor(sa, 2);
            float y = 0.f;
#pragma unroll
            for (int q = 0; q < 16; ++q) { st[q] = st[q] * vw[q] + sa * vb[q] + vi * vk[q]; y += st[q] * vr[q]; }
            y += __shfl_xor(y, 1); y += __shfl_xor(y, 2);
            if (jq == 0) Y[(row0 + (size_t)c * SC_STEPS + s) * HW + col0 + rg * 16 + i] = (bf16)f2bf(y);
        }
        if (c + 1 < NCH) SC_STORE((c + 1) & 1);
    }
#undef SC_LOAD
#undef SC_STORE
}
__device__ __forceinline__ void phase_scan(const PArgs& a, LAS unsigned char* lds) {
    const int bidx_ = obid();
    const int wave = __builtin_amdgcn_readfirstlane(otid() >> 6), G = ogrid();
    if (wave < 3) for (int task = bidx_ + wave * G; task < 256; task += 3 * G) scan_task(a, task, lds + wave * (2 * SC_BUF));
}
__device__ __forceinline__ void phase_router(const PArgs& a) {
    const int bidx_ = obid();
    const int tid = otid(), lane = tid & 63, wave = __builtin_amdgcn_readfirstlane(tid >> 6), G = ogrid();
    const int gw = bidx_ * NWV + wave, NGW = G * NWV;
    const float* gf = INF(34) + D; const float* wr = INF(38);
    int* sel = (int*)(a.ws + WS_CTL + C_SEL); float* wts = (float*)(a.ws + WS_CTL + C_WTS); int* rank = (int*)(a.ws + WS_CTL + C_RANK); float* rs1 = (float*)(a.ws + WS_CTL + C_RS1);
    unsigned* cnt = (unsigned*)(a.ws + WS_CTL + C_MOE);
    for (int bi = gw; bi < T / 8; bi += NGW) { int my_e0 = -1, my_e1 = -1;
        for (int i = 0; i < 8; ++i) { const int t = bi * 8 + i; const f32x4* hr = (const f32x4*)(a.out + (size_t)t * D) + lane;
            f32x4 x[4]; float ssq = 0.f;
#pragma unroll
            for (int q = 0; q < 4; ++q) { x[q] = hr[64 * q]; ssq += (x[q][0] * x[q][0] + x[q][1] * x[q][1]) + (x[q][2] * x[q][2] + x[q][3] * x[q][3]); }
            ssq = wave_sum(ssq); const float rs = rsqrtf(ssq * (1.f / D) + NORM_EPS);
            float lg[8];
#pragma unroll
            for (int e = 0; e < 8; ++e) lg[e] = 0.f;
#pragma unroll
            for (int q = 0; q < 4; ++q) { const f32x4 g4 = *((const f32x4*)gf + lane + 64 * q);
#pragma unroll
                for (int j = 0; j < 4; ++j) { const int k = (lane + 64 * q) * 4 + j; const float u = x[q][j] * rs * g4[j]; const f32x4 w0 = *(const f32x4*)(wr + (size_t)k * 8), w1 = *(const f32x4*)(wr + (size_t)k * 8 + 4);
                    lg[0] += u * w0[0]; lg[1] += u * w0[1]; lg[2] += u * w0[2]; lg[3] += u * w0[3]; lg[4] += u * w1[0]; lg[5] += u * w1[1]; lg[6] += u * w1[2]; lg[7] += u * w1[3]; } }
#pragma unroll
            for (int e = 0; e < 8; ++e) lg[e] = wave_sum(lg[e]);
            int e0 = 0; float l0 = lg[0];
#pragma unroll
            for (int e = 1; e < 8; ++e) if (lg[e] > l0) { l0 = lg[e]; e0 = e; }
            int e1 = -1; float l1 = -3.4e38f;
#pragma unroll
            for (int e = 0; e < 8; ++e) if (e != e0 && lg[e] > l1) { l1 = lg[e]; e1 = e; }
            const float wa = 1.f / (1.f + __expf(l1 - l0));
            if (lane == i) { my_e0 = e0; my_e1 = e1; sel[t * 2] = e0; sel[t * 2 + 1] = e1; wts[t * 2] = wa; wts[t * 2 + 1] = 1.f - wa; rs1[t] = rs; } }
#pragma unroll
        for (int s = 0; s < 2; ++s) { const int me = s ? my_e1 : my_e0;
            for (int e = 0; e < 8; ++e) { const unsigned long long m = __ballot(me == e); if (m == 0ull) continue; const int n = __popcll(m);
                unsigned base = 0; if (lane == 0) base = atomicAdd(cnt + e, (unsigned)n); base = __builtin_amdgcn_readfirstlane(base);
                if (me == e) rank[(bi * 8 + lane) * 2 + s] = (int)base + __popcll(m & ((1ull << lane) - 1ull)); } }
    }
}
__device__ __forceinline__ void phase_assign(const PArgs& a) {
    const int bidx_ = obid();
    const int tid = otid(), lane = tid & 63, wave = __builtin_amdgcn_readfirstlane(tid >> 6), G = ogrid();
    const int gw = bidx_ * NWV + wave, NGW = G * NWV;
    const unsigned* cnt = (const unsigned*)(a.ws + WS_CTL + C_MOE);
    const int* sel = (const int*)(a.ws + WS_CTL + C_SEL); const int* rank = (const int*)(a.ws + WS_CTL + C_RANK); const float* rs1 = (const float*)(a.ws + WS_CTL + C_RS1);
    int* dest = (int*)(a.ws + WS_CTL + C_DEST); float* rsx = (float*)(a.ws + WS_CTL + C_RSX); int* blke = (int*)(a.ws + WS_CTL + C_BLKE);
    const bf16* hb = (const bf16*)(a.ws + WS_HB); bf16* xg = (bf16*)(a.ws + S_XG);
    int pstart[9]; pstart[0] = 0;
#pragma unroll
    for (int e = 0; e < 8; ++e) pstart[e + 1] = pstart[e] + (int)((cnt[e] + 255u) / 256u) * 256;
    if (bidx_ == 0 && tid < NBLK_MAX + 1) { if (tid == NBLK_MAX) blke[NBLK_MAX] = pstart[8] / 256; else { int e = 0;
#pragma unroll
            for (int q = 1; q < 8; ++q) if (tid * 256 >= pstart[q]) e = q;
            blke[tid] = e; } }
    for (int as = gw; as < T * 2; as += NGW) { const int t = as >> 1; const int e = sel[as];
        int ps = 0;
#pragma unroll
        for (int q = 0; q < 8; ++q) if (e == q) ps = pstart[q];
        const int d = ps + rank[as];
        if (lane == 0) { dest[as] = d; rsx[d] = rs1[t]; }
        const u32x4* src = (const u32x4*)(hb + (size_t)t * D); u32x4* dst = (u32x4*)(xg + (size_t)d * D);
        dst[lane] = src[lane]; dst[lane + 64] = src[lane + 64]; }
}
__device__ __forceinline__ void phase_combine(const PArgs& a) {
    const int bidx_ = obid();
    const int tid = otid(), lane = tid & 63, wave = __builtin_amdgcn_readfirstlane(tid >> 6), G = ogrid();
    const int gw = bidx_ * NWV + wave, NGW = G * NWV;
    const int* dest = (const int*)(a.ws + WS_CTL + C_DEST); const float* wts = (const float*)(a.ws + WS_CTL + C_WTS);
    const bf16* y = (const bf16*)(a.ws + S_XG); bf16* hb = (bf16*)(a.ws + WS_HB);
    for (int t = gw; t < T; t += NGW) { const int d0 = dest[t * 2], d1 = dest[t * 2 + 1]; const float w0 = wts[t * 2], w1 = wts[t * 2 + 1];
        f32x4* hr = (f32x4*)(a.out + (size_t)t * D); const u32x2* y0 = (const u32x2*)(y + (size_t)d0 * D); const u32x2* y1 = (const u32x2*)(y + (size_t)d1 * D); u32x2* hbr = (u32x2*)(hb + (size_t)t * D);
#pragma unroll
        for (int q = 0; q < 4; ++q) { const int ix = lane + 64 * q; f32x4 h = hr[ix]; const u32x2 a0 = y0[ix], a1 = y1[ix];
            h[0] += w0 * bf2f(a0.x & 0xffffu) + w1 * bf2f(a1.x & 0xffffu); h[1] += w0 * bf2f(a0.x >> 16) + w1 * bf2f(a1.x >> 16);
            h[2] += w0 * bf2f(a0.y & 0xffffu) + w1 * bf2f(a1.y & 0xffffu); h[3] += w0 * bf2f(a0.y >> 16) + w1 * bf2f(a1.y >> 16);
            hr[ix] = h; u32x2 w; w.x = pk2(h[0], h[1]); w.y = pk2(h[2], h[3]); hbr[ix] = w; } }
}
#ifndef MK_ONE_LAUNCH
#define MK_ONE_LAUNCH 1
#endif
#define XB_TMO      128
#define XB_XCNT(j)  (256  + 64 * (j))
#define XB_XSUB(j)  (1280 + 64 * (j))
#define XB_XGEN(j)  (2304 + 64 * (j))
#define XB_TOP      3328
#define XB_TOPGEN   3392
#define XCD_BAR_WORDS 3456
#define XB_SPIN_CAP (1u << 22)
__device__ __forceinline__ unsigned xb_ld(unsigned* p)              { return __hip_atomic_load(p, __ATOMIC_RELAXED, __HIP_MEMORY_SCOPE_AGENT); }
__device__ __forceinline__ unsigned xb_add(unsigned* p, unsigned v) { return __hip_atomic_fetch_add(p, v, __ATOMIC_RELAXED, __HIP_MEMORY_SCOPE_AGENT); }
__device__ __forceinline__ unsigned xb_xcc_id() { return (unsigned)__builtin_amdgcn_s_getreg((3 << 11) | 20) & 0xFu; }
#define XB_SPIN(cond, bar) do { unsigned _sp = 0; while (cond) { __builtin_amdgcn_s_sleep(1); \
    if ((++_sp & 255u) == 0u) { if (xb_ld(&(bar)[XB_TMO])) break; if (_sp > XB_SPIN_CAP) { atomicAdd(&(bar)[XB_TMO], 1u); break; } } } } while (0)
struct XcdBarrier { unsigned* bar; unsigned x; volatile LAS unsigned* st; };
__device__ __forceinline__ XcdBarrier xcd_barrier_post(unsigned* bar, volatile LAS unsigned* st) {
    XcdBarrier b; b.bar = bar; b.x = xb_xcc_id(); b.st = st;
    if (threadIdx.x == 0) (void)xb_add(&bar[XB_XCNT(b.x)], 1u);
    return b;
}
__device__ __forceinline__ void xcd_barrier_complete(unsigned* bar, unsigned x, unsigned& nloc, unsigned& nx) {
    const unsigned G = gridDim.x * gridDim.y * gridDim.z;
    unsigned sum, cnt, mine, sp = 0u;
    for (;;) {
        sum = 0u; cnt = 0u; mine = 0u;
#pragma unroll
        for (unsigned j = 0; j < 16; ++j) { const unsigned c = xb_ld(&bar[XB_XCNT(j)]); sum += c; cnt += (c > 0u) ? 1u : 0u; mine = (j == x) ? c : mine; }
        if (sum == G) break;
        __builtin_amdgcn_s_sleep(1);
        if ((++sp & 255u) == 0u) { if (xb_ld(&bar[XB_TMO])) break; if (sp > XB_SPIN_CAP) { atomicAdd(&bar[XB_TMO], 1u); break; } }
    }
    nloc = mine > 0u ? mine : 1u; nx = cnt > 0u ? cnt : 1u;
}
__device__ __forceinline__ void xcd_barrier(const XcdBarrier& b_) {
    asm volatile("s_waitcnt vmcnt(0)" ::: "memory");
    __syncthreads();
    if (otid() == 0) {
        XcdBarrier b = b_; asm volatile("" : "+s"(b.bar)); b.x = xb_xcc_id();
        unsigned* bar = b.bar;
        __builtin_amdgcn_s_waitcnt(0);
        unsigned nloc = b.st[0], nx = b.st[1];
        if (nloc == 0u) { xcd_barrier_complete(bar, b.x, nloc, nx); b.st[0] = nloc; b.st[1] = nx; }
        const unsigned old = xb_add(&bar[XB_XSUB(b.x)], 1u);
        const unsigned gen = old / nloc;
        if (old + 1u == (gen + 1u) * nloc) {
            __builtin_amdgcn_fence(__ATOMIC_RELEASE, "agent");
            asm volatile("s_waitcnt vmcnt(0)" ::: "memory");
            const unsigned og = xb_add(&bar[XB_TOP], 1u);
            const unsigned tg = og / nx;
            if (og + 1u == (tg + 1u) * nx) xb_add(&bar[XB_TOPGEN], 1u);
            else XB_SPIN(xb_ld(&bar[XB_TOPGEN]) == tg, bar);
            __builtin_amdgcn_fence(__ATOMIC_ACQUIRE, "agent");
            xb_add(&bar[XB_XGEN(b.x)], 1u);
            asm volatile("s_waitcnt vmcnt(0)" ::: "memory");
        } else {
            XB_SPIN(xb_ld(&bar[XB_XGEN(b.x)]) == gen, bar);
            __builtin_amdgcn_fence(__ATOMIC_ACQUIRE, "agent");
            asm volatile("s_waitcnt vmcnt(0)" ::: "memory");
        }
    }
    __syncthreads();
}

enum PhaseKind { PK_PRO = 0, PK_G1A, PK_PRE, PK_G23, PK_MLAPOST, PK_ATT, PK_RGPREP, PK_SCAN, PK_FIN, PK_G1B, PK_MRG, PK_OUT, PK_FGU, PK_FD, PK_MOEA, PK_MOEB, PK_MGU0, PK_MD0, PK_MGU1, PK_MD1, PK_COMB, PK_PP, PK_PG };
struct PhaseEnt { int kind, layer; };
__constant__ PhaseEnt g_prog[] = {
    {PK_PRO, 0},
    {PK_G1A, 0}, {PK_PRE, 0}, {PK_G23, 0}, {PK_MLAPOST, 0}, {PK_ATT, 0}, {PK_RGPREP, 0}, {PK_SCAN, 0}, {PK_FIN, 0}, {PK_G1B, 0}, {PK_MRG, 0}, {PK_OUT, 0}, {PK_FGU, 0}, {PK_FD, 0}, {PK_PP, 0}, {PK_PG, 0},
    {PK_G1A, 1}, {PK_PRE, 1}, {PK_G23, 1}, {PK_MLAPOST, 1}, {PK_ATT, 1}, {PK_RGPREP, 1}, {PK_SCAN, 1}, {PK_FIN, 1}, {PK_G1B, 1}, {PK_MRG, 1}, {PK_OUT, 1},
    {PK_MOEA, 1}, {PK_MOEB, 1}, {PK_MGU0, 1}, {PK_MD0, 1}, {PK_MGU1, 1}, {PK_MD1, 1}, {PK_COMB, 1}, {PK_PP, 1}, {PK_PG, 1},
};
constexpr int NPHASE = sizeof(g_prog) / sizeof(PhaseEnt);

constexpr int LDS_BYTES = 147456;
constexpr int LDS_MISC = 131072 + 8192;

template <int KINDT> __device__ __forceinline__ void run_phase(const Args& a_, int kind_rt, int l, LAS unsigned char* lds) {
    const int kind = KINDT >= 0 ? KINDT : kind_rt; const PArgs a = make_pargs(a_);
    const int G = ogrid(), c = obid();
    unsigned char* ws = a.ws;
    const bf16* Wl = (const bf16*)(ws + WS_W + (size_t)l * WL);
    float* SS0 = (float*)(ws + S_SSP0); float* SS1 = (float*)(ws + S_SSP1); float* SSE = (float*)(ws + S_SSP2);
    bf16* HB = (bf16*)(ws + WS_HB); const bf16* HBin = (const bf16*)(ws + (l == 0 ? WS_HB : WS_HB2));
    const bf16* Wp = (const bf16*)(ws + WS_W + W_PLE + (size_t)l * WPL);
    switch (kind) {
    case PK_PRO: phase_prologue(a, lds); break;
    case PK_G1A: { pg8::Gemm g{HBin, Wl + W_IN / 2, D, D, D}; pg8::StaticOrder S; S.init(T / 256, N1 / 256, G, c);
        EpiInProj E{(bf16*)(ws + S_ZR), (bf16*)(ws + S_ZQ), (bf16*)(ws + S_ZG), (bf16*)(ws + S_ZM), SS0}; pg8::gemm_phase(lds, g, S, E); } break;
    case PK_PRE: phase_pre(a, l); break;
    case PK_G23: { { pg8::Gemm g{(const bf16*)(ws + S_ZM), Wl + W_2 / 2, K2, NZM, K2}; pg8::StaticOrder S; S.init(T / 256, N2 / 256, G, c);
            EpiMla E{(bf16*)(ws + S_QRAW), (bf16*)(ws + S_KVRAW), (const float*)(ws + WS_CTL + C_RSQ), (const float*)(ws + WS_CTL + C_RSKV)}; pg8::gemm_phase(lds, g, S, E); }
        { pg8::Gemm g{(const bf16*)(ws + S_A2), Wl + W_3 / 2, K3, K3, K3}; pg8::StaticOrder S; S.init(T / 256, N3 / 256, G, c);
            EpiPlain E{(bf16*)(ws + S_L2), N3}; pg8::gemm_phase(lds, g, S, E); } } break;
    case PK_MLAPOST: phase_mla_post(a, l, lds); break;
    case PK_ATT: phase_attn(a, lds); break;
    case PK_RGPREP: phase_rwkv_post(a, l); phase_gdn_prep(a, l); break;
    case PK_SCAN: phase_scan(a, lds); break;
    case PK_FIN: phase_finish(a, l); break;
    case PK_G1B: { pg8::Gemm g{HBin, Wl + W_GATE / 2, D, D, D}; pg8::StaticOrder S; S.init(T / 256, NGATE / 256, G, c);
        EpiGate E{(bf16*)(ws + S_ZS), SS0}; pg8::gemm_phase(lds, g, S, E); } break;
    case PK_MRG: { pg8::StaticOrder S; S.init(T / 256, D / 256, G, c);
        { pg8::Gemm g{(const bf16*)(ws + S_OA), Wl + W_BRA / 2, HW, HW, HW}; EpiMerge<true> E{(bf16*)(ws + S_M), (const bf16*)(ws + S_ZS), 0}; pg8::gemm_phase(lds, g, S, E); }
        { pg8::Gemm g{(const bf16*)(ws + S_OB), Wl + W_BRB / 2, HW, HW, HW}; EpiMerge<false> E{(bf16*)(ws + S_M), (const bf16*)(ws + S_ZS), 1}; pg8::gemm_phase(lds, g, S, E); }
        { pg8::Gemm g{(const bf16*)(ws + S_OC), Wl + W_BRC / 2, HW, HW, HW}; EpiMerge<false> E{(bf16*)(ws + S_M), (const bf16*)(ws + S_ZS), 2}; pg8::gemm_phase(lds, g, S, E); } } break;
    case PK_OUT: { pg8::Gemm g{(const bf16*)(ws + S_M), Wl + W_OUT / 2, D, D, D}; pg8::StaticOrder S; S.init(T / 256, D / 256, G, c);
        EpiResid E{a.out, HB, SS1}; pg8::gemm_phase(lds, g, S, E); } break;
    case PK_FGU: { pg8::Gemm g{HB, (const bf16*)(ws + WS_W + W_FGU), D, D, D}; pg8::StaticOrder S; S.init(T / 256, 2 * FFD / 256, G, c);
        EpiSwiglu<false> E{(bf16*)(ws + S_ACT), FFD, SS1}; pg8::gemm_phase(lds, g, S, E); } break;
    case PK_FD: { pg8::Gemm g{(const bf16*)(ws + S_ACT), (const bf16*)(ws + WS_W + W_FD), FFD, FFD, FFD}; pg8::StaticOrder S; S.init(T / 256, D / 256, G, c);
        EpiResid E{a.out, HB, nullptr}; pg8::gemm_phase(lds, g, S, E); } break;
    case PK_MOEA: phase_moe_cvt(a, lds); phase_router(a); break;
    case PK_MOEB: phase_assign(a); break;
    case PK_MGU0: case PK_MGU1: { const int half = (kind == PK_MGU1); const int* blke = (const int*)(ws + WS_CTL + C_BLKE); const int nblk = __builtin_amdgcn_readfirstlane(blke[NBLK_MAX]);
        const int lo = half * HALF_BLK, hi = nblk < lo + HALF_BLK ? nblk : lo + HALF_BLK, nM = hi > lo ? hi - lo : 0;
        pg8::Gemm g{(const bf16*)(ws + S_XG), (const bf16*)(ws + S_MWGU), D, D, D}; pg8::StaticOrder S; S.init(nM, 2 * FFE / 256, G, c, lo, blke);
        EpiSwiglu<true> E{(bf16*)(ws + S_MACT) - (size_t)lo * 256 * FFE, FFE, (const float*)(ws + WS_CTL + C_RSX)}; pg8::gemm_phase(lds, g, S, E); } break;
    case PK_MD0: case PK_MD1: { const int half = (kind == PK_MD1); const int* blke = (const int*)(ws + WS_CTL + C_BLKE); const int nblk = __builtin_amdgcn_readfirstlane(blke[NBLK_MAX]);
        const int lo = half * HALF_BLK, hi = nblk < lo + HALF_BLK ? nblk : lo + HALF_BLK, nM = hi > lo ? hi - lo : 0;
        pg8::Gemm g{(const bf16*)(ws + S_MACT) - (size_t)lo * 256 * FFE, (const bf16*)(ws + S_MWD), FFE, FFE, FFE}; pg8::StaticOrder S; S.init(nM, D / 256, G, c, lo, blke);
        EpiPlain E{(bf16*)(ws + S_XG), D}; pg8::gemm_phase(lds, g, S, E); } break;
    case PK_COMB: phase_combine(a); break;
    case PK_PP: { pg8::Gemm g{(const bf16*)(ws + WS_PB) + (size_t)l * T * PLE, Wp + W_PP / 2, PLE, PLE, PLE}; pg8::StaticOrder S; S.init(T / 256, D / 256, G, c);
        EpiPleProj E{(bf16*)(ws + S_E), SSE}; pg8::gemm_phase(lds, g, S, E); } break;
    case PK_PG: { pg8::Gemm g{HB, Wp + W_PG / 2, D, D, D}; pg8::StaticOrder S; S.init(T / 256, D / 256, G, c);
        EpiPleGate E{a.out, l + 1 < NL ? (bf16*)(ws + WS_HB2) : nullptr, (const bf16*)(ws + S_E), SSE, INF(44) + l * D, l + 1 < NL ? SS0 : nullptr}; pg8::gemm_phase(lds, g, S, E); } break;
    default: break;
    }
}

template <int KINDT> __global__ void __launch_bounds__(NTH, 2) k_one(Args a, int l) {
    extern __shared__ __attribute__((aligned(16))) unsigned char lds_raw[];
    run_phase<KINDT>(a, KINDT, l, (LAS unsigned char*)lds_raw);
}
#if MK_ONE_LAUNCH
__global__ void __launch_bounds__(NTH, 2) k_fwd(Args a) {
    extern __shared__ __attribute__((aligned(16))) unsigned char lds_raw[];
    LAS unsigned char* lds = (LAS unsigned char*)lds_raw;
    volatile LAS unsigned* misc = (volatile LAS unsigned*)(lds + LDS_MISC);
    if (threadIdx.x < 64) misc[threadIdx.x] = 0u;
    __syncthreads();
    const XcdBarrier bar = xcd_barrier_post((unsigned*)(a.ws + WS_CTL + C_BAR), misc + 8);
#define RUN(K, l) run_phase<K>(a, K, l, lds)
#define BAR() xcd_barrier(bar)
    RUN(PK_PRO, 0); BAR();
#define MIXER(l) RUN(PK_G1A, l); BAR(); RUN(PK_PRE, l); BAR(); RUN(PK_G23, l); BAR(); RUN(PK_MLAPOST, l); BAR(); RUN(PK_ATT, l); BAR(); RUN(PK_RGPREP, l); BAR(); \
        RUN(PK_SCAN, l); BAR(); RUN(PK_FIN, l); BAR(); RUN(PK_G1B, l); BAR(); RUN(PK_MRG, l); BAR(); RUN(PK_OUT, l); BAR();
    MIXER(0)
    RUN(PK_FGU, 0); BAR(); RUN(PK_FD, 0); BAR();
    RUN(PK_PP, 0); BAR(); RUN(PK_PG, 0); BAR();
    MIXER(1)
    RUN(PK_MOEA, 1); BAR(); RUN(PK_MOEB, 1); BAR(); RUN(PK_MGU0, 1); BAR(); RUN(PK_MD0, 1); BAR(); RUN(PK_MGU1, 1); BAR(); RUN(PK_MD1, 1); BAR(); RUN(PK_COMB, 1); BAR();
    RUN(PK_PP, 1); BAR(); RUN(PK_PG, 1);
#undef MIXER
#undef RUN
#undef BAR
}
#endif

#ifndef MK_ONE_LAUNCH
#define MK_ONE_LAUNCH 1
#endif
extern "C" void kernel_launch(void* const* d_in, const int* in_sizes, int n_in, void* d_out, int out_size, void* d_ws, size_t ws_size, hipStream_t stream) {
    static int grid = 0;
    if (grid == 0) {
        if (n_in != 45 || out_size != T * D || ws_size < WS_END) { fprintf(stderr, "kernel_launch: unexpected shapes: n_in %d out %d ws %zu (need %zu)\n", n_in, out_size, ws_size, (size_t)WS_END); grid = -1; return; }
        int dev = 0, cus = 0;
        if (hipGetDevice(&dev) != hipSuccess || hipDeviceGetAttribute(&cus, hipDeviceAttributeMultiprocessorCount, dev) != hipSuccess) { grid = -1; return; }
#if MK_ONE_LAUNCH
        if (hipFuncSetAttribute((const void*)k_fwd, hipFuncAttributeMaxDynamicSharedMemorySize, LDS_BYTES) != hipSuccess) { fprintf(stderr, "kernel_launch: hipFuncSetAttribute failed\n"); grid = -1; return; }
#else
#define SA(K) (void)hipFuncSetAttribute((const void*)k_one<K>, hipFuncAttributeMaxDynamicSharedMemorySize, LDS_BYTES);
        SA(PK_PRO) SA(PK_G1A) SA(PK_PRE) SA(PK_G23) SA(PK_MLAPOST) SA(PK_ATT) SA(PK_RGPREP) SA(PK_SCAN) SA(PK_FIN) SA(PK_G1B) SA(PK_MRG) SA(PK_OUT) SA(PK_FGU) SA(PK_FD) SA(PK_MOEA) SA(PK_MOEB) SA(PK_MGU0) SA(PK_MD0) SA(PK_MGU1) SA(PK_MD1) SA(PK_COMB) SA(PK_PP) SA(PK_PG)
#undef SA
#endif
        int per_cu = 0;
#if MK_ONE_LAUNCH
        if (hipOccupancyMaxActiveBlocksPerMultiprocessor(&per_cu, (const void*)k_fwd, NTH, LDS_BYTES) != hipSuccess || per_cu < 1) { fprintf(stderr, "kernel_launch: occupancy query says %d blocks/CU\n", per_cu); }
#endif
        (void)hipGetLastError();
        grid = cus;
    }
    if (grid < 0) return;
    (void)hipMemsetAsync((char*)d_ws + WS_CTL, 0, CTL_ZERO, stream);
    (void)hipMemsetAsync((char*)d_ws + WS_W, 0, 71 * MiB, stream);
    Args a{};
    for (int i = 0; i < 45; ++i) a.in[i] = d_in[i];
    a.out = (float*)d_out; a.ws = (unsigned char*)d_ws; a.layer = 0; a.pad = 0;
#if MK_ONE_LAUNCH
    hipLaunchKernelGGL(k_fwd, dim3(grid), dim3(NTH), LDS_BYTES, stream, a);
#else
    static const PhaseEnt prog_h[] = {
        {PK_PRO, 0},
        {PK_G1A, 0}, {PK_PRE, 0}, {PK_G23, 0}, {PK_MLAPOST, 0}, {PK_ATT, 0}, {PK_RGPREP, 0}, {PK_SCAN, 0}, {PK_FIN, 0}, {PK_G1B, 0}, {PK_MRG, 0}, {PK_OUT, 0}, {PK_FGU, 0}, {PK_FD, 0}, {PK_PP, 0}, {PK_PG, 0},
        {PK_G1A, 1}, {PK_PRE, 1}, {PK_G23, 1}, {PK_MLAPOST, 1}, {PK_ATT, 1}, {PK_RGPREP, 1}, {PK_SCAN, 1}, {PK_FIN, 1}, {PK_G1B, 1}, {PK_MRG, 1}, {PK_OUT, 1},
        {PK_MOEA, 1}, {PK_MOEB, 1}, {PK_MGU0, 1}, {PK_MD0, 1}, {PK_MGU1, 1}, {PK_MD1, 1}, {PK_COMB, 1}, {PK_PP, 1}, {PK_PG, 1} };
    for (int p = 0; p < (int)(sizeof(prog_h) / sizeof(prog_h[0])); ++p) { const int l = prog_h[p].layer;
#define LK(K) case K: hipLaunchKernelGGL(k_one<K>, dim3(grid), dim3(NTH), LDS_BYTES, stream, a, l); break;
        switch (prog_h[p].kind) { LK(PK_PRO) LK(PK_G1A) LK(PK_PRE) LK(PK_G23) LK(PK_MLAPOST) LK(PK_ATT) LK(PK_RGPREP) LK(PK_SCAN) LK(PK_FIN) LK(PK_G1B) LK(PK_MRG) LK(PK_OUT) LK(PK_FGU) LK(PK_FD) LK(PK_MOEA) LK(PK_MOEB) LK(PK_MGU0) LK(PK_MD0) LK(PK_MGU1) LK(PK_MD1) LK(PK_COMB) LK(PK_PP) LK(PK_PG) default: break; }
#undef LK
    }
#endif
}
```

```cpp
#include <hip/hip_runtime.h>
#include <cstdio>
#include <cstdint>
__device__ __forceinline__ int otid() { int t = threadIdx.x; asm volatile("" : "+v"(t)); return t; }
__device__ __forceinline__ int obid() { int t = blockIdx.x; asm volatile("" : "+s"(t)); return t; }
__device__ __forceinline__ int ogrid() { int t = gridDim.x; asm volatile("" : "+s"(t)); return t; }
namespace pg8 {
#define PG8_LAS __attribute__((address_space(3)))
typedef unsigned short bf16_t;
typedef short bf16x8 __attribute__((ext_vector_type(8)));
typedef float f32x4 __attribute__((ext_vector_type(4)));
typedef unsigned u32x4 __attribute__((ext_vector_type(4)));
typedef unsigned u32x2 __attribute__((ext_vector_type(2)));
constexpr int BM = 256, BK = 64, HALF = 128, HTB = HALF * BK * 2, STAGE_BYTES = 8 * HTB, NXCD = 8, WGM = 8;

__host__ __device__ __forceinline__ int lds_byte(int r, int c) { const int st = (r >> 4) * 2 + (c >> 5), rr = r & 15, cc = c & 31, ob = rr * 64 + cc * 2; return st * 1024 + (ob ^ (((ob >> 9) & 1) << 5)); }
__host__ __device__ __forceinline__ void stage_rc(int b, int& R, int& C) { const int st = b / 1024, sb = b % 1024, swz = sb ^ (((sb >> 9) & 1) << 5); R = (st >> 1) * 16 + swz / 64; C = (st & 1) * 32 + (swz % 64) / 2; }
__host__ __device__ __forceinline__ int perm32(int rho) { const int n = rho >> 4, i = rho & 15; return 8 * (i >> 2) + 4 * n + (i & 3); }

struct Unit { int pm, pn, pb; };
struct Gemm { const bf16_t* A; const bf16_t* Bt; int K, lda, ldb; };

struct StaticOrder {
    int nM, nN, nwg, G, c, pm0; const int* blk_e;
    __device__ void init(int nM_, int nN_, int G_, int c_, int pm0_ = 0, const int* blk_e_ = nullptr) { nM = nM_; nN = nN_; nwg = nM * nN; G = G_; c = c_; pm0 = pm0_; blk_e = blk_e_; }
    __device__ bool next(int i, Unit& u) const {
        const long L = (long)i * G + c; if (L >= nwg) return false;
        int wgid = (int)L; { const int q = nwg / NXCD, r = nwg % NXCD, xcd = wgid % NXCD, off = wgid / NXCD; wgid = (xcd < r ? xcd * (q + 1) : r * (q + 1) + (xcd - r) * q) + off; }
        const int nig = WGM * nN, gid = wgid / nig, fm = gid * WGM, gsz = (nM - fm) < WGM ? (nM - fm) : WGM;
        u.pm = pm0 + fm + ((wgid % nig) % gsz); u.pn = (wgid % nig) / gsz;
        u.pb = blk_e ? (__builtin_amdgcn_readfirstlane(blk_e[u.pm]) * nN + u.pn) : u.pn;
        return true;
    }
};

__device__ __forceinline__ unsigned cvt_pk_bf16(float lo, float hi) { unsigned r; asm volatile("v_cvt_pk_bf16_f32 %0, %1, %2" : "=v"(r) : "v"(lo), "v"(hi)); return r; }

template <class Epi, class Sched>
__device__ __forceinline__ void gemm_phase(PG8_LAS unsigned char* lds, const Gemm g, const Sched& S, const Epi& E) {
    const int tid = otid(), wid = __builtin_amdgcn_readfirstlane(tid >> 6), lane = tid & 63, wr = wid >> 2, wc = wid & 3, fr = lane & 15, fq = lane >> 4;
    const int K = g.K, nt = K / BK;
    unsigned voffA[2], voffB[2];
#pragma unroll
    for (int i = 0; i < 2; ++i) { int R, C; stage_rc(tid * 16 + i * 8192, R, C); const int Rb = Epi::PERM ? ((R & ~31) + perm32(R & 31)) : R;
        voffA[i] = (unsigned)(R * g.lda + C) * 2u; voffB[i] = (unsigned)(Rb * g.ldb + C) * 2u; }
    const size_t kstep = (size_t)(BK * 2);
    const size_t hA = (size_t)HALF * g.lda * 2, hB = (size_t)HALF * g.ldb * 2;
    const size_t tA = 2 * hA, tB = 2 * hB;
    const unsigned ldsw = (unsigned)wid * 1024u;
    const int aoff = lds_byte(wr * 64 + fr, fq * 8), boff = lds_byte(wc * 32 + fr, fq * 8);
#define PG8_SA(b, h) (((b) * 2 + (h)) * HTB)
#define PG8_SB(b, h) ((4 + (b) * 2 + (h)) * HTB)
#define PG8_STAGE(bufoff, gbase, voff) do { _Pragma("unroll") for (int _i = 0; _i < 2; ++_i) \
        __builtin_amdgcn_global_load_lds((const unsigned*)((const char*)(gbase) + (voff)[_i]), (PG8_LAS unsigned*)(lds + (bufoff) + ldsw + _i * 8192), 16, 0, 0); } while (0)
#define PG8_LDA(dst, b, h) do { _Pragma("unroll") for (int m = 0; m < 4; ++m) _Pragma("unroll") for (int k = 0; k < 2; ++k) dst[m][k] = *(const PG8_LAS bf16x8*)(lds + PG8_SA(b, h) + aoff + m * 2048 + k * 1024); } while (0)
#define PG8_LDB(dst, b, h) do { _Pragma("unroll") for (int n = 0; n < 2; ++n) _Pragma("unroll") for (int k = 0; k < 2; ++k) dst[n][k] = *(const PG8_LAS bf16x8*)(lds + PG8_SB(b, h) + boff + n * 2048 + k * 1024); } while (0)
#define PG8_MMA(ai, bj, At, Bt) do { __builtin_amdgcn_s_setprio(1); _Pragma("unroll") for (int m = 0; m < 4; ++m) _Pragma("unroll") for (int n = 0; n < 2; ++n) _Pragma("unroll") for (int k = 0; k < 2; ++k) \
        acc[ai][bj][m][n] = __builtin_amdgcn_mfma_f32_16x16x32_bf16(Bt[n][k], At[m][k], acc[ai][bj][m][n], 0, 0, 0); __builtin_amdgcn_s_setprio(0); } while (0)
#define PG8_WAIT_V(n) asm volatile("s_waitcnt vmcnt(" #n ")" ::: "memory")
#define PG8_WAIT_L(n) asm volatile("s_waitcnt lgkmcnt(" #n ")" ::: "memory")
#define PG8_BAR __builtin_amdgcn_s_barrier()
#define PG8_SCHED __builtin_amdgcn_sched_barrier(0)
    Unit cur, nxt; int ui = 0;
    if (!S.next(0, cur)) return;
    f32x4 acc[2][2][4][2];
#pragma unroll
    for (int a = 0; a < 2; ++a)
#pragma unroll
        for (int b = 0; b < 2; ++b)
#pragma unroll
            for (int m = 0; m < 4; ++m)
#pragma unroll
                for (int n = 0; n < 2; ++n) acc[a][b][m][n] = (f32x4){0.f, 0.f, 0.f, 0.f};
    bf16x8 At[4][2], B0[2][2], B1[2][2];
    const char* cA = (const char*)g.A + (size_t)cur.pm * tA; const char* cB = (const char*)g.Bt + (size_t)cur.pb * tB;
    PG8_STAGE(PG8_SB(0, 0), cB, voffB); PG8_STAGE(PG8_SB(0, 1), cB + hB, voffB); PG8_STAGE(PG8_SA(0, 0), cA, voffA); PG8_STAGE(PG8_SA(0, 1), cA + hA, voffA);
    if (wr == 1) PG8_BAR;
    PG8_WAIT_V(2); PG8_BAR;
    PG8_STAGE(PG8_SB(1, 0), cB + kstep, voffB); PG8_STAGE(PG8_SA(1, 0), cA + kstep, voffA); PG8_STAGE(PG8_SB(1, 1), cB + hB + kstep, voffB);
    PG8_WAIT_V(6); PG8_BAR;
    for (;;) {
        const bool has_next = S.next(ui + 1, nxt);
        const char* nA = has_next ? (const char*)g.A + (size_t)nxt.pm * tA : cA; const char* nB = has_next ? (const char*)g.Bt + (size_t)nxt.pb * tB : cB;
        for (int t = 0; t < nt; t += 2) {
            const bool last = (t == nt - 2);
            const char* a1 = cA + (size_t)(t + 1) * kstep;
            const char* a2 = last ? nA : cA + (size_t)(t + 2) * kstep; const char* b2 = last ? nB : cB + (size_t)(t + 2) * kstep;
            const char* a3 = a2 + kstep; const char* b3 = b2 + kstep;
            PG8_LDB(B0, 0, 0); PG8_LDB(B1, 0, 1); PG8_SCHED; PG8_LDA(At, 0, 0); PG8_STAGE(PG8_SA(1, 1), a1 + hA, voffA);
            PG8_WAIT_V(8); PG8_WAIT_L(0); PG8_BAR; PG8_MMA(0, 0, At, B0); PG8_MMA(0, 1, At, B1); PG8_BAR; PG8_SCHED;
            PG8_LDA(At, 0, 1); PG8_STAGE(PG8_SB(0, 0), b2, voffB); PG8_STAGE(PG8_SB(0, 1), b2 + hB, voffB); PG8_STAGE(PG8_SA(0, 0), a2, voffA);
            PG8_WAIT_V(8); PG8_WAIT_L(0); PG8_BAR; PG8_MMA(1, 0, At, B0); PG8_MMA(1, 1, At, B1); PG8_BAR; PG8_SCHED;
            PG8_LDB(B0, 1, 0); PG8_LDB(B1, 1, 1); PG8_SCHED; PG8_LDA(At, 1, 0); PG8_STAGE(PG8_SA(0, 1), a2 + hA, voffA);
            PG8_WAIT_V(8); PG8_WAIT_L(0); PG8_BAR; PG8_MMA(0, 0, At, B0); PG8_MMA(0, 1, At, B1); PG8_BAR; PG8_SCHED;
            PG8_LDA(At, 1, 1); PG8_STAGE(PG8_SB(1, 0), b3, voffB); PG8_STAGE(PG8_SB(1, 1), b3 + hB, voffB); PG8_STAGE(PG8_SA(1, 0), a3, voffA);
            PG8_WAIT_V(8); PG8_WAIT_L(0); PG8_BAR; PG8_MMA(1, 0, At, B0); PG8_MMA(1, 1, At, B1); PG8_BAR; PG8_SCHED;
        }
        if (wr == 0) PG8_BAR;
        E(acc, cur, wr, wc, fr, fq);
        if (!has_next) break;
#pragma unroll
        for (int a = 0; a < 2; ++a)
#pragma unroll
            for (int b = 0; b < 2; ++b)
#pragma unroll
                for (int m = 0; m < 4; ++m)
#pragma unroll
                    for (int n = 0; n < 2; ++n) acc[a][b][m][n] = (f32x4){0.f, 0.f, 0.f, 0.f};
        cur = nxt; cA = nA; cB = nB; ++ui;
        if (wr == 1) PG8_BAR;
    }
    PG8_WAIT_V(0);
    PG8_BAR;
#undef PG8_SA
#undef PG8_SB
#undef PG8_STAGE
#undef PG8_LDA
#undef PG8_LDB
#undef PG8_MMA
#undef PG8_WAIT_V
#undef PG8_WAIT_L
#undef PG8_BAR
#undef PG8_SCHED
}
}
#define GAS __attribute__((address_space(1)))
#define LAS __attribute__((address_space(3)))
typedef unsigned short bf16;
typedef float f32x4 __attribute__((ext_vector_type(4)));
typedef float f32x2 __attribute__((ext_vector_type(2)));
typedef float f32x16 __attribute__((ext_vector_type(16)));
typedef short bf16x8 __attribute__((ext_vector_type(8)));
typedef unsigned u32x4 __attribute__((ext_vector_type(4)));
typedef unsigned u32x2 __attribute__((ext_vector_type(2)));

constexpr int NB = 4, SEQ = 4096, T = NB * SEQ, D = 1024, NL = 2;
constexpr int NH = 8, HD = 64, HW = 512;
constexpr int N_IN = 7344, FFD = 2816, FFE = 3584, NE = 8, PLE = 256;
constexpr int N1 = 4352, NZR = 1792, NZQ = 1536, NZG = 512, NZM = 512, NGATE = 3072;
constexpr int K2 = 512, N2 = 1792, K3 = 384, N3 = 2048;
constexpr int QKD = 96;
constexpr int NBLK_MAX = 136, HALF_BLK = 68;
constexpr float NORM_EPS = 1e-6f;
constexpr int NTH = 512, NWV = 8;

constexpr size_t MiB = 1u << 20;
constexpr size_t WS_CTL = 0;
constexpr size_t WS_W = 2 * MiB;
constexpr size_t WS_HB = 73 * MiB;
constexpr size_t WS_PB = 105 * MiB;
constexpr size_t WS_VF = 121 * MiB;
constexpr size_t WS_S = 137 * MiB;
constexpr size_t WS_END = 553 * MiB;
constexpr size_t S_ZR = WS_S + 0 * MiB, S_ZQ = WS_S + 56 * MiB, S_ZG = WS_S + 104 * MiB, S_ZM = WS_S + 120 * MiB;
constexpr size_t S_A2 = WS_S + 136 * MiB, S_L2 = WS_S + 148 * MiB;
constexpr size_t S_QRAW = WS_S + 212 * MiB, S_KVRAW = WS_S + 236 * MiB, S_Q = WS_S + 268 * MiB, S_K = WS_S + 292 * MiB, S_VT = WS_S + 316 * MiB, S_OB = WS_S + 332 * MiB;
constexpr size_t S_RR = WS_S + 212 * MiB, S_RK = WS_S + 228 * MiB, S_RV = WS_S + 244 * MiB, S_RA = WS_S + 260 * MiB, S_RB = WS_S + 276 * MiB, S_RW = WS_S + 292 * MiB, S_RG = WS_S + 348 * MiB;
constexpr size_t S_GQ = WS_S + 364 * MiB, S_GK = WS_S + 380 * MiB, S_GV = WS_S + 396 * MiB, S_GAL = WS_S + 412 * MiB, S_GBE = WS_S + 412 * MiB + 524288;
constexpr size_t S_YA = WS_S + 148 * MiB, S_YC = WS_S + 164 * MiB, S_OA = WS_S + 212 * MiB, S_OC = WS_S + 228 * MiB;
constexpr size_t S_ZS = WS_S + 0 * MiB, S_M = WS_S + 348 * MiB;
constexpr size_t S_CMR = WS_S + 0 * MiB, S_S0R = WS_S + 64 * MiB, S_CMG = WS_S + 120 * MiB, S_S0G = WS_S + 184 * MiB;
constexpr size_t S_ACT = WS_S + 0 * MiB;
constexpr size_t S_MWGU = WS_S + 0 * MiB;
constexpr size_t S_MWD = WS_S + 112 * MiB;
constexpr size_t S_XG = WS_S + 168 * MiB;
constexpr size_t S_MACT = WS_S + 237 * MiB;
constexpr size_t S_E = WS_S + 358 * MiB;
constexpr size_t S_SSP0 = WS_S + 413 * MiB, S_SSP1 = WS_S + 414 * MiB, S_SSP2 = WS_S + 415 * MiB;
static_assert(S_SSP2 + MiB <= WS_END, "ws map");
static_assert(S_E + 32 * MiB <= WS_END, "ws map");
static_assert(S_MACT + (size_t)HALF_BLK * 256 * FFE * 2 <= S_E, "ws map");
static_assert(S_XG + (size_t)NBLK_MAX * 256 * D * 2 <= S_MACT, "ws map");
static_assert(S_GBE + 524288 <= WS_END, "ws map");

constexpr size_t WL = 41 * MiB;
constexpr size_t W_IN = 0, W_GATE = 9 * MiB, W_2 = 15 * MiB, W_3 = 17 * MiB, W_BRA = 19 * MiB, W_BRB = 20 * MiB, W_BRC = 21 * MiB, W_OUT = 22 * MiB;
constexpr size_t W_FGU = 24 * MiB, W_FD = 35 * MiB;
constexpr size_t W_PLE = 65 * MiB, WPL = 2 * MiB + 524288, W_PP = 0, W_PG = 524288;
static_assert(W_FD + (size_t)D * FFD * 2 <= WL && W_PLE + 2 * WPL <= 71 * MiB, "w map");
constexpr size_t WS_HB2 = WS_W;
constexpr size_t CTL_ZERO = 512 * 1024;
constexpr size_t C_BAR = 0;
constexpr size_t C_MOE = 16384;
constexpr size_t C_SS = 65536;
constexpr size_t C_RSQ = 512 * 1024, C_RSKV = C_RSQ + 65536;
constexpr size_t C_SEL = C_RSKV + 65536;
constexpr size_t C_WTS = C_SEL + 131072;
constexpr size_t C_RANK = C_WTS + 131072;
constexpr size_t C_DEST = C_RANK + 131072;
constexpr size_t C_RSX = C_DEST + 131072;
constexpr size_t C_BLKE = C_RSX + 139264;
constexpr size_t C_RS1 = C_BLKE + 1024;
constexpr size_t C_BSC = C_RS1 + 65536;
static_assert(C_BSC + 524288 <= 2 * MiB, "ctl map");

__device__ __forceinline__ float bf2f(unsigned v) { return __uint_as_float(v << 16); }
__device__ __forceinline__ unsigned f2bf(float f) { unsigned u = __float_as_uint(f); return (u + 0x7fffu + ((u >> 16) & 1u)) >> 16; }
__device__ __forceinline__ unsigned pk2(float lo, float hi) { return f2bf(lo) | (f2bf(hi) << 16); }
__device__ __forceinline__ float wave_sum(float v) {
#pragma unroll
    for (int o = 1; o < 64; o <<= 1) v += __shfl_xor(v, o);
    return v;
}
__device__ __forceinline__ float sigmoidf_(float x) { return 1.f / (1.f + __expf(-x)); }
__device__ __forceinline__ float siluf_(float x) { return x / (1.f + __expf(-x)); }
__device__ __forceinline__ float softplusf_(float x) { return fmaxf(x, 0.f) + log1pf(__expf(-fabsf(x))); }

struct Args { const void* in[45]; float* out; unsigned char* ws; int layer; int pad; };
typedef const void* gptr_t;
typedef const __attribute__((address_space(4))) gptr_t* kin_t;
struct PArgs { kin_t in; float* out; unsigned char* ws; };
__device__ __forceinline__ PArgs make_pargs(const Args& a) {
    PArgs p; p.in = (kin_t)__builtin_amdgcn_kernarg_segment_ptr(); p.out = a.out; p.ws = a.ws;
    asm volatile("" : "+s"(p.in), "+s"(p.out), "+s"(p.ws)); return p; }
#define INF(i) ((const float*)a.in[i])
#define EPI_ARGS const pg8::f32x4 (&acc)[2][2][4][2], const pg8::Unit& u, int wr, int wc, int fr, int fq
#define EPI_ROWS _Pragma("unroll") for (int ai = 0; ai < 2; ++ai) _Pragma("unroll") for (int m = 0; m < 4; ++m)
__device__ __forceinline__ u32x4 pack8(const f32x4 v0, const f32x4 v1) { u32x4 w; w.x = pg8::cvt_pk_bf16(v0[0], v0[1]); w.y = pg8::cvt_pk_bf16(v0[2], v0[3]); w.z = pg8::cvt_pk_bf16(v1[0], v1[1]); w.w = pg8::cvt_pk_bf16(v1[2], v1[3]); return w; }
__device__ __forceinline__ void unpack8(const u32x4 w, float (&f)[8]) { f[0] = bf2f(w.x & 0xffffu); f[1] = bf2f(w.x >> 16); f[2] = bf2f(w.y & 0xffffu); f[3] = bf2f(w.y >> 16); f[4] = bf2f(w.z & 0xffffu); f[5] = bf2f(w.z >> 16); f[6] = bf2f(w.w & 0xffffu); f[7] = bf2f(w.w >> 16); }

__device__ __forceinline__ float rowscale16(const float* ssp, int r) { const f32x4* p = (const f32x4*)(ssp + (size_t)r * 16); const f32x4 a = p[0], b = p[1], c = p[2], d = p[3];
    const float s = ((a[0] + a[1]) + (a[2] + a[3])) + ((b[0] + b[1]) + (b[2] + b[3])) + ((c[0] + c[1]) + (c[2] + c[3])) + ((d[0] + d[1]) + (d[2] + d[3])); return rsqrtf(s * (1.f / D) + NORM_EPS); }
struct EpiInProj {
    static constexpr bool PERM = true;
    bf16 *zr, *zq, *zg, *zm; const float* ss;
    __device__ __forceinline__ void operator()(EPI_ARGS) const {
        bf16* O; int ld, ct; const int pn = u.pn;
        if (pn < 7) { O = zr; ld = NZR; ct = pn * 256; } else if (pn < 13) { O = zq; ld = NZQ; ct = (pn - 7) * 256; } else if (pn < 15) { O = zg; ld = NZG; ct = (pn - 13) * 256; } else { O = zm; ld = NZM; ct = (pn - 15) * 256; }
        const int row0 = u.pm * 256 + wr * 64 + fr, col0 = ct + wc * 32 + 8 * fq;
        EPI_ROWS { const int r = row0 + ai * 128 + m * 16; const float s = rowscale16(ss, r); bf16* rowp = O + (size_t)r * ld + col0;
#pragma unroll
            for (int bj = 0; bj < 2; ++bj) *(u32x4*)(rowp + bj * 128) = pack8(acc[ai][bj][m][0] * s, acc[ai][bj][m][1] * s); }
    }
};
struct EpiGate {
    static constexpr bool PERM = true;
    bf16* O; const float* ss;
    __device__ __forceinline__ void operator()(EPI_ARGS) const {
        const int row0 = u.pm * 256 + wr * 64 + fr, col0 = u.pn * 256 + wc * 32 + 8 * fq;
        EPI_ROWS { const int r = row0 + ai * 128 + m * 16; const float s = rowscale16(ss, r); bf16* rowp = O + (size_t)r * NGATE + col0;
#pragma unroll
            for (int bj = 0; bj < 2; ++bj) { f32x4 v0 = acc[ai][bj][m][0] * s, v1 = acc[ai][bj][m][1] * s;
#pragma unroll
                for (int j = 0; j < 4; ++j) { v0[j] = sigmoidf_(v0[j]); v1[j] = sigmoidf_(v1[j]); }
                *(u32x4*)(rowp + bj * 128) = pack8(v0, v1); } }
    }
};
struct EpiMla {
    static constexpr bool PERM = true;
    bf16 *qraw, *kvraw; const float *rsq, *rskv;
    __device__ __forceinline__ void operator()(EPI_ARGS) const {
        const bool isq = u.pn < 3; bf16* O = isq ? qraw : kvraw; const int ld = isq ? 768 : 1024, ct = isq ? u.pn * 256 : (u.pn - 3) * 256; const float* rs = isq ? rsq : rskv;
        const int row0 = u.pm * 256 + wr * 64 + fr, col0 = ct + wc * 32 + 8 * fq;
        EPI_ROWS { const int r = row0 + ai * 128 + m * 16; const float s = rs[r]; bf16* rowp = O + (size_t)r * ld + col0;
#pragma unroll
            for (int bj = 0; bj < 2; ++bj) *(u32x4*)(rowp + bj * 128) = pack8(acc[ai][bj][m][0] * s, acc[ai][bj][m][1] * s); }
    }
};
struct EpiPlain {
    static constexpr bool PERM = true;
    bf16* O; int ld;
    __device__ __forceinline__ void operator()(EPI_ARGS) const {
        const int row0 = u.pm * 256 + wr * 64 + fr, col0 = u.pn * 256 + wc * 32 + 8 * fq;
        EPI_ROWS { const int r = row0 + ai * 128 + m * 16; bf16* rowp = O + (size_t)r * ld + col0;
#pragma unroll
            for (int bj = 0; bj < 2; ++bj) *(u32x4*)(rowp + bj * 128) = pack8(acc[ai][bj][m][0], acc[ai][bj][m][1]); }
    }
};
template <bool FIRST> struct EpiMerge {
    static constexpr bool PERM = true;
    bf16* M; const bf16* zs; int br;
    __device__ __forceinline__ void operator()(EPI_ARGS) const {
        const int row0 = u.pm * 256 + wr * 64 + fr, col0 = u.pn * 256 + wc * 32 + 8 * fq;
        EPI_ROWS { const int r = row0 + ai * 128 + m * 16;
#pragma unroll
            for (int bj = 0; bj < 2; ++bj) { const int c = col0 + bj * 128; float g[8], o[8]; unpack8(*(const u32x4*)(zs + (size_t)r * NGATE + br * 1024 + c), g);
                if (!FIRST) unpack8(*(const u32x4*)(M + (size_t)r * D + c), o);
                f32x4 v0, v1;
#pragma unroll
                for (int j = 0; j < 4; ++j) { v0[j] = g[j] * acc[ai][bj][m][0][j] + (FIRST ? 0.f : o[j]); v1[j] = g[4 + j] * acc[ai][bj][m][1][j] + (FIRST ? 0.f : o[4 + j]); }
                *(u32x4*)(M + (size_t)r * D + c) = pack8(v0, v1); } }
    }
};
struct EpiResid {
    static constexpr bool PERM = false;
    float* out; bf16* hb; float* ss;
    __device__ __forceinline__ void operator()(EPI_ARGS) const {
        const int row0 = u.pm * 256 + wr * 64 + fr, col0 = u.pn * 256 + wc * 32 + 4 * fq;
        EPI_ROWS { const int r = row0 + ai * 128 + m * 16; float sq = 0.f;
#pragma unroll
            for (int bj = 0; bj < 2; ++bj)
#pragma unroll
                for (int n = 0; n < 2; ++n) { const size_t off = (size_t)r * D + col0 + bj * 128 + n * 16; f32x4 h = *(const f32x4*)(out + off); h += acc[ai][bj][m][n]; *(f32x4*)(out + off) = h;
                    u32x2 w; w.x = pg8::cvt_pk_bf16(h[0], h[1]); w.y = pg8::cvt_pk_bf16(h[2], h[3]); *(u32x2*)(hb + off) = w; sq += (h[0] * h[0] + h[1] * h[1]) + (h[2] * h[2] + h[3] * h[3]); }
            if (ss) { sq += __shfl_xor(sq, 16); sq += __shfl_xor(sq, 32); if (fq == 0) ss[(size_t)r * 16 + u.pn * 4 + wc] = sq; } }
    }
};
template <bool MOE> struct EpiSwiglu {
    static constexpr bool PERM = true;
    bf16* O; int ld; const float* rs;
    __device__ __forceinline__ void operator()(EPI_ARGS) const {
        const int row0 = u.pm * 256 + wr * 64 + fr, col0 = u.pn * 128 + wc * 32 + 8 * fq;
        EPI_ROWS { const int r = row0 + ai * 128 + m * 16; const float s = MOE ? rs[r] : rowscale16(rs, r);
            f32x4 v0, v1;
#pragma unroll
            for (int j = 0; j < 4; ++j) { v0[j] = siluf_(acc[ai][0][m][0][j] * s) * (acc[ai][1][m][0][j] * s); v1[j] = siluf_(acc[ai][0][m][1][j] * s) * (acc[ai][1][m][1][j] * s); }
            *(u32x4*)(O + (size_t)r * ld + col0) = pack8(v0, v1); }
    }
};
struct EpiPleProj {
    static constexpr bool PERM = true;
    bf16* O; float* sse;
    __device__ __forceinline__ void operator()(EPI_ARGS) const {
        const int row0 = u.pm * 256 + wr * 64 + fr, col0 = u.pn * 256 + wc * 32 + 8 * fq;
        EPI_ROWS { const int r = row0 + ai * 128 + m * 16; float sq = 0.f;
#pragma unroll
            for (int bj = 0; bj < 2; ++bj) { const f32x4 v0 = acc[ai][bj][m][0], v1 = acc[ai][bj][m][1]; *(u32x4*)(O + (size_t)r * D + col0 + bj * 128) = pack8(v0, v1);
                sq += (v0[0] * v0[0] + v0[1] * v0[1]) + (v0[2] * v0[2] + v0[3] * v0[3]) + (v1[0] * v1[0] + v1[1] * v1[1]) + (v1[2] * v1[2] + v1[3] * v1[3]); }
            sq += __shfl_xor(sq, 16); sq += __shfl_xor(sq, 32); if (fq == 0) sse[(size_t)r * 16 + u.pn * 4 + wc] = sq; }
    }
};
struct EpiPleGate {
    static constexpr bool PERM = false;
    float* out; bf16* hb; const bf16* E; const float* sse; const float* png; float* ssn;
    __device__ __forceinline__ void operator()(EPI_ARGS) const {
        const int row0 = u.pm * 256 + wr * 64 + fr, col0 = u.pn * 256 + wc * 32 + 4 * fq;
        EPI_ROWS { const int r = row0 + ai * 128 + m * 16; float sq = 0.f; const float se = rowscale16(sse, r);
#pragma unroll
            for (int bj = 0; bj < 2; ++bj)
#pragma unroll
                for (int n = 0; n < 2; ++n) { const int c = col0 + bj * 128 + n * 16; const size_t off = (size_t)r * D + c; f32x4 h = *(const f32x4*)(out + off);
                    const u32x2 ew = *(const u32x2*)(E + off); const f32x4 g = *(const f32x4*)(png + c);
                    const float e0 = bf2f(ew.x & 0xffffu), e1 = bf2f(ew.x >> 16), e2 = bf2f(ew.y & 0xffffu), e3 = bf2f(ew.y >> 16);
                    const f32x4 a4 = acc[ai][bj][m][n];
                    h[0] += sigmoidf_(a4[0]) * (e0 * se * g[0]); h[1] += sigmoidf_(a4[1]) * (e1 * se * g[1]); h[2] += sigmoidf_(a4[2]) * (e2 * se * g[2]); h[3] += sigmoidf_(a4[3]) * (e3 * se * g[3]);
                    *(f32x4*)(out + off) = h; if (hb) { u32x2 w; w.x = pg8::cvt_pk_bf16(h[0], h[1]); w.y = pg8::cvt_pk_bf16(h[2], h[3]); *(u32x2*)(hb + off) = w; }
                    sq += (h[0] * h[0] + h[1] * h[1]) + (h[2] * h[2] + h[3] * h[3]); }
            if (ssn) { sq += __shfl_xor(sq, 16); sq += __shfl_xor(sq, 32); if (fq == 0) ssn[(size_t)r * 16 + u.pn * 4 + wc] = sq; } }
    }
};
struct TJob { int src, src_off, K, ldn, n0, ncnt; int dst_off, dst_ld, dst_k0, dst_row0, rowmode; int gain, gain_off, gain2, gain2_off, g2mode; };
#define WOFF(l, o) ((int)((l) * WL + (o)))
#define LAYER_JOBS(l) \
    {4, (l) * D * N_IN, D, N_IN, 0, 1792, WOFF(l, W_IN), D, 0, 0, 0, 3, (l) * D, -1, 0, 0}, \
    {4, (l) * D * N_IN, D, N_IN, 2208, 1536, WOFF(l, W_IN), D, 0, 1792, 0, 3, (l) * D, -1, 0, 0}, \
    {4, (l) * D * N_IN, D, N_IN, 3760, 512, WOFF(l, W_IN), D, 0, 3328, 0, 3, (l) * D, -1, 0, 0}, \
    {4, (l) * D * N_IN, D, N_IN, 1792, 416, WOFF(l, W_IN), D, 0, 3840, 0, 3, (l) * D, -1, 0, 0}, \
    {4, (l) * D * N_IN, D, N_IN, 3744, 16, WOFF(l, W_IN), D, 0, 3840 + 416, 0, 3, (l) * D, -1, 0, 0}, \
    {4, (l) * D * N_IN, D, N_IN, 4272, 3072, WOFF(l, W_GATE), D, 0, 0, 0, 3, (l) * D, -1, 0, 0}, \
    {7, (l) * 64 * 512, 64, 512, 0, 512, WOFF(l, W_3), K3, 0, 0, 0, -1, 0, -1, 0, 0}, \
    {9, (l) * 64 * 512, 64, 512, 0, 512, WOFF(l, W_3), K3, 64, 512, 0, -1, 0, -1, 0, 0}, \
    {10, (l) * 128 * 512, 128, 512, 0, 512, WOFF(l, W_3), K3, 128, 1024, 0, -1, 0, -1, 0, 0}, \
    {22, (l) * 256 * 768, 256, 768, 0, 768, WOFF(l, W_2), K2, 0, 0, 0, 20, (l) * 256, -1, 0, 0}, \
    {23, (l) * 128 * 1024, 128, 1024, 0, 1024, WOFF(l, W_2), K2, 256, 768, 0, 21, (l) * 128, -1, 0, 0}, \
    {30, (l) * 512 * 1024, 512, 1024, 0, 1024, WOFF(l, W_BRA), 512, 0, 0, 0, -1, 0, -1, 0, 0}, \
    {31, (l) * 512 * 1024, 512, 1024, 0, 1024, WOFF(l, W_BRB), 512, 0, 0, 0, -1, 0, -1, 0, 0}, \
    {32, (l) * 512 * 1024, 512, 1024, 0, 1024, WOFF(l, W_BRC), 512, 0, 0, 0, -1, 0, -1, 0, 0}, \
    {33, (l) * D * D, D, D, 0, D, WOFF(l, W_OUT), D, 0, 0, 0, -1, 0, -1, 0, 0}, \
    {42, (l) * PLE * D, PLE, D, 0, D, (int)(W_PLE + (l) * WPL + W_PP), PLE, 0, 0, 0, -1, 0, -1, 0, 0}, \
    {43, (l) * D * D, D, D, 0, D, (int)(W_PLE + (l) * WPL + W_PG), D, 0, 0, 0, -1, 0, -1, 0, 0}
__constant__ TJob g_jobs[] = {
    LAYER_JOBS(0), LAYER_JOBS(1),
    {17, 0, D, 32, 0, 32, WOFF(1, W_IN), D, 0, 3840 + 432, 0, 3, 1 * D, 16, 0, 1},
    {17, 0, D, 32, 0, 32, WOFF(1, W_IN), D, 0, 3840 + 464, 0, 3, 1 * D, 16, 0, 2},
    {18, 0, 32, 512, 0, 512, WOFF(1, W_3), K3, 256, 1536, 0, -1, 0, -1, 0, 0},
    {35, 0, D, FFD, 0, FFD, (int)W_FGU, D, 0, 0, 1, 34, 0, -1, 0, 0},
    {36, 0, D, FFD, 0, FFD, (int)W_FGU, D, 0, 0, 2, 34, 0, -1, 0, 0},
    {37, 0, FFD, D, 0, D, (int)W_FD, FFD, 0, 0, 0, -1, 0, -1, 0, 0},
};
constexpr int NJOBS = sizeof(g_jobs) / sizeof(TJob);

__device__ __forceinline__ void transpose_item(const PArgs& a, const TJob& j, bf16* dstbase, LAS float* scr, int item, int lane) {
    const float* W = INF(j.src) + j.src_off;
    const float* G1 = j.gain >= 0 ? INF(j.gain) + j.gain_off : nullptr;
    const float* G2 = j.gain2 >= 0 ? INF(j.gain2) + j.gain2_off : nullptr;
    const int nblk = (j.ncnt + 31) / 32, kb = item / nblk, nb = item % nblk, k0 = 64 * kb, nl0 = 32 * nb;
    const int nl = nl0 + (lane & 31);
#pragma unroll 8
    for (int i = 0; i < 32; ++i) { const int kk = 2 * i + (lane >> 5), k = k0 + kk; float v = 0.f;
        if (k < j.K && nl < j.ncnt) { v = W[(size_t)k * j.ldn + j.n0 + nl]; if (G1) v *= G1[k]; if (G2) { const float g2 = G2[k]; v *= (j.g2mode == 1) ? (1.f - g2) : g2; } }
        scr[kk * 33 + (lane & 31)] = v; }
    asm volatile("s_waitcnt lgkmcnt(0)" ::: "memory");
    const int c = lane & 7;
    if (k0 + 8 * c < j.K) {
#pragma unroll
        for (int q = 0; q < 4; ++q) { const int nloc = (lane >> 3) + 8 * q, n = nl0 + nloc; if (n < j.ncnt) { const LAS float* s = scr + (8 * c) * 33 + nloc;
            u32x4 o; o.x = pk2(s[0 * 33], s[1 * 33]); o.y = pk2(s[2 * 33], s[3 * 33]); o.z = pk2(s[4 * 33], s[5 * 33]); o.w = pk2(s[6 * 33], s[7 * 33]);
            const int row = j.dst_row0 + (j.rowmode == 0 ? n : (n / 128) * 256 + (n % 128) + (j.rowmode == 2 ? 128 : 0));
            *(u32x4*)(dstbase + (size_t)row * j.dst_ld + j.dst_k0 + k0 + 8 * c) = o; } }
    }
    asm volatile("s_waitcnt lgkmcnt(0)" ::: "memory");
}

__device__ __forceinline__ void phase_prologue(const PArgs& a, LAS unsigned char* lds) {
    const int bidx_ = obid();
    const int tid = otid(), lane = tid & 63, wave = __builtin_amdgcn_readfirstlane(tid >> 6), G = ogrid();
    const int gw = bidx_ * NWV + wave, NGW = G * NWV;
    LAS float* scr = (LAS float*)(lds + wave * 16384);
    for (int ji = 0; ji < NJOBS; ++ji) { const TJob j = g_jobs[ji]; const int nit = ((j.K + 63) / 64) * ((j.ncnt + 31) / 32);
        bf16* dstbase = (bf16*)(a.ws + WS_W + j.dst_off);
        for (int it = gw; it < nit; it += NGW) transpose_item(a, j, dstbase, scr, it, lane); }
    const float* x = INF(0); bf16* hb = (bf16*)(a.ws + WS_HB); float* ss0 = (float*)(a.ws + S_SSP0);
    for (int m = gw; m < T; m += NGW) { const f32x4* xr = (const f32x4*)(x + (size_t)m * D) + lane; f32x4* orow = (f32x4*)(a.out + (size_t)m * D) + lane; u32x2* hrow = (u32x2*)(hb + (size_t)m * D) + lane;
        float s = 0.f;
#pragma unroll
        for (int q = 0; q < 4; ++q) { const f32x4 v = xr[64 * q]; orow[64 * q] = v; u32x2 w; w.x = pk2(v[0], v[1]); w.y = pk2(v[2], v[3]); hrow[64 * q] = w; s += (v[0] * v[0] + v[1] * v[1]) + (v[2] * v[2] + v[3] * v[3]); }
        s = wave_sum(s); if (lane < 16) ss0[(size_t)m * 16 + lane] = lane == 0 ? s : 0.f; }
    const f32x4* p4 = (const f32x4*)INF(1); u32x2* pb = (u32x2*)(a.ws + WS_PB);
    for (size_t i = (size_t)bidx_ * NTH + tid; i < (size_t)NL * T * PLE / 4; i += (size_t)G * NTH) { const f32x4 v = p4[i]; u32x2 w; w.x = pk2(v[0], v[1]); w.y = pk2(v[2], v[3]); pb[i] = w; }
}

__device__ __forceinline__ void phase_moe_cvt(const PArgs& a, LAS unsigned char* lds) {
    const int bidx_ = obid();
    const int tid = otid(), lane = tid & 63, wave = __builtin_amdgcn_readfirstlane(tid >> 6), G = ogrid();
    const int gw = bidx_ * NWV + wave, NGW = G * NWV;
    LAS float* scr = (LAS float*)(lds + wave * 16384);
    constexpr int IT_GU = (D / 64) * (FFE / 32), IT_D = (FFE / 64) * (D / 32);
    constexpr int PER_E = 2 * IT_GU + IT_D;
    for (int it = gw; it < NE * PER_E; it += NGW) { const int e = it / PER_E; int r = it % PER_E;
        TJob j; j.gain2 = -1; j.gain2_off = 0; j.g2mode = 0; j.n0 = 0; j.dst_k0 = 0;
        if (r < 2 * IT_GU) { const int up = r >= IT_GU; if (up) r -= IT_GU; j.src = up ? 40 : 39; j.src_off = e * D * FFE; j.K = D; j.ldn = FFE; j.ncnt = FFE; j.dst_ld = D; j.dst_row0 = e * 2 * FFE; j.rowmode = up ? 2 : 1; j.gain = 34; j.gain_off = D;
            transpose_item(a, j, (bf16*)(a.ws + S_MWGU), scr, r, lane); }
        else { r -= 2 * IT_GU; j.src = 41; j.src_off = e * FFE * D; j.K = FFE; j.ldn = D; j.ncnt = D; j.dst_ld = FFE; j.dst_row0 = e * D; j.rowmode = 0; j.gain = -1; j.gain_off = 0;
            transpose_item(a, j, (bf16*)(a.ws + S_MWD), scr, r, lane); } }
}
__device__ __forceinline__ void phase_pre(const PArgs& a, int l) {
    const int bidx_ = obid();
    const int tid = otid(), lane = tid & 63, wave = tid >> 6, G = ogrid();
    const bf16* zr = (const bf16*)(a.ws + S_ZR); const bf16* zm = (const bf16*)(a.ws + S_ZM); bf16* A2 = (bf16*)(a.ws + S_A2);
    float* rsq = (float*)(a.ws + WS_CTL + C_RSQ); float* rskv = (float*)(a.ws + WS_CTL + C_RSKV);
    constexpr int TT = 8;
    const float mu = tid < 256 ? INF(5)[l * 1792 + 1536 + tid] : 0.f;
    for (int g = bidx_; g < T / TT; g += G) { const int t0 = g * TT;
        if (tid < 256) { const int col = 1536 + tid; float v[TT + 1];
            v[0] = (t0 % SEQ == 0) ? 0.f : bf2f(zr[(size_t)(t0 - 1) * NZR + col]);
#pragma unroll
            for (int i = 0; i < TT; ++i) v[i + 1] = bf2f(zr[(size_t)(t0 + i) * NZR + col]);
#pragma unroll
            for (int i = 0; i < TT; ++i) { float x = v[i + 1] + (v[i] - v[i + 1]) * mu; if (tid < 64) x = tanhf(x); else if (tid >= 128) x = sigmoidf_(x); A2[(size_t)(t0 + i) * K3 + tid] = (bf16)f2bf(x); }
        } else if (tid < 288) { const int jx = tid - 256; float c1[TT], c2[TT + 1];
            c2[0] = (t0 % SEQ == 0) ? 0.f : bf2f(zm[(size_t)(t0 - 1) * NZM + 464 + jx]);
#pragma unroll
            for (int i = 0; i < TT; ++i) { c1[i] = bf2f(zm[(size_t)(t0 + i) * NZM + 432 + jx]); c2[i + 1] = bf2f(zm[(size_t)(t0 + i) * NZM + 464 + jx]); }
#pragma unroll
            for (int i = 0; i < TT; ++i) A2[(size_t)(t0 + i) * K3 + tid] = (bf16)f2bf(c1[i] + c2[i]);
        } else if (tid < 384) {
#pragma unroll
            for (int i = 0; i < TT; ++i) A2[(size_t)(t0 + i) * K3 + tid] = 0;
        } else if (wave == 6) { float s[TT];
#pragma unroll
            for (int i = 0; i < TT; ++i) { const u32x2 w = *(const u32x2*)(zm + (size_t)(t0 + i) * NZM + lane * 4); const float f0 = bf2f(w.x & 0xffffu), f1 = bf2f(w.x >> 16), f2 = bf2f(w.y & 0xffffu), f3 = bf2f(w.y >> 16); s[i] = f0 * f0 + f1 * f1 + f2 * f2 + f3 * f3; }
#pragma unroll
            for (int i = 0; i < TT; ++i) { const float q = wave_sum(s[i]); if (lane == 0) rsq[t0 + i] = rsqrtf(q * (1.f / 256.f) + NORM_EPS); }
        } else { float s[TT];
#pragma unroll
            for (int i = 0; i < TT; ++i) { const unsigned w = *(const unsigned*)(zm + (size_t)(t0 + i) * NZM + 256 + lane * 2); const float f0 = bf2f(w & 0xffffu), f1 = bf2f(w >> 16); s[i] = f0 * f0 + f1 * f1; }
#pragma unroll
            for (int i = 0; i < TT; ++i) { const float q = wave_sum(s[i]); if (lane == 0) rskv[t0 + i] = rsqrtf(q * (1.f / 128.f) + NORM_EPS); }
        }
    }
}

__device__ __forceinline__ void phase_mla_post(const PArgs& a, int l, LAS unsigned char* lds) {
    const int bidx_ = obid();
    const int tid = otid(), lane = tid & 63, h = tid >> 6, G = ogrid();
    const bf16* qraw = (const bf16*)(a.ws + S_QRAW); const bf16* kvraw = (const bf16*)(a.ws + S_KVRAW); const bf16* zm = (const bf16*)(a.ws + S_ZM);
    bf16* Q = (bf16*)(a.ws + S_Q); bf16* Kk = (bf16*)(a.ws + S_K); bf16* Vt = (bf16*)(a.ws + S_VT);
    const int* pos = (const int*)a.in[2];
    LAS bf16* vt = (LAS bf16*)lds;
    const float* gq = INF(24) + l * QKD; const float* gk = INF(25) + l * QKD;
    const float gq0 = gq[lane], gk0 = gk[lane], gq1 = lane < 32 ? gq[64 + lane] : 0.f, gk1 = lane < 32 ? gk[64 + lane] : 0.f;
    const float invf = exp2f(-(float)(lane & 15) * (13.287712379549449f / 16.f));
    const float qscale = 0.10206207261596577f * 1.4426950408889634f;
    for (int tile = bidx_; tile < T / 64; tile += G) { const int t0 = tile * 64, b = t0 / SEQ, s0 = t0 % SEQ;
        for (int i0 = 0; i0 < 64; i0 += 4) {
            float q0[4], q1[4], k0[4], k1[4], ang[4]; unsigned short vv[4];
#pragma unroll
            for (int ii = 0; ii < 4; ++ii) { const int t = t0 + i0 + ii;
                q0[ii] = bf2f(qraw[(size_t)t * 768 + h * 96 + lane]); q1[ii] = lane < 32 ? bf2f(qraw[(size_t)t * 768 + h * 96 + 64 + lane]) : 0.f;
                k0[ii] = bf2f(kvraw[(size_t)t * 1024 + h * 128 + lane]); k1[ii] = lane < 32 ? bf2f(zm[(size_t)t * NZM + 384 + lane]) : 0.f;
                vv[ii] = kvraw[(size_t)t * 1024 + h * 128 + 64 + lane]; ang[ii] = (float)pos[t] * invf; }
#pragma unroll
            for (int ii = 0; ii < 4; ++ii) { const int i = i0 + ii;
                const float sq = wave_sum(q0[ii] * q0[ii] + q1[ii] * q1[ii]), sk = wave_sum(k0[ii] * k0[ii] + k1[ii] * k1[ii]);
                const float rq = rsqrtf(sq * (1.f / QKD) + NORM_EPS), rk = rsqrtf(sk * (1.f / QKD) + NORM_EPS);
                const float qn0 = q0[ii] * rq * gq0, qn1 = q1[ii] * rq * gq1, kn0 = k0[ii] * rk * gk0, kn1 = k1[ii] * rk * gk1;
                const double rev = (double)ang[ii] * 0.15915494309189535; const float fr = (float)(rev - rint(rev));
                const float sn = __builtin_amdgcn_sinf(fr), cs = __builtin_amdgcn_cosf(fr);
                const float qp = __shfl_xor(qn1, 16), kp = __shfl_xor(kn1, 16);
                const float qr = (lane < 16) ? (qn1 * cs - qp * sn) : (qn1 * cs + qp * sn);
                const float kr = (lane < 16) ? (kn1 * cs - kp * sn) : (kn1 * cs + kp * sn);
                const size_t ro = ((size_t)(b * NH + h) * SEQ + s0 + i) * QKD;
                Q[ro + lane] = (bf16)f2bf(qn0 * qscale); Kk[ro + lane] = (bf16)f2bf(kn0);
                if (lane < 32) { Q[ro + 64 + lane] = (bf16)f2bf(qr * qscale); Kk[ro + 64 + lane] = (bf16)f2bf(kr); }
                vt[(h * 64 + lane) * 72 + i] = vv[ii]; }
        }
        __syncthreads();
        { const int row = tid; const LAS u32x4* src = (const LAS u32x4*)(vt + row * 72); u32x4* dst = (u32x4*)(Vt + ((size_t)(b * NH) * 64 + row) * SEQ + s0);
#pragma unroll
          for (int q = 0; q < 8; ++q) dst[q] = src[q]; }
        __syncthreads();
    }
}

__device__ __forceinline__ void phase_rwkv_post(const PArgs& a, int l) {
    const int bidx_ = obid();
    const int tid = otid(), G = ogrid(), c = tid;
    const bf16* zr = (const bf16*)(a.ws + S_ZR); const bf16* L2 = (const bf16*)(a.ws + S_L2); bf16* vf = (bf16*)(a.ws + WS_VF);
    bf16* RR = (bf16*)(a.ws + S_RR); bf16* RK = (bf16*)(a.ws + S_RK); bf16* RV = (bf16*)(a.ws + S_RV); bf16* RA = (bf16*)(a.ws + S_RA); bf16* RB = (bf16*)(a.ws + S_RB); float* RW = (float*)(a.ws + S_RW); bf16* RG = (bf16*)(a.ws + S_RG);
    const float mur = INF(5)[l * 1792 + c], muk = INF(5)[l * 1792 + 512 + c], muv = INF(5)[l * 1792 + 1024 + c];
    const float w0 = INF(6)[l * 512 + c], a0 = INF(8)[l * 512 + c], kkc = INF(11)[l * 512 + c], kac = INF(12)[l * 512 + c];
    const float vb = l > 0 ? INF(19)[(l - 1) * 512 + c] : 0.f; const float rkc = INF(13)[l * 512 + c]; float* bscA = (float*)(a.ws + WS_CTL + C_BSC);
    constexpr int TT = 4;
    for (int g = bidx_; g < T / TT; g += G) { const int t0 = g * TT; float zr_[TT + 1], zk_[TT + 1], zv_[TT + 1], lw[TT], la[TT], lg[TT], lv[TT], vfi[TT];
        const bool first = (t0 % SEQ == 0);
        zr_[0] = first ? 0.f : bf2f(zr[(size_t)(t0 - 1) * NZR + c]); zk_[0] = first ? 0.f : bf2f(zr[(size_t)(t0 - 1) * NZR + 512 + c]); zv_[0] = first ? 0.f : bf2f(zr[(size_t)(t0 - 1) * NZR + 1024 + c]);
#pragma unroll
        for (int i = 0; i < TT; ++i) { const size_t t = t0 + i; zr_[i + 1] = bf2f(zr[t * NZR + c]); zk_[i + 1] = bf2f(zr[t * NZR + 512 + c]); zv_[i + 1] = bf2f(zr[t * NZR + 1024 + c]);
            lw[i] = bf2f(L2[t * N3 + c]); la[i] = bf2f(L2[t * N3 + 512 + c]); lg[i] = bf2f(L2[t * N3 + 1024 + c]); lv[i] = l > 0 ? bf2f(L2[t * N3 + 1536 + c]) : 0.f; vfi[i] = l > 0 ? bf2f(vf[t * HW + c]) : 0.f; }
#pragma unroll
        for (int i = 0; i < TT; ++i) { const size_t t = t0 + i;
            const float r = zr_[i + 1] + (zr_[i] - zr_[i + 1]) * mur; const float k = zk_[i + 1] + (zk_[i] - zk_[i + 1]) * muk; float v = zv_[i + 1] + (zv_[i] - zv_[i + 1]) * muv;
            const float logw = -softplusf_(-(w0 + lw[i])) - 0.5f; const float decay = -__expf(logw);
            const float iclr = sigmoidf_(a0 + la[i]);
            if (l == 0) vf[t * HW + c] = (bf16)f2bf(v); else v = v + (vfi[i] - v) * sigmoidf_(vb + lv[i]);
            const float kkr = k * kkc; const float ssq = wave_sum(kkr * kkr); const float kk = kkr * rsqrtf(ssq + 1e-12f);
            const float kp = k * (1.f + (iclr - 1.f) * kac);
            { const float bs = wave_sum(r * kp * rkc); if ((tid & 63) == 0) bscA[t * 8 + (tid >> 6)] = bs; }
            RR[t * HW + c] = (bf16)f2bf(r); RK[t * HW + c] = (bf16)f2bf(kp); RV[t * HW + c] = (bf16)f2bf(v); RA[t * HW + c] = (bf16)f2bf(-kk); RB[t * HW + c] = (bf16)f2bf(kk * iclr); RW[t * HW + c] = decay; RG[t * HW + c] = (bf16)f2bf(lg[i]); }
    }
}

__device__ __forceinline__ void phase_gdn_prep(const PArgs& a, int l) {
    const int bidx_ = obid();
    const int tid = otid(), lane = tid & 63, h = tid >> 6, G = ogrid(), c = tid;
    const bf16* zq = (const bf16*)(a.ws + S_ZQ); const bf16* zm = (const bf16*)(a.ws + S_ZM);
    bf16* GQ = (bf16*)(a.ws + S_GQ); bf16* GK = (bf16*)(a.ws + S_GK); bf16* GV = (bf16*)(a.ws + S_GV); float* GAL = (float*)(a.ws + S_GAL); float* GBE = (float*)(a.ws + S_GBE);
    const float* cw = INF(26) + l * 4 * NZQ;
    float wq[4], wk[4], wv[4];
#pragma unroll
    for (int j = 0; j < 4; ++j) { wq[j] = cw[j * NZQ + c]; wk[j] = cw[j * NZQ + 512 + c]; wv[j] = cw[j * NZQ + 1024 + c]; }
    const float alog = INF(27)[l * 8 + h], dtb = INF(28)[l * 8 + h];
    constexpr int TT = 4;
    for (int g = bidx_; g < T / TT; g += G) { const int t0 = g * TT; float xq[TT + 3], xk[TT + 3], xv[TT + 3];
        const bool first = (t0 % SEQ == 0);
#pragma unroll
        for (int i = 0; i < TT + 3; ++i) { const int t = t0 - 3 + i; const bool ok = (i >= 3) || !first; const size_t tt = ok ? t : t0;
            const float q_ = bf2f(zq[tt * NZQ + c]), k_ = bf2f(zq[tt * NZQ + 512 + c]), v_ = bf2f(zq[tt * NZQ + 1024 + c]); xq[i] = ok ? q_ : 0.f; xk[i] = ok ? k_ : 0.f; xv[i] = ok ? v_ : 0.f; }
#pragma unroll
        for (int i = 0; i < TT; ++i) { const size_t t = t0 + i;
            float q = 0.f, k = 0.f, v = 0.f;
#pragma unroll
            for (int j = 0; j < 4; ++j) { q += wq[j] * xq[i + j]; k += wk[j] * xk[i + j]; v += wv[j] * xv[i + j]; }
            q = siluf_(q); k = siluf_(k); v = siluf_(v);
            const float sq = wave_sum(q * q), sk = wave_sum(k * k);
            q = q * rsqrtf(sq + 1e-12f) * 0.125f; k = k * rsqrtf(sk + 1e-12f);
            GQ[t * HW + c] = (bf16)f2bf(q); GK[t * HW + c] = (bf16)f2bf(k); GV[t * HW + c] = (bf16)f2bf(v);
            if (lane == 0) { const float bl = bf2f(zm[t * NZM + 416 + h]), al = bf2f(zm[t * NZM + 424 + h]); GBE[t * 8 + h] = sigmoidf_(bl); GAL[t * 8 + h] = -__expf(alog) * softplusf_(al + dtb); }     }
    }
}

__device__ __forceinline__ void phase_finish(const PArgs& a, int l) {
    const int bidx_ = obid();
    const int tid = otid(), lane = tid & 63, h = tid >> 6, G = ogrid(), c = tid;
    const bf16* YA = (const bf16*)(a.ws + S_YA); const bf16* YC = (const bf16*)(a.ws + S_YC); const bf16* RR = (const bf16*)(a.ws + S_RR); const bf16* RK = (const bf16*)(a.ws + S_RK); const bf16* RV = (const bf16*)(a.ws + S_RV); const bf16* RG = (const bf16*)(a.ws + S_RG);
    const bf16* zg = (const bf16*)(a.ws + S_ZG); bf16* OA = (bf16*)(a.ws + S_OA); bf16* OC = (bf16*)(a.ws + S_OC);
    const float rkc = INF(13)[l * 512 + c], lng = INF(14)[l * 512 + c], lnb = INF(15)[l * 512 + c], gng = INF(29)[l * 64 + lane];
    constexpr int TT = 4;
    for (int g = bidx_; g < T / TT; g += G) { const int t0 = g * TT; float ya[TT], yc[TT], r[TT], k[TT], v[TT], gt[TT], gg[TT];
#pragma unroll
        for (int i = 0; i < TT; ++i) { const size_t o = (size_t)(t0 + i) * HW + c; ya[i] = bf2f(YA[o]); yc[i] = bf2f(YC[o]); r[i] = bf2f(RR[o]); k[i] = bf2f(RK[o]); v[i] = bf2f(RV[o]); gt[i] = bf2f(RG[o]); gg[i] = bf2f(zg[o]); }
#pragma unroll
        for (int i = 0; i < TT; ++i) { const size_t o = (size_t)(t0 + i) * HW + c;
            const float mean = wave_sum(ya[i]) * (1.f / 64.f); const float d = ya[i] - mean; const float var = wave_sum(d * d) * (1.f / 64.f);
            const float bon = wave_sum(r[i] * k[i] * rkc) * v[i];
            const float y = d * rsqrtf(var + 64e-5f) * lng + lnb + bon;
            OA[o] = (bf16)f2bf(y * gt[i]);
            const float ms = wave_sum(yc[i] * yc[i]) * (1.f / 64.f);
            OC[o] = (bf16)f2bf(yc[i] * rsqrtf(ms + NORM_EPS) * gng * siluf_(gg[i])); }
    }
}
constexpr int AT_KP = 208, AT_VP = 136, AT_KB = 64 * AT_KP, AT_BUF = AT_KB + 64 * AT_VP;
__device__ __forceinline__ void attn_unit(const bf16* Q, const bf16* K, const bf16* Vt, bf16* OB, LAS unsigned char* lds, int b, int h, int qb) {
    const int tid = otid(), lane = tid & 63, wave = __builtin_amdgcn_readfirstlane(tid >> 6), ql = lane & 31, hh = lane >> 5;
    const int qrow0 = qb * 256 + wave * 32;
    const size_t bh = (size_t)(b * NH + h);
    bf16x8 qf[6];
    { const bf16* qp = Q + (bh * SEQ + qrow0 + ql) * QKD + 8 * hh;
#pragma unroll
      for (int s = 0; s < 6; ++s) qf[s] = *(const bf16x8*)(qp + 16 * s); }
    f32x16 o0, o1;
#pragma unroll
    for (int r = 0; r < 16; ++r) { o0[r] = 0.f; o1[r] = 0.f; }
    float mrun = -1e30f, lsum = 0.f;
    const int nkt = 4 * qb + 4;
    const unsigned char* Kb = (const unsigned char*)(K + bh * SEQ * QKD);
    const unsigned char* Vb = (const unsigned char*)(Vt + bh * 64 * SEQ);
    const int kr0 = tid / 12, kc0 = tid % 12, id1 = tid + 512, kr1 = id1 / 12, kc1 = id1 % 12; const bool k1v = id1 < 768;
    const int vr = tid >> 3, vc = tid & 7;
    u32x4 rk0, rk1, rv;
#define AT_LOAD(kt) do { const size_t key0 = (size_t)(kt) * 64; rk0 = *(const u32x4*)(Kb + (key0 + kr0) * (QKD * 2) + kc0 * 16); if (k1v) rk1 = *(const u32x4*)(Kb + (key0 + kr1) * (QKD * 2) + kc1 * 16); \
        rv = *(const u32x4*)(Vb + ((size_t)vr * SEQ + key0) * 2 + vc * 16); } while (0)
#define AT_STORE(buf) do { LAS unsigned char* bp = lds + (buf) * AT_BUF; *(LAS u32x4*)(bp + kr0 * AT_KP + kc0 * 16) = rk0; if (k1v) *(LAS u32x4*)(bp + kr1 * AT_KP + kc1 * 16) = rk1; \
        LAS u32x2* vp = (LAS u32x2*)(bp + AT_KB + vr * AT_VP + vc * 16); vp[0] = (u32x2){rv.x, rv.y}; vp[1] = (u32x2){rv.z, rv.w}; } while (0)
    AT_LOAD(0); AT_STORE(0);
    __syncthreads();
    for (int kt = 0; kt < nkt; ++kt) {
        if (kt + 1 < nkt) AT_LOAD(kt + 1);
        if (64 * kt <= qrow0 + 31) {
            const LAS unsigned char* kb = lds + (kt & 1) * AT_BUF; const LAS unsigned char* vb = kb + AT_KB;
            f32x16 s0, s1;
#pragma unroll
            for (int r = 0; r < 16; ++r) { s0[r] = 0.f; s1[r] = 0.f; }
#pragma unroll
            for (int s = 0; s < 6; ++s) { const bf16x8 kf0 = *(const LAS bf16x8*)(kb + ql * AT_KP + (16 * s + 8 * hh) * 2), kf1 = *(const LAS bf16x8*)(kb + (32 + ql) * AT_KP + (16 * s + 8 * hh) * 2);
                s0 = __builtin_amdgcn_mfma_f32_32x32x16_bf16(kf0, qf[s], s0, 0, 0, 0); s1 = __builtin_amdgcn_mfma_f32_32x32x16_bf16(kf1, qf[s], s1, 0, 0, 0); }
            if (64 * kt + 63 > qrow0) { const int qi = qrow0 + ql, kbase = 64 * kt + 4 * hh;
#pragma unroll
                for (int r = 0; r < 16; ++r) { const int key = kbase + (r & 3) + 8 * (r >> 2); if (key > qi) s0[r] = -1e30f; if (key + 32 > qi) s1[r] = -1e30f; } }
            float mx = s0[0];
#pragma unroll
            for (int r = 1; r < 16; ++r) mx = fmaxf(mx, s0[r]);
#pragma unroll
            for (int r = 0; r < 16; ++r) mx = fmaxf(mx, s1[r]);
            mx = fmaxf(mx, __shfl_xor(mx, 32));
            const float mnew = fmaxf(mrun, mx), alpha = exp2f(mrun - mnew); mrun = mnew;
            float ps = 0.f;
#pragma unroll
            for (int r = 0; r < 16; ++r) { s0[r] = exp2f(s0[r] - mnew); s1[r] = exp2f(s1[r] - mnew); ps += s0[r] + s1[r]; }
            lsum = lsum * alpha + ps;
#pragma unroll
            for (int r = 0; r < 16; ++r) { o0[r] *= alpha; o1[r] *= alpha; }
#pragma unroll
            for (int sub = 0; sub < 2; ++sub)
#pragma unroll
                for (int s2 = 0; s2 < 2; ++s2) {
                    union { u32x4 u; bf16x8 v; } pf;
                    if (sub == 0) { pf.u.x = pg8::cvt_pk_bf16(s0[8 * s2 + 0], s0[8 * s2 + 1]); pf.u.y = pg8::cvt_pk_bf16(s0[8 * s2 + 2], s0[8 * s2 + 3]); pf.u.z = pg8::cvt_pk_bf16(s0[8 * s2 + 4], s0[8 * s2 + 5]); pf.u.w = pg8::cvt_pk_bf16(s0[8 * s2 + 6], s0[8 * s2 + 7]); }
                    else { pf.u.x = pg8::cvt_pk_bf16(s1[8 * s2 + 0], s1[8 * s2 + 1]); pf.u.y = pg8::cvt_pk_bf16(s1[8 * s2 + 2], s1[8 * s2 + 3]); pf.u.z = pg8::cvt_pk_bf16(s1[8 * s2 + 4], s1[8 * s2 + 5]); pf.u.w = pg8::cvt_pk_bf16(s1[8 * s2 + 6], s1[8 * s2 + 7]); }
                    const int kofs = (sub * 32 + 16 * s2 + 4 * hh) * 2;
                    union { u32x4 u; bf16x8 v; } va, vb2;
                    { const u32x2 lo = *(const LAS u32x2*)(vb + ql * AT_VP + kofs), hi = *(const LAS u32x2*)(vb + ql * AT_VP + kofs + 16); va.u = (u32x4){lo.x, lo.y, hi.x, hi.y}; }
                    { const u32x2 lo = *(const LAS u32x2*)(vb + (32 + ql) * AT_VP + kofs), hi = *(const LAS u32x2*)(vb + (32 + ql) * AT_VP + kofs + 16); vb2.u = (u32x4){lo.x, lo.y, hi.x, hi.y}; }
                    o0 = __builtin_amdgcn_mfma_f32_32x32x16_bf16(va.v, pf.v, o0, 0, 0, 0); o1 = __builtin_amdgcn_mfma_f32_32x32x16_bf16(vb2.v, pf.v, o1, 0, 0, 0);
                }
        }
        if (kt + 1 < nkt) AT_STORE((kt + 1) & 1);
        __syncthreads();
    }
#undef AT_LOAD
#undef AT_STORE
    const float ltot = lsum + __shfl_xor(lsum, 32), inv = 1.f / ltot;
    bf16* op = OB + ((size_t)b * SEQ + qrow0 + ql) * HW + h * 64 + 4 * hh;
#pragma unroll
    for (int g = 0; g < 4; ++g) { u32x2 w0, w1; w0.x = pg8::cvt_pk_bf16(o0[4 * g] * inv, o0[4 * g + 1] * inv); w0.y = pg8::cvt_pk_bf16(o0[4 * g + 2] * inv, o0[4 * g + 3] * inv);
        w1.x = pg8::cvt_pk_bf16(o1[4 * g] * inv, o1[4 * g + 1] * inv); w1.y = pg8::cvt_pk_bf16(o1[4 * g + 2] * inv, o1[4 * g + 3] * inv);
        *(u32x2*)(op + 8 * g) = w0; *(u32x2*)(op + 32 + 8 * g) = w1; }
}
__device__ __forceinline__ void phase_attn(const PArgs& a, LAS unsigned char* lds) {
    const int bidx_ = obid();
    const bf16* Q = (const bf16*)(a.ws + S_Q); const bf16* K = (const bf16*)(a.ws + S_K); const bf16* Vt = (const bf16*)(a.ws + S_VT); bf16* OB = (bf16*)(a.ws + S_OB);
    for (int pi = bidx_; pi < NB * NH * 8; pi += ogrid()) { const int bh = pi >> 3, j = pi & 7;
        attn_unit(Q, K, Vt, OB, lds, bh >> 3, bh & 7, 15 - j);
        attn_unit(Q, K, Vt, OB, lds, bh >> 3, bh & 7, j); }
}

constexpr int SC_STEPS = 16, SC_ROW = 5 * 64 + 16, SC_BUF = SC_STEPS * SC_ROW * 4;
__device__ __forceinline__ void scan_task(const PArgs& a, int task, LAS unsigned char* wlds) {
    const int lane = otid() & 63, i = lane >> 2, jq = lane & 3;
    const bool gdn = task >= 128; const int tt = gdn ? task - 128 : task; const int b = tt >> 5, h = (tt >> 2) & 7, rg = tt & 3;
    const bf16 *PR, *PK, *PV, *PA, *PB; const float* PW; const float *PAL, *PBE; bf16* Y;
    if (!gdn) { PR = (const bf16*)(a.ws + S_RR); PK = (const bf16*)(a.ws + S_RK); PV = (const bf16*)(a.ws + S_RV); PA = (const bf16*)(a.ws + S_RA); PB = (const bf16*)(a.ws + S_RB); PW = (const float*)(a.ws + S_RW); PAL = nullptr; PBE = nullptr; Y = (bf16*)(a.ws + S_YA); }
    else { PR = (const bf16*)(a.ws + S_GQ); PK = (const bf16*)(a.ws + S_GK); PV = (const bf16*)(a.ws + S_GV); PA = nullptr; PB = nullptr; PW = nullptr; PAL = (const float*)(a.ws + S_GAL); PBE = (const float*)(a.ws + S_GBE); Y = (bf16*)(a.ws + S_YC); }
    const size_t row0 = (size_t)b * SEQ; const int col0 = h * 64;
    const int bs = lane >> 3, be = 8 * (lane & 7);
    u32x4 gr[2], gk[2], ga[2], gb[2], gv; f32x4 gw[4]; float gal[2], gbe[2];
#define SC_LOAD(c) do { const size_t t0_ = row0 + (size_t)(c) * SC_STEPS; \
        _Pragma("unroll") for (int q = 0; q < 2; ++q) { const size_t o_ = (t0_ + bs + 8 * q) * HW + col0 + be; gr[q] = *(const u32x4*)(PR + o_); gk[q] = *(const u32x4*)(PK + o_); \
            if (!gdn) { ga[q] = *(const u32x4*)(PA + o_); gb[q] = *(const u32x4*)(PB + o_); } else { gal[q] = PAL[(t0_ + bs + 8 * q) * 8 + h]; gbe[q] = PBE[(t0_ + bs + 8 * q) * 8 + h]; } } \
        if (!gdn) { _Pragma("unroll") for (int q = 0; q < 4; ++q) gw[q] = *(const f32x4*)(PW + (t0_ + (lane >> 4) + 4 * q) * HW + col0 + 4 * (lane & 15)); } \
        if (lane < 32) gv = *(const u32x4*)(PV + (t0_ + (lane >> 1)) * HW + col0 + rg * 16 + (lane & 1) * 8); } while (0)
#define SC_STORE(buf) do { LAS float* B_ = (LAS float*)(wlds + (buf) * SC_BUF); \
        _Pragma("unroll") for (int q = 0; q < 2; ++q) { LAS float* R_ = B_ + (bs + 8 * q) * SC_ROW; float fr_[8], fk_[8]; unpack8(gr[q], fr_); unpack8(gk[q], fk_); \
            if (!gdn) { float fa_[8], fb_[8]; unpack8(ga[q], fa_); unpack8(gb[q], fb_); \
                *(LAS f32x4*)(R_ + 0 + be) = (f32x4){fa_[0], fa_[1], fa_[2], fa_[3]}; *(LAS f32x4*)(R_ + 0 + be + 4) = (f32x4){fa_[4], fa_[5], fa_[6], fa_[7]}; \
                *(LAS f32x4*)(R_ + 128 + be) = (f32x4){fb_[0], fb_[1], fb_[2], fb_[3]}; *(LAS f32x4*)(R_ + 128 + be + 4) = (f32x4){fb_[4], fb_[5], fb_[6], fb_[7]}; \
                *(LAS f32x4*)(R_ + 192 + be) = (f32x4){fk_[0], fk_[1], fk_[2], fk_[3]}; *(LAS f32x4*)(R_ + 192 + be + 4) = (f32x4){fk_[4], fk_[5], fk_[6], fk_[7]}; } \
            else { const float al_ = gal[q], be_ = gbe[q], nab_ = -al_ * be_; \
                *(LAS f32x4*)(R_ + 0 + be) = (f32x4){fk_[0], fk_[1], fk_[2], fk_[3]}; *(LAS f32x4*)(R_ + 0 + be + 4) = (f32x4){fk_[4], fk_[5], fk_[6], fk_[7]}; \
                *(LAS f32x4*)(R_ + 64 + be) = (f32x4){al_, al_, al_, al_}; *(LAS f32x4*)(R_ + 64 + be + 4) = (f32x4){al_, al_, al_, al_}; \
                *(LAS f32x4*)(R_ + 128 + be) = (f32x4){fk_[0] * nab_, fk_[1] * nab_, fk_[2] * nab_, fk_[3] * nab_}; *(LAS f32x4*)(R_ + 128 + be + 4) = (f32x4){fk_[4] * nab_, fk_[5] * nab_, fk_[6] * nab_, fk_[7] * nab_}; \
                *(LAS f32x4*)(R_ + 192 + be) = (f32x4){fk_[0] * be_, fk_[1] * be_, fk_[2] * be_, fk_[3] * be_}; *(LAS f32x4*)(R_ + 192 + be + 4) = (f32x4){fk_[4] * be_, fk_[5] * be_, fk_[6] * be_, fk_[7] * be_}; } \
            *(LAS f32x4*)(R_ + 256 + be) = (f32x4){fr_[0], fr_[1], fr_[2], fr_[3]}; *(LAS f32x4*)(R_ + 256 + be + 4) = (f32x4){fr_[4], fr_[5], fr_[6], fr_[7]}; } \
        if (!gdn) { _Pragma("unroll") for (int q = 0; q < 4; ++q) *(LAS f32x4*)(B_ + ((lane >> 4) + 4 * q) * SC_ROW + 64 + 4 * (lane & 15)) = gw[q]; } \
        if (lane < 32) { float fv_[8]; unpack8(gv, fv_); LAS float* V_ = B_ + (lane >> 1) * SC_ROW + 320 + (lane & 1) * 8; *(LAS f32x4*)(V_) = (f32x4){fv_[0], fv_[1], fv_[2], fv_[3]}; *(LAS f32x4*)(V_ + 4) = (f32x4){fv_[4], fv_[5], fv_[6], fv_[7]}; } } while (0)
    float st[16];
#pragma unroll
    for (int q = 0; q < 16; ++q) st[q] = 0.f;
    SC_LOAD(0); SC_STORE(0);
    constexpr int NCH = SEQ / SC_STEPS;
    for (int c = 0; c < NCH; ++c) {
        if (c + 1 < NCH) SC_LOAD(c + 1);
        const LAS float* B_ = (const LAS float*)(wlds + (c & 1) * SC_BUF);
        for (int s = 0; s < SC_STEPS; ++s) { const LAS float* R_ = B_ + s * SC_ROW + 16 * jq;
            float va[16], vw[16], vb[16], vk[16], vr[16];
#pragma unroll
            for (int q = 0; q < 4; ++q) { const f32x4 x0 = *(const LAS f32x4*)(R_ + 4 * q), x1 = *(const LAS f32x4*)(R_ + 64 + 4 * q), x2 = *(const LAS f32x4*)(R_ + 128 + 4 * q), x3 = *(const LAS f32x4*)(R_ + 192 + 4 * q), x4 = *(const LAS f32x4*)(R_ + 256 + 4 * q);
#pragma unroll
                for (int e = 0; e < 4; ++e) { va[4 * q + e] = x0[e]; vw[4 * q + e] = x1[e]; vb[4 * q + e] = x2[e]; vk[4 * q + e] = x3[e]; vr[4 * q + e] = x4[e]; } }
            const float vi = B_[s * SC_ROW + 320 + i];
            float sa = 0.f;
#pragma unroll
            for (int q = 0; q < 16; ++q) sa += st[q] * va[q];
            sa += __shfl_xor(sa, 1); sa += __shfl_xor(sa, 2);
            float y = 0.f;
#pragma unroll
            for (int q = 0; q < 16; ++q) { st[q] = st[q] * vw[q] + sa * vb[q] + vi * vk[q]; y += st[q] * vr[q]; }
            y += __shfl_xor(y, 1); y += __shfl_xor(y, 2);
            if (jq == 0) Y[(row0 + (size_t)c * SC_STEPS + s) * HW + col0 + rg * 16 + i] = (bf16)f2bf(y);
        }
        if (c + 1 < NCH) SC_STORE((c + 1) & 1);
    }
#undef SC_LOAD
#undef SC_STORE
}
__device__ __forceinline__ void phase_scan(const PArgs& a, LAS unsigned char* lds) {
    const int bidx_ = obid();
    const int wave = __builtin_amdgcn_readfirstlane(otid() >> 6), G = ogrid();
    if (wave < 3) for (int task = bidx_ + wave * G; task < 256; task += 3 * G) scan_task(a, task, lds + wave * (2 * SC_BUF));
}
constexpr int CK_TP = 144;
constexpr int CK_AT = 0, CK_BT = 9216, CK_KT = 18432, CK_RT = 27648, CK_BW = 36864, CK_KW = 46080, CK_V = 55296, CK_LAB = 64512, CK_LAK = 81920, CK_LRB = 91136, CK_LRK = 100352, CK_AW = 109568, CK_W1 = 118784;
constexpr int CK_LV = CK_BT;
constexpr int CK_CUM = 128000, CK_CUMP = 128256, CK_PC = 128512, CK_WTOT = 128768;
constexpr int CK_LP = 68;
constexpr int CK_XL = 130816;
constexpr int CM_ITEM = 32768;
__device__ __forceinline__ bf16x8 ck_frag(const LAS unsigned char* tile, int row, int ks, int hh) { return *(const LAS bf16x8*)(tile + row * CK_TP + (16 * ks + 8 * hh) * 2); }
__device__ __forceinline__ int crow_(int r, int hh) { return (r & 3) + 8 * (r >> 2) + 4 * hh; }

template <int NSUB> __device__ __forceinline__ void ck_solve_rows(float (&x)[64], const LAS float* lab) {}
__device__ __forceinline__ void phase_cprep(const PArgs& a, LAS unsigned char* lds) {
    const int bidx_ = obid();
    const int tid = otid(), lane = tid & 63, wave = __builtin_amdgcn_readfirstlane(tid >> 6), G = ogrid(), ql = lane & 31, hh = lane >> 5;
    const int t = tid >> 3, j0 = (tid & 7) * 8;
    LAS float* cumA = (LAS float*)(lds + CK_CUM); LAS float* cumpA = (LAS float*)(lds + CK_CUMP); LAS float* pcA = (LAS float*)(lds + CK_PC); LAS float* wtot = (LAS float*)(lds + CK_WTOT);
    for (int item = bidx_; item < 4096; item += G) {
        const bool gdn = item >= 2048; const int it = item & 2047, bh = it >> 6, ch = it & 63, b = bh >> 3, h = bh & 7;
        const size_t row = (size_t)b * SEQ + ch * 64 + t; const size_t eo = row * HW + h * 64 + j0;
        float fr[8], fk[8], fv[8], fa[8], fb[8], lw[8];
        if (!gdn) { unpack8(*(const u32x4*)((const bf16*)(a.ws + S_RR) + eo), fr); unpack8(*(const u32x4*)((const bf16*)(a.ws + S_RK) + eo), fk); unpack8(*(const u32x4*)((const bf16*)(a.ws + S_RV) + eo), fv);
            unpack8(*(const u32x4*)((const bf16*)(a.ws + S_RA) + eo), fa); unpack8(*(const u32x4*)((const bf16*)(a.ws + S_RB) + eo), fb);
            const f32x4 w0 = *(const f32x4*)((const float*)(a.ws + S_RW) + eo), w1 = *(const f32x4*)((const float*)(a.ws + S_RW) + eo + 4);
#pragma unroll
            for (int e = 0; e < 4; ++e) { lw[e] = w0[e]; lw[4 + e] = w1[e]; } }
        else { float fq[8], fkk[8]; unpack8(*(const u32x4*)((const bf16*)(a.ws + S_GQ) + eo), fq); unpack8(*(const u32x4*)((const bf16*)(a.ws + S_GK) + eo), fkk); unpack8(*(const u32x4*)((const bf16*)(a.ws + S_GV) + eo), fv);
            const float g = ((const float*)(a.ws + S_GAL))[row * 8 + h], be = ((const float*)(a.ws + S_GBE))[row * 8 + h], al = __expf(g);
#pragma unroll
            for (int e = 0; e < 8; ++e) { fr[e] = fq[e]; fa[e] = fkk[e]; fb[e] = -al * be * fkk[e]; fk[e] = be * fkk[e]; lw[e] = g; } }
        float cum[8];
#pragma unroll
        for (int e = 0; e < 8; ++e) { float x = lw[e];
#pragma unroll
            for (int d = 8; d < 64; d <<= 1) { const float y = __shfl_up(x, d); if (lane >= d) x += y; }
            cum[e] = x; }
        if (lane >= 56) {
#pragma unroll
            for (int e = 0; e < 8; ++e) wtot[wave * 64 + j0 + e] = cum[e]; }
        __syncthreads();
        float pc[8];
#pragma unroll
        for (int e = 0; e < 8; ++e) { float off = 0.f, tot = 0.f;
#pragma unroll
            for (int w2 = 0; w2 < 8; ++w2) { const float x = wtot[w2 * 64 + j0 + e]; tot += x; if (w2 < wave) off += x; }
            cum[e] += off; pc[e] = tot; }
        if (gdn) { if ((tid & 7) == 0) { cumA[t] = cum[0]; cumpA[t] = cum[0] - lw[0]; } }
        else if ((tid & 7) == 0) { cumA[t] = 0.f; cumpA[t] = 0.f; }
        if (t == 0) {
#pragma unroll
            for (int e = 0; e < 8; ++e) pcA[j0 + e] = pc[e]; }
        { float xa[8], xr[8], xb[8], xk[8], yb[8], yk[8];
#pragma unroll
          for (int e = 0; e < 8; ++e) { const float ec = gdn ? 1.f : __expf(cum[e]), ecp = gdn ? 1.f : __expf(cum[e] - lw[e]), eci = gdn ? 1.f : __expf(-cum[e]), et = __expf(pc[e] - cum[e]);
              xa[e] = fa[e] * ecp; xr[e] = fr[e] * ec; xb[e] = fb[e] * eci; xk[e] = fk[e] * eci; yb[e] = fb[e] * et; yk[e] = fk[e] * et; }
          const int ro = t * CK_TP + j0 * 2;
          *(LAS u32x4*)(lds + CK_AT + ro) = (u32x4){pk2(xa[0], xa[1]), pk2(xa[2], xa[3]), pk2(xa[4], xa[5]), pk2(xa[6], xa[7])};
          *(LAS u32x4*)(lds + CK_RT + ro) = (u32x4){pk2(xr[0], xr[1]), pk2(xr[2], xr[3]), pk2(xr[4], xr[5]), pk2(xr[6], xr[7])};
          *(LAS u32x4*)(lds + CK_BT + ro) = (u32x4){pk2(xb[0], xb[1]), pk2(xb[2], xb[3]), pk2(xb[4], xb[5]), pk2(xb[6], xb[7])};
          *(LAS u32x4*)(lds + CK_KT + ro) = (u32x4){pk2(xk[0], xk[1]), pk2(xk[2], xk[3]), pk2(xk[4], xk[5]), pk2(xk[6], xk[7])};
#pragma unroll
          for (int e = 0; e < 8; ++e) { const int to = (j0 + e) * CK_TP + t * 2; *(LAS unsigned short*)(lds + CK_BW + to) = (unsigned short)f2bf(yb[e]); *(LAS unsigned short*)(lds + CK_KW + to) = (unsigned short)f2bf(yk[e]); *(LAS unsigned short*)(lds + CK_V + to) = (unsigned short)f2bf(fv[e]); } }
        __syncthreads();
        { const int p = wave >> 1, hf = wave & 1; const LAS unsigned char* At = lds + (p < 2 ? CK_AT : CK_RT); const LAS unsigned char* Bt = lds + ((p & 1) ? CK_KT : CK_BT);
          const LAS float* dA = (p < 2) ? cumpA : cumA;
#pragma unroll
          for (int sq = 0; sq < 2; ++sq) { f32x16 acc;
#pragma unroll
              for (int r = 0; r < 16; ++r) acc[r] = 0.f;
              if (!(sq == 1 && hf == 0)) {
#pragma unroll
                  for (int ks = 0; ks < 4; ++ks) acc = __builtin_amdgcn_mfma_f32_32x32x16_bf16(ck_frag(At, 32 * hf + ql, ks, hh), ck_frag(Bt, 32 * sq + ql, ks, hh), acc, 0, 0, 0); }
              const int s = 32 * sq + ql; const float dBs = cumA[s];
#pragma unroll
              for (int r = 0; r < 16; ++r) { const int tt = 32 * hf + crow_(r, hh); const bool keep = (p < 2) ? (s < tt) : (s <= tt); const float val = keep ? acc[r] * __expf(dA[tt] - dBs) : 0.f;
                  if (p == 0) *(LAS float*)(lds + CK_LAB + (s * CK_LP + tt) * 4) = val;
                  else *(LAS unsigned short*)(lds + (p == 1 ? CK_LAK : p == 2 ? CK_LRB : CK_LRK) + tt * CK_TP + s * 2) = (unsigned short)f2bf(val); } } }
        __syncthreads();
        if (wave < 4) { const int tq = wave >> 1, iq = wave & 1; f32x16 acc;
#pragma unroll
            for (int r = 0; r < 16; ++r) acc[r] = 0.f;
#pragma unroll
            for (int ks = 0; ks < 4; ++ks) acc = __builtin_amdgcn_mfma_f32_32x32x16_bf16(ck_frag(lds + CK_LAK, 32 * tq + ql, ks, hh), ck_frag(lds + CK_V, 32 * iq + ql, ks, hh), acc, 0, 0, 0);
#pragma unroll
            for (int r = 0; r < 16; ++r) *(LAS float*)(lds + CK_LV + ((32 * tq + crow_(r, hh)) * CK_LP + 32 * iq + ql) * 4) = acc[r]; }
        __syncthreads();
#ifndef CK_NO_C
        if (wave < 2) { const LAS float* labt = (const LAS float*)(lds + CK_LAB); LAS float* xl = (LAS float*)(lds + (wave == 0 ? CK_XL : CK_LV));
            LAS unsigned char* dst = lds + (wave == 0 ? CK_AW : CK_W1) + lane * CK_TP;
#pragma unroll 1
            for (int I = 0; I < 4; ++I) { float v[16];
#pragma unroll
                for (int tt = 0; tt < 16; ++tt) { const int t2 = 16 * I + tt; v[tt] = (wave == 0) ? bf2f(*(const LAS unsigned short*)(lds + CK_AT + t2 * CK_TP + lane * 2)) * __expf(cumpA[t2]) : xl[t2 * CK_LP + lane]; }
#pragma unroll 2
                for (int s2 = 0; s2 < 16 * I; ++s2) { const float xs = xl[s2 * CK_LP + lane]; const LAS f32x4* lp = (const LAS f32x4*)(labt + s2 * CK_LP + 16 * I);
#pragma unroll
                    for (int q = 0; q < 4; ++q) { const f32x4 l4 = lp[q];
#pragma unroll
                        for (int e = 0; e < 4; ++e) v[4 * q + e] += l4[e] * xs; } }
#pragma unroll
                for (int ss = 0; ss < 16; ++ss) { const float xs = v[ss]; xl[(16 * I + ss) * CK_LP + lane] = xs; const LAS f32x4* lp = (const LAS f32x4*)(labt + (16 * I + ss) * CK_LP + 16 * I);
#pragma unroll
                    for (int q = (ss + 1) / 4; q < 4; ++q) { const f32x4 l4 = lp[q];
#pragma unroll
                        for (int e = 0; e < 4; ++e) if (4 * q + e > ss) v[4 * q + e] += l4[e] * xs; } }
                *(LAS u32x4*)(dst + I * 32) = (u32x4){pk2(v[0], v[1]), pk2(v[2], v[3]), pk2(v[4], v[5]), pk2(v[6], v[7])};
                *(LAS u32x4*)(dst + I * 32 + 16) = (u32x4){pk2(v[8], v[9]), pk2(v[10], v[11]), pk2(v[12], v[13]), pk2(v[14], v[15])}; } }
#endif
        __syncthreads();
        { const int quad = wave & 3, rq = quad >> 1, cq = quad & 1; const bool lo = wave < 4;
          bf16* cm = (bf16*)(a.ws + (gdn ? S_CMG : S_CMR) + (size_t)it * CM_ITEM);
          const LAS unsigned char* A1 = lds + (lo ? CK_BW : CK_LRB); const LAS unsigned char* A2 = lds + (lo ? CK_KW : CK_LRK);
          f32x16 g1, g2;
#pragma unroll
          for (int r = 0; r < 16; ++r) { g1[r] = 0.f; g2[r] = 0.f; }
#pragma unroll
          for (int ks = 0; ks < 4; ++ks) { const bf16x8 af = ck_frag(A1, 32 * rq + ql, ks, hh);
              g1 = __builtin_amdgcn_mfma_f32_32x32x16_bf16(af, ck_frag(lds + CK_AW, 32 * cq + ql, ks, hh), g1, 0, 0, 0);
              g2 = __builtin_amdgcn_mfma_f32_32x32x16_bf16(af, ck_frag(lds + CK_W1, 32 * cq + ql, ks, hh), g2, 0, 0, 0); }
#pragma unroll
          for (int ks = 0; ks < 4; ++ks) g2 = __builtin_amdgcn_mfma_f32_32x32x16_bf16(ck_frag(A2, 32 * rq + ql, ks, hh), ck_frag(lds + CK_V, 32 * cq + ql, ks, hh), g2, 0, 0, 0);
          const int col = 32 * cq + ql;
          if (lo) { const float dg = __expf(pcA[col]);
#pragma unroll
              for (int r = 0; r < 16; ++r) { const int rw = 32 * rq + crow_(r, hh); cm[rw * 64 + col] = (bf16)f2bf(g1[r] + (rw == col ? dg : 0.f)); }
#pragma unroll
              for (int g4 = 0; g4 < 4; ++g4) *(u32x2*)(cm + 4096 + col * 64 + 32 * rq + 8 * g4 + 4 * hh) = (u32x2){pk2(g2[4 * g4], g2[4 * g4 + 1]), pk2(g2[4 * g4 + 2], g2[4 * g4 + 3])}; }
          else {
#pragma unroll
              for (int r = 0; r < 16; ++r) { const int rw = 32 * rq + crow_(r, hh); const float rh = bf2f(*(const LAS unsigned short*)(lds + CK_RT + rw * CK_TP + col * 2)) * __expf(cumA[rw]);
                  cm[8192 + rw * 64 + col] = (bf16)f2bf(g1[r] + rh); cm[12288 + rw * 64 + col] = (bf16)f2bf(g2[r]); } } }
        __syncthreads();
    }
}

__device__ __forceinline__ void phase_cscan(const PArgs& a, LAS unsigned char* lds) {
    const int bidx_ = obid();
    const int tid = otid(), lane = tid & 63, wave = __builtin_amdgcn_readfirstlane(tid >> 6), G = ogrid(), ql = lane & 31, hh = lane >> 5;
    for (int task = bidx_; task < 64; task += G) { const bool gdn = task >= 32; const int bh = task & 31;
        const bf16* cm = (const bf16*)(a.ws + (gdn ? S_CMG : S_CMR)) + (size_t)bh * 64 * (CM_ITEM / 2); bf16* s0 = (bf16*)(a.ws + (gdn ? S_S0G : S_S0R)) + (size_t)bh * 64 * 4096;
        const int rq = (wave >> 1) & 1, cq = wave & 1;
        for (int q = tid; q < 64 * CK_TP / 4; q += NTH) ((LAS unsigned*)lds)[q] = 0u;
        __syncthreads();
        bf16x8 ga[4]; u32x2 hc[4];
        if (wave < 4) {
#pragma unroll
            for (int ks = 0; ks < 4; ++ks) ga[ks] = *(const bf16x8*)(cm + (32 * rq + ql) * 64 + 16 * ks + 8 * hh);
#pragma unroll
            for (int g4 = 0; g4 < 4; ++g4) hc[g4] = *(const u32x2*)(cm + 4096 + (32 * cq + ql) * 64 + 32 * rq + 8 * g4 + 4 * hh); }
        for (int c = 0; c < 64; ++c) {
            bf16x8 gn[4]; u32x2 hn[4];
            if (wave < 4 && c + 1 < 64) { const bf16* cn = cm + (size_t)(c + 1) * (CM_ITEM / 2);
#pragma unroll
                for (int ks = 0; ks < 4; ++ks) gn[ks] = *(const bf16x8*)(cn + (32 * rq + ql) * 64 + 16 * ks + 8 * hh);
#pragma unroll
                for (int g4 = 0; g4 < 4; ++g4) hn[g4] = *(const u32x2*)(cn + 4096 + (32 * cq + ql) * 64 + 32 * rq + 8 * g4 + 4 * hh); }
            { const int rr = tid >> 3, cc = (tid & 7) * 16; *(u32x4*)((unsigned char*)(s0 + (size_t)c * 4096) + rr * 128 + cc) = *(const LAS u32x4*)(lds + rr * CK_TP + cc); }
            f32x16 acc;
            if (wave < 4) {
#pragma unroll
                for (int g4 = 0; g4 < 4; ++g4) { acc[4 * g4] = bf2f(hc[g4].x & 0xffffu); acc[4 * g4 + 1] = bf2f(hc[g4].x >> 16); acc[4 * g4 + 2] = bf2f(hc[g4].y & 0xffffu); acc[4 * g4 + 3] = bf2f(hc[g4].y >> 16); }
#pragma unroll
                for (int ks = 0; ks < 4; ++ks) acc = __builtin_amdgcn_mfma_f32_32x32x16_bf16(ga[ks], ck_frag(lds, 32 * cq + ql, ks, hh), acc, 0, 0, 0); }
            __syncthreads();
            if (wave < 4) {
#pragma unroll
                for (int g4 = 0; g4 < 4; ++g4) *(LAS u32x2*)(lds + (32 * cq + ql) * CK_TP + (32 * rq + 8 * g4 + 4 * hh) * 2) = (u32x2){pk2(acc[4 * g4], acc[4 * g4 + 1]), pk2(acc[4 * g4 + 2], acc[4 * g4 + 3])};
#pragma unroll
                for (int ks = 0; ks < 4; ++ks) ga[ks] = gn[ks];
#pragma unroll
                for (int g4 = 0; g4 < 4; ++g4) hc[g4] = hn[g4]; }
            __syncthreads();
        }
    }
}

__device__ __forceinline__ void phase_cout(const PArgs& a, int l) {
    const int bidx_ = obid();
    const int tid = otid(), lane = tid & 63, wave = __builtin_amdgcn_readfirstlane(tid >> 6), G = ogrid(), ql = lane & 31, hh = lane >> 5;
    for (int wt = bidx_ * NWV + wave; wt < 8192; wt += G * NWV) { const int item = wt >> 1, th = wt & 1; const bool gdn = item >= 2048; const int it = item & 2047, bh = it >> 6, ch = it & 63, b = bh >> 3, h = bh & 7;
        const bf16* cm = (const bf16*)(a.ws + (gdn ? S_CMG : S_CMR) + (size_t)it * CM_ITEM); const bf16* s0 = (const bf16*)(a.ws + (gdn ? S_S0G : S_S0R)) + (size_t)it * 4096;
        f32x16 y0, y1;
        { const bf16* yy = cm + 12288 + (32 * th + ql) * 64 + 4 * hh;
#pragma unroll
          for (int g4 = 0; g4 < 4; ++g4) { const u32x2 w0 = *(const u32x2*)(yy + 8 * g4), w1 = *(const u32x2*)(yy + 32 + 8 * g4);
              y0[4 * g4] = bf2f(w0.x & 0xffffu); y0[4 * g4 + 1] = bf2f(w0.x >> 16); y0[4 * g4 + 2] = bf2f(w0.y & 0xffffu); y0[4 * g4 + 3] = bf2f(w0.y >> 16);
              y1[4 * g4] = bf2f(w1.x & 0xffffu); y1[4 * g4 + 1] = bf2f(w1.x >> 16); y1[4 * g4 + 2] = bf2f(w1.y & 0xffffu); y1[4 * g4 + 3] = bf2f(w1.y >> 16); } }
#pragma unroll
        for (int ks = 0; ks < 4; ++ks) { const bf16x8 qf = *(const bf16x8*)(cm + 8192 + (32 * th + ql) * 64 + 16 * ks + 8 * hh);
            y0 = __builtin_amdgcn_mfma_f32_32x32x16_bf16(*(const bf16x8*)(s0 + ql * 64 + 16 * ks + 8 * hh), qf, y0, 0, 0, 0);
            y1 = __builtin_amdgcn_mfma_f32_32x32x16_bf16(*(const bf16x8*)(s0 + (32 + ql) * 64 + 16 * ks + 8 * hh), qf, y1, 0, 0, 0); }
        const size_t tok = (size_t)b * SEQ + ch * 64 + 32 * th + ql; const size_t base = tok * HW + h * 64 + 4 * hh;
        float s1 = 0.f;
#pragma unroll
        for (int r = 0; r < 16; ++r) s1 += y0[r] + y1[r];
        if (!gdn) { s1 += __shfl_xor(s1, 32); const float mean = s1 * (1.f / 64.f); float s2 = 0.f;
#pragma unroll
            for (int r = 0; r < 16; ++r) { const float d0 = y0[r] - mean, d1 = y1[r] - mean; s2 += d0 * d0 + d1 * d1; }
            s2 += __shfl_xor(s2, 32); const float rstd = rsqrtf(s2 * (1.f / 64.f) + 64e-5f); const float bsc = ((const float*)(a.ws + WS_CTL + C_BSC))[tok * 8 + h];
            const bf16* RV = (const bf16*)(a.ws + S_RV) + base; const bf16* RG = (const bf16*)(a.ws + S_RG) + base; bf16* OA = (bf16*)(a.ws + S_OA) + base;
            const float* lng = INF(14) + l * 512 + h * 64 + 4 * hh; const float* lnb = INF(15) + l * 512 + h * 64 + 4 * hh;
#pragma unroll
            for (int half = 0; half < 2; ++half)
#pragma unroll
                for (int g4 = 0; g4 < 4; ++g4) { const int co = 32 * half + 8 * g4; const u32x2 vw = *(const u32x2*)(RV + co), gw = *(const u32x2*)(RG + co); const f32x4 lg = *(const f32x4*)(lng + co), lb = *(const f32x4*)(lnb + co);
                    const float vv[4] = {bf2f(vw.x & 0xffffu), bf2f(vw.x >> 16), bf2f(vw.y & 0xffffu), bf2f(vw.y >> 16)}, gg[4] = {bf2f(gw.x & 0xffffu), bf2f(gw.x >> 16), bf2f(gw.y & 0xffffu), bf2f(gw.y >> 16)}; float o[4];
#pragma unroll
                    for (int e = 0; e < 4; ++e) { const float yv = half ? y1[4 * g4 + e] : y0[4 * g4 + e]; o[e] = ((yv - mean) * rstd * lg[e] + lb[e] + bsc * vv[e]) * gg[e]; }
                    *(u32x2*)(OA + co) = (u32x2){pk2(o[0], o[1]), pk2(o[2], o[3])}; } }
        else { float s2 = 0.f;
#pragma unroll
            for (int r = 0; r < 16; ++r) s2 += y0[r] * y0[r] + y1[r] * y1[r];
            s2 += __shfl_xor(s2, 32); const float rstd = rsqrtf(s2 * (1.f / 64.f) + NORM_EPS);
            const bf16* ZG = (const bf16*)(a.ws + S_ZG) + base; bf16* OC = (bf16*)(a.ws + S_OC) + base; const float* gng = INF(29) + l * 64 + 4 * hh;
#pragma unroll
            for (int half = 0; half < 2; ++half)
#pragma unroll
                for (int g4 = 0; g4 < 4; ++g4) { const int co = 32 * half + 8 * g4; const u32x2 gw = *(const u32x2*)(ZG + co); const f32x4 ng = *(const f32x4*)(gng + co);
                    const float gg[4] = {bf2f(gw.x & 0xffffu), bf2f(gw.x >> 16), bf2f(gw.y & 0xffffu), bf2f(gw.y >> 16)}; float o[4];
#pragma unroll
                    for (int e = 0; e < 4; ++e) { const float yv = half ? y1[4 * g4 + e] : y0[4 * g4 + e]; o[e] = yv * rstd * ng[e] * siluf_(gg[e]); }
                    *(u32x2*)(OC + co) = (u32x2){pk2(o[0], o[1]), pk2(o[2], o[3])}; } }
    }
}
__device__ __forceinline__ void phase_router(const PArgs& a) {
    const int bidx_ = obid();
    const int tid = otid(), lane = tid & 63, wave = __builtin_amdgcn_readfirstlane(tid >> 6), G = ogrid();
    const int gw = bidx_ * NWV + wave, NGW = G * NWV;
    const float* gf = INF(34) + D; const float* wr = INF(38);
    int* sel = (int*)(a.ws + WS_CTL + C_SEL); float* wts = (float*)(a.ws + WS_CTL + C_WTS); int* rank = (int*)(a.ws + WS_CTL + C_RANK); float* rs1 = (float*)(a.ws + WS_CTL + C_RS1);
    unsigned* cnt = (unsigned*)(a.ws + WS_CTL + C_MOE);
    for (int bi = gw; bi < T / 8; bi += NGW) { int my_e0 = -1, my_e1 = -1;
        for (int i = 0; i < 8; ++i) { const int t = bi * 8 + i; const f32x4* hr = (const f32x4*)(a.out + (size_t)t * D) + lane;
            f32x4 x[4]; float ssq = 0.f;
#pragma unroll
            for (int q = 0; q < 4; ++q) { x[q] = hr[64 * q]; ssq += (x[q][0] * x[q][0] + x[q][1] * x[q][1]) + (x[q][2] * x[q][2] + x[q][3] * x[q][3]); }
            ssq = wave_sum(ssq); const float rs = rsqrtf(ssq * (1.f / D) + NORM_EPS);
            float lg[8];
#pragma unroll
            for (int e = 0; e < 8; ++e) lg[e] = 0.f;
#pragma unroll
            for (int q = 0; q < 4; ++q) { const f32x4 g4 = *((const f32x4*)gf + lane + 64 * q);
#pragma unroll
                for (int j = 0; j < 4; ++j) { const int k = (lane + 64 * q) * 4 + j; const float u = x[q][j] * rs * g4[j]; const f32x4 w0 = *(const f32x4*)(wr + (size_t)k * 8), w1 = *(const f32x4*)(wr + (size_t)k * 8 + 4);
                    lg[0] += u * w0[0]; lg[1] += u * w0[1]; lg[2] += u * w0[2]; lg[3] += u * w0[3]; lg[4] += u * w1[0]; lg[5] += u * w1[1]; lg[6] += u * w1[2]; lg[7] += u * w1[3]; } }
#pragma unroll
            for (int e = 0; e < 8; ++e) lg[e] = wave_sum(lg[e]);
            int e0 = 0; float l0 = lg[0];
#pragma unroll
            for (int e = 1; e < 8; ++e) if (lg[e] > l0) { l0 = lg[e]; e0 = e; }
            int e1 = -1; float l1 = -3.4e38f;
#pragma unroll
            for (int e = 0; e < 8; ++e) if (e != e0 && lg[e] > l1) { l1 = lg[e]; e1 = e; }
            const float wa = 1.f / (1.f + __expf(l1 - l0));
            if (lane == i) { my_e0 = e0; my_e1 = e1; sel[t * 2] = e0; sel[t * 2 + 1] = e1; wts[t * 2] = wa; wts[t * 2 + 1] = 1.f - wa; rs1[t] = rs; } }
#pragma unroll
        for (int s = 0; s < 2; ++s) { const int me = s ? my_e1 : my_e0;
            for (int e = 0; e < 8; ++e) { const unsigned long long m = __ballot(me == e); if (m == 0ull) continue; const int n = __popcll(m);
                unsigned base = 0; if (lane == 0) base = atomicAdd(cnt + e, (unsigned)n); base = __builtin_amdgcn_readfirstlane(base);
                if (me == e) rank[(bi * 8 + lane) * 2 + s] = (int)base + __popcll(m & ((1ull << lane) - 1ull)); } }
    }
}
__device__ __forceinline__ void phase_assign(const PArgs& a) {
    const int bidx_ = obid();
    const int tid = otid(), lane = tid & 63, wave = __builtin_amdgcn_readfirstlane(tid >> 6), G = ogrid();
    const int gw = bidx_ * NWV + wave, NGW = G * NWV;
    const unsigned* cnt = (const unsigned*)(a.ws + WS_CTL + C_MOE);
    const int* sel = (const int*)(a.ws + WS_CTL + C_SEL); const int* rank = (const int*)(a.ws + WS_CTL + C_RANK); const float* rs1 = (const float*)(a.ws + WS_CTL + C_RS1);
    int* dest = (int*)(a.ws + WS_CTL + C_DEST); float* rsx = (float*)(a.ws + WS_CTL + C_RSX); int* blke = (int*)(a.ws + WS_CTL + C_BLKE);
    const bf16* hb = (const bf16*)(a.ws + WS_HB); bf16* xg = (bf16*)(a.ws + S_XG);
    int pstart[9]; pstart[0] = 0;
#pragma unroll
    for (int e = 0; e < 8; ++e) pstart[e + 1] = pstart[e] + (int)((cnt[e] + 255u) / 256u) * 256;
    if (bidx_ == 0 && tid < NBLK_MAX + 1) { if (tid == NBLK_MAX) blke[NBLK_MAX] = pstart[8] / 256; else { int e = 0;
#pragma unroll
            for (int q = 1; q < 8; ++q) if (tid * 256 >= pstart[q]) e = q;
            blke[tid] = e; } }
    for (int as = gw; as < T * 2; as += NGW) { const int t = as >> 1; const int e = sel[as];
        int ps = 0;
#pragma unroll
        for (int q = 0; q < 8; ++q) if (e == q) ps = pstart[q];
        const int d = ps + rank[as];
        if (lane == 0) { dest[as] = d; rsx[d] = rs1[t]; }
        const u32x4* src = (const u32x4*)(hb + (size_t)t * D); u32x4* dst = (u32x4*)(xg + (size_t)d * D);
        dst[lane] = src[lane]; dst[lane + 64] = src[lane + 64]; }
}
__device__ __forceinline__ void phase_combine(const PArgs& a) {
    const int bidx_ = obid();
    const int tid = otid(), lane = tid & 63, wave = __builtin_amdgcn_readfirstlane(tid >> 6), G = ogrid();
    const int gw = bidx_ * NWV + wave, NGW = G * NWV;
    const int* dest = (const int*)(a.ws + WS_CTL + C_DEST); const float* wts = (const float*)(a.ws + WS_CTL + C_WTS);
    const bf16* y = (const bf16*)(a.ws + S_XG); bf16* hb = (bf16*)(a.ws + WS_HB);
    for (int t = gw; t < T; t += NGW) { const int d0 = dest[t * 2], d1 = dest[t * 2 + 1]; const float w0 = wts[t * 2], w1 = wts[t * 2 + 1];
        f32x4* hr = (f32x4*)(a.out + (size_t)t * D); const u32x2* y0 = (const u32x2*)(y + (size_t)d0 * D); const u32x2* y1 = (const u32x2*)(y + (size_t)d1 * D); u32x2* hbr = (u32x2*)(hb + (size_t)t * D);
#pragma unroll
        for (int q = 0; q < 4; ++q) { const int ix = lane + 64 * q; f32x4 h = hr[ix]; const u32x2 a0 = y0[ix], a1 = y1[ix];
            h[0] += w0 * bf2f(a0.x & 0xffffu) + w1 * bf2f(a1.x & 0xffffu); h[1] += w0 * bf2f(a0.x >> 16) + w1 * bf2f(a1.x >> 16);
            h[2] += w0 * bf2f(a0.y & 0xffffu) + w1 * bf2f(a1.y & 0xffffu); h[3] += w0 * bf2f(a0.y >> 16) + w1 * bf2f(a1.y >> 16);
            hr[ix] = h; u32x2 w; w.x = pk2(h[0], h[1]); w.y = pk2(h[2], h[3]); hbr[ix] = w; } }
}
#ifndef MK_ONE_LAUNCH
#define MK_ONE_LAUNCH 1
#endif
#define XB_TMO      128
#define XB_XCNT(j)  (256  + 64 * (j))
#define XB_XSUB(j)  (1280 + 64 * (j))
#define XB_XGEN(j)  (2304 + 64 * (j))
#define XB_TOP      3328
#define XB_TOPGEN   3392
#define XCD_BAR_WORDS 3456
#define XB_SPIN_CAP (1u << 22)
__device__ __forceinline__ unsigned xb_ld(unsigned* p)              { return __hip_atomic_load(p, __ATOMIC_RELAXED, __HIP_MEMORY_SCOPE_AGENT); }
__device__ __forceinline__ unsigned xb_add(unsigned* p, unsigned v) { return __hip_atomic_fetch_add(p, v, __ATOMIC_RELAXED, __HIP_MEMORY_SCOPE_AGENT); }
__device__ __forceinline__ unsigned xb_xcc_id() { return (unsigned)__builtin_amdgcn_s_getreg((3 << 11) | 20) & 0xFu; }
#define XB_SPIN(cond, bar) do { unsigned _sp = 0; while (cond) { __builtin_amdgcn_s_sleep(1); \
    if ((++_sp & 255u) == 0u) { if (xb_ld(&(bar)[XB_TMO])) break; if (_sp > XB_SPIN_CAP) { atomicAdd(&(bar)[XB_TMO], 1u); break; } } } } while (0)
struct XcdBarrier { unsigned* bar; unsigned x; volatile LAS unsigned* st; };
__device__ __forceinline__ XcdBarrier xcd_barrier_post(unsigned* bar, volatile LAS unsigned* st) {
    XcdBarrier b; b.bar = bar; b.x = xb_xcc_id(); b.st = st;
    if (threadIdx.x == 0) (void)xb_add(&bar[XB_XCNT(b.x)], 1u);
    return b;
}
__device__ __forceinline__ void xcd_barrier_complete(unsigned* bar, unsigned x, unsigned& nloc, unsigned& nx) {
    const unsigned G = gridDim.x * gridDim.y * gridDim.z;
    unsigned sum, cnt, mine, sp = 0u;
    for (;;) {
        sum = 0u; cnt = 0u; mine = 0u;
#pragma unroll
        for (unsigned j = 0; j < 16; ++j) { const unsigned c = xb_ld(&bar[XB_XCNT(j)]); sum += c; cnt += (c > 0u) ? 1u : 0u; mine = (j == x) ? c : mine; }
        if (sum == G) break;
        __builtin_amdgcn_s_sleep(1);
        if ((++sp & 255u) == 0u) { if (xb_ld(&bar[XB_TMO])) break; if (sp > XB_SPIN_CAP) { atomicAdd(&bar[XB_TMO], 1u); break; } }
    }
    nloc = mine > 0u ? mine : 1u; nx = cnt > 0u ? cnt : 1u;
}
__device__ __forceinline__ void xcd_barrier(const XcdBarrier& b_) {
    asm volatile("s_waitcnt vmcnt(0)" ::: "memory");
    __syncthreads();
    if (otid() == 0) {
        XcdBarrier b = b_; asm volatile("" : "+s"(b.bar)); b.x = xb_xcc_id();
        unsigned* bar = b.bar;
        __builtin_amdgcn_s_waitcnt(0);
        unsigned nloc = b.st[0], nx = b.st[1];
        if (nloc == 0u) { xcd_barrier_complete(bar, b.x, nloc, nx); b.st[0] = nloc; b.st[1] = nx; }
        const unsigned old = xb_add(&bar[XB_XSUB(b.x)], 1u);
        const unsigned gen = old / nloc;
        if (old + 1u == (gen + 1u) * nloc) {
            __builtin_amdgcn_fence(__ATOMIC_RELEASE, "agent");
            asm volatile("s_waitcnt vmcnt(0)" ::: "memory");
            const unsigned og = xb_add(&bar[XB_TOP], 1u);
            const unsigned tg = og / nx;
            if (og + 1u == (tg + 1u) * nx) xb_add(&bar[XB_TOPGEN], 1u);
            else XB_SPIN(xb_ld(&bar[XB_TOPGEN]) == tg, bar);
            __builtin_amdgcn_fence(__ATOMIC_ACQUIRE, "agent");
            xb_add(&bar[XB_XGEN(b.x)], 1u);
            asm volatile("s_waitcnt vmcnt(0)" ::: "memory");
        } else {
            XB_SPIN(xb_ld(&bar[XB_XGEN(b.x)]) == gen, bar);
            __builtin_amdgcn_fence(__ATOMIC_ACQUIRE, "agent");
            asm volatile("s_waitcnt vmcnt(0)" ::: "memory");
        }
    }
    __syncthreads();
}

enum PhaseKind { PK_PRO = 0, PK_G1A, PK_PRE, PK_G23, PK_MLAPOST, PK_ATT, PK_RGPREP, PK_SCAN, PK_FIN, PK_G1B, PK_MRG, PK_OUT, PK_FGU, PK_FD, PK_MOEA, PK_MOEB, PK_MGU0, PK_MD0, PK_MGU1, PK_MD1, PK_COMB, PK_PP, PK_PG, PK_COUT };
struct PhaseEnt { int kind, layer; };
__constant__ PhaseEnt g_prog[] = {
    {PK_PRO, 0},
    {PK_G1A, 0}, {PK_PRE, 0}, {PK_G23, 0}, {PK_MLAPOST, 0}, {PK_ATT, 0}, {PK_RGPREP, 0}, {PK_SCAN, 0}, {PK_FIN, 0}, {PK_COUT, 0}, {PK_G1B, 0}, {PK_MRG, 0}, {PK_OUT, 0}, {PK_FGU, 0}, {PK_FD, 0}, {PK_PP, 0}, {PK_PG, 0},
    {PK_G1A, 1}, {PK_PRE, 1}, {PK_G23, 1}, {PK_MLAPOST, 1}, {PK_ATT, 1}, {PK_RGPREP, 1}, {PK_SCAN, 1}, {PK_FIN, 1}, {PK_COUT, 1}, {PK_G1B, 1}, {PK_MRG, 1}, {PK_OUT, 1},
    {PK_MOEA, 1}, {PK_MOEB, 1}, {PK_MGU0, 1}, {PK_MD0, 1}, {PK_MGU1, 1}, {PK_MD1, 1}, {PK_COMB, 1}, {PK_PP, 1}, {PK_PG, 1},
};
constexpr int NPHASE = sizeof(g_prog) / sizeof(PhaseEnt);

constexpr int LDS_BYTES = 163840;
constexpr int LDS_MISC = 163840 - 1024;

template <int KINDT> __device__ __forceinline__ void run_phase(const Args& a_, int kind_rt, int l, LAS unsigned char* lds) {
    const int kind = KINDT >= 0 ? KINDT : kind_rt; const PArgs a = make_pargs(a_);
    const int G = ogrid(), c = obid();
    unsigned char* ws = a.ws;
    const bf16* Wl = (const bf16*)(ws + WS_W + (size_t)l * WL);
    float* SS0 = (float*)(ws + S_SSP0); float* SS1 = (float*)(ws + S_SSP1); float* SSE = (float*)(ws + S_SSP2);
    bf16* HB = (bf16*)(ws + WS_HB); const bf16* HBin = (const bf16*)(ws + (l == 0 ? WS_HB : WS_HB2));
    const bf16* Wp = (const bf16*)(ws + WS_W + W_PLE + (size_t)l * WPL);
    switch (kind) {
    case PK_PRO: phase_prologue(a, lds); break;
    case PK_G1A: { pg8::Gemm g{HBin, Wl + W_IN / 2, D, D, D}; pg8::StaticOrder S; S.init(T / 256, N1 / 256, G, c);
        EpiInProj E{(bf16*)(ws + S_ZR), (bf16*)(ws + S_ZQ), (bf16*)(ws + S_ZG), (bf16*)(ws + S_ZM), SS0}; pg8::gemm_phase(lds, g, S, E); } break;
    case PK_PRE: phase_pre(a, l); break;
    case PK_G23: { { pg8::Gemm g{(const bf16*)(ws + S_ZM), Wl + W_2 / 2, K2, NZM, K2}; pg8::StaticOrder S; S.init(T / 256, N2 / 256, G, c);
            EpiMla E{(bf16*)(ws + S_QRAW), (bf16*)(ws + S_KVRAW), (const float*)(ws + WS_CTL + C_RSQ), (const float*)(ws + WS_CTL + C_RSKV)}; pg8::gemm_phase(lds, g, S, E); }
        { pg8::Gemm g{(const bf16*)(ws + S_A2), Wl + W_3 / 2, K3, K3, K3}; pg8::StaticOrder S; S.init(T / 256, N3 / 256, G, c);
            EpiPlain E{(bf16*)(ws + S_L2), N3}; pg8::gemm_phase(lds, g, S, E); } } break;
    case PK_MLAPOST: phase_mla_post(a, l, lds); break;
    case PK_ATT: phase_attn(a, lds); break;
    case PK_RGPREP: phase_rwkv_post(a, l); phase_gdn_prep(a, l); break;
    case PK_SCAN: phase_cprep(a, lds); break;
    case PK_FIN: phase_cscan(a, lds); break;
    case PK_COUT: phase_cout(a, l); break;
    case PK_G1B: { pg8::Gemm g{HBin, Wl + W_GATE / 2, D, D, D}; pg8::StaticOrder S; S.init(T / 256, NGATE / 256, G, c);
        EpiGate E{(bf16*)(ws + S_ZS), SS0}; pg8::gemm_phase(lds, g, S, E); } break;
    case PK_MRG: { pg8::StaticOrder S; S.init(T / 256, D / 256, G, c);
        { pg8::Gemm g{(const bf16*)(ws + S_OA), Wl + W_BRA / 2, HW, HW, HW}; EpiMerge<true> E{(bf16*)(ws + S_M), (const bf16*)(ws + S_ZS), 0}; pg8::gemm_phase(lds, g, S, E); }
        { pg8::Gemm g{(const bf16*)(ws + S_OB), Wl + W_BRB / 2, HW, HW, HW}; EpiMerge<false> E{(bf16*)(ws + S_M), (const bf16*)(ws + S_ZS), 1}; pg8::gemm_phase(lds, g, S, E); }
        { pg8::Gemm g{(const bf16*)(ws + S_OC), Wl + W_BRC / 2, HW, HW, HW}; EpiMerge<false> E{(bf16*)(ws + S_M), (const bf16*)(ws + S_ZS), 2}; pg8::gemm_phase(lds, g, S, E); } } break;
    case PK_OUT: { pg8::Gemm g{(const bf16*)(ws + S_M), Wl + W_OUT / 2, D, D, D}; pg8::StaticOrder S; S.init(T / 256, D / 256, G, c);
        EpiResid E{a.out, HB, SS1}; pg8::gemm_phase(lds, g, S, E); } break;
    case PK_FGU: { pg8::Gemm g{HB, (const bf16*)(ws + WS_W + W_FGU), D, D, D}; pg8::StaticOrder S; S.init(T / 256, 2 * FFD / 256, G, c);
        EpiSwiglu<false> E{(bf16*)(ws + S_ACT), FFD, SS1}; pg8::gemm_phase(lds, g, S, E); } break;
    case PK_FD: { pg8::Gemm g{(const bf16*)(ws + S_ACT), (const bf16*)(ws + WS_W + W_FD), FFD, FFD, FFD}; pg8::StaticOrder S; S.init(T / 256, D / 256, G, c);
        EpiResid E{a.out, HB, nullptr}; pg8::gemm_phase(lds, g, S, E); } break;
    case PK_MOEA: phase_moe_cvt(a, lds); phase_router(a); break;
    case PK_MOEB: phase_assign(a); break;
    case PK_MGU0: case PK_MGU1: { const int half = (kind == PK_MGU1); const int* blke = (const int*)(ws + WS_CTL + C_BLKE); const int nblk = __builtin_amdgcn_readfirstlane(blke[NBLK_MAX]);
        const int lo = half * HALF_BLK, hi = nblk < lo + HALF_BLK ? nblk : lo + HALF_BLK, nM = hi > lo ? hi - lo : 0;
        pg8::Gemm g{(const bf16*)(ws + S_XG), (const bf16*)(ws + S_MWGU), D, D, D}; pg8::StaticOrder S; S.init(nM, 2 * FFE / 256, G, c, lo, blke);
        EpiSwiglu<true> E{(bf16*)(ws + S_MACT) - (size_t)lo * 256 * FFE, FFE, (const float*)(ws + WS_CTL + C_RSX)}; pg8::gemm_phase(lds, g, S, E); } break;
    case PK_MD0: case PK_MD1: { const int half = (kind == PK_MD1); const int* blke = (const int*)(ws + WS_CTL + C_BLKE); const int nblk = __builtin_amdgcn_readfirstlane(blke[NBLK_MAX]);
        const int lo = half * HALF_BLK, hi = nblk < lo + HALF_BLK ? nblk : lo + HALF_BLK, nM = hi > lo ? hi - lo : 0;
        pg8::Gemm g{(const bf16*)(ws + S_MACT) - (size_t)lo * 256 * FFE, (const bf16*)(ws + S_MWD), FFE, FFE, FFE}; pg8::StaticOrder S; S.init(nM, D / 256, G, c, lo, blke);
        EpiPlain E{(bf16*)(ws + S_XG), D}; pg8::gemm_phase(lds, g, S, E); } break;
    case PK_COMB: phase_combine(a); break;
    case PK_PP: { pg8::Gemm g{(const bf16*)(ws + WS_PB) + (size_t)l * T * PLE, Wp + W_PP / 2, PLE, PLE, PLE}; pg8::StaticOrder S; S.init(T / 256, D / 256, G, c);
        EpiPleProj E{(bf16*)(ws + S_E), SSE}; pg8::gemm_phase(lds, g, S, E); } break;
    case PK_PG: { pg8::Gemm g{HB, Wp + W_PG / 2, D, D, D}; pg8::StaticOrder S; S.init(T / 256, D / 256, G, c);
        EpiPleGate E{a.out, l + 1 < NL ? (bf16*)(ws + WS_HB2) : nullptr, (const bf16*)(ws + S_E), SSE, INF(44) + l * D, l + 1 < NL ? SS0 : nullptr}; pg8::gemm_phase(lds, g, S, E); } break;
    default: break;
    }
}

template <int KINDT> __global__ void __launch_bounds__(NTH, 2) k_one(Args a, int l) {
    extern __shared__ __attribute__((aligned(16))) unsigned char lds_raw[];
    run_phase<KINDT>(a, KINDT, l, (LAS unsigned char*)lds_raw);
}
#if MK_ONE_LAUNCH
__global__ void __launch_bounds__(NTH, 2) k_fwd(Args a) {
    extern __shared__ __attribute__((aligned(16))) unsigned char lds_raw[];
    LAS unsigned char* lds = (LAS unsigned char*)lds_raw;
    volatile LAS unsigned* misc = (volatile LAS unsigned*)(lds + LDS_MISC);
    if (threadIdx.x < 64) misc[threadIdx.x] = 0u;
    __syncthreads();
    const XcdBarrier bar = xcd_barrier_post((unsigned*)(a.ws + WS_CTL + C_BAR), misc + 8);
#ifndef PROBE_MASK
#define PROBE_MASK 0u
#endif
#define BAR() xcd_barrier(bar)
#define RUN(K, l) do { if ((PROBE_MASK >> K) & 1u) { run_phase<K>(a, K, l, lds); BAR(); } run_phase<K>(a, K, l, lds); } while (0)
    RUN(PK_PRO, 0); BAR();
#define MIXER(l) RUN(PK_G1A, l); BAR(); RUN(PK_PRE, l); BAR(); RUN(PK_G23, l); BAR(); RUN(PK_MLAPOST, l); BAR(); RUN(PK_ATT, l); BAR(); RUN(PK_RGPREP, l); BAR(); \
        RUN(PK_SCAN, l); BAR(); RUN(PK_FIN, l); BAR(); RUN(PK_COUT, l); BAR(); RUN(PK_G1B, l); BAR(); RUN(PK_MRG, l); BAR(); RUN(PK_OUT, l); BAR();
    MIXER(0)
    RUN(PK_FGU, 0); BAR(); RUN(PK_FD, 0); BAR();
    RUN(PK_PP, 0); BAR(); RUN(PK_PG, 0); BAR();
    MIXER(1)
    RUN(PK_MOEA, 1); BAR(); RUN(PK_MOEB, 1); BAR(); RUN(PK_MGU0, 1); BAR(); RUN(PK_MD0, 1); BAR(); RUN(PK_MGU1, 1); BAR(); RUN(PK_MD1, 1); BAR(); RUN(PK_COMB, 1); BAR();
    RUN(PK_PP, 1); BAR(); RUN(PK_PG, 1);
#undef MIXER
#undef RUN
#undef BAR
}
#endif

#ifndef MK_ONE_LAUNCH
#define MK_ONE_LAUNCH 1
#endif
extern "C" void kernel_launch(void* const* d_in, const int* in_sizes, int n_in, void* d_out, int out_size, void* d_ws, size_t ws_size, hipStream_t stream) {
    static int grid = 0;
    if (grid == 0) {
        if (n_in != 45 || out_size != T * D || ws_size < WS_END) { fprintf(stderr, "kernel_launch: unexpected shapes: n_in %d out %d ws %zu (need %zu)\n", n_in, out_size, ws_size, (size_t)WS_END); grid = -1; return; }
        int dev = 0, cus = 0;
        if (hipGetDevice(&dev) != hipSuccess || hipDeviceGetAttribute(&cus, hipDeviceAttributeMultiprocessorCount, dev) != hipSuccess) { grid = -1; return; }
#if MK_ONE_LAUNCH
        if (hipFuncSetAttribute((const void*)k_fwd, hipFuncAttributeMaxDynamicSharedMemorySize, LDS_BYTES) != hipSuccess) { fprintf(stderr, "kernel_launch: hipFuncSetAttribute failed\n"); grid = -1; return; }
#else
#define SA(K) (void)hipFuncSetAttribute((const void*)k_one<K>, hipFuncAttributeMaxDynamicSharedMemorySize, LDS_BYTES);
        SA(PK_PRO) SA(PK_G1A) SA(PK_PRE) SA(PK_G23) SA(PK_MLAPOST) SA(PK_ATT) SA(PK_RGPREP) SA(PK_SCAN) SA(PK_FIN) SA(PK_G1B) SA(PK_MRG) SA(PK_OUT) SA(PK_FGU) SA(PK_FD) SA(PK_MOEA) SA(PK_MOEB) SA(PK_MGU0) SA(PK_MD0) SA(PK_MGU1) SA(PK_MD1) SA(PK_COMB) SA(PK_PP) SA(PK_PG) SA(PK_COUT)
#undef SA
#endif
        int per_cu = 0;
#if MK_ONE_LAUNCH
        if (hipOccupancyMaxActiveBlocksPerMultiprocessor(&per_cu, (const void*)k_fwd, NTH, LDS_BYTES) != hipSuccess || per_cu < 1) { fprintf(stderr, "kernel_launch: occupancy query says %d blocks/CU\n", per_cu); }
#endif
        (void)hipGetLastError();
        grid = cus;
    }
    if (grid < 0) return;
    (void)hipMemsetAsync((char*)d_ws + WS_CTL, 0, CTL_ZERO, stream);
    (void)hipMemsetAsync((char*)d_ws + WS_W, 0, 71 * MiB, stream);
    Args a{};
    for (int i = 0; i < 45; ++i) a.in[i] = d_in[i];
    a.out = (float*)d_out; a.ws = (unsigned char*)d_ws; a.layer = 0; a.pad = 0;
#if MK_ONE_LAUNCH
    hipLaunchKernelGGL(k_fwd, dim3(grid), dim3(NTH), LDS_BYTES, stream, a);
#else
    static const PhaseEnt prog_h[] = {
        {PK_PRO, 0},
        {PK_G1A, 0}, {PK_PRE, 0}, {PK_G23, 0}, {PK_MLAPOST, 0}, {PK_ATT, 0}, {PK_RGPREP, 0}, {PK_SCAN, 0}, {PK_FIN, 0}, {PK_COUT, 0}, {PK_G1B, 0}, {PK_MRG, 0}, {PK_OUT, 0}, {PK_FGU, 0}, {PK_FD, 0}, {PK_PP, 0}, {PK_PG, 0},
        {PK_G1A, 1}, {PK_PRE, 1}, {PK_G23, 1}, {PK_MLAPOST, 1}, {PK_ATT, 1}, {PK_RGPREP, 1}, {PK_SCAN, 1}, {PK_FIN, 1}, {PK_COUT, 1}, {PK_G1B, 1}, {PK_MRG, 1}, {PK_OUT, 1},
        {PK_MOEA, 1}, {PK_MOEB, 1}, {PK_MGU0, 1}, {PK_MD0, 1}, {PK_MGU1, 1}, {PK_MD1, 1}, {PK_COMB, 1}, {PK_PP, 1}, {PK_PG, 1} };
    for (int p = 0; p < (int)(sizeof(prog_h) / sizeof(prog_h[0])); ++p) { const int l = prog_h[p].layer;
#define LK(K) case K: hipLaunchKernelGGL(k_one<K>, dim3(grid), dim3(NTH), LDS_BYTES, stream, a, l); break;
        switch (prog_h[p].kind) { LK(PK_PRO) LK(PK_G1A) LK(PK_PRE) LK(PK_G23) LK(PK_MLAPOST) LK(PK_ATT) LK(PK_RGPREP) LK(PK_SCAN) LK(PK_FIN) LK(PK_G1B) LK(PK_MRG) LK(PK_OUT) LK(PK_FGU) LK(PK_FD) LK(PK_MOEA) LK(PK_MOEB) LK(PK_MGU0) LK(PK_MD0) LK(PK_MGU1) LK(PK_MD1) LK(PK_COMB) LK(PK_PP) LK(PK_PG) LK(PK_COUT) default: break; }
#undef LK
    }
#endif
}
```

```cpp
#include <hip/hip_runtime.h>
#include <cstdio>
#include <cstdint>
__device__ __forceinline__ int otid() { int t = threadIdx.x; asm volatile("" : "+v"(t)); return t; }
__device__ __forceinline__ int obid() { int t = blockIdx.x; asm volatile("" : "+s"(t)); return t; }
__device__ __forceinline__ int ogrid() { int t = gridDim.x; asm volatile("" : "+s"(t)); return t; }
namespace pg8 {
#define PG8_LAS __attribute__((address_space(3)))
typedef unsigned short bf16_t;
typedef short bf16x8 __attribute__((ext_vector_type(8)));
typedef float f32x4 __attribute__((ext_vector_type(4)));
typedef unsigned u32x4 __attribute__((ext_vector_type(4)));
typedef unsigned u32x2 __attribute__((ext_vector_type(2)));
constexpr int BM = 256, BK = 64, HALF = 128, HTB = HALF * BK * 2, STAGE_BYTES = 8 * HTB, NXCD = 8, WGM = 8;

__host__ __device__ __forceinline__ int lds_byte(int r, int c) { const int st = (r >> 4) * 2 + (c >> 5), rr = r & 15, cc = c & 31, ob = rr * 64 + cc * 2; return st * 1024 + (ob ^ (((ob >> 9) & 1) << 5)); }
__host__ __device__ __forceinline__ void stage_rc(int b, int& R, int& C) { const int st = b / 1024, sb = b % 1024, swz = sb ^ (((sb >> 9) & 1) << 5); R = (st >> 1) * 16 + swz / 64; C = (st & 1) * 32 + (swz % 64) / 2; }
__host__ __device__ __forceinline__ int perm32(int rho) { const int n = rho >> 4, i = rho & 15; return 8 * (i >> 2) + 4 * n + (i & 3); }

struct Unit { int pm, pn, pb; };
struct Gemm { const bf16_t* A; const bf16_t* Bt; int K, lda, ldb; };

struct StaticOrder {
    int nM, nN, nwg, G, c, pm0; const int* blk_e;
    __device__ void init(int nM_, int nN_, int G_, int c_, int pm0_ = 0, const int* blk_e_ = nullptr) { nM = nM_; nN = nN_; nwg = nM * nN; G = G_; c = c_; pm0 = pm0_; blk_e = blk_e_; }
    __device__ bool next(int i, Unit& u) const {
        const long L = (long)i * G + c; if (L >= nwg) return false;
        int wgid = (int)L; { const int q = nwg / NXCD, r = nwg % NXCD, xcd = wgid % NXCD, off = wgid / NXCD; wgid = (xcd < r ? xcd * (q + 1) : r * (q + 1) + (xcd - r) * q) + off; }
        const int nig = WGM * nN, gid = wgid / nig, fm = gid * WGM, gsz = (nM - fm) < WGM ? (nM - fm) : WGM;
        u.pm = pm0 + fm + ((wgid % nig) % gsz); u.pn = (wgid % nig) / gsz;
        u.pb = blk_e ? (__builtin_amdgcn_readfirstlane(blk_e[u.pm]) * nN + u.pn) : u.pn;
        return true;
    }
};

__device__ __forceinline__ unsigned cvt_pk_bf16(float lo, float hi) { unsigned r; asm volatile("v_cvt_pk_bf16_f32 %0, %1, %2" : "=v"(r) : "v"(lo), "v"(hi)); return r; }

template <class Epi, class Sched>
__device__ __forceinline__ void gemm_phase(PG8_LAS unsigned char* lds, const Gemm g, const Sched& S, const Epi& E) {
    const int tid = otid(), wid = __builtin_amdgcn_readfirstlane(tid >> 6), lane = tid & 63, wr = wid >> 2, wc = wid & 3, fr = lane & 15, fq = lane >> 4;
    const int K = g.K, nt = K / BK;
    unsigned voffA[2], voffB[2];
#pragma unroll
    for (int i = 0; i < 2; ++i) { int R, C; stage_rc(tid * 16 + i * 8192, R, C); const int Rb = Epi::PERM ? ((R & ~31) + perm32(R & 31)) : R;
        voffA[i] = (unsigned)(R * g.lda + C) * 2u; voffB[i] = (unsigned)(Rb * g.ldb + C) * 2u; }
    const size_t kstep = (size_t)(BK * 2);
    const size_t hA = (size_t)HALF * g.lda * 2, hB = (size_t)HALF * g.ldb * 2;
    const size_t tA = 2 * hA, tB = 2 * hB;
    const unsigned ldsw = (unsigned)wid * 1024u;
    const int aoff = lds_byte(wr * 64 + fr, fq * 8), boff = lds_byte(wc * 32 + fr, fq * 8);
#define PG8_SA(b, h) (((b) * 2 + (h)) * HTB)
#define PG8_SB(b, h) ((4 + (b) * 2 + (h)) * HTB)
#define PG8_STAGE(bufoff, gbase, voff) do { _Pragma("unroll") for (int _i = 0; _i < 2; ++_i) \
        __builtin_amdgcn_global_load_lds((const unsigned*)((const char*)(gbase) + (voff)[_i]), (PG8_LAS unsigned*)(lds + (bufoff) + ldsw + _i * 8192), 16, 0, 0); } while (0)
#define PG8_LDA(dst, b, h) do { _Pragma("unroll") for (int m = 0; m < 4; ++m) _Pragma("unroll") for (int k = 0; k < 2; ++k) dst[m][k] = *(const PG8_LAS bf16x8*)(lds + PG8_SA(b, h) + aoff + m * 2048 + k * 1024); } while (0)
#define PG8_LDB(dst, b, h) do { _Pragma("unroll") for (int n = 0; n < 2; ++n) _Pragma("unroll") for (int k = 0; k < 2; ++k) dst[n][k] = *(const PG8_LAS bf16x8*)(lds + PG8_SB(b, h) + boff + n * 2048 + k * 1024); } while (0)
#define PG8_MMA(ai, bj, At, Bt) do { __builtin_amdgcn_s_setprio(1); _Pragma("unroll") for (int m = 0; m < 4; ++m) _Pragma("unroll") for (int n = 0; n < 2; ++n) _Pragma("unroll") for (int k = 0; k < 2; ++k) \
        acc[ai][bj][m][n] = __builtin_amdgcn_mfma_f32_16x16x32_bf16(Bt[n][k], At[m][k], acc[ai][bj][m][n], 0, 0, 0); __builtin_amdgcn_s_setprio(0); } while (0)
#define PG8_WAIT_V(n) asm volatile("s_waitcnt vmcnt(" #n ")" ::: "memory")
#define PG8_WAIT_L(n) asm volatile("s_waitcnt lgkmcnt(" #n ")" ::: "memory")
#define PG8_BAR __builtin_amdgcn_s_barrier()
#define PG8_SCHED __builtin_amdgcn_sched_barrier(0)
    Unit cur, nxt; int ui = 0;
    if (!S.next(0, cur)) return;
    f32x4 acc[2][2][4][2];
#pragma unroll
    for (int a = 0; a < 2; ++a)
#pragma unroll
        for (int b = 0; b < 2; ++b)
#pragma unroll
            for (int m = 0; m < 4; ++m)
#pragma unroll
                for (int n = 0; n < 2; ++n) acc[a][b][m][n] = (f32x4){0.f, 0.f, 0.f, 0.f};
    bf16x8 At[4][2], B0[2][2], B1[2][2];
    const char* cA = (const char*)g.A + (size_t)cur.pm * tA; const char* cB = (const char*)g.Bt + (size_t)cur.pb * tB;
    PG8_STAGE(PG8_SB(0, 0), cB, voffB); PG8_STAGE(PG8_SB(0, 1), cB + hB, voffB); PG8_STAGE(PG8_SA(0, 0), cA, voffA); PG8_STAGE(PG8_SA(0, 1), cA + hA, voffA);
    if (wr == 1) PG8_BAR;
    PG8_WAIT_V(2); PG8_BAR;
    PG8_STAGE(PG8_SB(1, 0), cB + kstep, voffB); PG8_STAGE(PG8_SA(1, 0), cA + kstep, voffA); PG8_STAGE(PG8_SB(1, 1), cB + hB + kstep, voffB);
    PG8_WAIT_V(6); PG8_BAR;
    for (;;) {
        const bool has_next = S.next(ui + 1, nxt);
        const char* nA = has_next ? (const char*)g.A + (size_t)nxt.pm * tA : cA; const char* nB = has_next ? (const char*)g.Bt + (size_t)nxt.pb * tB : cB;
        for (int t = 0; t < nt; t += 2) {
            const bool last = (t == nt - 2);
            const char* a1 = cA + (size_t)(t + 1) * kstep;
            const char* a2 = last ? nA : cA + (size_t)(t + 2) * kstep; const char* b2 = last ? nB : cB + (size_t)(t + 2) * kstep;
            const char* a3 = a2 + kstep; const char* b3 = b2 + kstep;
            PG8_LDB(B0, 0, 0); PG8_LDB(B1, 0, 1); PG8_SCHED; PG8_LDA(At, 0, 0); PG8_STAGE(PG8_SA(1, 1), a1 + hA, voffA);
            PG8_WAIT_V(8); PG8_WAIT_L(0); PG8_BAR; PG8_MMA(0, 0, At, B0); PG8_MMA(0, 1, At, B1); PG8_BAR; PG8_SCHED;
            PG8_LDA(At, 0, 1); PG8_STAGE(PG8_SB(0, 0), b2, voffB); PG8_STAGE(PG8_SB(0, 1), b2 + hB, voffB); PG8_STAGE(PG8_SA(0, 0), a2, voffA);
            PG8_WAIT_V(8); PG8_WAIT_L(0); PG8_BAR; PG8_MMA(1, 0, At, B0); PG8_MMA(1, 1, At, B1); PG8_BAR; PG8_SCHED;
            PG8_LDB(B0, 1, 0); PG8_LDB(B1, 1, 1); PG8_SCHED; PG8_LDA(At, 1, 0); PG8_STAGE(PG8_SA(0, 1), a2 + hA, voffA);
            PG8_WAIT_V(8); PG8_WAIT_L(0); PG8_BAR; PG8_MMA(0, 0, At, B0); PG8_MMA(0, 1, At, B1); PG8_BAR; PG8_SCHED;
            PG8_LDA(At, 1, 1); PG8_STAGE(PG8_SB(1, 0), b3, voffB); PG8_STAGE(PG8_SB(1, 1), b3 + hB, voffB); PG8_STAGE(PG8_SA(1, 0), a3, voffA);
            PG8_WAIT_V(8); PG8_WAIT_L(0); PG8_BAR; PG8_MMA(1, 0, At, B0); PG8_MMA(1, 1, At, B1); PG8_BAR; PG8_SCHED;
        }
        if (wr == 0) PG8_BAR;
        E(acc, cur, wr, wc, fr, fq);
        if (!has_next) break;
#pragma unroll
        for (int a = 0; a < 2; ++a)
#pragma unroll
            for (int b = 0; b < 2; ++b)
#pragma unroll
                for (int m = 0; m < 4; ++m)
#pragma unroll
                    for (int n = 0; n < 2; ++n) acc[a][b][m][n] = (f32x4){0.f, 0.f, 0.f, 0.f};
        cur = nxt; cA = nA; cB = nB; ++ui;
        if (wr == 1) PG8_BAR;
    }
    PG8_WAIT_V(0);
    PG8_BAR;
#undef PG8_SA
#undef PG8_SB
#undef PG8_STAGE
#undef PG8_LDA
#undef PG8_LDB
#undef PG8_MMA
#undef PG8_WAIT_V
#undef PG8_WAIT_L
#undef PG8_BAR
#undef PG8_SCHED
}
}
#define GAS __attribute__((address_space(1)))
#define LAS __attribute__((address_space(3)))
typedef unsigned short bf16;
typedef float f32x4 __attribute__((ext_vector_type(4)));
typedef float f32x2 __attribute__((ext_vector_type(2)));
typedef float f32x16 __attribute__((ext_vector_type(16)));
typedef short bf16x8 __attribute__((ext_vector_type(8)));
typedef unsigned u32x4 __attribute__((ext_vector_type(4)));
typedef unsigned u32x2 __attribute__((ext_vector_type(2)));

constexpr int NB = 4, SEQ = 4096, T = NB * SEQ, D = 1024, NL = 2;
constexpr int NH = 8, HD = 64, HW = 512;
constexpr int N_IN = 7344, FFD = 2816, FFE = 3584, NE = 8, PLE = 256;
constexpr int N1 = 4352, NZR = 1792, NZQ = 1536, NZG = 512, NZM = 512, NGATE = 3072;
constexpr int K2 = 512, N2 = 1792, K3 = 384, N3 = 2048;
constexpr int QKD = 96;
constexpr int NBLK_MAX = 136, HALF_BLK = 68;
constexpr float NORM_EPS = 1e-6f;
constexpr int NTH = 512, NWV = 8;

constexpr size_t MiB = 1u << 20;
constexpr size_t WS_CTL = 0;
constexpr size_t WS_W = 2 * MiB;
constexpr size_t WS_HB = 73 * MiB;
constexpr size_t WS_PB = 105 * MiB;
constexpr size_t WS_VF = 121 * MiB;
constexpr size_t WS_S = 137 * MiB;
constexpr size_t WS_END = 553 * MiB;
constexpr size_t S_ZR = WS_S + 0 * MiB, S_ZQ = WS_S + 56 * MiB, S_ZG = WS_S + 104 * MiB, S_ZM = WS_S + 120 * MiB;
constexpr size_t S_A2 = WS_S + 136 * MiB, S_L2 = WS_S + 148 * MiB;
constexpr size_t S_QRAW = WS_S + 212 * MiB, S_KVRAW = WS_S + 236 * MiB, S_Q = WS_S + 268 * MiB, S_K = WS_S + 292 * MiB, S_VT = WS_S + 316 * MiB, S_OB = WS_S + 332 * MiB;
constexpr size_t S_RR = WS_S + 212 * MiB, S_RK = WS_S + 228 * MiB, S_RV = WS_S + 244 * MiB, S_RA = WS_S + 260 * MiB, S_RB = WS_S + 276 * MiB, S_RW = WS_S + 292 * MiB, S_RG = WS_S + 348 * MiB;
constexpr size_t S_GQ = WS_S + 364 * MiB, S_GK = WS_S + 380 * MiB, S_GV = WS_S + 396 * MiB, S_GAL = WS_S + 412 * MiB, S_GBE = WS_S + 412 * MiB + 524288;
constexpr size_t S_YA = WS_S + 148 * MiB, S_YC = WS_S + 164 * MiB, S_OA = WS_S + 212 * MiB, S_OC = WS_S + 228 * MiB;
constexpr size_t S_ZS = WS_S + 0 * MiB, S_M = WS_S + 348 * MiB;
constexpr size_t S_CMR = WS_S + 0 * MiB, S_S0R = WS_S + 64 * MiB, S_CMG = WS_S + 120 * MiB, S_S0G = WS_S + 184 * MiB;
constexpr size_t S_ACT = WS_S + 0 * MiB;
constexpr size_t S_MWGU = WS_S + 0 * MiB;
constexpr size_t S_MWD = WS_S + 112 * MiB;
constexpr size_t S_XG = WS_S + 168 * MiB;
constexpr size_t S_MACT = WS_S + 237 * MiB;
constexpr size_t S_E = WS_S + 358 * MiB;
constexpr size_t S_SSP0 = WS_S + 413 * MiB, S_SSP1 = WS_S + 414 * MiB, S_SSP2 = WS_S + 415 * MiB;
static_assert(S_SSP2 + MiB <= WS_END, "ws map");
static_assert(S_E + 32 * MiB <= WS_END, "ws map");
static_assert(S_MACT + (size_t)HALF_BLK * 256 * FFE * 2 <= S_E, "ws map");
static_assert(S_XG + (size_t)NBLK_MAX * 256 * D * 2 <= S_MACT, "ws map");
static_assert(S_GBE + 524288 <= WS_END, "ws map");

constexpr size_t WL = 41 * MiB;
constexpr size_t W_IN = 0, W_GATE = 9 * MiB, W_2 = 15 * MiB, W_3 = 17 * MiB, W_BRA = 19 * MiB, W_BRB = 20 * MiB, W_BRC = 21 * MiB, W_OUT = 22 * MiB;
constexpr size_t W_FGU = 24 * MiB, W_FD = 35 * MiB;
constexpr size_t W_PLE = 65 * MiB, WPL = 2 * MiB + 524288, W_PP = 0, W_PG = 524288;
static_assert(W_FD + (size_t)D * FFD * 2 <= WL && W_PLE + 2 * WPL <= 71 * MiB, "w map");
constexpr size_t WS_HB2 = WS_W;
constexpr size_t CTL_ZERO = 512 * 1024;
constexpr size_t C_BAR = 0;
constexpr size_t C_MOE = 16384;
constexpr size_t C_SS = 65536;
constexpr size_t C_RSQ = 512 * 1024, C_RSKV = C_RSQ + 65536;
constexpr size_t C_SEL = C_RSKV + 65536;
constexpr size_t C_WTS = C_SEL + 131072;
constexpr size_t C_RANK = C_WTS + 131072;
constexpr size_t C_DEST = C_RANK + 131072;
constexpr size_t C_RSX = C_DEST + 131072;
constexpr size_t C_BLKE = C_RSX + 139264;
constexpr size_t C_RS1 = C_BLKE + 1024;
constexpr size_t C_BSC = C_RS1 + 65536;
static_assert(C_BSC + 524288 <= 2 * MiB, "ctl map");

__device__ __forceinline__ float bf2f(unsigned v) { return __uint_as_float(v << 16); }
__device__ __forceinline__ unsigned f2bf(float f) { unsigned u = __float_as_uint(f); return (u + 0x7fffu + ((u >> 16) & 1u)) >> 16; }
__device__ __forceinline__ unsigned pk2(float lo, float hi) { return f2bf(lo) | (f2bf(hi) << 16); }
__device__ __forceinline__ float wave_sum(float v) {
#pragma unroll
    for (int o = 1; o < 64; o <<= 1) v += __shfl_xor(v, o);
    return v;
}
__device__ __forceinline__ float sigmoidf_(float x) { return 1.f / (1.f + __expf(-x)); }
__device__ __forceinline__ float siluf_(float x) { return x / (1.f + __expf(-x)); }
__device__ __forceinline__ float softplusf_(float x) { return fmaxf(x, 0.f) + log1pf(__expf(-fabsf(x))); }

struct Args { const void* in[45]; float* out; unsigned char* ws; int layer; int pad; };
typedef const void* gptr_t;
typedef const __attribute__((address_space(4))) gptr_t* kin_t;
struct PArgs { kin_t in; float* out; unsigned char* ws; };
__device__ __forceinline__ PArgs make_pargs(const Args& a) {
    PArgs p; p.in = (kin_t)__builtin_amdgcn_kernarg_segment_ptr(); p.out = a.out; p.ws = a.ws;
    asm volatile("" : "+s"(p.in), "+s"(p.out), "+s"(p.ws)); return p; }
#define INF(i) ((const float*)a.in[i])
#define EPI_ARGS const pg8::f32x4 (&acc)[2][2][4][2], const pg8::Unit& u, int wr, int wc, int fr, int fq
#define EPI_ROWS _Pragma("unroll") for (int ai = 0; ai < 2; ++ai) _Pragma("unroll") for (int m = 0; m < 4; ++m)
__device__ __forceinline__ u32x4 pack8(const f32x4 v0, const f32x4 v1) { u32x4 w; w.x = pg8::cvt_pk_bf16(v0[0], v0[1]); w.y = pg8::cvt_pk_bf16(v0[2], v0[3]); w.z = pg8::cvt_pk_bf16(v1[0], v1[1]); w.w = pg8::cvt_pk_bf16(v1[2], v1[3]); return w; }
__device__ __forceinline__ void unpack8(const u32x4 w, float (&f)[8]) { f[0] = bf2f(w.x & 0xffffu); f[1] = bf2f(w.x >> 16); f[2] = bf2f(w.y & 0xffffu); f[3] = bf2f(w.y >> 16); f[4] = bf2f(w.z & 0xffffu); f[5] = bf2f(w.z >> 16); f[6] = bf2f(w.w & 0xffffu); f[7] = bf2f(w.w >> 16); }

__device__ __forceinline__ float rowscale16(const float* ssp, int r) { const f32x4* p = (const f32x4*)(ssp + (size_t)r * 16); const f32x4 a = p[0], b = p[1], c = p[2], d = p[3];
    const float s = ((a[0] + a[1]) + (a[2] + a[3])) + ((b[0] + b[1]) + (b[2] + b[3])) + ((c[0] + c[1]) + (c[2] + c[3])) + ((d[0] + d[1]) + (d[2] + d[3])); return rsqrtf(s * (1.f / D) + NORM_EPS); }
struct EpiInProj {
    static constexpr bool PERM = true;
    bf16 *zr, *zq, *zg, *zm; const float* ss;
    __device__ __forceinline__ void operator()(EPI_ARGS) const {
        bf16* O; int ld, ct; const int pn = u.pn;
        if (pn < 7) { O = zr; ld = NZR; ct = pn * 256; } else if (pn < 13) { O = zq; ld = NZQ; ct = (pn - 7) * 256; } else if (pn < 15) { O = zg; ld = NZG; ct = (pn - 13) * 256; } else { O = zm; ld = NZM; ct = (pn - 15) * 256; }
        const int row0 = u.pm * 256 + wr * 64 + fr, col0 = ct + wc * 32 + 8 * fq;
        EPI_ROWS { const int r = row0 + ai * 128 + m * 16; const float s = rowscale16(ss, r); bf16* rowp = O + (size_t)r * ld + col0;
#pragma unroll
            for (int bj = 0; bj < 2; ++bj) *(u32x4*)(rowp + bj * 128) = pack8(acc[ai][bj][m][0] * s, acc[ai][bj][m][1] * s); }
    }
};
struct EpiGate {
    static constexpr bool PERM = true;
    bf16* O; const float* ss;
    __device__ __forceinline__ void operator()(EPI_ARGS) const {
        const int row0 = u.pm * 256 + wr * 64 + fr, col0 = u.pn * 256 + wc * 32 + 8 * fq;
        EPI_ROWS { const int r = row0 + ai * 128 + m * 16; const float s = rowscale16(ss, r); bf16* rowp = O + (size_t)r * NGATE + col0;
#pragma unroll
            for (int bj = 0; bj < 2; ++bj) { f32x4 v0 = acc[ai][bj][m][0] * s, v1 = acc[ai][bj][m][1] * s;
#pragma unroll
                for (int j = 0; j < 4; ++j) { v0[j] = sigmoidf_(v0[j]); v1[j] = sigmoidf_(v1[j]); }
                *(u32x4*)(rowp + bj * 128) = pack8(v0, v1); } }
    }
};
struct EpiMla {
    static constexpr bool PERM = true;
    bf16 *qraw, *kvraw; const float *rsq, *rskv;
    __device__ __forceinline__ void operator()(EPI_ARGS) const {
        const bool isq = u.pn < 3; bf16* O = isq ? qraw : kvraw; const int ld = isq ? 768 : 1024, ct = isq ? u.pn * 256 : (u.pn - 3) * 256; const float* rs = isq ? rsq : rskv;
        const int row0 = u.pm * 256 + wr * 64 + fr, col0 = ct + wc * 32 + 8 * fq;
        EPI_ROWS { const int r = row0 + ai * 128 + m * 16; const float s = rs[r]; bf16* rowp = O + (size_t)r * ld + col0;
#pragma unroll
            for (int bj = 0; bj < 2; ++bj) *(u32x4*)(rowp + bj * 128) = pack8(acc[ai][bj][m][0] * s, acc[ai][bj][m][1] * s); }
    }
};
struct EpiPlain {
    static constexpr bool PERM = true;
    bf16* O; int ld;
    __device__ __forceinline__ void operator()(EPI_ARGS) const {
        const int row0 = u.pm * 256 + wr * 64 + fr, col0 = u.pn * 256 + wc * 32 + 8 * fq;
        EPI_ROWS { const int r = row0 + ai * 128 + m * 16; bf16* rowp = O + (size_t)r * ld + col0;
#pragma unroll
            for (int bj = 0; bj < 2; ++bj) *(u32x4*)(rowp + bj * 128) = pack8(acc[ai][bj][m][0], acc[ai][bj][m][1]); }
    }
};
template <bool FIRST> struct EpiMerge {
    static constexpr bool PERM = true;
    bf16* M; const bf16* zs; int br;
    __device__ __forceinline__ void operator()(EPI_ARGS) const {
        const int row0 = u.pm * 256 + wr * 64 + fr, col0 = u.pn * 256 + wc * 32 + 8 * fq;
        EPI_ROWS { const int r = row0 + ai * 128 + m * 16;
#pragma unroll
            for (int bj = 0; bj < 2; ++bj) { const int c = col0 + bj * 128; float g[8], o[8]; unpack8(*(const u32x4*)(zs + (size_t)r * NGATE + br * 1024 + c), g);
                if (!FIRST) unpack8(*(const u32x4*)(M + (size_t)r * D + c), o);
                f32x4 v0, v1;
#pragma unroll
                for (int j = 0; j < 4; ++j) { v0[j] = g[j] * acc[ai][bj][m][0][j] + (FIRST ? 0.f : o[j]); v1[j] = g[4 + j] * acc[ai][bj][m][1][j] + (FIRST ? 0.f : o[4 + j]); }
                *(u32x4*)(M + (size_t)r * D + c) = pack8(v0, v1); } }
    }
};
struct EpiResid {
    static constexpr bool PERM = false;
    float* out; bf16* hb; float* ss;
    __device__ __forceinline__ void operator()(EPI_ARGS) const {
        const int row0 = u.pm * 256 + wr * 64 + fr, col0 = u.pn * 256 + wc * 32 + 4 * fq;
        EPI_ROWS { const int r = row0 + ai * 128 + m * 16; float sq = 0.f;
#pragma unroll
            for (int bj = 0; bj < 2; ++bj)
#pragma unroll
                for (int n = 0; n < 2; ++n) { const size_t off = (size_t)r * D + col0 + bj * 128 + n * 16; f32x4 h = *(const f32x4*)(out + off); h += acc[ai][bj][m][n]; *(f32x4*)(out + off) = h;
                    u32x2 w; w.x = pg8::cvt_pk_bf16(h[0], h[1]); w.y = pg8::cvt_pk_bf16(h[2], h[3]); *(u32x2*)(hb + off) = w; sq += (h[0] * h[0] + h[1] * h[1]) + (h[2] * h[2] + h[3] * h[3]); }
            if (ss) { sq += __shfl_xor(sq, 16); sq += __shfl_xor(sq, 32); if (fq == 0) ss[(size_t)r * 16 + u.pn * 4 + wc] = sq; } }
    }
};
template <bool MOE> struct EpiSwiglu {
    static constexpr bool PERM = true;
    bf16* O; int ld; const float* rs;
    __device__ __forceinline__ void operator()(EPI_ARGS) const {
        const int row0 = u.pm * 256 + wr * 64 + fr, col0 = u.pn * 128 + wc * 32 + 8 * fq;
        EPI_ROWS { const int r = row0 + ai * 128 + m * 16; const float s = MOE ? rs[r] : rowscale16(rs, r);
            f32x4 v0, v1;
#pragma unroll
            for (int j = 0; j < 4; ++j) { v0[j] = siluf_(acc[ai][0][m][0][j] * s) * (acc[ai][1][m][0][j] * s); v1[j] = siluf_(acc[ai][0][m][1][j] * s) * (acc[ai][1][m][1][j] * s); }
            *(u32x4*)(O + (size_t)r * ld + col0) = pack8(v0, v1); }
    }
};
struct EpiPleProj {
    static constexpr bool PERM = true;
    bf16* O; float* sse;
    __device__ __forceinline__ void operator()(EPI_ARGS) const {
        const int row0 = u.pm * 256 + wr * 64 + fr, col0 = u.pn * 256 + wc * 32 + 8 * fq;
        EPI_ROWS { const int r = row0 + ai * 128 + m * 16; float sq = 0.f;
#pragma unroll
            for (int bj = 0; bj < 2; ++bj) { const f32x4 v0 = acc[ai][bj][m][0], v1 = acc[ai][bj][m][1]; *(u32x4*)(O + (size_t)r * D + col0 + bj * 128) = pack8(v0, v1);
                sq += (v0[0] * v0[0] + v0[1] * v0[1]) + (v0[2] * v0[2] + v0[3] * v0[3]) + (v1[0] * v1[0] + v1[1] * v1[1]) + (v1[2] * v1[2] + v1[3] * v1[3]); }
            sq += __shfl_xor(sq, 16); sq += __shfl_xor(sq, 32); if (fq == 0) sse[(size_t)r * 16 + u.pn * 4 + wc] = sq; }
    }
};
struct EpiPleGate {
    static constexpr bool PERM = false;
    float* out; bf16* hb; const bf16* E; const float* sse; const float* png; float* ssn;
    __device__ __forceinline__ void operator()(EPI_ARGS) const {
        const int row0 = u.pm * 256 + wr * 64 + fr, col0 = u.pn * 256 + wc * 32 + 4 * fq;
        EPI_ROWS { const int r = row0 + ai * 128 + m * 16; float sq = 0.f; const float se = rowscale16(sse, r);
#pragma unroll
            for (int bj = 0; bj < 2; ++bj)
#pragma unroll
                for (int n = 0; n < 2; ++n) { const int c = col0 + bj * 128 + n * 16; const size_t off = (size_t)r * D + c; f32x4 h = *(const f32x4*)(out + off);
                    const u32x2 ew = *(const u32x2*)(E + off); const f32x4 g = *(const f32x4*)(png + c);
                    const float e0 = bf2f(ew.x & 0xffffu), e1 = bf2f(ew.x >> 16), e2 = bf2f(ew.y & 0xffffu), e3 = bf2f(ew.y >> 16);
                    const f32x4 a4 = acc[ai][bj][m][n];
                    h[0] += sigmoidf_(a4[0]) * (e0 * se * g[0]); h[1] += sigmoidf_(a4[1]) * (e1 * se * g[1]); h[2] += sigmoidf_(a4[2]) * (e2 * se * g[2]); h[3] += sigmoidf_(a4[3]) * (e3 * se * g[3]);
                    *(f32x4*)(out + off) = h; if (hb) { u32x2 w; w.x = pg8::cvt_pk_bf16(h[0], h[1]); w.y = pg8::cvt_pk_bf16(h[2], h[3]); *(u32x2*)(hb + off) = w; }
                    sq += (h[0] * h[0] + h[1] * h[1]) + (h[2] * h[2] + h[3] * h[3]); }
            if (ssn) { sq += __shfl_xor(sq, 16); sq += __shfl_xor(sq, 32); if (fq == 0) ssn[(size_t)r * 16 + u.pn * 4 + wc] = sq; } }
    }
};
struct TJob { int src, src_off, K, ldn, n0, ncnt; int dst_off, dst_ld, dst_k0, dst_row0, rowmode; int gain, gain_off, gain2, gain2_off, g2mode; };
#define WOFF(l, o) ((int)((l) * WL + (o)))
#define LAYER_JOBS(l) \
    {4, (l) * D * N_IN, D, N_IN, 0, 1792, WOFF(l, W_IN), D, 0, 0, 0, 3, (l) * D, -1, 0, 0}, \
    {4, (l) * D * N_IN, D, N_IN, 2208, 1536, WOFF(l, W_IN), D, 0, 1792, 0, 3, (l) * D, -1, 0, 0}, \
    {4, (l) * D * N_IN, D, N_IN, 3760, 512, WOFF(l, W_IN), D, 0, 3328, 0, 3, (l) * D, -1, 0, 0}, \
    {4, (l) * D * N_IN, D, N_IN, 1792, 416, WOFF(l, W_IN), D, 0, 3840, 0, 3, (l) * D, -1, 0, 0}, \
    {4, (l) * D * N_IN, D, N_IN, 3744, 16, WOFF(l, W_IN), D, 0, 3840 + 416, 0, 3, (l) * D, -1, 0, 0}, \
    {4, (l) * D * N_IN, D, N_IN, 4272, 3072, WOFF(l, W_GATE), D, 0, 0, 0, 3, (l) * D, -1, 0, 0}, \
    {7, (l) * 64 * 512, 64, 512, 0, 512, WOFF(l, W_3), K3, 0, 0, 0, -1, 0, -1, 0, 0}, \
    {9, (l) * 64 * 512, 64, 512, 0, 512, WOFF(l, W_3), K3, 64, 512, 0, -1, 0, -1, 0, 0}, \
    {10, (l) * 128 * 512, 128, 512, 0, 512, WOFF(l, W_3), K3, 128, 1024, 0, -1, 0, -1, 0, 0}, \
    {22, (l) * 256 * 768, 256, 768, 0, 768, WOFF(l, W_2), K2, 0, 0, 0, 20, (l) * 256, -1, 0, 0}, \
    {23, (l) * 128 * 1024, 128, 1024, 0, 1024, WOFF(l, W_2), K2, 256, 768, 0, 21, (l) * 128, -1, 0, 0}, \
    {30, (l) * 512 * 1024, 512, 1024, 0, 1024, WOFF(l, W_BRA), 512, 0, 0, 0, -1, 0, -1, 0, 0}, \
    {31, (l) * 512 * 1024, 512, 1024, 0, 1024, WOFF(l, W_BRB), 512, 0, 0, 0, -1, 0, -1, 0, 0}, \
    {32, (l) * 512 * 1024, 512, 1024, 0, 1024, WOFF(l, W_BRC), 512, 0, 0, 0, -1, 0, -1, 0, 0}, \
    {33, (l) * D * D, D, D, 0, D, WOFF(l, W_OUT), D, 0, 0, 0, -1, 0, -1, 0, 0}, \
    {42, (l) * PLE * D, PLE, D, 0, D, (int)(W_PLE + (l) * WPL + W_PP), PLE, 0, 0, 0, -1, 0, -1, 0, 0}, \
    {43, (l) * D * D, D, D, 0, D, (int)(W_PLE + (l) * WPL + W_PG), D, 0, 0, 0, -1, 0, -1, 0, 0}
__constant__ TJob g_jobs[] = {
    LAYER_JOBS(0), LAYER_JOBS(1),
    {17, 0, D, 32, 0, 32, WOFF(1, W_IN), D, 0, 3840 + 432, 0, 3, 1 * D, 16, 0, 1},
    {17, 0, D, 32, 0, 32, WOFF(1, W_IN), D, 0, 3840 + 464, 0, 3, 1 * D, 16, 0, 2},
    {18, 0, 32, 512, 0, 512, WOFF(1, W_3), K3, 256, 1536, 0, -1, 0, -1, 0, 0},
    {35, 0, D, FFD, 0, FFD, (int)W_FGU, D, 0, 0, 1, 34, 0, -1, 0, 0},
    {36, 0, D, FFD, 0, FFD, (int)W_FGU, D, 0, 0, 2, 34, 0, -1, 0, 0},
    {37, 0, FFD, D, 0, D, (int)W_FD, FFD, 0, 0, 0, -1, 0, -1, 0, 0},
};
constexpr int NJOBS = sizeof(g_jobs) / sizeof(TJob);

__device__ __forceinline__ void transpose_item(const PArgs& a, const TJob& j, bf16* dstbase, LAS float* scr, int item, int lane) {
    const float* W = INF(j.src) + j.src_off;
    const int nblk = (j.ncnt + 31) / 32, kb = item / nblk, nb = item % nblk, k0 = 64 * kb, nl0 = 32 * nb;
    const int nl = nl0 + (lane & 31);
    float v[32];
#pragma unroll
    for (int i = 0; i < 32; ++i) { const int k = k0 + 2 * i + (lane >> 5); v[i] = (k < j.K && nl < j.ncnt) ? W[(size_t)k * j.ldn + j.n0 + nl] : 0.f; }
    const int c = lane & 7;
    float gn[8];
#pragma unroll
    for (int e = 0; e < 8; ++e) gn[e] = 1.f;
    if (k0 + 8 * c < j.K) {
        if (j.gain >= 0) { const float* G1 = INF(j.gain) + j.gain_off + k0 + 8 * c; const f32x4 g0 = *(const f32x4*)G1, g1 = *(const f32x4*)(G1 + 4);
#pragma unroll
            for (int e = 0; e < 4; ++e) { gn[e] = g0[e]; gn[4 + e] = g1[e]; } }
        if (j.gain2 >= 0) { const float* G2 = INF(j.gain2) + j.gain2_off + k0 + 8 * c; const f32x4 g0 = *(const f32x4*)G2, g1 = *(const f32x4*)(G2 + 4);
#pragma unroll
            for (int e = 0; e < 4; ++e) { gn[e] *= (j.g2mode == 1) ? (1.f - g0[e]) : g0[e]; gn[4 + e] *= (j.g2mode == 1) ? (1.f - g1[e]) : g1[e]; } } }
#pragma unroll
    for (int i = 0; i < 32; ++i) scr[(2 * i + (lane >> 5)) * 33 + (lane & 31)] = v[i];
    asm volatile("s_waitcnt lgkmcnt(0)" ::: "memory");
    if (k0 + 8 * c < j.K) {
#pragma unroll
        for (int q = 0; q < 4; ++q) { const int nloc = (lane >> 3) + 8 * q, n = nl0 + nloc; if (n < j.ncnt) { const LAS float* s = scr + (8 * c) * 33 + nloc;
            u32x4 o; o.x = pk2(s[0 * 33] * gn[0], s[1 * 33] * gn[1]); o.y = pk2(s[2 * 33] * gn[2], s[3 * 33] * gn[3]); o.z = pk2(s[4 * 33] * gn[4], s[5 * 33] * gn[5]); o.w = pk2(s[6 * 33] * gn[6], s[7 * 33] * gn[7]);
            const int row = j.dst_row0 + (j.rowmode == 0 ? n : (n / 128) * 256 + (n % 128) + (j.rowmode == 2 ? 128 : 0));
            *(u32x4*)(dstbase + (size_t)row * j.dst_ld + j.dst_k0 + k0 + 8 * c) = o; } }
    }
    asm volatile("s_waitcnt lgkmcnt(0)" ::: "memory");
}

__device__ __forceinline__ void phase_prologue(const PArgs& a, LAS unsigned char* lds) {
    const int bidx_ = obid();
    const int tid = otid(), lane = tid & 63, wave = __builtin_amdgcn_readfirstlane(tid >> 6), G = ogrid();
    const int gw = bidx_ * NWV + wave, NGW = G * NWV;
    LAS float* scr = (LAS float*)(lds + wave * 16384);
    { int ji = 0, base = 0, nit = ((g_jobs[0].K + 63) / 64) * ((g_jobs[0].ncnt + 31) / 32);
      for (int it = gw; ; it += NGW) {
          while (ji < NJOBS && it >= base + nit) { base += nit; ++ji; if (ji < NJOBS) nit = ((g_jobs[ji].K + 63) / 64) * ((g_jobs[ji].ncnt + 31) / 32); }
          if (ji >= NJOBS) break;
          const TJob j = g_jobs[ji]; transpose_item(a, j, (bf16*)(a.ws + WS_W + j.dst_off), scr, it - base, lane); } }
    const float* x = INF(0); bf16* hb = (bf16*)(a.ws + WS_HB); float* ss0 = (float*)(a.ws + S_SSP0);
    for (int m = gw; m < T; m += NGW) { const f32x4* xr = (const f32x4*)(x + (size_t)m * D) + lane; f32x4* orow = (f32x4*)(a.out + (size_t)m * D) + lane; u32x2* hrow = (u32x2*)(hb + (size_t)m * D) + lane;
        float s = 0.f;
#pragma unroll
        for (int q = 0; q < 4; ++q) { const f32x4 v = xr[64 * q]; orow[64 * q] = v; u32x2 w; w.x = pk2(v[0], v[1]); w.y = pk2(v[2], v[3]); hrow[64 * q] = w; s += (v[0] * v[0] + v[1] * v[1]) + (v[2] * v[2] + v[3] * v[3]); }
        s = wave_sum(s); if (lane < 16) ss0[(size_t)m * 16 + lane] = lane == 0 ? s : 0.f; }
    const f32x4* p4 = (const f32x4*)INF(1); u32x2* pb = (u32x2*)(a.ws + WS_PB);
    for (size_t i = (size_t)bidx_ * NTH + tid; i < (size_t)NL * T * PLE / 4; i += (size_t)G * NTH) { const f32x4 v = p4[i]; u32x2 w; w.x = pk2(v[0], v[1]); w.y = pk2(v[2], v[3]); pb[i] = w; }
}

__device__ __forceinline__ void phase_moe_cvt(const PArgs& a, LAS unsigned char* lds) {
    const int bidx_ = obid();
    const int tid = otid(), lane = tid & 63, wave = __builtin_amdgcn_readfirstlane(tid >> 6), G = ogrid();
    const int gw = bidx_ * NWV + wave, NGW = G * NWV;
    LAS float* scr = (LAS float*)(lds + wave * 16384);
    constexpr int IT_GU = (D / 64) * (FFE / 32), IT_D = (FFE / 64) * (D / 32);
    constexpr int PER_E = 2 * IT_GU + IT_D;
    for (int it = gw; it < NE * PER_E; it += NGW) { const int e = it / PER_E; int r = it % PER_E;
        TJob j; j.gain2 = -1; j.gain2_off = 0; j.g2mode = 0; j.n0 = 0; j.dst_k0 = 0;
        if (r < 2 * IT_GU) { const int up = r >= IT_GU; if (up) r -= IT_GU; j.src = up ? 40 : 39; j.src_off = e * D * FFE; j.K = D; j.ldn = FFE; j.ncnt = FFE; j.dst_ld = D; j.dst_row0 = e * 2 * FFE; j.rowmode = up ? 2 : 1; j.gain = 34; j.gain_off = D;
            transpose_item(a, j, (bf16*)(a.ws + S_MWGU), scr, r, lane); }
        else { r -= 2 * IT_GU; j.src = 41; j.src_off = e * FFE * D; j.K = FFE; j.ldn = D; j.ncnt = D; j.dst_ld = FFE; j.dst_row0 = e * D; j.rowmode = 0; j.gain = -1; j.gain_off = 0;
            transpose_item(a, j, (bf16*)(a.ws + S_MWD), scr, r, lane); } }
}
__device__ __forceinline__ void phase_pre(const PArgs& a, int l) {
    const int bidx_ = obid();
    const int tid = otid(), lane = tid & 63, wave = tid >> 6, G = ogrid();
    const bf16* zr = (const bf16*)(a.ws + S_ZR); const bf16* zm = (const bf16*)(a.ws + S_ZM); bf16* A2 = (bf16*)(a.ws + S_A2);
    float* rsq = (float*)(a.ws + WS_CTL + C_RSQ); float* rskv = (float*)(a.ws + WS_CTL + C_RSKV);
    constexpr int TT = 8;
    const float mu = tid < 256 ? INF(5)[l * 1792 + 1536 + tid] : 0.f;
    for (int g = bidx_; g < T / TT; g += G) { const int t0 = g * TT;
        if (tid < 256) { const int col = 1536 + tid; float v[TT + 1];
            v[0] = (t0 % SEQ == 0) ? 0.f : bf2f(zr[(size_t)(t0 - 1) * NZR + col]);
#pragma unroll
            for (int i = 0; i < TT; ++i) v[i + 1] = bf2f(zr[(size_t)(t0 + i) * NZR + col]);
#pragma unroll
            for (int i = 0; i < TT; ++i) { float x = v[i + 1] + (v[i] - v[i + 1]) * mu; if (tid < 64) x = tanhf(x); else if (tid >= 128) x = sigmoidf_(x); A2[(size_t)(t0 + i) * K3 + tid] = (bf16)f2bf(x); }
        } else if (tid < 288) { const int jx = tid - 256; float c1[TT], c2[TT + 1];
            c2[0] = (t0 % SEQ == 0) ? 0.f : bf2f(zm[(size_t)(t0 - 1) * NZM + 464 + jx]);
#pragma unroll
            for (int i = 0; i < TT; ++i) { c1[i] = bf2f(zm[(size_t)(t0 + i) * NZM + 432 + jx]); c2[i + 1] = bf2f(zm[(size_t)(t0 + i) * NZM + 464 + jx]); }
#pragma unroll
            for (int i = 0; i < TT; ++i) A2[(size_t)(t0 + i) * K3 + tid] = (bf16)f2bf(c1[i] + c2[i]);
        } else if (tid < 384) {
#pragma unroll
            for (int i = 0; i < TT; ++i) A2[(size_t)(t0 + i) * K3 + tid] = 0;
        } else if (wave == 6) { float s[TT];
#pragma unroll
            for (int i = 0; i < TT; ++i) { const u32x2 w = *(const u32x2*)(zm + (size_t)(t0 + i) * NZM + lane * 4); const float f0 = bf2f(w.x & 0xffffu), f1 = bf2f(w.x >> 16), f2 = bf2f(w.y & 0xffffu), f3 = bf2f(w.y >> 16); s[i] = f0 * f0 + f1 * f1 + f2 * f2 + f3 * f3; }
#pragma unroll
            for (int i = 0; i < TT; ++i) { const float q = wave_sum(s[i]); if (lane == 0) rsq[t0 + i] = rsqrtf(q * (1.f / 256.f) + NORM_EPS); }
        } else { float s[TT];
#pragma unroll
            for (int i = 0; i < TT; ++i) { const unsigned w = *(const unsigned*)(zm + (size_t)(t0 + i) * NZM + 256 + lane * 2); const float f0 = bf2f(w & 0xffffu), f1 = bf2f(w >> 16); s[i] = f0 * f0 + f1 * f1; }
#pragma unroll
            for (int i = 0; i < TT; ++i) { const float q = wave_sum(s[i]); if (lane == 0) rskv[t0 + i] = rsqrtf(q * (1.f / 128.f) + NORM_EPS); }
        }
    }
}

__device__ __forceinline__ void phase_mla_post(const PArgs& a, int l, LAS unsigned char* lds) {
    const int bidx_ = obid();
    const int tid = otid(), lane = tid & 63, h = tid >> 6, G = ogrid();
    const bf16* qraw = (const bf16*)(a.ws + S_QRAW); const bf16* kvraw = (const bf16*)(a.ws + S_KVRAW); const bf16* zm = (const bf16*)(a.ws + S_ZM);
    bf16* Q = (bf16*)(a.ws + S_Q); bf16* Kk = (bf16*)(a.ws + S_K); bf16* Vt = (bf16*)(a.ws + S_VT);
    const int* pos = (const int*)a.in[2];
    LAS bf16* vt = (LAS bf16*)lds;
    const float* gq = INF(24) + l * QKD; const float* gk = INF(25) + l * QKD;
    const float gq0 = gq[lane], gk0 = gk[lane], gq1 = lane < 32 ? gq[64 + lane] : 0.f, gk1 = lane < 32 ? gk[64 + lane] : 0.f;
    const float invf = exp2f(-(float)(lane & 15) * (13.287712379549449f / 16.f));
    const float qscale = 0.10206207261596577f * 1.4426950408889634f;
    for (int tile = bidx_; tile < T / 64; tile += G) { const int t0 = tile * 64, b = t0 / SEQ, s0 = t0 % SEQ;
        for (int i0 = 0; i0 < 64; i0 += 4) {
            float q0[4], q1[4], k0[4], k1[4], ang[4]; unsigned short vv[4];
#pragma unroll
            for (int ii = 0; ii < 4; ++ii) { const int t = t0 + i0 + ii;
                q0[ii] = bf2f(qraw[(size_t)t * 768 + h * 96 + lane]); q1[ii] = lane < 32 ? bf2f(qraw[(size_t)t * 768 + h * 96 + 64 + lane]) : 0.f;
                k0[ii] = bf2f(kvraw[(size_t)t * 1024 + h * 128 + lane]); k1[ii] = lane < 32 ? bf2f(zm[(size_t)t * NZM + 384 + lane]) : 0.f;
                vv[ii] = kvraw[(size_t)t * 1024 + h * 128 + 64 + lane]; ang[ii] = (float)pos[t] * invf; }
#pragma unroll
            for (int ii = 0; ii < 4; ++ii) { const int i = i0 + ii;
                const float sq = wave_sum(q0[ii] * q0[ii] + q1[ii] * q1[ii]), sk = wave_sum(k0[ii] * k0[ii] + k1[ii] * k1[ii]);
                const float rq = rsqrtf(sq * (1.f / QKD) + NORM_EPS), rk = rsqrtf(sk * (1.f / QKD) + NORM_EPS);
                const float qn0 = q0[ii] * rq * gq0, qn1 = q1[ii] * rq * gq1, kn0 = k0[ii] * rk * gk0, kn1 = k1[ii] * rk * gk1;
                const double rev = (double)ang[ii] * 0.15915494309189535; const float fr = (float)(rev - rint(rev));
                const float sn = __builtin_amdgcn_sinf(fr), cs = __builtin_amdgcn_cosf(fr);
                const float qp = __shfl_xor(qn1, 16), kp = __shfl_xor(kn1, 16);
                const float qr = (lane < 16) ? (qn1 * cs - qp * sn) : (qn1 * cs + qp * sn);
                const float kr = (lane < 16) ? (kn1 * cs - kp * sn) : (kn1 * cs + kp * sn);
                const size_t ro = ((size_t)(b * NH + h) * SEQ + s0 + i) * QKD;
                Q[ro + lane] = (bf16)f2bf(qn0 * qscale); Kk[ro + lane] = (bf16)f2bf(kn0);
                if (lane < 32) { Q[ro + 64 + lane] = (bf16)f2bf(qr * qscale); Kk[ro + 64 + lane] = (bf16)f2bf(kr); }
                vt[(h * 64 + lane) * 72 + i] = vv[ii]; }
        }
        __syncthreads();
        { const int row = tid; const LAS u32x4* src = (const LAS u32x4*)(vt + row * 72); u32x4* dst = (u32x4*)(Vt + ((size_t)(b * NH) * 64 + row) * SEQ + s0);
#pragma unroll
          for (int q = 0; q < 8; ++q) dst[q] = src[q]; }
        __syncthreads();
    }
}

__device__ __forceinline__ void ld8(const bf16* p, float (&f)[8]) { unpack8(*(const u32x4*)p, f); }
__device__ __forceinline__ void st8(bf16* p, const float (&f)[8]) { *(u32x4*)p = (u32x4){pk2(f[0], f[1]), pk2(f[2], f[3]), pk2(f[4], f[5]), pk2(f[6], f[7])}; }
__device__ __forceinline__ void ldf8(const float* p, float (&f)[8]) { const f32x4 a = *(const f32x4*)p, b = *(const f32x4*)(p + 4); f[0] = a[0]; f[1] = a[1]; f[2] = a[2]; f[3] = a[3]; f[4] = b[0]; f[5] = b[1]; f[6] = b[2]; f[7] = b[3]; }
__device__ __forceinline__ float sum8lanes(float v) { v += __shfl_xor(v, 1); v += __shfl_xor(v, 2); v += __shfl_xor(v, 4); return v; }
__device__ __forceinline__ void phase_rwkv_post(const PArgs& a, int l) {
    const int bidx_ = obid();
    const int tid = otid(), lane = tid & 63, wave = __builtin_amdgcn_readfirstlane(tid >> 6), G = ogrid(), c0 = lane * 8, h = lane >> 3;
    const bf16* zr = (const bf16*)(a.ws + S_ZR); const bf16* L2 = (const bf16*)(a.ws + S_L2); bf16* vf = (bf16*)(a.ws + WS_VF);
    bf16* RR = (bf16*)(a.ws + S_RR); bf16* RK = (bf16*)(a.ws + S_RK); bf16* RV = (bf16*)(a.ws + S_RV); bf16* RA = (bf16*)(a.ws + S_RA); bf16* RB = (bf16*)(a.ws + S_RB); float* RW = (float*)(a.ws + S_RW); bf16* RG = (bf16*)(a.ws + S_RG);
    float* bscA = (float*)(a.ws + WS_CTL + C_BSC);
    float mur[8], muk[8], muv[8], w0[8], a0[8], kkc[8], kac[8], rkc[8], vb[8];
    ldf8(INF(5) + l * 1792 + c0, mur); ldf8(INF(5) + l * 1792 + 512 + c0, muk); ldf8(INF(5) + l * 1792 + 1024 + c0, muv);
    ldf8(INF(6) + l * 512 + c0, w0); ldf8(INF(8) + l * 512 + c0, a0); ldf8(INF(11) + l * 512 + c0, kkc); ldf8(INF(12) + l * 512 + c0, kac); ldf8(INF(13) + l * 512 + c0, rkc);
    if (l > 0) ldf8(INF(19) + (l - 1) * 512 + c0, vb);
    for (int g = bidx_ * NWV + wave; g < T / 8; g += G * NWV) { const int t0 = g * 8;
        float pr[8], pk[8], pv[8];
        if (t0 % SEQ == 0) {
#pragma unroll
            for (int e = 0; e < 8; ++e) { pr[e] = 0.f; pk[e] = 0.f; pv[e] = 0.f; } }
        else { ld8(zr + (size_t)(t0 - 1) * NZR + c0, pr); ld8(zr + (size_t)(t0 - 1) * NZR + 512 + c0, pk); ld8(zr + (size_t)(t0 - 1) * NZR + 1024 + c0, pv); }
#pragma unroll 2
        for (int i = 0; i < 8; ++i) { const size_t t = t0 + i; float zr_[8], zk_[8], zv_[8], lw[8], la[8], lg[8], lv[8], vfi[8];
            ld8(zr + t * NZR + c0, zr_); ld8(zr + t * NZR + 512 + c0, zk_); ld8(zr + t * NZR + 1024 + c0, zv_);
            ld8(L2 + t * N3 + c0, lw); ld8(L2 + t * N3 + 512 + c0, la); ld8(L2 + t * N3 + 1024 + c0, lg);
            if (l > 0) { ld8(L2 + t * N3 + 1536 + c0, lv); ld8(vf + t * HW + c0, vfi); }
            float r[8], kp[8], v[8], av[8], bv[8], dw[8]; float ssq = 0.f, bs = 0.f;
#pragma unroll
            for (int e = 0; e < 8; ++e) { r[e] = zr_[e] + (pr[e] - zr_[e]) * mur[e]; const float k = zk_[e] + (pk[e] - zk_[e]) * muk[e]; v[e] = zv_[e] + (pv[e] - zv_[e]) * muv[e];
                pr[e] = zr_[e]; pk[e] = zk_[e]; pv[e] = zv_[e];
                const float logw = -softplusf_(-(w0[e] + lw[e])) - 0.5f; dw[e] = -__expf(logw);
                const float iclr = sigmoidf_(a0[e] + la[e]);
                if (l > 0) v[e] = v[e] + (vfi[e] - v[e]) * sigmoidf_(vb[e] + lv[e]);
                const float kkr = k * kkc[e]; ssq += kkr * kkr; av[e] = kkr; bv[e] = iclr;
                kp[e] = k * (1.f + (iclr - 1.f) * kac[e]); bs += r[e] * kp[e] * rkc[e]; }
            ssq = sum8lanes(ssq); bs = sum8lanes(bs); const float rn = rsqrtf(ssq + 1e-12f);
#pragma unroll
            for (int e = 0; e < 8; ++e) { const float kk = av[e] * rn; av[e] = -kk; bv[e] = kk * bv[e]; }
            if (l == 0) st8(vf + t * HW + c0, v);
            st8(RR + t * HW + c0, r); st8(RK + t * HW + c0, kp); st8(RV + t * HW + c0, v); st8(RA + t * HW + c0, av); st8(RB + t * HW + c0, bv); st8(RG + t * HW + c0, lg);
            *(f32x4*)(RW + t * HW + c0) = (f32x4){dw[0], dw[1], dw[2], dw[3]}; *(f32x4*)(RW + t * HW + c0 + 4) = (f32x4){dw[4], dw[5], dw[6], dw[7]};
            if ((lane & 7) == 0) bscA[t * 8 + h] = bs; }
    }
}

__device__ __forceinline__ void phase_gdn_prep(const PArgs& a, int l) {
    const int bidx_ = obid();
    const int tid = otid(), lane = tid & 63, wave = __builtin_amdgcn_readfirstlane(tid >> 6), G = ogrid(), c0 = lane * 8, h = lane >> 3;
    const bf16* zq = (const bf16*)(a.ws + S_ZQ); const bf16* zm = (const bf16*)(a.ws + S_ZM);
    float* GAL = (float*)(a.ws + S_GAL); float* GBE = (float*)(a.ws + S_GBE);
    const float* cw = INF(26) + l * 4 * NZQ;
    for (int u = bidx_ * NWV + wave; u < 3 * (T / 8); u += G * NWV) { const int which = u / (T / 8), t0 = (u % (T / 8)) * 8;
        const int cc = which * 512 + c0; bf16* O = (bf16*)(a.ws + (which == 0 ? S_GQ : which == 1 ? S_GK : S_GV));
        float w[4][8];
#pragma unroll
        for (int j = 0; j < 4; ++j) ldf8(cw + j * NZQ + cc, w[j]);
        float x0[8], x1[8], x2[8];
        if (t0 % SEQ == 0) {
#pragma unroll
            for (int e = 0; e < 8; ++e) { x0[e] = 0.f; x1[e] = 0.f; x2[e] = 0.f; } }
        else { ld8(zq + (size_t)(t0 - 3) * NZQ + cc, x0); ld8(zq + (size_t)(t0 - 2) * NZQ + cc, x1); ld8(zq + (size_t)(t0 - 1) * NZQ + cc, x2); }
        float alog = 0.f, dtb = 0.f; if (which == 0 && lane < 8) { alog = INF(27)[l * 8 + lane]; dtb = INF(28)[l * 8 + lane]; }
#pragma unroll 2
        for (int i = 0; i < 8; ++i) { const size_t t = t0 + i; float x3[8], y[8]; ld8(zq + t * NZQ + cc, x3);
            float ss = 0.f;
#pragma unroll
            for (int e = 0; e < 8; ++e) { const float c = w[0][e] * x0[e] + w[1][e] * x1[e] + w[2][e] * x2[e] + w[3][e] * x3[e]; y[e] = siluf_(c); ss += y[e] * y[e]; x0[e] = x1[e]; x1[e] = x2[e]; x2[e] = x3[e]; }
            if (which < 2) { ss = sum8lanes(ss); const float rn = rsqrtf(ss + 1e-12f) * (which == 0 ? 0.125f : 1.f);
#pragma unroll
                for (int e = 0; e < 8; ++e) y[e] *= rn; }
            st8(O + t * HW + c0, y);
            if (which == 0 && lane < 8) { const float bl = bf2f(zm[t * NZM + 416 + lane]), al = bf2f(zm[t * NZM + 424 + lane]); GBE[t * 8 + lane] = sigmoidf_(bl); GAL[t * 8 + lane] = -__expf(alog) * softplusf_(al + dtb); } }
    }
}

__device__ __forceinline__ void phase_finish(const PArgs& a, int l) {
    const int bidx_ = obid();
    const int tid = otid(), lane = tid & 63, h = tid >> 6, G = ogrid(), c = tid;
    const bf16* YA = (const bf16*)(a.ws + S_YA); const bf16* YC = (const bf16*)(a.ws + S_YC); const bf16* RR = (const bf16*)(a.ws + S_RR); const bf16* RK = (const bf16*)(a.ws + S_RK); const bf16* RV = (const bf16*)(a.ws + S_RV); const bf16* RG = (const bf16*)(a.ws + S_RG);
    const bf16* zg = (const bf16*)(a.ws + S_ZG); bf16* OA = (bf16*)(a.ws + S_OA); bf16* OC = (bf16*)(a.ws + S_OC);
    const float rkc = INF(13)[l * 512 + c], lng = INF(14)[l * 512 + c], lnb = INF(15)[l * 512 + c], gng = INF(29)[l * 64 + lane];
    constexpr int TT = 4;
    for (int g = bidx_; g < T / TT; g += G) { const int t0 = g * TT; float ya[TT], yc[TT], r[TT], k[TT], v[TT], gt[TT], gg[TT];
#pragma unroll
        for (int i = 0; i < TT; ++i) { const size_t o = (size_t)(t0 + i) * HW + c; ya[i] = bf2f(YA[o]); yc[i] = bf2f(YC[o]); r[i] = bf2f(RR[o]); k[i] = bf2f(RK[o]); v[i] = bf2f(RV[o]); gt[i] = bf2f(RG[o]); gg[i] = bf2f(zg[o]); }
#pragma unroll
        for (int i = 0; i < TT; ++i) { const size_t o = (size_t)(t0 + i) * HW + c;
            const float mean = wave_sum(ya[i]) * (1.f / 64.f); const float d = ya[i] - mean; const float var = wave_sum(d * d) * (1.f / 64.f);
            const float bon = wave_sum(r[i] * k[i] * rkc) * v[i];
            const float y = d * rsqrtf(var + 64e-5f) * lng + lnb + bon;
            OA[o] = (bf16)f2bf(y * gt[i]);
            const float ms = wave_sum(yc[i] * yc[i]) * (1.f / 64.f);
            OC[o] = (bf16)f2bf(yc[i] * rsqrtf(ms + NORM_EPS) * gng * siluf_(gg[i])); }
    }
}
constexpr int AT_KP = 208, AT_VP = 136, AT_KB = 64 * AT_KP, AT_BUF = AT_KB + 64 * AT_VP;
__device__ __forceinline__ void attn_unit(const bf16* Q, const bf16* K, const bf16* Vt, bf16* OB, LAS unsigned char* lds, int b, int h, int qb) {
    const int tid = otid(), lane = tid & 63, wave = __builtin_amdgcn_readfirstlane(tid >> 6), ql = lane & 31, hh = lane >> 5;
    const int qrow0 = qb * 256 + wave * 32;
    const size_t bh = (size_t)(b * NH + h);
    bf16x8 qf[6];
    { const bf16* qp = Q + (bh * SEQ + qrow0 + ql) * QKD + 8 * hh;
#pragma unroll
      for (int s = 0; s < 6; ++s) qf[s] = *(const bf16x8*)(qp + 16 * s); }
    f32x16 o0, o1;
#pragma unroll
    for (int r = 0; r < 16; ++r) { o0[r] = 0.f; o1[r] = 0.f; }
    float mrun = -1e30f, lsum = 0.f;
    const int nkt = 4 * qb + 4;
    const unsigned char* Kb = (const unsigned char*)(K + bh * SEQ * QKD);
    const unsigned char* Vb = (const unsigned char*)(Vt + bh * 64 * SEQ);
    const int kr0 = tid / 12, kc0 = tid % 12, id1 = tid + 512, kr1 = id1 / 12, kc1 = id1 % 12; const bool k1v = id1 < 768;
    const int vr = tid >> 3, vc = tid & 7;
    u32x4 rk0, rk1, rv;
#define AT_LOAD(kt) do { const size_t key0 = (size_t)(kt) * 64; rk0 = *(const u32x4*)(Kb + (key0 + kr0) * (QKD * 2) + kc0 * 16); if (k1v) rk1 = *(const u32x4*)(Kb + (key0 + kr1) * (QKD * 2) + kc1 * 16); \
        rv = *(const u32x4*)(Vb + ((size_t)vr * SEQ + key0) * 2 + vc * 16); } while (0)
#define AT_STORE(buf) do { LAS unsigned char* bp = lds + (buf) * AT_BUF; *(LAS u32x4*)(bp + kr0 * AT_KP + kc0 * 16) = rk0; if (k1v) *(LAS u32x4*)(bp + kr1 * AT_KP + kc1 * 16) = rk1; \
        LAS u32x2* vp = (LAS u32x2*)(bp + AT_KB + vr * AT_VP + vc * 16); vp[0] = (u32x2){rv.x, rv.y}; vp[1] = (u32x2){rv.z, rv.w}; } while (0)
    AT_LOAD(0); AT_STORE(0);
    __syncthreads();
    for (int kt = 0; kt < nkt; ++kt) {
        if (kt + 1 < nkt) AT_LOAD(kt + 1);
        if (64 * kt <= qrow0 + 31) {
            const LAS unsigned char* kb = lds + (kt & 1) * AT_BUF; const LAS unsigned char* vb = kb + AT_KB;
            f32x16 s0, s1;
#pragma unroll
            for (int r = 0; r < 16; ++r) { s0[r] = 0.f; s1[r] = 0.f; }
#pragma unroll
            for (int s = 0; s < 6; ++s) { const bf16x8 kf0 = *(const LAS bf16x8*)(kb + ql * AT_KP + (16 * s + 8 * hh) * 2), kf1 = *(const LAS bf16x8*)(kb + (32 + ql) * AT_KP + (16 * s + 8 * hh) * 2);
                s0 = __builtin_amdgcn_mfma_f32_32x32x16_bf16(kf0, qf[s], s0, 0, 0, 0); s1 = __builtin_amdgcn_mfma_f32_32x32x16_bf16(kf1, qf[s], s1, 0, 0, 0); }
            if (64 * kt + 63 > qrow0) { const int qi = qrow0 + ql, kbase = 64 * kt + 4 * hh;
#pragma unroll
                for (int r = 0; r < 16; ++r) { const int key = kbase + (r & 3) + 8 * (r >> 2); if (key > qi) s0[r] = -1e30f; if (key + 32 > qi) s1[r] = -1e30f; } }
            float mx = s0[0];
#pragma unroll
            for (int r = 1; r < 16; ++r) mx = fmaxf(mx, s0[r]);
#pragma unroll
            for (int r = 0; r < 16; ++r) mx = fmaxf(mx, s1[r]);
            mx = fmaxf(mx, __shfl_xor(mx, 32));
            const float mnew = fmaxf(mrun, mx), alpha = exp2f(mrun - mnew); mrun = mnew;
            float ps = 0.f;
#pragma unroll
            for (int r = 0; r < 16; ++r) { s0[r] = exp2f(s0[r] - mnew); s1[r] = exp2f(s1[r] - mnew); ps += s0[r] + s1[r]; }
            lsum = lsum * alpha + ps;
#pragma unroll
            for (int r = 0; r < 16; ++r) { o0[r] *= alpha; o1[r] *= alpha; }
#pragma unroll
            for (int sub = 0; sub < 2; ++sub)
#pragma unroll
                for (int s2 = 0; s2 < 2; ++s2) {
                    union { u32x4 u; bf16x8 v; } pf;
                    if (sub == 0) { pf.u.x = pg8::cvt_pk_bf16(s0[8 * s2 + 0], s0[8 * s2 + 1]); pf.u.y = pg8::cvt_pk_bf16(s0[8 * s2 + 2], s0[8 * s2 + 3]); pf.u.z = pg8::cvt_pk_bf16(s0[8 * s2 + 4], s0[8 * s2 + 5]); pf.u.w = pg8::cvt_pk_bf16(s0[8 * s2 + 6], s0[8 * s2 + 7]); }
                    else { pf.u.x = pg8::cvt_pk_bf16(s1[8 * s2 + 0], s1[8 * s2 + 1]); pf.u.y = pg8::cvt_pk_bf16(s1[8 * s2 + 2], s1[8 * s2 + 3]); pf.u.z = pg8::cvt_pk_bf16(s1[8 * s2 + 4], s1[8 * s2 + 5]); pf.u.w = pg8::cvt_pk_bf16(s1[8 * s2 + 6], s1[8 * s2 + 7]); }
                    const int kofs = (sub * 32 + 16 * s2 + 4 * hh) * 2;
                    union { u32x4 u; bf16x8 v; } va, vb2;
                    { const u32x2 lo = *(const LAS u32x2*)(vb + ql * AT_VP + kofs), hi = *(const LAS u32x2*)(vb + ql * AT_VP + kofs + 16); va.u = (u32x4){lo.x, lo.y, hi.x, hi.y}; }
                    { const u32x2 lo = *(const LAS u32x2*)(vb + (32 + ql) * AT_VP + kofs), hi = *(const LAS u32x2*)(vb + (32 + ql) * AT_VP + kofs + 16); vb2.u = (u32x4){lo.x, lo.y, hi.x, hi.y}; }
                    o0 = __builtin_amdgcn_mfma_f32_32x32x16_bf16(va.v, pf.v, o0, 0, 0, 0); o1 = __builtin_amdgcn_mfma_f32_32x32x16_bf16(vb2.v, pf.v, o1, 0, 0, 0);
                }
        }
        if (kt + 1 < nkt) AT_STORE((kt + 1) & 1);
        __syncthreads();
    }
#undef AT_LOAD
#undef AT_STORE
    const float ltot = lsum + __shfl_xor(lsum, 32), inv = 1.f / ltot;
    bf16* op = OB + ((size_t)b * SEQ + qrow0 + ql) * HW + h * 64 + 4 * hh;
#pragma unroll
    for (int g = 0; g < 4; ++g) { u32x2 w0, w1; w0.x = pg8::cvt_pk_bf16(o0[4 * g] * inv, o0[4 * g + 1] * inv); w0.y = pg8::cvt_pk_bf16(o0[4 * g + 2] * inv, o0[4 * g + 3] * inv);
        w1.x = pg8::cvt_pk_bf16(o1[4 * g] * inv, o1[4 * g + 1] * inv); w1.y = pg8::cvt_pk_bf16(o1[4 * g + 2] * inv, o1[4 * g + 3] * inv);
        *(u32x2*)(op + 8 * g) = w0; *(u32x2*)(op + 32 + 8 * g) = w1; }
}
__device__ __forceinline__ void phase_attn(const PArgs& a, LAS unsigned char* lds) {
    const int bidx_ = obid();
    const bf16* Q = (const bf16*)(a.ws + S_Q); const bf16* K = (const bf16*)(a.ws + S_K); const bf16* Vt = (const bf16*)(a.ws + S_VT); bf16* OB = (bf16*)(a.ws + S_OB);
    for (int pi = bidx_; pi < NB * NH * 8; pi += ogrid()) { const int bh = pi >> 3, j = pi & 7;
        attn_unit(Q, K, Vt, OB, lds, bh >> 3, bh & 7, 15 - j);
        attn_unit(Q, K, Vt, OB, lds, bh >> 3, bh & 7, j); }
}

constexpr int SC_STEPS = 16, SC_ROW = 5 * 64 + 16, SC_BUF = SC_STEPS * SC_ROW * 4;
__device__ __forceinline__ void scan_task(const PArgs& a, int task, LAS unsigned char* wlds) {
    const int lane = otid() & 63, i = lane >> 2, jq = lane & 3;
    const bool gdn = task >= 128; const int tt = gdn ? task - 128 : task; const int b = tt >> 5, h = (tt >> 2) & 7, rg = tt & 3;
    const bf16 *PR, *PK, *PV, *PA, *PB; const float* PW; const float *PAL, *PBE; bf16* Y;
    if (!gdn) { PR = (const bf16*)(a.ws + S_RR); PK = (const bf16*)(a.ws + S_RK); PV = (const bf16*)(a.ws + S_RV); PA = (const bf16*)(a.ws + S_RA); PB = (const bf16*)(a.ws + S_RB); PW = (const float*)(a.ws + S_RW); PAL = nullptr; PBE = nullptr; Y = (bf16*)(a.ws + S_YA); }
    else { PR = (const bf16*)(a.ws + S_GQ); PK = (const bf16*)(a.ws + S_GK); PV = (const bf16*)(a.ws + S_GV); PA = nullptr; PB = nullptr; PW = nullptr; PAL = (const float*)(a.ws + S_GAL); PBE = (const float*)(a.ws + S_GBE); Y = (bf16*)(a.ws + S_YC); }
    const size_t row0 = (size_t)b * SEQ; const int col0 = h * 64;
    const int bs = lane >> 3, be = 8 * (lane & 7);
    u32x4 gr[2], gk[2], ga[2], gb[2], gv; f32x4 gw[4]; float gal[2], gbe[2];
#define SC_LOAD(c) do { const size_t t0_ = row0 + (size_t)(c) * SC_STEPS; \
        _Pragma("unroll") for (int q = 0; q < 2; ++q) { const size_t o_ = (t0_ + bs + 8 * q) * HW + col0 + be; gr[q] = *(const u32x4*)(PR + o_); gk[q] = *(const u32x4*)(PK + o_); \
            if (!gdn) { ga[q] = *(const u32x4*)(PA + o_); gb[q] = *(const u32x4*)(PB + o_); } else { gal[q] = PAL[(t0_ + bs + 8 * q) * 8 + h]; gbe[q] = PBE[(t0_ + bs + 8 * q) * 8 + h]; } } \
        if (!gdn) { _Pragma("unroll") for (int q = 0; q < 4; ++q) gw[q] = *(const f32x4*)(PW + (t0_ + (lane >> 4) + 4 * q) * HW + col0 + 4 * (lane & 15)); } \
        if (lane < 32) gv = *(const u32x4*)(PV + (t0_ + (lane >> 1)) * HW + col0 + rg * 16 + (lane & 1) * 8); } while (0)
#define SC_STORE(buf) do { LAS float* B_ = (LAS float*)(wlds + (buf) * SC_BUF); \
        _Pragma("unroll") for (int q = 0; q < 2; ++q) { LAS float* R_ = B_ + (bs + 8 * q) * SC_ROW; float fr_[8], fk_[8]; unpack8(gr[q], fr_); unpack8(gk[q], fk_); \
            if (!gdn) { float fa_[8], fb_[8]; unpack8(ga[q], fa_); unpack8(gb[q], fb_); \
                *(LAS f32x4*)(R_ + 0 + be) = (f32x4){fa_[0], fa_[1], fa_[2], fa_[3]}; *(LAS f32x4*)(R_ + 0 + be + 4) = (f32x4){fa_[4], fa_[5], fa_[6], fa_[7]}; \
                *(LAS f32x4*)(R_ + 128 + be) = (f32x4){fb_[0], fb_[1], fb_[2], fb_[3]}; *(LAS f32x4*)(R_ + 128 + be + 4) = (f32x4){fb_[4], fb_[5], fb_[6], fb_[7]}; \
                *(LAS f32x4*)(R_ + 192 + be) = (f32x4){fk_[0], fk_[1], fk_[2], fk_[3]}; *(LAS f32x4*)(R_ + 192 + be + 4) = (f32x4){fk_[4], fk_[5], fk_[6], fk_[7]}; } \
            else { const float al_ = gal[q], be_ = gbe[q], nab_ = -al_ * be_; \
                *(LAS f32x4*)(R_ + 0 + be) = (f32x4){fk_[0], fk_[1], fk_[2], fk_[3]}; *(LAS f32x4*)(R_ + 0 + be + 4) = (f32x4){fk_[4], fk_[5], fk_[6], fk_[7]}; \
                *(LAS f32x4*)(R_ + 64 + be) = (f32x4){al_, al_, al_, al_}; *(LAS f32x4*)(R_ + 64 + be + 4) = (f32x4){al_, al_, al_, al_}; \
                *(LAS f32x4*)(R_ + 128 + be) = (f32x4){fk_[0] * nab_, fk_[1] * nab_, fk_[2] * nab_, fk_[3] * nab_}; *(LAS f32x4*)(R_ + 128 + be + 4) = (f32x4){fk_[4] * nab_, fk_[5] * nab_, fk_[6] * nab_, fk_[7] * nab_}; \
                *(LAS f32x4*)(R_ + 192 + be) = (f32x4){fk_[0] * be_, fk_[1] * be_, fk_[2] * be_, fk_[3] * be_}; *(LAS f32x4*)(R_ + 192 + be + 4) = (f32x4){fk_[4] * be_, fk_[5] * be_, fk_[6] * be_, fk_[7] * be_}; } \
            *(LAS f32x4*)(R_ + 256 + be) = (f32x4){fr_[0], fr_[1], fr_[2], fr_[3]}; *(LAS f32x4*)(R_ + 256 + be + 4) = (f32x4){fr_[4], fr_[5], fr_[6], fr_[7]}; } \
        if (!gdn) { _Pragma("unroll") for (int q = 0; q < 4; ++q) *(LAS f32x4*)(B_ + ((lane >> 4) + 4 * q) * SC_ROW + 64 + 4 * (lane & 15)) = gw[q]; } \
        if (lane < 32) { float fv_[8]; unpack8(gv, fv_); LAS float* V_ = B_ + (lane >> 1) * SC_ROW + 320 + (lane & 1) * 8; *(LAS f32x4*)(V_) = (f32x4){fv_[0], fv_[1], fv_[2], fv_[3]}; *(LAS f32x4*)(V_ + 4) = (f32x4){fv_[4], fv_[5], fv_[6], fv_[7]}; } } while (0)
    float st[16];
#pragma unroll
    for (int q = 0; q < 16; ++q) st[q] = 0.f;
    SC_LOAD(0); SC_STORE(0);
    constexpr int NCH = SEQ / SC_STEPS;
    for (int c = 0; c < NCH; ++c) {
        if (c + 1 < NCH) SC_LOAD(c + 1);
        const LAS float* B_ = (const LAS float*)(wlds + (c & 1) * SC_BUF);
        for (int s = 0; s < SC_STEPS; ++s) { const LAS float* R_ = B_ + s * SC_ROW + 16 * jq;
            float va[16], vw[16], vb[16], vk[16], vr[16];
#pragma unroll
            for (int q = 0; q < 4; ++q) { const f32x4 x0 = *(const LAS f32x4*)(R_ + 4 * q), x1 = *(const LAS f32x4*)(R_ + 64 + 4 * q), x2 = *(const LAS f32x4*)(R_ + 128 + 4 * q), x3 = *(const LAS f32x4*)(R_ + 192 + 4 * q), x4 = *(const LAS f32x4*)(R_ + 256 + 4 * q);
#pragma unroll
                for (int e = 0; e < 4; ++e) { va[4 * q + e] = x0[e]; vw[4 * q + e] = x1[e]; vb[4 * q + e] = x2[e]; vk[4 * q + e] = x3[e]; vr[4 * q + e] = x4[e]; } }
            const float vi = B_[s * SC_ROW + 320 + i];
            float sa = 0.f;
#pragma unroll
            for (int q = 0; q < 16; ++q) sa += st[q] * va[q];
            sa += __shfl_xor(sa, 1); sa += __shfl_xor(sa, 2);
            float y = 0.f;
#pragma unroll
            for (int q = 0; q < 16; ++q) { st[q] = st[q] * vw[q] + sa * vb[q] + vi * vk[q]; y += st[q] * vr[q]; }
            y += __shfl_xor(y, 1); y += __shfl_xor(y, 2);
            if (jq == 0) Y[(row0 + (size_t)c * SC_STEPS + s) * HW + col0 + rg * 16 + i] = (bf16)f2bf(y);
        }
        if (c + 1 < NCH) SC_STORE((c + 1) & 1);
    }
#undef SC_LOAD
#undef SC_STORE
}
__device__ __forceinline__ void phase_scan(const PArgs& a, LAS unsigned char* lds) {
    const int bidx_ = obid();
    const int wave = __builtin_amdgcn_readfirstlane(otid() >> 6), G = ogrid();
    if (wave < 3) for (int task = bidx_ + wave * G; task < 256; task += 3 * G) scan_task(a, task, lds + wave * (2 * SC_BUF));
}
constexpr int CK_TP = 144;
constexpr int CK_AT = 0, CK_BT = 9216, CK_KT = 18432, CK_RT = 27648, CK_BW = 36864, CK_KW = 46080, CK_V = 55296, CK_N = 64512, CK_LAK = 73728, CK_LRB = 82944, CK_LRK = 92160,
              CK_AW = 101376, CK_W1 = 110592, CK_AH = 119808, CK_LVT = 129024, CK_DD = 138240;
constexpr int CK_CUM = 147456, CK_CUMP = 147712, CK_PC = 147968, CK_WTOT = 148224;
constexpr int CM_ITEM = 32768;
typedef short s16x4 __attribute__((ext_vector_type(4)));
__device__ __forceinline__ bf16x8 ck_frag(const LAS unsigned char* tile, int row, int ks, int hh) { return *(const LAS bf16x8*)(tile + row * CK_TP + (16 * ks + 8 * hh) * 2); }
__device__ __forceinline__ int crow_(int r, int hh) { return (r & 3) + 8 * (r >> 2) + 4 * hh; }
struct CkIn { u32x4 r, k, v, a, b; f32x4 w0, w1; float g, be; };
__device__ __forceinline__ void ck_load(const PArgs& a, int item, int t, int j0, CkIn& o) {
    const bool gdn = item >= 2048; const int it = item & 2047, bh = it >> 6, ch = it & 63, b = bh >> 3, h = bh & 7;
    const size_t row = (size_t)b * SEQ + ch * 64 + t; const size_t eo = row * HW + h * 64 + j0;
    if (!gdn) { o.r = *(const u32x4*)((const bf16*)(a.ws + S_RR) + eo); o.k = *(const u32x4*)((const bf16*)(a.ws + S_RK) + eo); o.v = *(const u32x4*)((const bf16*)(a.ws + S_RV) + eo);
        o.a = *(const u32x4*)((const bf16*)(a.ws + S_RA) + eo); o.b = *(const u32x4*)((const bf16*)(a.ws + S_RB) + eo);
        o.w0 = *(const f32x4*)((const float*)(a.ws + S_RW) + eo); o.w1 = *(const f32x4*)((const float*)(a.ws + S_RW) + eo + 4); }
    else { o.r = *(const u32x4*)((const bf16*)(a.ws + S_GQ) + eo); o.k = *(const u32x4*)((const bf16*)(a.ws + S_GK) + eo); o.v = *(const u32x4*)((const bf16*)(a.ws + S_GV) + eo);
        o.g = ((const float*)(a.ws + S_GAL))[row * 8 + h]; o.be = ((const float*)(a.ws + S_GBE))[row * 8 + h]; }
}
__device__ __forceinline__ void phase_cprep(const PArgs& a, LAS unsigned char* lds) {
    const int bidx_ = obid();
    const int tid = otid(), lane = tid & 63, wave = __builtin_amdgcn_readfirstlane(tid >> 6), G = ogrid(), ql = lane & 31, hh = lane >> 5;
    const int t = lane, j0 = wave * 8;
    LAS float* cumA = (LAS float*)(lds + CK_CUM); LAS float* cumpA = (LAS float*)(lds + CK_CUMP); LAS float* pcA = (LAS float*)(lds + CK_PC);
    CkIn in; if (bidx_ < 4096) ck_load(a, bidx_, t, j0, in);
    for (int item = bidx_; item < 4096; item += G) {
        const bool gdn = item >= 2048; const int it = item & 2047;
        float fr[8], fk[8], fv[8], fa[8], fb[8], lw[8];
        unpack8(in.v, fv);
        if (!gdn) { unpack8(in.r, fr); unpack8(in.k, fk); unpack8(in.a, fa); unpack8(in.b, fb);
#pragma unroll
            for (int e = 0; e < 4; ++e) { lw[e] = in.w0[e]; lw[4 + e] = in.w1[e]; } }
        else { float fkk[8]; unpack8(in.r, fr); unpack8(in.k, fkk); const float g = in.g, be = in.be, al = __expf(g);
#pragma unroll
            for (int e = 0; e < 8; ++e) { fa[e] = fkk[e]; fb[e] = -al * be * fkk[e]; fk[e] = be * fkk[e]; lw[e] = g; } }
        if (item + G < 4096) ck_load(a, item + G, t, j0, in);
        float cum[8], pc[8];
#pragma unroll
        for (int e = 0; e < 8; ++e) { float x = lw[e];
#pragma unroll
            for (int d = 1; d < 64; d <<= 1) { const float y = __shfl_up(x, d); if (lane >= d) x += y; }
            cum[e] = x; pc[e] = __shfl(x, 63); }
        if (wave == 0) { cumA[t] = gdn ? cum[0] : 0.f; cumpA[t] = gdn ? cum[0] - lw[0] : 0.f; }
        if (lane == 0) {
#pragma unroll
            for (int e = 0; e < 8; ++e) pcA[j0 + e] = pc[e]; }
        { float xa[8], xr[8], xb[8], xk[8], yb[8], yk[8], ya[8];
#pragma unroll
          for (int e = 0; e < 8; ++e) { const float ecp_true = __expf(cum[e] - lw[e]); const float ec = gdn ? 1.f : __expf(cum[e]), ecp = gdn ? 1.f : ecp_true, eci = gdn ? 1.f : __expf(-cum[e]), et = __expf(pc[e] - cum[e]);
              xa[e] = fa[e] * ecp; xr[e] = fr[e] * ec; xb[e] = fb[e] * eci; xk[e] = fk[e] * eci; yb[e] = fb[e] * et; yk[e] = fk[e] * et; ya[e] = fa[e] * ecp_true; }
          const int ro = t * CK_TP + j0 * 2;
          *(LAS u32x4*)(lds + CK_AT + ro) = (u32x4){pk2(xa[0], xa[1]), pk2(xa[2], xa[3]), pk2(xa[4], xa[5]), pk2(xa[6], xa[7])};
          *(LAS u32x4*)(lds + CK_RT + ro) = (u32x4){pk2(xr[0], xr[1]), pk2(xr[2], xr[3]), pk2(xr[4], xr[5]), pk2(xr[6], xr[7])};
          *(LAS u32x4*)(lds + CK_BT + ro) = (u32x4){pk2(xb[0], xb[1]), pk2(xb[2], xb[3]), pk2(xb[4], xb[5]), pk2(xb[6], xb[7])};
          *(LAS u32x4*)(lds + CK_KT + ro) = (u32x4){pk2(xk[0], xk[1]), pk2(xk[2], xk[3]), pk2(xk[4], xk[5]), pk2(xk[6], xk[7])};
#pragma unroll
          for (int e = 0; e < 8; ++e) { const int to = (j0 + e) * CK_TP + t * 2; *(LAS unsigned short*)(lds + CK_BW + to) = (unsigned short)f2bf(yb[e]); *(LAS unsigned short*)(lds + CK_KW + to) = (unsigned short)f2bf(yk[e]);
              *(LAS unsigned short*)(lds + CK_V + to) = (unsigned short)f2bf(fv[e]); *(LAS unsigned short*)(lds + CK_AH + to) = (unsigned short)f2bf(ya[e]); } }
        __syncthreads();
        { const int p = wave >> 1, hf = wave & 1; const LAS unsigned char* At = lds + (p < 2 ? CK_AT : CK_RT); const LAS unsigned char* Bt = lds + ((p & 1) ? CK_KT : CK_BT);
          const LAS float* dA = (p < 2) ? cumpA : cumA; LAS unsigned char* Ot = lds + (p == 0 ? CK_N : p == 1 ? CK_LAK : p == 2 ? CK_LRB : CK_LRK); const int incl = (p >= 2) ? 1 : 0;
#pragma unroll
          for (int sq = 0; sq < 2; ++sq) { f32x16 acc;
#pragma unroll
              for (int r = 0; r < 16; ++r) acc[r] = 0.f;
              if (!(sq == 1 && hf == 0)) {
#pragma unroll
                  for (int ks = 0; ks < 4; ++ks) acc = __builtin_amdgcn_mfma_f32_32x32x16_bf16(ck_frag(At, 32 * hf + ql, ks, hh), ck_frag(Bt, 32 * sq + ql, ks, hh), acc, 0, 0, 0); }
              const int s = 32 * sq + ql; const float dBs = cumA[s];
#pragma unroll
              for (int r = 0; r < 16; ++r) { const int tt = 32 * hf + crow_(r, hh); const bool keep = s < tt + incl; const float val = keep ? acc[r] * __expf(dA[tt] - dBs) : 0.f;
                  *(LAS unsigned short*)(Ot + tt * CK_TP + s * 2) = (unsigned short)f2bf(val); } } }
        __syncthreads();
        if (wave >= 1 && wave <= 4) { const int w4 = wave - 1, tq = w4 >> 1, iq = w4 & 1; f32x16 acc;
#pragma unroll
            for (int r = 0; r < 16; ++r) acc[r] = 0.f;
#pragma unroll
            for (int ks = 0; ks < 4; ++ks) acc = __builtin_amdgcn_mfma_f32_32x32x16_bf16(ck_frag(lds + CK_LAK, 32 * tq + ql, ks, hh), ck_frag(lds + CK_V, 32 * iq + ql, ks, hh), acc, 0, 0, 0);
#pragma unroll
            for (int g4 = 0; g4 < 4; ++g4) *(LAS u32x2*)(lds + CK_LVT + (32 * iq + ql) * CK_TP + (32 * tq + 8 * g4 + 4 * hh) * 2) = (u32x2){pk2(acc[4 * g4], acc[4 * g4 + 1]), pk2(acc[4 * g4 + 2], acc[4 * g4 + 3])}; }
        else if (wave == 0) { const int I = lane >> 4, c = lane & 15; float d[16];
#pragma unroll
            for (int r = 0; r < 16; ++r) { float nr[16]; { float lo8[8], hi8[8]; unpack8(*(const LAS u32x4*)(lds + CK_N + (16 * I + r) * CK_TP + (16 * I) * 2), lo8); unpack8(*(const LAS u32x4*)(lds + CK_N + (16 * I + r) * CK_TP + (16 * I + 8) * 2), hi8);
#pragma unroll
                    for (int e = 0; e < 8; ++e) { nr[e] = lo8[e]; nr[8 + e] = hi8[e]; } }
                float v = (r == c) ? 1.f : 0.f;
#pragma unroll
                for (int s2 = 0; s2 < r; ++s2) v += nr[s2] * d[s2];
                d[r] = v; *(LAS unsigned short*)(lds + CK_DD + (16 * I + r) * CK_TP + (16 * I + c) * 2) = (unsigned short)f2bf(v); } }
        __syncthreads();
        { const int col = lane & 15, g = lane >> 4; const int rb = (wave < 4) ? (16 * wave + col) : (16 * (wave - 4) + col);
          const LAS unsigned char* RTt = lds + (wave < 4 ? CK_AH : CK_LVT) + rb * CK_TP; LAS unsigned char* XTt = lds + (wave < 4 ? CK_AW : CK_W1) + rb * CK_TP;
          s16x4 xb[4];
#pragma unroll
          for (int I = 0; I < 4; ++I) { f32x4 acc; { const u32x2 w = *(const LAS u32x2*)(RTt + (16 * I + 4 * g) * 2); acc[0] = bf2f(w.x & 0xffffu); acc[1] = bf2f(w.x >> 16); acc[2] = bf2f(w.y & 0xffffu); acc[3] = bf2f(w.y >> 16); }
#pragma unroll
              for (int J = 0; J < I; ++J) acc = __builtin_amdgcn_mfma_f32_16x16x16bf16_1k(*(const LAS s16x4*)(lds + CK_N + (16 * I + col) * CK_TP + (16 * J + 4 * g) * 2), xb[J], acc, 0, 0, 0);
              union { u32x2 u; s16x4 v; } zb; zb.u = (u32x2){pk2(acc[0], acc[1]), pk2(acc[2], acc[3])};
              f32x4 x = (f32x4){0.f, 0.f, 0.f, 0.f};
              x = __builtin_amdgcn_mfma_f32_16x16x16bf16_1k(*(const LAS s16x4*)(lds + CK_DD + (16 * I + col) * CK_TP + (16 * I + 4 * g) * 2), zb.v, x, 0, 0, 0);
              union { u32x2 u; s16x4 v; } xo; xo.u = (u32x2){pk2(x[0], x[1]), pk2(x[2], x[3])}; xb[I] = xo.v;
              *(LAS u32x2*)(XTt + (16 * I + 4 * g) * 2) = xo.u; } }
        __syncthreads();
        { const int quad = wave & 3, rq = quad >> 1, cq = quad & 1; const bool lo = wave < 4;
          bf16* cm = (bf16*)(a.ws + (gdn ? S_CMG : S_CMR) + (size_t)it * CM_ITEM);
          const LAS unsigned char* A1 = lds + (lo ? CK_BW : CK_LRB); const LAS unsigned char* A2 = lds + (lo ? CK_KW : CK_LRK);
          f32x16 g1, g2;
#pragma unroll
          for (int r = 0; r < 16; ++r) { g1[r] = 0.f; g2[r] = 0.f; }
#pragma unroll
          for (int ks = 0; ks < 4; ++ks) { const bf16x8 af = ck_frag(A1, 32 * rq + ql, ks, hh);
              g1 = __builtin_amdgcn_mfma_f32_32x32x16_bf16(af, ck_frag(lds + CK_AW, 32 * cq + ql, ks, hh), g1, 0, 0, 0);
              g2 = __builtin_amdgcn_mfma_f32_32x32x16_bf16(af, ck_frag(lds + CK_W1, 32 * cq + ql, ks, hh), g2, 0, 0, 0); }
#pragma unroll
          for (int ks = 0; ks < 4; ++ks) g2 = __builtin_amdgcn_mfma_f32_32x32x16_bf16(ck_frag(A2, 32 * rq + ql, ks, hh), ck_frag(lds + CK_V, 32 * cq + ql, ks, hh), g2, 0, 0, 0);
          const int col = 32 * cq + ql;
          if (lo) { const float dg = __expf(pcA[col]);
#pragma unroll
              for (int r = 0; r < 16; ++r) { const int rw = 32 * rq + crow_(r, hh); *(LAS unsigned short*)(lds + CK_AT + rw * CK_TP + col * 2) = (unsigned short)f2bf(g1[r] + (rw == col ? dg : 0.f)); }
#pragma unroll
              for (int g4 = 0; g4 < 4; ++g4) *(LAS u32x2*)(lds + CK_BT + col * CK_TP + (32 * rq + 8 * g4 + 4 * hh) * 2) = (u32x2){pk2(g2[4 * g4], g2[4 * g4 + 1]), pk2(g2[4 * g4 + 2], g2[4 * g4 + 3])}; }
          else {
#pragma unroll
              for (int r = 0; r < 16; ++r) { const int rw = 32 * rq + crow_(r, hh); const float rh = bf2f(*(const LAS unsigned short*)(lds + CK_RT + rw * CK_TP + col * 2)) * __expf(cumA[rw]);
                  *(LAS unsigned short*)(lds + CK_KT + rw * CK_TP + col * 2) = (unsigned short)f2bf(g1[r] + rh); *(LAS unsigned short*)(lds + CK_N + rw * CK_TP + col * 2) = (unsigned short)f2bf(g2[r]); } }
          __syncthreads();
          { const int rr = tid >> 3, cc = (tid & 7) * 16; unsigned char* o = (unsigned char*)cm + rr * 128 + cc;
            *(u32x4*)(o) = *(const LAS u32x4*)(lds + CK_AT + rr * CK_TP + cc); *(u32x4*)(o + 8192) = *(const LAS u32x4*)(lds + CK_BT + rr * CK_TP + cc);
            *(u32x4*)(o + 16384) = *(const LAS u32x4*)(lds + CK_KT + rr * CK_TP + cc); *(u32x4*)(o + 24576) = *(const LAS u32x4*)(lds + CK_N + rr * CK_TP + cc); } }
        __syncthreads();
    }
}

__device__ __forceinline__ void phase_cscan(const PArgs& a, LAS unsigned char* lds) {
    const int bidx_ = obid();
    const int tid = otid(), lane = tid & 63, wave = __builtin_amdgcn_readfirstlane(tid >> 6), G = ogrid(), ql = lane & 31, hh = lane >> 5;
    for (int task = bidx_; task < 64; task += G) { const bool gdn = task >= 32; const int bh = task & 31;
        const bf16* cm = (const bf16*)(a.ws + (gdn ? S_CMG : S_CMR)) + (size_t)bh * 64 * (CM_ITEM / 2); bf16* s0 = (bf16*)(a.ws + (gdn ? S_S0G : S_S0R)) + (size_t)bh * 64 * 4096;
        const int rq = (wave >> 1) & 1, cq = wave & 1;
        for (int q = tid; q < 64 * CK_TP / 4; q += NTH) ((LAS unsigned*)lds)[q] = 0u;
        __syncthreads();
        bf16x8 ga[4][4]; u32x2 hc[4][4];
        if (wave < 4) {
#pragma unroll
            for (int u = 0; u < 4; ++u) { const bf16* cn = cm + (size_t)u * (CM_ITEM / 2);
#pragma unroll
                for (int ks = 0; ks < 4; ++ks) ga[u][ks] = *(const bf16x8*)(cn + (32 * rq + ql) * 64 + 16 * ks + 8 * hh);
#pragma unroll
                for (int g4 = 0; g4 < 4; ++g4) hc[u][g4] = *(const u32x2*)(cn + 4096 + (32 * cq + ql) * 64 + 32 * rq + 8 * g4 + 4 * hh); } }
        for (int c0 = 0; c0 < 64; c0 += 4) {
#pragma unroll
            for (int u = 0; u < 4; ++u) { const int c = c0 + u;
                { const int rr = tid >> 3, cc = (tid & 7) * 16; *(u32x4*)((unsigned char*)(s0 + (size_t)c * 4096) + rr * 128 + cc) = *(const LAS u32x4*)(lds + rr * CK_TP + cc); }
                f32x16 acc;
                if (wave < 4) {
#pragma unroll
                    for (int g4 = 0; g4 < 4; ++g4) { acc[4 * g4] = bf2f(hc[u][g4].x & 0xffffu); acc[4 * g4 + 1] = bf2f(hc[u][g4].x >> 16); acc[4 * g4 + 2] = bf2f(hc[u][g4].y & 0xffffu); acc[4 * g4 + 3] = bf2f(hc[u][g4].y >> 16); }
#pragma unroll
                    for (int ks = 0; ks < 4; ++ks) acc = __builtin_amdgcn_mfma_f32_32x32x16_bf16(ga[u][ks], ck_frag(lds, 32 * cq + ql, ks, hh), acc, 0, 0, 0);
                    if (c + 4 < 64) { const bf16* cn = cm + (size_t)(c + 4) * (CM_ITEM / 2);
#pragma unroll
                        for (int ks = 0; ks < 4; ++ks) ga[u][ks] = *(const bf16x8*)(cn + (32 * rq + ql) * 64 + 16 * ks + 8 * hh);
#pragma unroll
                        for (int g4 = 0; g4 < 4; ++g4) hc[u][g4] = *(const u32x2*)(cn + 4096 + (32 * cq + ql) * 64 + 32 * rq + 8 * g4 + 4 * hh); } }
                __syncthreads();
                if (wave < 4) {
#pragma unroll
                    for (int g4 = 0; g4 < 4; ++g4) *(LAS u32x2*)(lds + (32 * cq + ql) * CK_TP + (32 * rq + 8 * g4 + 4 * hh) * 2) = (u32x2){pk2(acc[4 * g4], acc[4 * g4 + 1]), pk2(acc[4 * g4 + 2], acc[4 * g4 + 3])}; }
                __syncthreads();
            }
        }
    }
}

__device__ __forceinline__ void phase_cout(const PArgs& a, int l) {
    const int bidx_ = obid();
    const int tid = otid(), lane = tid & 63, wave = __builtin_amdgcn_readfirstlane(tid >> 6), G = ogrid(), ql = lane & 31, hh = lane >> 5;
    for (int wt = bidx_ * NWV + wave; wt < 8192; wt += G * NWV) { const int item = wt >> 1, th = wt & 1; const bool gdn = item >= 2048; const int it = item & 2047, bh = it >> 6, ch = it & 63, b = bh >> 3, h = bh & 7;
        const bf16* cm = (const bf16*)(a.ws + (gdn ? S_CMG : S_CMR) + (size_t)it * CM_ITEM); const bf16* s0 = (const bf16*)(a.ws + (gdn ? S_S0G : S_S0R)) + (size_t)it * 4096;
        f32x16 y0, y1;
        { const bf16* yy = cm + 12288 + (32 * th + ql) * 64 + 4 * hh;
#pragma unroll
          for (int g4 = 0; g4 < 4; ++g4) { const u32x2 w0 = *(const u32x2*)(yy + 8 * g4), w1 = *(const u32x2*)(yy + 32 + 8 * g4);
              y0[4 * g4] = bf2f(w0.x & 0xffffu); y0[4 * g4 + 1] = bf2f(w0.x >> 16); y0[4 * g4 + 2] = bf2f(w0.y & 0xffffu); y0[4 * g4 + 3] = bf2f(w0.y >> 16);
              y1[4 * g4] = bf2f(w1.x & 0xffffu); y1[4 * g4 + 1] = bf2f(w1.x >> 16); y1[4 * g4 + 2] = bf2f(w1.y & 0xffffu); y1[4 * g4 + 3] = bf2f(w1.y >> 16); } }
#pragma unroll
        for (int ks = 0; ks < 4; ++ks) { const bf16x8 qf = *(const bf16x8*)(cm + 8192 + (32 * th + ql) * 64 + 16 * ks + 8 * hh);
            y0 = __builtin_amdgcn_mfma_f32_32x32x16_bf16(*(const bf16x8*)(s0 + ql * 64 + 16 * ks + 8 * hh), qf, y0, 0, 0, 0);
            y1 = __builtin_amdgcn_mfma_f32_32x32x16_bf16(*(const bf16x8*)(s0 + (32 + ql) * 64 + 16 * ks + 8 * hh), qf, y1, 0, 0, 0); }
        const size_t tok = (size_t)b * SEQ + ch * 64 + 32 * th + ql; const size_t base = tok * HW + h * 64 + 4 * hh;
        float s1 = 0.f;
#pragma unroll
        for (int r = 0; r < 16; ++r) s1 += y0[r] + y1[r];
        if (!gdn) { s1 += __shfl_xor(s1, 32); const float mean = s1 * (1.f / 64.f); float s2 = 0.f;
#pragma unroll
            for (int r = 0; r < 16; ++r) { const float d0 = y0[r] - mean, d1 = y1[r] - mean; s2 += d0 * d0 + d1 * d1; }
            s2 += __shfl_xor(s2, 32); const float rstd = rsqrtf(s2 * (1.f / 64.f) + 64e-5f); const float bsc = ((const float*)(a.ws + WS_CTL + C_BSC))[tok * 8 + h];
            const bf16* RV = (const bf16*)(a.ws + S_RV) + base; const bf16* RG = (const bf16*)(a.ws + S_RG) + base; bf16* OA = (bf16*)(a.ws + S_OA) + base;
            const float* lng = INF(14) + l * 512 + h * 64 + 4 * hh; const float* lnb = INF(15) + l * 512 + h * 64 + 4 * hh;
#pragma unroll
            for (int half = 0; half < 2; ++half)
#pragma unroll
                for (int g4 = 0; g4 < 4; ++g4) { const int co = 32 * half + 8 * g4; const u32x2 vw = *(const u32x2*)(RV + co), gw = *(const u32x2*)(RG + co); const f32x4 lg = *(const f32x4*)(lng + co), lb = *(const f32x4*)(lnb + co);
                    const float vv[4] = {bf2f(vw.x & 0xffffu), bf2f(vw.x >> 16), bf2f(vw.y & 0xffffu), bf2f(vw.y >> 16)}, gg[4] = {bf2f(gw.x & 0xffffu), bf2f(gw.x >> 16), bf2f(gw.y & 0xffffu), bf2f(gw.y >> 16)}; float o[4];
#pragma unroll
                    for (int e = 0; e < 4; ++e) { const float yv = half ? y1[4 * g4 + e] : y0[4 * g4 + e]; o[e] = ((yv - mean) * rstd * lg[e] + lb[e] + bsc * vv[e]) * gg[e]; }
                    *(u32x2*)(OA + co) = (u32x2){pk2(o[0], o[1]), pk2(o[2], o[3])}; } }
        else { float s2 = 0.f;
#pragma unroll
            for (int r = 0; r < 16; ++r) s2 += y0[r] * y0[r] + y1[r] * y1[r];
            s2 += __shfl_xor(s2, 32); const float rstd = rsqrtf(s2 * (1.f / 64.f) + NORM_EPS);
            const bf16* ZG = (const bf16*)(a.ws + S_ZG) + base; bf16* OC = (bf16*)(a.ws + S_OC) + base; const float* gng = INF(29) + l * 64 + 4 * hh;
#pragma unroll
            for (int half = 0; half < 2; ++half)
#pragma unroll
                for (int g4 = 0; g4 < 4; ++g4) { const int co = 32 * half + 8 * g4; const u32x2 gw = *(const u32x2*)(ZG + co); const f32x4 ng = *(const f32x4*)(gng + co);
                    const float gg[4] = {bf2f(gw.x & 0xffffu), bf2f(gw.x >> 16), bf2f(gw.y & 0xffffu), bf2f(gw.y >> 16)}; float o[4];
#pragma unroll
                    for (int e = 0; e < 4; ++e) { const float yv = half ? y1[4 * g4 + e] : y0[4 * g4 + e]; o[e] = yv * rstd * ng[e] * siluf_(gg[e]); }
                    *(u32x2*)(OC + co) = (u32x2){pk2(o[0], o[1]), pk2(o[2], o[3])}; } }
    }
}
__device__ __forceinline__ void phase_router(const PArgs& a) {
    const int bidx_ = obid();
    const int tid = otid(), lane = tid & 63, wave = __builtin_amdgcn_readfirstlane(tid >> 6), G = ogrid();
    const int gw = bidx_ * NWV + wave, NGW = G * NWV;
    const float* gf = INF(34) + D; const float* wr = INF(38);
    int* sel = (int*)(a.ws + WS_CTL + C_SEL); float* wts = (float*)(a.ws + WS_CTL + C_WTS); int* rank = (int*)(a.ws + WS_CTL + C_RANK); float* rs1 = (float*)(a.ws + WS_CTL + C_RS1);
    unsigned* cnt = (unsigned*)(a.ws + WS_CTL + C_MOE);
    for (int bi = gw; bi < T / 8; bi += NGW) { int my_e0 = -1, my_e1 = -1;
        for (int i = 0; i < 8; ++i) { const int t = bi * 8 + i; const f32x4* hr = (const f32x4*)(a.out + (size_t)t * D) + lane;
            f32x4 x[4]; float ssq = 0.f;
#pragma unroll
            for (int q = 0; q < 4; ++q) { x[q] = hr[64 * q]; ssq += (x[q][0] * x[q][0] + x[q][1] * x[q][1]) + (x[q][2] * x[q][2] + x[q][3] * x[q][3]); }
            ssq = wave_sum(ssq); const float rs = rsqrtf(ssq * (1.f / D) + NORM_EPS);
            float lg[8];
#pragma unroll
            for (int e = 0; e < 8; ++e) lg[e] = 0.f;
#pragma unroll
            for (int q = 0; q < 4; ++q) { const f32x4 g4 = *((const f32x4*)gf + lane + 64 * q);
#pragma unroll
                for (int j = 0; j < 4; ++j) { const int k = (lane + 64 * q) * 4 + j; const float u = x[q][j] * rs * g4[j]; const f32x4 w0 = *(const f32x4*)(wr + (size_t)k * 8), w1 = *(const f32x4*)(wr + (size_t)k * 8 + 4);
                    lg[0] += u * w0[0]; lg[1] += u * w0[1]; lg[2] += u * w0[2]; lg[3] += u * w0[3]; lg[4] += u * w1[0]; lg[5] += u * w1[1]; lg[6] += u * w1[2]; lg[7] += u * w1[3]; } }
#pragma unroll
            for (int e = 0; e < 8; ++e) lg[e] = wave_sum(lg[e]);
            int e0 = 0; float l0 = lg[0];
#pragma unroll
            for (int e = 1; e < 8; ++e) if (lg[e] > l0) { l0 = lg[e]; e0 = e; }
            int e1 = -1; float l1 = -3.4e38f;
#pragma unroll
            for (int e = 0; e < 8; ++e) if (e != e0 && lg[e] > l1) { l1 = lg[e]; e1 = e; }
            const float wa = 1.f / (1.f + __expf(l1 - l0));
            if (lane == i) { my_e0 = e0; my_e1 = e1; sel[t * 2] = e0; sel[t * 2 + 1] = e1; wts[t * 2] = wa; wts[t * 2 + 1] = 1.f - wa; rs1[t] = rs; } }
#pragma unroll
        for (int s = 0; s < 2; ++s) { const int me = s ? my_e1 : my_e0;
            for (int e = 0; e < 8; ++e) { const unsigned long long m = __ballot(me == e); if (m == 0ull) continue; const int n = __popcll(m);
                unsigned base = 0; if (lane == 0) base = atomicAdd(cnt + e, (unsigned)n); base = __builtin_amdgcn_readfirstlane(base);
                if (me == e) rank[(bi * 8 + lane) * 2 + s] = (int)base + __popcll(m & ((1ull << lane) - 1ull)); } }
    }
}
__device__ __forceinline__ void phase_assign(const PArgs& a) {
    const int bidx_ = obid();
    const int tid = otid(), lane = tid & 63, wave = __builtin_amdgcn_readfirstlane(tid >> 6), G = ogrid();
    const int gw = bidx_ * NWV + wave, NGW = G * NWV;
    const unsigned* cnt = (const unsigned*)(a.ws + WS_CTL + C_MOE);
    const int* sel = (const int*)(a.ws + WS_CTL + C_SEL); const int* rank = (const int*)(a.ws + WS_CTL + C_RANK); const float* rs1 = (const float*)(a.ws + WS_CTL + C_RS1);
    int* dest = (int*)(a.ws + WS_CTL + C_DEST); float* rsx = (float*)(a.ws + WS_CTL + C_RSX); int* blke = (int*)(a.ws + WS_CTL + C_BLKE);
    const bf16* hb = (const bf16*)(a.ws + WS_HB); bf16* xg = (bf16*)(a.ws + S_XG);
    int pstart[9]; pstart[0] = 0;
#pragma unroll
    for (int e = 0; e < 8; ++e) pstart[e + 1] = pstart[e] + (int)((cnt[e] + 255u) / 256u) * 256;
    if (bidx_ == 0 && tid < NBLK_MAX + 1) { if (tid == NBLK_MAX) blke[NBLK_MAX] = pstart[8] / 256; else { int e = 0;
#pragma unroll
            for (int q = 1; q < 8; ++q) if (tid * 256 >= pstart[q]) e = q;
            blke[tid] = e; } }
    for (int as = gw; as < T * 2; as += NGW) { const int t = as >> 1; const int e = sel[as];
        int ps = 0;
#pragma unroll
        for (int q = 0; q < 8; ++q) if (e == q) ps = pstart[q];
        const int d = ps + rank[as];
        if (lane == 0) { dest[as] = d; rsx[d] = rs1[t]; }
        const u32x4* src = (const u32x4*)(hb + (size_t)t * D); u32x4* dst = (u32x4*)(xg + (size_t)d * D);
        dst[lane] = src[lane]; dst[lane + 64] = src[lane + 64]; }
}
__device__ __forceinline__ void phase_combine(const PArgs& a) {
    const int bidx_ = obid();
    const int tid = otid(), lane = tid & 63, wave = __builtin_amdgcn_readfirstlane(tid >> 6), G = ogrid();
    const int gw = bidx_ * NWV + wave, NGW = G * NWV;
    const int* dest = (const int*)(a.ws + WS_CTL + C_DEST); const float* wts = (const float*)(a.ws + WS_CTL + C_WTS);
    const bf16* y = (const bf16*)(a.ws + S_XG); bf16* hb = (bf16*)(a.ws + WS_HB);
    for (int t = gw; t < T; t += NGW) { const int d0 = dest[t * 2], d1 = dest[t * 2 + 1]; const float w0 = wts[t * 2], w1 = wts[t * 2 + 1];
        f32x4* hr = (f32x4*)(a.out + (size_t)t * D); const u32x2* y0 = (const u32x2*)(y + (size_t)d0 * D); const u32x2* y1 = (const u32x2*)(y + (size_t)d1 * D); u32x2* hbr = (u32x2*)(hb + (size_t)t * D);
#pragma unroll
        for (int q = 0; q < 4; ++q) { const int ix = lane + 64 * q; f32x4 h = hr[ix]; const u32x2 a0 = y0[ix], a1 = y1[ix];
            h[0] += w0 * bf2f(a0.x & 0xffffu) + w1 * bf2f(a1.x & 0xffffu); h[1] += w0 * bf2f(a0.x >> 16) + w1 * bf2f(a1.x >> 16);
            h[2] += w0 * bf2f(a0.y & 0xffffu) + w1 * bf2f(a1.y & 0xffffu); h[3] += w0 * bf2f(a0.y >> 16) + w1 * bf2f(a1.y >> 16);
            hr[ix] = h; u32x2 w; w.x = pk2(h[0], h[1]); w.y = pk2(h[2], h[3]); hbr[ix] = w; } }
}
#ifndef PROBE_X
#define PROBE_X 0
#endif
#ifndef MK_ONE_LAUNCH
#define MK_ONE_LAUNCH 1
#endif
#define XB_TMO      128
#define XB_XCNT(j)  (256  + 64 * (j))
#define XB_XSUB(j)  (1280 + 64 * (j))
#define XB_XGEN(j)  (2304 + 64 * (j))
#define XB_TOP      3328
#define XB_TOPGEN   3392
#define XCD_BAR_WORDS 3456
#define XB_SPIN_CAP (1u << 22)
__device__ __forceinline__ unsigned xb_ld(unsigned* p)              { return __hip_atomic_load(p, __ATOMIC_RELAXED, __HIP_MEMORY_SCOPE_AGENT); }
__device__ __forceinline__ unsigned xb_add(unsigned* p, unsigned v) { return __hip_atomic_fetch_add(p, v, __ATOMIC_RELAXED, __HIP_MEMORY_SCOPE_AGENT); }
__device__ __forceinline__ unsigned xb_xcc_id() { return (unsigned)__builtin_amdgcn_s_getreg((3 << 11) | 20) & 0xFu; }
#define XB_SPIN(cond, bar) do { unsigned _sp = 0; while (cond) { __builtin_amdgcn_s_sleep(1); \
    if ((++_sp & 255u) == 0u) { if (xb_ld(&(bar)[XB_TMO])) break; if (_sp > XB_SPIN_CAP) { atomicAdd(&(bar)[XB_TMO], 1u); break; } } } } while (0)
struct XcdBarrier { unsigned* bar; unsigned x; volatile LAS unsigned* st; };
__device__ __forceinline__ XcdBarrier xcd_barrier_post(unsigned* bar, volatile LAS unsigned* st) {
    XcdBarrier b; b.bar = bar; b.x = xb_xcc_id(); b.st = st;
    if (threadIdx.x == 0) (void)xb_add(&bar[XB_XCNT(b.x)], 1u);
    return b;
}
__device__ __forceinline__ void xcd_barrier_complete(unsigned* bar, unsigned x, unsigned& nloc, unsigned& nx) {
    const unsigned G = gridDim.x * gridDim.y * gridDim.z;
    unsigned sum, cnt, mine, sp = 0u;
    for (;;) {
        sum = 0u; cnt = 0u; mine = 0u;
#pragma unroll
        for (unsigned j = 0; j < 16; ++j) { const unsigned c = xb_ld(&bar[XB_XCNT(j)]); sum += c; cnt += (c > 0u) ? 1u : 0u; mine = (j == x) ? c : mine; }
        if (sum == G) break;
        __builtin_amdgcn_s_sleep(1);
        if ((++sp & 255u) == 0u) { if (xb_ld(&bar[XB_TMO])) break; if (sp > XB_SPIN_CAP) { atomicAdd(&bar[XB_TMO], 1u); break; } }
    }
    nloc = mine > 0u ? mine : 1u; nx = cnt > 0u ? cnt : 1u;
}
__device__ __forceinline__ void xcd_barrier(const XcdBarrier& b_) {
    asm volatile("s_waitcnt vmcnt(0)" ::: "memory");
    __syncthreads();
    if (otid() == 0) {
        XcdBarrier b = b_; asm volatile("" : "+s"(b.bar)); b.x = xb_xcc_id();
        unsigned* bar = b.bar;
        __builtin_amdgcn_s_waitcnt(0);
        unsigned nloc = b.st[0], nx = b.st[1];
        if (nloc == 0u) { xcd_barrier_complete(bar, b.x, nloc, nx); b.st[0] = nloc; b.st[1] = nx; }
        const unsigned old = xb_add(&bar[XB_XSUB(b.x)], 1u);
        const unsigned gen = old / nloc;
        if (old + 1u == (gen + 1u) * nloc) {
            __builtin_amdgcn_fence(__ATOMIC_RELEASE, "agent");
            asm volatile("s_waitcnt vmcnt(0)" ::: "memory");
            const unsigned og = xb_add(&bar[XB_TOP], 1u);
            const unsigned tg = og / nx;
            if (og + 1u == (tg + 1u) * nx) xb_add(&bar[XB_TOPGEN], 1u);
            else XB_SPIN(xb_ld(&bar[XB_TOPGEN]) == tg, bar);
            __builtin_amdgcn_fence(__ATOMIC_ACQUIRE, "agent");
            xb_add(&bar[XB_XGEN(b.x)], 1u);
            asm volatile("s_waitcnt vmcnt(0)" ::: "memory");
        } else {
            XB_SPIN(xb_ld(&bar[XB_XGEN(b.x)]) == gen, bar);
            __builtin_amdgcn_fence(__ATOMIC_ACQUIRE, "agent");
            asm volatile("s_waitcnt vmcnt(0)" ::: "memory");
        }
    }
    __syncthreads();
}

enum PhaseKind { PK_PRO = 0, PK_G1A, PK_PRE, PK_G23, PK_MLAPOST, PK_ATT, PK_RGPREP, PK_SCAN, PK_FIN, PK_G1B, PK_MRG, PK_OUT, PK_FGU, PK_FD, PK_MOEA, PK_MOEB, PK_MGU0, PK_MD0, PK_MGU1, PK_MD1, PK_COMB, PK_PP, PK_PG, PK_COUT };
struct PhaseEnt { int kind, layer; };
__constant__ PhaseEnt g_prog[] = {
    {PK_PRO, 0},
    {PK_G1A, 0}, {PK_PRE, 0}, {PK_G23, 0}, {PK_MLAPOST, 0}, {PK_ATT, 0}, {PK_RGPREP, 0}, {PK_SCAN, 0}, {PK_FIN, 0}, {PK_COUT, 0}, {PK_G1B, 0}, {PK_MRG, 0}, {PK_OUT, 0}, {PK_FGU, 0}, {PK_FD, 0}, {PK_PP, 0}, {PK_PG, 0},
    {PK_G1A, 1}, {PK_PRE, 1}, {PK_G23, 1}, {PK_MLAPOST, 1}, {PK_ATT, 1}, {PK_RGPREP, 1}, {PK_SCAN, 1}, {PK_FIN, 1}, {PK_COUT, 1}, {PK_G1B, 1}, {PK_MRG, 1}, {PK_OUT, 1},
    {PK_MOEA, 1}, {PK_MOEB, 1}, {PK_MGU0, 1}, {PK_MD0, 1}, {PK_MGU1, 1}, {PK_MD1, 1}, {PK_COMB, 1}, {PK_PP, 1}, {PK_PG, 1},
};
constexpr int NPHASE = sizeof(g_prog) / sizeof(PhaseEnt);

constexpr int LDS_BYTES = 163840;
constexpr int LDS_MISC = 163840 - 1024;

template <int KINDT> __device__ __forceinline__ void run_phase(const Args& a_, int kind_rt, int l, LAS unsigned char* lds) {
    const int kind = KINDT >= 0 ? KINDT : kind_rt; const PArgs a = make_pargs(a_);
    const int G = ogrid(), c = obid();
    unsigned char* ws = a.ws;
    const bf16* Wl = (const bf16*)(ws + WS_W + (size_t)l * WL);
    float* SS0 = (float*)(ws + S_SSP0); float* SS1 = (float*)(ws + S_SSP1); float* SSE = (float*)(ws + S_SSP2);
    bf16* HB = (bf16*)(ws + WS_HB); const bf16* HBin = (const bf16*)(ws + (l == 0 ? WS_HB : WS_HB2));
    const bf16* Wp = (const bf16*)(ws + WS_W + W_PLE + (size_t)l * WPL);
    switch (kind) {
    case PK_PRO: phase_prologue(a, lds); break;
    case PK_G1A: { pg8::Gemm g{HBin, Wl + W_IN / 2, D, D, D}; pg8::StaticOrder S; S.init(T / 256, N1 / 256, G, c);
        EpiInProj E{(bf16*)(ws + S_ZR), (bf16*)(ws + S_ZQ), (bf16*)(ws + S_ZG), (bf16*)(ws + S_ZM), SS0}; pg8::gemm_phase(lds, g, S, E); } break;
    case PK_PRE: phase_pre(a, l); break;
    case PK_G23: { { pg8::Gemm g{(const bf16*)(ws + S_ZM), Wl + W_2 / 2, K2, NZM, K2}; pg8::StaticOrder S; S.init(T / 256, N2 / 256, G, c);
            EpiMla E{(bf16*)(ws + S_QRAW), (bf16*)(ws + S_KVRAW), (const float*)(ws + WS_CTL + C_RSQ), (const float*)(ws + WS_CTL + C_RSKV)}; pg8::gemm_phase(lds, g, S, E); }
        { pg8::Gemm g{(const bf16*)(ws + S_A2), Wl + W_3 / 2, K3, K3, K3}; pg8::StaticOrder S; S.init(T / 256, N3 / 256, G, c);
            EpiPlain E{(bf16*)(ws + S_L2), N3}; pg8::gemm_phase(lds, g, S, E); } } break;
    case PK_MLAPOST: phase_mla_post(a, l, lds); break;
    case PK_ATT: phase_attn(a, lds); break;
    case PK_RGPREP: phase_rwkv_post(a, l); phase_gdn_prep(a, l); break;
    case PK_SCAN: phase_cprep(a, lds); break;
    case PK_FIN: phase_cscan(a, lds); break;
    case PK_COUT: phase_cout(a, l); break;
    case PK_G1B: { pg8::Gemm g{HBin, Wl + W_GATE / 2, D, D, D}; pg8::StaticOrder S; S.init(T / 256, NGATE / 256, G, c);
        EpiGate E{(bf16*)(ws + S_ZS), SS0}; pg8::gemm_phase(lds, g, S, E); } break;
    case PK_MRG: { pg8::StaticOrder S; S.init(T / 256, D / 256, G, c);
        { pg8::Gemm g{(const bf16*)(ws + S_OA), Wl + W_BRA / 2, HW, HW, HW}; EpiMerge<true> E{(bf16*)(ws + S_M), (const bf16*)(ws + S_ZS), 0}; pg8::gemm_phase(lds, g, S, E); }
        { pg8::Gemm g{(const bf16*)(ws + S_OB), Wl + W_BRB / 2, HW, HW, HW}; EpiMerge<false> E{(bf16*)(ws + S_M), (const bf16*)(ws + S_ZS), 1}; pg8::gemm_phase(lds, g, S, E); }
        { pg8::Gemm g{(const bf16*)(ws + S_OC), Wl + W_BRC / 2, HW, HW, HW}; EpiMerge<false> E{(bf16*)(ws + S_M), (const bf16*)(ws + S_ZS), 2}; pg8::gemm_phase(lds, g, S, E); } } break;
    case PK_OUT: { pg8::Gemm g{(const bf16*)(ws + S_M), Wl + W_OUT / 2, D, D, D}; pg8::StaticOrder S; S.init(T / 256, D / 256, G, c);
#if PROBE_X == 1
        { EpiPlain E2{(bf16*)(ws + S_ZR), D}; pg8::gemm_phase(lds, g, S, E2); }
#endif
        EpiResid E{a.out, HB, SS1}; pg8::gemm_phase(lds, g, S, E); } break;
    case PK_FGU: { pg8::Gemm g{HB, (const bf16*)(ws + WS_W + W_FGU), D, D, D}; pg8::StaticOrder S; S.init(T / 256, 2 * FFD / 256, G, c);
        EpiSwiglu<false> E{(bf16*)(ws + S_ACT), FFD, SS1}; pg8::gemm_phase(lds, g, S, E); } break;
    case PK_FD: { pg8::Gemm g{(const bf16*)(ws + S_ACT), (const bf16*)(ws + WS_W + W_FD), FFD, FFD, FFD}; pg8::StaticOrder S; S.init(T / 256, D / 256, G, c);
#if PROBE_X == 2
        { EpiPlain E2{(bf16*)(ws + WS_S + 100 * MiB), D}; pg8::gemm_phase(lds, g, S, E2); }
#endif
        EpiResid E{a.out, HB, nullptr}; pg8::gemm_phase(lds, g, S, E); } break;
    case PK_MOEA: phase_moe_cvt(a, lds);
#ifdef PROBE_CVT
        phase_moe_cvt(a, lds);
#endif
        phase_router(a); break;
    case PK_MOEB: phase_assign(a); break;
    case PK_MGU0: case PK_MGU1: { const int half = (kind == PK_MGU1); const int* blke = (const int*)(ws + WS_CTL + C_BLKE); const int nblk = __builtin_amdgcn_readfirstlane(blke[NBLK_MAX]);
        const int lo = half * HALF_BLK, hi = nblk < lo + HALF_BLK ? nblk : lo + HALF_BLK, nM = hi > lo ? hi - lo : 0;
        pg8::Gemm g{(const bf16*)(ws + S_XG), (const bf16*)(ws + S_MWGU), D, D, D}; pg8::StaticOrder S; S.init(nM, 2 * FFE / 256, G, c, lo, blke);
        EpiSwiglu<true> E{(bf16*)(ws + S_MACT) - (size_t)lo * 256 * FFE, FFE, (const float*)(ws + WS_CTL + C_RSX)}; pg8::gemm_phase(lds, g, S, E); } break;
    case PK_MD0: case PK_MD1: { const int half = (kind == PK_MD1); const int* blke = (const int*)(ws + WS_CTL + C_BLKE); const int nblk = __builtin_amdgcn_readfirstlane(blke[NBLK_MAX]);
        const int lo = half * HALF_BLK, hi = nblk < lo + HALF_BLK ? nblk : lo + HALF_BLK, nM = hi > lo ? hi - lo : 0;
        pg8::Gemm g{(const bf16*)(ws + S_MACT) - (size_t)lo * 256 * FFE, (const bf16*)(ws + S_MWD), FFE, FFE, FFE}; pg8::StaticOrder S; S.init(nM, D / 256, G, c, lo, blke);
        EpiPlain E{(bf16*)(ws + S_XG), D}; pg8::gemm_phase(lds, g, S, E); } break;
    case PK_COMB: phase_combine(a); break;
    case PK_PP: { pg8::Gemm g{(const bf16*)(ws + WS_PB) + (size_t)l * T * PLE, Wp + W_PP / 2, PLE, PLE, PLE}; pg8::StaticOrder S; S.init(T / 256, D / 256, G, c);
        EpiPleProj E{(bf16*)(ws + S_E), SSE}; pg8::gemm_phase(lds, g, S, E); } break;
    case PK_PG: { pg8::Gemm g{HB, Wp + W_PG / 2, D, D, D}; pg8::StaticOrder S; S.init(T / 256, D / 256, G, c);
#if PROBE_X == 3
        { EpiPlain E2{(bf16*)(ws + WS_S + 100 * MiB), D}; pg8::gemm_phase(lds, g, S, E2); }
#endif
        EpiPleGate E{a.out, l + 1 < NL ? (bf16*)(ws + WS_HB2) : nullptr, (const bf16*)(ws + S_E), SSE, INF(44) + l * D, l + 1 < NL ? SS0 : nullptr}; pg8::gemm_phase(lds, g, S, E); } break;
    default: break;
    }
}

template <int KINDT> __global__ void __launch_bounds__(NTH, 2) k_one(Args a, int l) {
    extern __shared__ __attribute__((aligned(16))) unsigned char lds_raw[];
    run_phase<KINDT>(a, KINDT, l, (LAS unsigned char*)lds_raw);
}
#if MK_ONE_LAUNCH
__global__ void __launch_bounds__(NTH, 2) k_fwd(Args a) {
    extern __shared__ __attribute__((aligned(16))) unsigned char lds_raw[];
    LAS unsigned char* lds = (LAS unsigned char*)lds_raw;
    volatile LAS unsigned* misc = (volatile LAS unsigned*)(lds + LDS_MISC);
    if (threadIdx.x < 64) misc[threadIdx.x] = 0u;
    __syncthreads();
    const XcdBarrier bar = xcd_barrier_post((unsigned*)(a.ws + WS_CTL + C_BAR), misc + 8);
#ifndef PROBE_MASK
#define PROBE_MASK 0u
#endif
#define BAR() xcd_barrier(bar)
#define RUN(K, l) do { if ((PROBE_MASK >> K) & 1u) { run_phase<K>(a, K, l, lds); BAR(); } run_phase<K>(a, K, l, lds); } while (0)
#ifdef PROBE_BARS
    for (int q = 0; q < PROBE_BARS; ++q) BAR();
#endif
    RUN(PK_PRO, 0); BAR();
#define MIXER(l) RUN(PK_G1A, l); BAR(); RUN(PK_PRE, l); BAR(); RUN(PK_G23, l); BAR(); RUN(PK_MLAPOST, l); BAR(); RUN(PK_ATT, l); BAR(); RUN(PK_RGPREP, l); BAR(); \
        RUN(PK_SCAN, l); BAR(); RUN(PK_FIN, l); BAR(); RUN(PK_COUT, l); BAR(); RUN(PK_G1B, l); BAR(); RUN(PK_MRG, l); BAR(); RUN(PK_OUT, l); BAR();
    MIXER(0)
    RUN(PK_FGU, 0); BAR(); RUN(PK_FD, 0); BAR();
    RUN(PK_PP, 0); BAR(); RUN(PK_PG, 0); BAR();
    MIXER(1)
    RUN(PK_MOEA, 1); BAR(); RUN(PK_MOEB, 1); BAR(); RUN(PK_MGU0, 1); BAR(); RUN(PK_MD0, 1); BAR(); RUN(PK_MGU1, 1); BAR(); RUN(PK_MD1, 1); BAR(); RUN(PK_COMB, 1); BAR();
    RUN(PK_PP, 1); BAR(); RUN(PK_PG, 1);
#undef MIXER
#undef RUN
#undef BAR
}
#endif

#ifndef MK_ONE_LAUNCH
#define MK_ONE_LAUNCH 1
#endif
extern "C" void kernel_launch(void* const* d_in, const int* in_sizes, int n_in, void* d_out, int out_size, void* d_ws, size_t ws_size, hipStream_t stream) {
    static int grid = 0;
    if (grid == 0) {
        if (n_in != 45 || out_size != T * D || ws_size < WS_END) { fprintf(stderr, "kernel_launch: unexpected shapes: n_in %d out %d ws %zu (need %zu)\n", n_in, out_size, ws_size, (size_t)WS_END); grid = -1; return; }
        int dev = 0, cus = 0;
        if (hipGetDevice(&dev) != hipSuccess || hipDeviceGetAttribute(&cus, hipDeviceAttributeMultiprocessorCount, dev) != hipSuccess) { grid = -1; return; }
#if MK_ONE_LAUNCH
        if (hipFuncSetAttribute((const void*)k_fwd, hipFuncAttributeMaxDynamicSharedMemorySize, LDS_BYTES) != hipSuccess) { fprintf(stderr, "kernel_launch: hipFuncSetAttribute failed\n"); grid = -1; return; }
#else
#define SA(K) (void)hipFuncSetAttribute((const void*)k_one<K>, hipFuncAttributeMaxDynamicSharedMemorySize, LDS_BYTES);
        SA(PK_PRO) SA(PK_G1A) SA(PK_PRE) SA(PK_G23) SA(PK_MLAPOST) SA(PK_ATT) SA(PK_RGPREP) SA(PK_SCAN) SA(PK_FIN) SA(PK_G1B) SA(PK_MRG) SA(PK_OUT) SA(PK_FGU) SA(PK_FD) SA(PK_MOEA) SA(PK_MOEB) SA(PK_MGU0) SA(PK_MD0) SA(PK_MGU1) SA(PK_MD1) SA(PK_COMB) SA(PK_PP) SA(PK_PG) SA(PK_COUT)
#undef SA
#endif
        int per_cu = 0;
#if MK_ONE_LAUNCH
        if (hipOccupancyMaxActiveBlocksPerMultiprocessor(&per_cu, (const void*)k_fwd, NTH, LDS_BYTES) != hipSuccess || per_cu < 1) { fprintf(stderr, "kernel_launch: occupancy query says %d blocks/CU\n", per_cu); }
#endif
        (void)hipGetLastError();
        grid = cus;
    }
    if (grid < 0) return;
    (void)hipMemsetAsync((char*)d_ws + WS_CTL, 0, CTL_ZERO, stream);
    (void)hipMemsetAsync((char*)d_ws + WS_W, 0, 71 * MiB, stream);
    Args a{};
    for (int i = 0; i < 45; ++i) a.in[i] = d_in[i];
    a.out = (float*)d_out; a.ws = (unsigned char*)d_ws; a.layer = 0; a.pad = 0;
#if MK_ONE_LAUNCH
    hipLaunchKernelGGL(k_fwd, dim3(grid), dim3(NTH), LDS_BYTES, stream, a);
#else
    static const PhaseEnt prog_h[] = {
        {PK_PRO, 0},
        {PK_G1A, 0}, {PK_PRE, 0}, {PK_G23, 0}, {PK_MLAPOST, 0}, {PK_ATT, 0}, {PK_RGPREP, 0}, {PK_SCAN, 0}, {PK_FIN, 0}, {PK_COUT, 0}, {PK_G1B, 0}, {PK_MRG, 0}, {PK_OUT, 0}, {PK_FGU, 0}, {PK_FD, 0}, {PK_PP, 0}, {PK_PG, 0},
        {PK_G1A, 1}, {PK_PRE, 1}, {PK_G23, 1}, {PK_MLAPOST, 1}, {PK_ATT, 1}, {PK_RGPREP, 1}, {PK_SCAN, 1}, {PK_FIN, 1}, {PK_COUT, 1}, {PK_G1B, 1}, {PK_MRG, 1}, {PK_OUT, 1},
        {PK_MOEA, 1}, {PK_MOEB, 1}, {PK_MGU0, 1}, {PK_MD0, 1}, {PK_MGU1, 1}, {PK_MD1, 1}, {PK_COMB, 1}, {PK_PP, 1}, {PK_PG, 1} };
    for (int p = 0; p < (int)(sizeof(prog_h) / sizeof(prog_h[0])); ++p) { const int l = prog_h[p].layer;
#define LK(K) case K: hipLaunchKernelGGL(k_one<K>, dim3(grid), dim3(NTH), LDS_BYTES, stream, a, l); break;
        switch (prog_h[p].kind) { LK(PK_PRO) LK(PK_G1A) LK(PK_PRE) LK(PK_G23) LK(PK_MLAPOST) LK(PK_ATT) LK(PK_RGPREP) LK(PK_SCAN) LK(PK_FIN) LK(PK_G1B) LK(PK_MRG) LK(PK_OUT) LK(PK_FGU) LK(PK_FD) LK(PK_MOEA) LK(PK_MOEB) LK(PK_MGU0) LK(PK_MD0) LK(PK_MGU1) LK(PK_MD1) LK(PK_COMB) LK(PK_PP) LK(PK_PG) LK(PK_COUT) default: break; }
#undef LK
    }
#endif
}
```

```cpp
#include <hip/hip_runtime.h>
#include <cstdio>
#include <cstdint>
#ifndef PROBE_SUB
#define PROBE_SUB 0
#endif
__device__ __forceinline__ int otid() { int t = threadIdx.x; asm volatile("" : "+v"(t)); return t; }
__device__ __forceinline__ int obid() { int t = blockIdx.x; asm volatile("" : "+s"(t)); return t; }
__device__ __forceinline__ int ogrid() { int t = gridDim.x; asm volatile("" : "+s"(t)); return t; }
namespace pg8 {
#define PG8_LAS __attribute__((address_space(3)))
typedef unsigned short bf16_t;
typedef short bf16x8 __attribute__((ext_vector_type(8)));
typedef float f32x4 __attribute__((ext_vector_type(4)));
typedef unsigned u32x4 __attribute__((ext_vector_type(4)));
typedef unsigned u32x2 __attribute__((ext_vector_type(2)));
constexpr int BM = 256, BK = 64, HALF = 128, HTB = HALF * BK * 2, STAGE_BYTES = 8 * HTB, NXCD = 8, WGM = 8;

__host__ __device__ __forceinline__ int lds_byte(int r, int c) { const int st = (r >> 4) * 2 + (c >> 5), rr = r & 15, cc = c & 31, ob = rr * 64 + cc * 2; return st * 1024 + (ob ^ (((ob >> 9) & 1) << 5)); }
__host__ __device__ __forceinline__ void stage_rc(int b, int& R, int& C) { const int st = b / 1024, sb = b % 1024, swz = sb ^ (((sb >> 9) & 1) << 5); R = (st >> 1) * 16 + swz / 64; C = (st & 1) * 32 + (swz % 64) / 2; }
__host__ __device__ __forceinline__ int perm32(int rho) { const int n = rho >> 4, i = rho & 15; return 8 * (i >> 2) + 4 * n + (i & 3); }

struct Unit { int pm, pn, pb; };
struct Gemm { const bf16_t* A; const bf16_t* Bt; int K, lda, ldb; };

struct StaticOrder {
    int nM, nN, nwg, G, c, pm0; const int* blk_e;
    __device__ void init(int nM_, int nN_, int G_, int c_, int pm0_ = 0, const int* blk_e_ = nullptr) { nM = nM_; nN = nN_; nwg = nM * nN; G = G_; c = c_; pm0 = pm0_; blk_e = blk_e_; }
    __device__ bool next(int i, Unit& u) const {
        const long L = (long)i * G + c; if (L >= nwg) return false;
        int wgid = (int)L; { const int q = nwg / NXCD, r = nwg % NXCD, xcd = wgid % NXCD, off = wgid / NXCD; wgid = (xcd < r ? xcd * (q + 1) : r * (q + 1) + (xcd - r) * q) + off; }
        const int nig = WGM * nN, gid = wgid / nig, fm = gid * WGM, gsz = (nM - fm) < WGM ? (nM - fm) : WGM;
        u.pm = pm0 + fm + ((wgid % nig) % gsz); u.pn = (wgid % nig) / gsz;
        u.pb = blk_e ? (__builtin_amdgcn_readfirstlane(blk_e[u.pm]) * nN + u.pn) : u.pn;
        return true;
    }
};

typedef float cvt_f32x2 __attribute__((ext_vector_type(2)));
typedef __bf16 cvt_bf16x2 __attribute__((ext_vector_type(2)));
__device__ __forceinline__ unsigned cvt_pk_bf16(float lo, float hi) { const cvt_f32x2 v = {lo, hi}; return __builtin_bit_cast(unsigned, __builtin_convertvector(v, cvt_bf16x2)); }

template <class Epi, class Sched>
__device__ __forceinline__ void gemm_phase(PG8_LAS unsigned char* lds, const Gemm g, const Sched& S, const Epi& E) {
    const int tid = otid(), wid = __builtin_amdgcn_readfirstlane(tid >> 6), lane = tid & 63, wr = wid >> 2, wc = wid & 3, fr = lane & 15, fq = lane >> 4;
    const int K = g.K, nt = K / BK;
    unsigned voffA[2], voffB[2];
#pragma unroll
    for (int i = 0; i < 2; ++i) { int R, C; stage_rc(tid * 16 + i * 8192, R, C); const int Rb = Epi::PERM ? ((R & ~31) + perm32(R & 31)) : R;
        voffA[i] = (unsigned)(R * g.lda + C) * 2u; voffB[i] = (unsigned)(Rb * g.ldb + C) * 2u; }
    const size_t kstep = (size_t)(BK * 2);
    const size_t hA = (size_t)HALF * g.lda * 2, hB = (size_t)HALF * g.ldb * 2;
    const size_t tA = 2 * hA, tB = 2 * hB;
    const unsigned ldsw = (unsigned)wid * 1024u;
    const int aoff = lds_byte(wr * 64 + fr, fq * 8), boff = lds_byte(wc * 32 + fr, fq * 8);
#define PG8_SA(b, h) (((b) * 2 + (h)) * HTB)
#define PG8_SB(b, h) ((4 + (b) * 2 + (h)) * HTB)
#define PG8_STAGE(bufoff, gbase, voff) do { _Pragma("unroll") for (int _i = 0; _i < 2; ++_i) \
        __builtin_amdgcn_global_load_lds((const unsigned*)((const char*)(gbase) + (voff)[_i]), (PG8_LAS unsigned*)(lds + (bufoff) + ldsw + _i * 8192), 16, 0, 0); } while (0)
#define PG8_LDA(dst, b, h) do { _Pragma("unroll") for (int m = 0; m < 4; ++m) _Pragma("unroll") for (int k = 0; k < 2; ++k) dst[m][k] = *(const PG8_LAS bf16x8*)(lds + PG8_SA(b, h) + aoff + m * 2048 + k * 1024); } while (0)
#define PG8_LDB(dst, b, h) do { _Pragma("unroll") for (int n = 0; n < 2; ++n) _Pragma("unroll") for (int k = 0; k < 2; ++k) dst[n][k] = *(const PG8_LAS bf16x8*)(lds + PG8_SB(b, h) + boff + n * 2048 + k * 1024); } while (0)
#define PG8_MMA(ai, bj, At, Bt) do { __builtin_amdgcn_s_setprio(1); _Pragma("unroll") for (int m = 0; m < 4; ++m) _Pragma("unroll") for (int n = 0; n < 2; ++n) _Pragma("unroll") for (int k = 0; k < 2; ++k) \
        acc[ai][bj][m][n] = __builtin_amdgcn_mfma_f32_16x16x32_bf16(Bt[n][k], At[m][k], acc[ai][bj][m][n], 0, 0, 0); __builtin_amdgcn_s_setprio(0); } while (0)
#define PG8_WAIT_V(n) asm volatile("s_waitcnt vmcnt(" #n ")" ::: "memory")
#define PG8_WAIT_L(n) asm volatile("s_waitcnt lgkmcnt(" #n ")" ::: "memory")
#define PG8_BAR __builtin_amdgcn_s_barrier()
#define PG8_SCHED __builtin_amdgcn_sched_barrier(0)
    Unit cur, nxt; int ui = 0;
    if (!S.next(0, cur)) return;
    f32x4 acc[2][2][4][2];
#pragma unroll
    for (int a = 0; a < 2; ++a)
#pragma unroll
        for (int b = 0; b < 2; ++b)
#pragma unroll
            for (int m = 0; m < 4; ++m)
#pragma unroll
                for (int n = 0; n < 2; ++n) acc[a][b][m][n] = (f32x4){0.f, 0.f, 0.f, 0.f};
    bf16x8 At[4][2], B0[2][2], B1[2][2];
    const char* cA = (const char*)g.A + (size_t)cur.pm * tA; const char* cB = (const char*)g.Bt + (size_t)cur.pb * tB;
    PG8_STAGE(PG8_SB(0, 0), cB, voffB); PG8_STAGE(PG8_SB(0, 1), cB + hB, voffB); PG8_STAGE(PG8_SA(0, 0), cA, voffA); PG8_STAGE(PG8_SA(0, 1), cA + hA, voffA);
    if (wr == 1) PG8_BAR;
    PG8_WAIT_V(2); PG8_BAR;
    PG8_STAGE(PG8_SB(1, 0), cB + kstep, voffB); PG8_STAGE(PG8_SA(1, 0), cA + kstep, voffA); PG8_STAGE(PG8_SB(1, 1), cB + hB + kstep, voffB);
    PG8_WAIT_V(6); PG8_BAR;
    for (;;) {
        const bool has_next = S.next(ui + 1, nxt);
        const char* nA = has_next ? (const char*)g.A + (size_t)nxt.pm * tA : cA; const char* nB = has_next ? (const char*)g.Bt + (size_t)nxt.pb * tB : cB;
        for (int t = 0; t < nt; t += 2) {
            const bool last = (t == nt - 2);
            const char* a1 = cA + (size_t)(t + 1) * kstep;
            const char* a2 = last ? nA : cA + (size_t)(t + 2) * kstep; const char* b2 = last ? nB : cB + (size_t)(t + 2) * kstep;
            const char* a3 = a2 + kstep; const char* b3 = b2 + kstep;
            PG8_LDB(B0, 0, 0); PG8_LDB(B1, 0, 1); PG8_SCHED; PG8_LDA(At, 0, 0); PG8_STAGE(PG8_SA(1, 1), a1 + hA, voffA);
            PG8_WAIT_V(8); PG8_WAIT_L(0); PG8_BAR; PG8_MMA(0, 0, At, B0); PG8_MMA(0, 1, At, B1); PG8_BAR; PG8_SCHED;
            PG8_LDA(At, 0, 1); PG8_STAGE(PG8_SB(0, 0), b2, voffB); PG8_STAGE(PG8_SB(0, 1), b2 + hB, voffB); PG8_STAGE(PG8_SA(0, 0), a2, voffA);
            PG8_WAIT_V(8); PG8_WAIT_L(0); PG8_BAR; PG8_MMA(1, 0, At, B0); PG8_MMA(1, 1, At, B1); PG8_BAR; PG8_SCHED;
            PG8_LDB(B0, 1, 0); PG8_LDB(B1, 1, 1); PG8_SCHED; PG8_LDA(At, 1, 0); PG8_STAGE(PG8_SA(0, 1), a2 + hA, voffA);
            PG8_WAIT_V(8); PG8_WAIT_L(0); PG8_BAR; PG8_MMA(0, 0, At, B0); PG8_MMA(0, 1, At, B1); PG8_BAR; PG8_SCHED;
            PG8_LDA(At, 1, 1); PG8_STAGE(PG8_SB(1, 0), b3, voffB); PG8_STAGE(PG8_SB(1, 1), b3 + hB, voffB); PG8_STAGE(PG8_SA(1, 0), a3, voffA);
            PG8_WAIT_V(8); PG8_WAIT_L(0); PG8_BAR; PG8_MMA(1, 0, At, B0); PG8_MMA(1, 1, At, B1); PG8_BAR; PG8_SCHED;
        }
        if (wr == 0) PG8_BAR;
        E(acc, cur, wr, wc, fr, fq);
        if (!has_next) break;
#pragma unroll
        for (int a = 0; a < 2; ++a)
#pragma unroll
            for (int b = 0; b < 2; ++b)
#pragma unroll
                for (int m = 0; m < 4; ++m)
#pragma unroll
                    for (int n = 0; n < 2; ++n) acc[a][b][m][n] = (f32x4){0.f, 0.f, 0.f, 0.f};
        cur = nxt; cA = nA; cB = nB; ++ui;
        if (wr == 1) PG8_BAR;
    }
    PG8_WAIT_V(0);
    PG8_BAR;
#undef PG8_SA
#undef PG8_SB
#undef PG8_STAGE
#undef PG8_LDA
#undef PG8_LDB
#undef PG8_MMA
#undef PG8_WAIT_V
#undef PG8_WAIT_L
#undef PG8_BAR
#undef PG8_SCHED
}
}
#define GAS __attribute__((address_space(1)))
#define LAS __attribute__((address_space(3)))
typedef unsigned short bf16;
typedef float f32x4 __attribute__((ext_vector_type(4)));
typedef float f32x2 __attribute__((ext_vector_type(2)));
typedef float f32x16 __attribute__((ext_vector_type(16)));
typedef short bf16x8 __attribute__((ext_vector_type(8)));
typedef unsigned u32x4 __attribute__((ext_vector_type(4)));
typedef unsigned u32x2 __attribute__((ext_vector_type(2)));

constexpr int NB = 4, SEQ = 4096, T = NB * SEQ, D = 1024, NL = 2;
constexpr int NH = 8, HD = 64, HW = 512;
constexpr int N_IN = 7344, FFD = 2816, FFE = 3584, NE = 8, PLE = 256;
constexpr int N1 = 4352, NZR = 1792, NZQ = 1536, NZG = 512, NZM = 512, NGATE = 3072;
constexpr int K2 = 512, N2 = 1792, K3 = 384, N3 = 2048;
constexpr int QKD = 96;
constexpr int NBLK_MAX = 136, HALF_BLK = 68;
constexpr float NORM_EPS = 1e-6f;
constexpr int NTH = 512, NWV = 8;

constexpr size_t MiB = 1u << 20;
constexpr size_t WS_CTL = 0;
constexpr size_t WS_W = 2 * MiB;
constexpr size_t WS_HB = 73 * MiB;
constexpr size_t WS_PB = 105 * MiB;
constexpr size_t WS_VF = 121 * MiB;
constexpr size_t WS_S = 137 * MiB;
constexpr size_t WS_END = 553 * MiB;
constexpr size_t S_ZR = WS_S + 0 * MiB, S_ZQ = WS_S + 56 * MiB, S_ZG = WS_S + 104 * MiB, S_ZM = WS_S + 120 * MiB;
constexpr size_t S_A2 = WS_S + 136 * MiB, S_L2 = WS_S + 148 * MiB;
constexpr size_t S_QRAW = WS_S + 212 * MiB, S_KVRAW = WS_S + 236 * MiB, S_Q = WS_S + 268 * MiB, S_K = WS_S + 292 * MiB, S_VT = WS_S + 316 * MiB, S_OB = WS_S + 332 * MiB;
constexpr size_t S_RR = WS_S + 212 * MiB, S_RK = WS_S + 228 * MiB, S_RV = WS_S + 244 * MiB, S_RA = WS_S + 260 * MiB, S_RB = WS_S + 276 * MiB, S_RW = WS_S + 292 * MiB, S_RG = WS_S + 348 * MiB;
constexpr size_t S_GQ = WS_S + 364 * MiB, S_GK = WS_S + 380 * MiB, S_GV = WS_S + 396 * MiB, S_GAL = WS_S + 412 * MiB, S_GBE = WS_S + 412 * MiB + 524288;
constexpr size_t S_YA = WS_S + 148 * MiB, S_YC = WS_S + 164 * MiB, S_OA = WS_S + 212 * MiB, S_OC = WS_S + 228 * MiB;
constexpr size_t S_ZS = WS_S + 0 * MiB, S_M = WS_S + 348 * MiB;
constexpr size_t S_CMR = WS_S + 0 * MiB, S_S0R = WS_S + 64 * MiB, S_CMG = WS_S + 120 * MiB, S_S0G = WS_S + 184 * MiB;
constexpr size_t S_ACT = WS_S + 0 * MiB;
constexpr size_t S_MWGU = WS_S + 0 * MiB;
constexpr size_t S_MWD = WS_S + 112 * MiB;
constexpr size_t S_XG = WS_S + 168 * MiB;
constexpr size_t S_MACT = WS_S + 237 * MiB;
constexpr size_t S_E = WS_S + 358 * MiB;
constexpr size_t S_SSP0 = WS_S + 413 * MiB, S_SSP1 = WS_S + 414 * MiB, S_SSP2 = WS_S + 415 * MiB;
static_assert(S_SSP2 + MiB <= WS_END, "ws map");
static_assert(S_E + 32 * MiB <= WS_END, "ws map");
static_assert(S_MACT + (size_t)HALF_BLK * 256 * FFE * 2 <= S_E, "ws map");
static_assert(S_XG + (size_t)NBLK_MAX * 256 * D * 2 <= S_MACT, "ws map");
static_assert(S_GBE + 524288 <= WS_END, "ws map");

constexpr size_t WL = 41 * MiB;
constexpr size_t W_IN = 0, W_GATE = 9 * MiB, W_2 = 15 * MiB, W_3 = 17 * MiB, W_BRA = 19 * MiB, W_BRB = 20 * MiB, W_BRC = 21 * MiB, W_OUT = 22 * MiB;
constexpr size_t W_FGU = 24 * MiB, W_FD = 35 * MiB;
constexpr size_t W_PLE = 65 * MiB, WPL = 2 * MiB + 524288, W_PP = 0, W_PG = 524288;
static_assert(W_FD + (size_t)D * FFD * 2 <= WL && W_PLE + 2 * WPL <= 71 * MiB, "w map");
constexpr size_t WS_HB2 = WS_W;
constexpr size_t CTL_ZERO = 512 * 1024;
constexpr size_t C_BAR = 0;
constexpr size_t C_MOE = 16384;
constexpr size_t C_SS = 65536;
constexpr size_t C_RSQ = 512 * 1024, C_RSKV = C_RSQ + 65536;
constexpr size_t C_SEL = C_RSKV + 65536;
constexpr size_t C_WTS = C_SEL + 131072;
constexpr size_t C_RANK = C_WTS + 131072;
constexpr size_t C_DEST = C_RANK + 131072;
constexpr size_t C_RSX = C_DEST + 131072;
constexpr size_t C_BLKE = C_RSX + 139264;
constexpr size_t C_RS1 = C_BLKE + 1024;
constexpr size_t C_BSC = C_RS1 + 65536;
static_assert(C_BSC + 524288 <= 2 * MiB, "ctl map");

__device__ __forceinline__ float bf2f(unsigned v) { return __uint_as_float(v << 16); }
__device__ __forceinline__ unsigned f2bf(float f) { return pg8::cvt_pk_bf16(f, f) & 0xffffu; }
__device__ __forceinline__ unsigned pk2(float lo, float hi) { return pg8::cvt_pk_bf16(lo, hi); }
__device__ __forceinline__ float wave_sum(float v) {
#pragma unroll
    for (int o = 1; o < 64; o <<= 1) v += __shfl_xor(v, o);
    return v;
}
__device__ __forceinline__ float sigmoidf_(float x) { return __builtin_amdgcn_rcpf(1.f + __builtin_amdgcn_exp2f(-1.4426950408889634f * x)); }
__device__ __forceinline__ float sigmoid_fast_(float x) { return __builtin_amdgcn_rcpf(1.f + __builtin_amdgcn_exp2f(-1.4426950408889634f * x)); }
__device__ __forceinline__ float siluf_(float x) { return x * __builtin_amdgcn_rcpf(1.f + __builtin_amdgcn_exp2f(-1.4426950408889634f * x)); }
__device__ __forceinline__ float softplusf_(float x) { return fmaxf(x, 0.f) + log1pf(__expf(-fabsf(x))); }

struct Args { const void* in[45]; float* out; unsigned char* ws; int layer; int pad; };
typedef const void* gptr_t;
typedef const __attribute__((address_space(4))) gptr_t* kin_t;
struct PArgs { kin_t in; float* out; unsigned char* ws; };
__device__ __forceinline__ PArgs make_pargs(const Args& a) {
    PArgs p; p.in = (kin_t)__builtin_amdgcn_kernarg_segment_ptr();
    GAS float* o1 = (GAS float*)a.out; GAS unsigned char* w1 = (GAS unsigned char*)a.ws;
    asm volatile("" : "+s"(p.in), "+s"(o1), "+s"(w1)); p.out = (float*)o1; p.ws = (unsigned char*)w1; return p; }
#define INF(i) ((const float*)(const GAS float*)a.in[i])
#define EPI_ARGS const pg8::f32x4 (&acc)[2][2][4][2], const pg8::Unit& u, int wr, int wc, int fr, int fq
#define EPI_ROWS _Pragma("unroll") for (int ai = 0; ai < 2; ++ai) _Pragma("unroll") for (int m = 0; m < 4; ++m)
__device__ __forceinline__ u32x4 pack8(const f32x4 v0, const f32x4 v1) { u32x4 w; w.x = pg8::cvt_pk_bf16(v0[0], v0[1]); w.y = pg8::cvt_pk_bf16(v0[2], v0[3]); w.z = pg8::cvt_pk_bf16(v1[0], v1[1]); w.w = pg8::cvt_pk_bf16(v1[2], v1[3]); return w; }
__device__ __forceinline__ void unpack8(const u32x4 w, float (&f)[8]) { f[0] = bf2f(w.x & 0xffffu); f[1] = bf2f(w.x >> 16); f[2] = bf2f(w.y & 0xffffu); f[3] = bf2f(w.y >> 16); f[4] = bf2f(w.z & 0xffffu); f[5] = bf2f(w.z >> 16); f[6] = bf2f(w.w & 0xffffu); f[7] = bf2f(w.w >> 16); }

__device__ __forceinline__ float rowscale16(const float* ssp, int r) { const f32x4* p = (const f32x4*)(ssp + (size_t)r * 16); const f32x4 a = p[0], b = p[1], c = p[2], d = p[3];
    const float s = ((a[0] + a[1]) + (a[2] + a[3])) + ((b[0] + b[1]) + (b[2] + b[3])) + ((c[0] + c[1]) + (c[2] + c[3])) + ((d[0] + d[1]) + (d[2] + d[3])); return rsqrtf(s * (1.f / D) + NORM_EPS); }
struct EpiInProj {
    static constexpr bool PERM = true;
    bf16 *zr, *zq, *zg, *zm; const float* ss;
    __device__ __forceinline__ void operator()(EPI_ARGS) const {
        bf16* O; int ld, ct; const int pn = u.pn;
        if (pn < 7) { O = zr; ld = NZR; ct = pn * 256; } else if (pn < 13) { O = zq; ld = NZQ; ct = (pn - 7) * 256; } else if (pn < 15) { O = zg; ld = NZG; ct = (pn - 13) * 256; } else { O = zm; ld = NZM; ct = (pn - 15) * 256; }
        const int row0 = u.pm * 256 + wr * 64 + fr, col0 = ct + wc * 32 + 8 * fq;
        EPI_ROWS { const int r = row0 + ai * 128 + m * 16; const float s = rowscale16(ss, r); bf16* rowp = O + (size_t)r * ld + col0;
#pragma unroll
            for (int bj = 0; bj < 2; ++bj) *(u32x4*)(rowp + bj * 128) = pack8(acc[ai][bj][m][0] * s, acc[ai][bj][m][1] * s); }
    }
};
struct EpiGate {
    static constexpr bool PERM = true;
    bf16* O; const float* ss;
    __device__ __forceinline__ void operator()(EPI_ARGS) const {
        const int row0 = u.pm * 256 + wr * 64 + fr, col0 = u.pn * 256 + wc * 32 + 8 * fq;
        EPI_ROWS { const int r = row0 + ai * 128 + m * 16; const float s = rowscale16(ss, r); bf16* rowp = O + (size_t)r * NGATE + col0;
#pragma unroll
            for (int bj = 0; bj < 2; ++bj) { f32x4 v0 = acc[ai][bj][m][0] * s, v1 = acc[ai][bj][m][1] * s;
#pragma unroll
                for (int j = 0; j < 4; ++j) { v0[j] = sigmoid_fast_(v0[j]); v1[j] = sigmoid_fast_(v1[j]); }
                *(u32x4*)(rowp + bj * 128) = pack8(v0, v1); } }
    }
};
struct EpiMla {
    static constexpr bool PERM = true;
    bf16 *qraw, *kvraw; const float *rsq, *rskv;
    __device__ __forceinline__ void operator()(EPI_ARGS) const {
        const bool isq = u.pn < 3; bf16* O = isq ? qraw : kvraw; const int ld = isq ? 768 : 1024, ct = isq ? u.pn * 256 : (u.pn - 3) * 256; const float* rs = isq ? rsq : rskv;
        const int row0 = u.pm * 256 + wr * 64 + fr, col0 = ct + wc * 32 + 8 * fq;
        EPI_ROWS { const int r = row0 + ai * 128 + m * 16; const float s = rs[r]; bf16* rowp = O + (size_t)r * ld + col0;
#pragma unroll
            for (int bj = 0; bj < 2; ++bj) *(u32x4*)(rowp + bj * 128) = pack8(acc[ai][bj][m][0] * s, acc[ai][bj][m][1] * s); }
    }
};
struct EpiPlain {
    static constexpr bool PERM = true;
    bf16* O; int ld;
    __device__ __forceinline__ void operator()(EPI_ARGS) const {
        const int row0 = u.pm * 256 + wr * 64 + fr, col0 = u.pn * 256 + wc * 32 + 8 * fq;
        EPI_ROWS { const int r = row0 + ai * 128 + m * 16; bf16* rowp = O + (size_t)r * ld + col0;
#pragma unroll
            for (int bj = 0; bj < 2; ++bj) *(u32x4*)(rowp + bj * 128) = pack8(acc[ai][bj][m][0], acc[ai][bj][m][1]); }
    }
};
template <bool FIRST> struct EpiMerge {
    static constexpr bool PERM = true;
    bf16* M; const bf16* zs; int br;
    __device__ __forceinline__ void operator()(EPI_ARGS) const {
        const int row0 = u.pm * 256 + wr * 64 + fr, col0 = u.pn * 256 + wc * 32 + 8 * fq;
        EPI_ROWS { const int r = row0 + ai * 128 + m * 16;
#pragma unroll
            for (int bj = 0; bj < 2; ++bj) { const int c = col0 + bj * 128; float g[8], o[8]; unpack8(*(const u32x4*)(zs + (size_t)r * NGATE + br * 1024 + c), g);
                if (!FIRST) unpack8(*(const u32x4*)(M + (size_t)r * D + c), o);
                f32x4 v0, v1;
#pragma unroll
                for (int j = 0; j < 4; ++j) { v0[j] = g[j] * acc[ai][bj][m][0][j] + (FIRST ? 0.f : o[j]); v1[j] = g[4 + j] * acc[ai][bj][m][1][j] + (FIRST ? 0.f : o[4 + j]); }
                *(u32x4*)(M + (size_t)r * D + c) = pack8(v0, v1); } }
    }
};
struct EpiResid {
    static constexpr bool PERM = false;
    const float* base; float* out; bf16* hb; float* ss;
    __device__ __forceinline__ void operator()(EPI_ARGS) const {
        const int row0 = u.pm * 256 + wr * 64 + fr, col0 = u.pn * 256 + wc * 32 + 4 * fq;
        EPI_ROWS { const int r = row0 + ai * 128 + m * 16; float sq = 0.f;
#pragma unroll
            for (int bj = 0; bj < 2; ++bj)
#pragma unroll
                for (int n = 0; n < 2; ++n) { const size_t off = (size_t)r * D + col0 + bj * 128 + n * 16; f32x4 h = *(const f32x4*)(base + off); h += acc[ai][bj][m][n]; *(f32x4*)(out + off) = h;
                    u32x2 w; w.x = pg8::cvt_pk_bf16(h[0], h[1]); w.y = pg8::cvt_pk_bf16(h[2], h[3]); *(u32x2*)(hb + off) = w; sq += (h[0] * h[0] + h[1] * h[1]) + (h[2] * h[2] + h[3] * h[3]); }
            if (ss) { sq += __shfl_xor(sq, 16); sq += __shfl_xor(sq, 32); if (fq == 0) ss[(size_t)r * 16 + u.pn * 4 + wc] = sq; } }
    }
};
template <bool MOE> struct EpiSwiglu {
    static constexpr bool PERM = true;
    bf16* O; int ld; const float* rs;
    __device__ __forceinline__ void operator()(EPI_ARGS) const {
        const int row0 = u.pm * 256 + wr * 64 + fr, col0 = u.pn * 128 + wc * 32 + 8 * fq;
        EPI_ROWS { const int r = row0 + ai * 128 + m * 16; const float s = MOE ? rs[r] : rowscale16(rs, r);
            f32x4 v0, v1;
#pragma unroll
            for (int j = 0; j < 4; ++j) { v0[j] = siluf_(acc[ai][0][m][0][j] * s) * (acc[ai][1][m][0][j] * s); v1[j] = siluf_(acc[ai][0][m][1][j] * s) * (acc[ai][1][m][1][j] * s); }
            *(u32x4*)(O + (size_t)r * ld + col0) = pack8(v0, v1); }
    }
};
struct EpiPleProj {
    static constexpr bool PERM = true;
    bf16* O; float* sse;
    __device__ __forceinline__ void operator()(EPI_ARGS) const {
        const int row0 = u.pm * 256 + wr * 64 + fr, col0 = u.pn * 256 + wc * 32 + 8 * fq;
        EPI_ROWS { const int r = row0 + ai * 128 + m * 16; float sq = 0.f;
#pragma unroll
            for (int bj = 0; bj < 2; ++bj) { const f32x4 v0 = acc[ai][bj][m][0], v1 = acc[ai][bj][m][1]; *(u32x4*)(O + (size_t)r * D + col0 + bj * 128) = pack8(v0, v1);
                sq += (v0[0] * v0[0] + v0[1] * v0[1]) + (v0[2] * v0[2] + v0[3] * v0[3]) + (v1[0] * v1[0] + v1[1] * v1[1]) + (v1[2] * v1[2] + v1[3] * v1[3]); }
            sq += __shfl_xor(sq, 16); sq += __shfl_xor(sq, 32); if (fq == 0) sse[(size_t)r * 16 + u.pn * 4 + wc] = sq; }
    }
};
struct EpiPleGate {
    static constexpr bool PERM = false;
    float* out; bf16* hb; const bf16* E; const float* sse; const float* png; float* ssn;
    __device__ __forceinline__ void operator()(EPI_ARGS) const {
        const int row0 = u.pm * 256 + wr * 64 + fr, col0 = u.pn * 256 + wc * 32 + 4 * fq;
        EPI_ROWS { const int r = row0 + ai * 128 + m * 16; float sq = 0.f; const float se = rowscale16(sse, r);
#pragma unroll
            for (int bj = 0; bj < 2; ++bj)
#pragma unroll
                for (int n = 0; n < 2; ++n) { const int c = col0 + bj * 128 + n * 16; const size_t off = (size_t)r * D + c; f32x4 h = *(const f32x4*)(out + off);
                    const u32x2 ew = *(const u32x2*)(E + off); const f32x4 g = *(const f32x4*)(png + c);
                    const float e0 = bf2f(ew.x & 0xffffu), e1 = bf2f(ew.x >> 16), e2 = bf2f(ew.y & 0xffffu), e3 = bf2f(ew.y >> 16);
                    const f32x4 a4 = acc[ai][bj][m][n];
                    h[0] += sigmoidf_(a4[0]) * (e0 * se * g[0]); h[1] += sigmoidf_(a4[1]) * (e1 * se * g[1]); h[2] += sigmoidf_(a4[2]) * (e2 * se * g[2]); h[3] += sigmoidf_(a4[3]) * (e3 * se * g[3]);
                    *(f32x4*)(out + off) = h; if (hb) { u32x2 w; w.x = pg8::cvt_pk_bf16(h[0], h[1]); w.y = pg8::cvt_pk_bf16(h[2], h[3]); *(u32x2*)(hb + off) = w; }
                    sq += (h[0] * h[0] + h[1] * h[1]) + (h[2] * h[2] + h[3] * h[3]); }
            if (ssn) { sq += __shfl_xor(sq, 16); sq += __shfl_xor(sq, 32); if (fq == 0) ssn[(size_t)r * 16 + u.pn * 4 + wc] = sq; } }
    }
};
struct TJob { int src, src_off, K, ldn, n0, ncnt; int dst_off, dst_ld, dst_k0, dst_row0, rowmode; int gain, gain_off, gain2, gain2_off, g2mode; };
#define WOFF(l, o) ((int)((l) * WL + (o)))
#define LAYER_JOBS(l) \
    {4, (l) * D * N_IN, D, N_IN, 0, 1792, WOFF(l, W_IN), D, 0, 0, 0, 3, (l) * D, -1, 0, 0}, \
    {4, (l) * D * N_IN, D, N_IN, 2208, 1536, WOFF(l, W_IN), D, 0, 1792, 0, 3, (l) * D, -1, 0, 0}, \
    {4, (l) * D * N_IN, D, N_IN, 3760, 512, WOFF(l, W_IN), D, 0, 3328, 0, 3, (l) * D, -1, 0, 0}, \
    {4, (l) * D * N_IN, D, N_IN, 1792, 416, WOFF(l, W_IN), D, 0, 3840, 0, 3, (l) * D, -1, 0, 0}, \
    {4, (l) * D * N_IN, D, N_IN, 3744, 16, WOFF(l, W_IN), D, 0, 3840 + 416, 0, 3, (l) * D, -1, 0, 0}, \
    {4, (l) * D * N_IN, D, N_IN, 4272, 3072, WOFF(l, W_GATE), D, 0, 0, 0, 3, (l) * D, -1, 0, 0}, \
    {7, (l) * 64 * 512, 64, 512, 0, 512, WOFF(l, W_3), K3, 0, 0, 0, -1, 0, -1, 0, 0}, \
    {9, (l) * 64 * 512, 64, 512, 0, 512, WOFF(l, W_3), K3, 64, 512, 0, -1, 0, -1, 0, 0}, \
    {10, (l) * 128 * 512, 128, 512, 0, 512, WOFF(l, W_3), K3, 128, 1024, 0, -1, 0, -1, 0, 0}, \
    {22, (l) * 256 * 768, 256, 768, 0, 768, WOFF(l, W_2), K2, 0, 0, 0, 20, (l) * 256, -1, 0, 0}, \
    {23, (l) * 128 * 1024, 128, 1024, 0, 1024, WOFF(l, W_2), K2, 256, 768, 0, 21, (l) * 128, -1, 0, 0}, \
    {30, (l) * 512 * 1024, 512, 1024, 0, 1024, WOFF(l, W_BRA), 512, 0, 0, 0, -1, 0, -1, 0, 0}, \
    {31, (l) * 512 * 1024, 512, 1024, 0, 1024, WOFF(l, W_BRB), 512, 0, 0, 0, -1, 0, -1, 0, 0}, \
    {32, (l) * 512 * 1024, 512, 1024, 0, 1024, WOFF(l, W_BRC), 512, 0, 0, 0, -1, 0, -1, 0, 0}, \
    {33, (l) * D * D, D, D, 0, D, WOFF(l, W_OUT), D, 0, 0, 0, -1, 0, -1, 0, 0}, \
    {42, (l) * PLE * D, PLE, D, 0, D, (int)(W_PLE + (l) * WPL + W_PP), PLE, 0, 0, 0, -1, 0, -1, 0, 0}, \
    {43, (l) * D * D, D, D, 0, D, (int)(W_PLE + (l) * WPL + W_PG), D, 0, 0, 0, -1, 0, -1, 0, 0}
__constant__ TJob g_jobs[] = {
    LAYER_JOBS(0), LAYER_JOBS(1),
    {17, 0, D, 32, 0, 32, WOFF(1, W_IN), D, 0, 3840 + 432, 0, 3, 1 * D, 16, 0, 1},
    {17, 0, D, 32, 0, 32, WOFF(1, W_IN), D, 0, 3840 + 464, 0, 3, 1 * D, 16, 0, 2},
    {18, 0, 32, 512, 0, 512, WOFF(1, W_3), K3, 256, 1536, 0, -1, 0, -1, 0, 0},
    {35, 0, D, FFD, 0, FFD, (int)W_FGU, D, 0, 0, 1, 34, 0, -1, 0, 0},
    {36, 0, D, FFD, 0, FFD, (int)W_FGU, D, 0, 0, 2, 34, 0, -1, 0, 0},
    {37, 0, FFD, D, 0, D, (int)W_FD, FFD, 0, 0, 0, -1, 0, -1, 0, 0},
};
constexpr int NJOBS = sizeof(g_jobs) / sizeof(TJob);

__device__ __forceinline__ void transpose_item(const PArgs& a, const TJob& j, bf16* dstbase, LAS float* scr, int item, int lane) {
    const float* W = INF(j.src) + j.src_off;
    const int nblk = (j.ncnt + 31) / 32, kb = item / nblk, nb = item % nblk, k0 = 64 * kb, nl0 = 32 * nb;
    const int nl = nl0 + (lane & 31);
    float v[32];
#pragma unroll
    for (int i = 0; i < 32; ++i) { const int k = k0 + 2 * i + (lane >> 5); v[i] = (k < j.K && nl < j.ncnt) ? W[(size_t)k * j.ldn + j.n0 + nl] : 0.f; }
    const int c = lane & 7;
    float gn[8];
#pragma unroll
    for (int e = 0; e < 8; ++e) gn[e] = 1.f;
    if (k0 + 8 * c < j.K) {
        if (j.gain >= 0) { const float* G1 = INF(j.gain) + j.gain_off + k0 + 8 * c; const f32x4 g0 = *(const f32x4*)G1, g1 = *(const f32x4*)(G1 + 4);
#pragma unroll
            for (int e = 0; e < 4; ++e) { gn[e] = g0[e]; gn[4 + e] = g1[e]; } }
        if (j.gain2 >= 0) { const float* G2 = INF(j.gain2) + j.gain2_off + k0 + 8 * c; const f32x4 g0 = *(const f32x4*)G2, g1 = *(const f32x4*)(G2 + 4);
#pragma unroll
            for (int e = 0; e < 4; ++e) { gn[e] *= (j.g2mode == 1) ? (1.f - g0[e]) : g0[e]; gn[4 + e] *= (j.g2mode == 1) ? (1.f - g1[e]) : g1[e]; } } }
#pragma unroll
    for (int i = 0; i < 32; ++i) scr[(2 * i + (lane >> 5)) * 33 + (lane & 31)] = v[i];
    asm volatile("s_waitcnt lgkmcnt(0)" ::: "memory");
    if (k0 + 8 * c < j.K) {
#pragma unroll
        for (int q = 0; q < 4; ++q) { const int nloc = (lane >> 3) + 8 * q, n = nl0 + nloc; if (n < j.ncnt) { const LAS float* s = scr + (8 * c) * 33 + nloc;
            u32x4 o; o.x = pk2(s[0 * 33] * gn[0], s[1 * 33] * gn[1]); o.y = pk2(s[2 * 33] * gn[2], s[3 * 33] * gn[3]); o.z = pk2(s[4 * 33] * gn[4], s[5 * 33] * gn[5]); o.w = pk2(s[6 * 33] * gn[6], s[7 * 33] * gn[7]);
            const int row = j.dst_row0 + (j.rowmode == 0 ? n : (n / 128) * 256 + (n % 128) + (j.rowmode == 2 ? 128 : 0));
            *(u32x4*)(dstbase + (size_t)row * j.dst_ld + j.dst_k0 + k0 + 8 * c) = o; } }
    }
    asm volatile("s_waitcnt lgkmcnt(0)" ::: "memory");
}

__device__ __forceinline__ void phase_prologue(const PArgs& a, LAS unsigned char* lds) {
    const int bidx_ = obid();
    const int tid = otid(), lane = tid & 63, wave = __builtin_amdgcn_readfirstlane(tid >> 6), G = ogrid();
    const int gw = bidx_ * NWV + wave, NGW = G * NWV;
    LAS float* scr = (LAS float*)(lds + wave * 16384);
    { int ji = 0, base = 0, nit = ((g_jobs[0].K + 63) / 64) * ((g_jobs[0].ncnt + 31) / 32);
      for (int it = gw; ; it += NGW) {
          while (ji < NJOBS && it >= base + nit) { base += nit; ++ji; if (ji < NJOBS) nit = ((g_jobs[ji].K + 63) / 64) * ((g_jobs[ji].ncnt + 31) / 32); }
          if (ji >= NJOBS) break;
          const TJob j = g_jobs[ji]; transpose_item(a, j, (bf16*)(a.ws + WS_W + j.dst_off), scr, it - base, lane); } }
    const float* x = INF(0); bf16* hb = (bf16*)(a.ws + WS_HB); float* ss0 = (float*)(a.ws + S_SSP0);
    for (int m = gw; m < T; m += NGW) { const f32x4* xr = (const f32x4*)(x + (size_t)m * D) + lane; u32x2* hrow = (u32x2*)(hb + (size_t)m * D) + lane;
        float s = 0.f;
#pragma unroll
        for (int q = 0; q < 4; ++q) { const f32x4 v = xr[64 * q]; u32x2 w; w.x = pk2(v[0], v[1]); w.y = pk2(v[2], v[3]); hrow[64 * q] = w; s += (v[0] * v[0] + v[1] * v[1]) + (v[2] * v[2] + v[3] * v[3]); }
        s = wave_sum(s); if (lane < 16) ss0[(size_t)m * 16 + lane] = lane == 0 ? s : 0.f; }
    const f32x4* p4 = (const f32x4*)INF(1); u32x2* pb = (u32x2*)(a.ws + WS_PB);
    for (size_t i = (size_t)bidx_ * NTH + tid; i < (size_t)NL * T * PLE / 4; i += (size_t)G * NTH) { const f32x4 v = p4[i]; u32x2 w; w.x = pk2(v[0], v[1]); w.y = pk2(v[2], v[3]); pb[i] = w; }
}

__device__ __forceinline__ void phase_moe_cvt(const PArgs& a, LAS unsigned char* lds) {
    const int bidx_ = obid();
    const int tid = otid(), lane = tid & 63, wave = __builtin_amdgcn_readfirstlane(tid >> 6), G = ogrid();
    const int gw = bidx_ * NWV + wave, NGW = G * NWV;
    LAS float* scr = (LAS float*)(lds + wave * 16384);
    constexpr int IT_GU = (D / 64) * (FFE / 32), IT_D = (FFE / 64) * (D / 32);
    constexpr int PER_E = 2 * IT_GU + IT_D;
    for (int it = gw; it < NE * PER_E; it += NGW) { const int e = it / PER_E; int r = it % PER_E;
        TJob j; j.gain2 = -1; j.gain2_off = 0; j.g2mode = 0; j.n0 = 0; j.dst_k0 = 0;
        if (r < 2 * IT_GU) { const int up = r >= IT_GU; if (up) r -= IT_GU; j.src = up ? 40 : 39; j.src_off = e * D * FFE; j.K = D; j.ldn = FFE; j.ncnt = FFE; j.dst_ld = D; j.dst_row0 = e * 2 * FFE; j.rowmode = up ? 2 : 1; j.gain = 34; j.gain_off = D;
            transpose_item(a, j, (bf16*)(a.ws + S_MWGU), scr, r, lane); }
        else { r -= 2 * IT_GU; j.src = 41; j.src_off = e * FFE * D; j.K = FFE; j.ldn = D; j.ncnt = D; j.dst_ld = FFE; j.dst_row0 = e * D; j.rowmode = 0; j.gain = -1; j.gain_off = 0;
            transpose_item(a, j, (bf16*)(a.ws + S_MWD), scr, r, lane); } }
}
__device__ __forceinline__ void phase_pre(const PArgs& a, int l) {
    const int bidx_ = obid();
    const int tid = otid(), lane = tid & 63, wave = tid >> 6, G = ogrid();
    const bf16* zr = (const bf16*)(a.ws + S_ZR); const bf16* zm = (const bf16*)(a.ws + S_ZM); bf16* A2 = (bf16*)(a.ws + S_A2);
    float* rsq = (float*)(a.ws + WS_CTL + C_RSQ); float* rskv = (float*)(a.ws + WS_CTL + C_RSKV);
    constexpr int TT = 8;
    const float mu = tid < 256 ? INF(5)[l * 1792 + 1536 + tid] : 0.f;
    for (int g = bidx_; g < T / TT; g += G) { const int t0 = g * TT;
        if (tid < 256) { const int col = 1536 + tid; float v[TT + 1];
            v[0] = (t0 % SEQ == 0) ? 0.f : bf2f(zr[(size_t)(t0 - 1) * NZR + col]);
#pragma unroll
            for (int i = 0; i < TT; ++i) v[i + 1] = bf2f(zr[(size_t)(t0 + i) * NZR + col]);
#pragma unroll
            for (int i = 0; i < TT; ++i) { float x = v[i + 1] + (v[i] - v[i + 1]) * mu; if (tid < 64) x = tanhf(x); else if (tid >= 128) x = sigmoidf_(x); A2[(size_t)(t0 + i) * K3 + tid] = (bf16)f2bf(x); }
        } else if (tid < 288) { const int jx = tid - 256; float c1[TT], c2[TT + 1];
            c2[0] = (t0 % SEQ == 0) ? 0.f : bf2f(zm[(size_t)(t0 - 1) * NZM + 464 + jx]);
#pragma unroll
            for (int i = 0; i < TT; ++i) { c1[i] = bf2f(zm[(size_t)(t0 + i) * NZM + 432 + jx]); c2[i + 1] = bf2f(zm[(size_t)(t0 + i) * NZM + 464 + jx]); }
#pragma unroll
            for (int i = 0; i < TT; ++i) A2[(size_t)(t0 + i) * K3 + tid] = (bf16)f2bf(c1[i] + c2[i]);
        } else if (tid < 384) {
#pragma unroll
            for (int i = 0; i < TT; ++i) A2[(size_t)(t0 + i) * K3 + tid] = 0;
        } else if (wave == 6) { float s[TT];
#pragma unroll
            for (int i = 0; i < TT; ++i) { const u32x2 w = *(const u32x2*)(zm + (size_t)(t0 + i) * NZM + lane * 4); const float f0 = bf2f(w.x & 0xffffu), f1 = bf2f(w.x >> 16), f2 = bf2f(w.y & 0xffffu), f3 = bf2f(w.y >> 16); s[i] = f0 * f0 + f1 * f1 + f2 * f2 + f3 * f3; }
#pragma unroll
            for (int i = 0; i < TT; ++i) { const float q = wave_sum(s[i]); if (lane == 0) rsq[t0 + i] = rsqrtf(q * (1.f / 256.f) + NORM_EPS); }
        } else { float s[TT];
#pragma unroll
            for (int i = 0; i < TT; ++i) { const unsigned w = *(const unsigned*)(zm + (size_t)(t0 + i) * NZM + 256 + lane * 2); const float f0 = bf2f(w & 0xffffu), f1 = bf2f(w >> 16); s[i] = f0 * f0 + f1 * f1; }
#pragma unroll
            for (int i = 0; i < TT; ++i) { const float q = wave_sum(s[i]); if (lane == 0) rskv[t0 + i] = rsqrtf(q * (1.f / 128.f) + NORM_EPS); }
        }
    }
}

__device__ __forceinline__ void ld8(const bf16* p, float (&f)[8]) { unpack8(*(const u32x4*)p, f); }
__device__ __forceinline__ void st8(bf16* p, const float (&f)[8]) { *(u32x4*)p = (u32x4){pk2(f[0], f[1]), pk2(f[2], f[3]), pk2(f[4], f[5]), pk2(f[6], f[7])}; }
__device__ __forceinline__ void ldf8(const float* p, float (&f)[8]) { const f32x4 a = *(const f32x4*)p, b = *(const f32x4*)(p + 4); f[0] = a[0]; f[1] = a[1]; f[2] = a[2]; f[3] = a[3]; f[4] = b[0]; f[5] = b[1]; f[6] = b[2]; f[7] = b[3]; }
__device__ __forceinline__ float sum8lanes(float v) { v += __shfl_xor(v, 1); v += __shfl_xor(v, 2); v += __shfl_xor(v, 4); return v; }
__device__ __forceinline__ void phase_mla_post(const PArgs& a, int l, LAS unsigned char* lds) {
    const int bidx_ = obid();
    const int tid = otid(), lane = tid & 63, wave = __builtin_amdgcn_readfirstlane(tid >> 6), G = ogrid(), h = lane >> 3, sub = lane & 7;
    const bf16* qraw = (const bf16*)(a.ws + S_QRAW); const bf16* kvraw = (const bf16*)(a.ws + S_KVRAW); const bf16* zm = (const bf16*)(a.ws + S_ZM);
    bf16* Q = (bf16*)(a.ws + S_Q); bf16* Kk = (bf16*)(a.ws + S_K); bf16* Vt = (bf16*)(a.ws + S_VT);
    const int* pos = (const int*)(const GAS int*)a.in[2];
    const bool rp = sub < 4;
    float gq0[8], gk0[8], gq1[8], gk1[8], invf[8];
    ldf8(INF(24) + l * QKD + 8 * sub, gq0); ldf8(INF(25) + l * QKD + 8 * sub, gk0);
    ldf8(INF(24) + l * QKD + 64 + 8 * (sub & 3), gq1); ldf8(INF(25) + l * QKD + 64 + 8 * (sub & 3), gk1);
#pragma unroll
    for (int e = 0; e < 8; ++e) invf[e] = exp2f(-(float)(8 * (sub & 1) + e) * (13.287712379549449f / 16.f));
    const float qscale = 0.10206207261596577f * 1.4426950408889634f;
    for (int g = bidx_ * NWV + wave; g < T / 8; g += G * NWV) { const int t0 = g * 8, b = t0 / SEQ, s0 = t0 % SEQ;
        unsigned vtr[8][4];
#pragma unroll 2
        for (int i = 0; i < 8; ++i) { const size_t t = t0 + i; float q0[8], q1[8], k0[8], k1[8];
            ld8(qraw + t * 768 + h * 96 + 8 * sub, q0); ld8(kvraw + t * 1024 + h * 128 + 8 * sub, k0);
            const u32x4 vw = *(const u32x4*)(kvraw + t * 1024 + h * 128 + 64 + 8 * sub);
            if (rp) { ld8(qraw + t * 768 + h * 96 + 64 + 8 * sub, q1); ld8(zm + t * NZM + 384 + 8 * sub, k1); }
            else {
#pragma unroll
                for (int e = 0; e < 8; ++e) { q1[e] = 0.f; k1[e] = 0.f; } }
            const float ps = (float)pos[t];
            float sq = 0.f, sk = 0.f;
#pragma unroll
            for (int e = 0; e < 8; ++e) { sq += q0[e] * q0[e] + q1[e] * q1[e]; sk += k0[e] * k0[e] + k1[e] * k1[e]; }
            sq = sum8lanes(sq); sk = sum8lanes(sk);
            const float rq = rsqrtf(sq * (1.f / QKD) + NORM_EPS), rk = rsqrtf(sk * (1.f / QKD) + NORM_EPS);
            float qo[8], ko[8], qr[8], kr[8];
#pragma unroll
            for (int e = 0; e < 8; ++e) { qo[e] = q0[e] * rq * gq0[e] * qscale; ko[e] = k0[e] * rk * gk0[e]; q1[e] = q1[e] * rq * gq1[e]; k1[e] = k1[e] * rk * gk1[e]; }
#pragma unroll
            for (int e = 0; e < 8; ++e) { const float qp = __shfl_xor(q1[e], 2), kp = __shfl_xor(k1[e], 2);
                const double rev = (double)(ps * invf[e]) * 0.15915494309189535; const float fr = (float)(rev - rint(rev));
                const float sn = __builtin_amdgcn_sinf(fr), cs = __builtin_amdgcn_cosf(fr);
                qr[e] = ((sub & 2) ? (q1[e] * cs + qp * sn) : (q1[e] * cs - qp * sn)) * qscale; kr[e] = (sub & 2) ? (k1[e] * cs + kp * sn) : (k1[e] * cs - kp * sn); }
            const size_t ro = ((size_t)(b * NH + h) * SEQ + s0 + i) * QKD;
            st8(Q + ro + 8 * sub, qo); st8(Kk + ro + 8 * sub, ko);
            if (rp) { st8(Q + ro + 64 + 8 * sub, qr); st8(Kk + ro + 64 + 8 * sub, kr); }
            vtr[i][0] = vw.x; vtr[i][1] = vw.y; vtr[i][2] = vw.z; vtr[i][3] = vw.w; }
#pragma unroll
        for (int e = 0; e < 8; ++e) { u32x4 o;
            const unsigned x0 = (e & 1) ? (vtr[0][e >> 1] >> 16) : (vtr[0][e >> 1] & 0xffffu), x1 = (e & 1) ? (vtr[1][e >> 1] >> 16) : (vtr[1][e >> 1] & 0xffffu);
            const unsigned x2 = (e & 1) ? (vtr[2][e >> 1] >> 16) : (vtr[2][e >> 1] & 0xffffu), x3 = (e & 1) ? (vtr[3][e >> 1] >> 16) : (vtr[3][e >> 1] & 0xffffu);
            const unsigned x4 = (e & 1) ? (vtr[4][e >> 1] >> 16) : (vtr[4][e >> 1] & 0xffffu), x5 = (e & 1) ? (vtr[5][e >> 1] >> 16) : (vtr[5][e >> 1] & 0xffffu);
            const unsigned x6 = (e & 1) ? (vtr[6][e >> 1] >> 16) : (vtr[6][e >> 1] & 0xffffu), x7 = (e & 1) ? (vtr[7][e >> 1] >> 16) : (vtr[7][e >> 1] & 0xffffu);
            o.x = x0 | (x1 << 16); o.y = x2 | (x3 << 16); o.z = x4 | (x5 << 16); o.w = x6 | (x7 << 16);
            *(u32x4*)(Vt + ((size_t)(b * NH + h) * 64 + 8 * sub + e) * SEQ + s0) = o; }
    }
}

__device__ __forceinline__ void phase_rwkv_post(const PArgs& a, int l) {
    const int bidx_ = obid();
    const int tid = otid(), lane = tid & 63, wave = __builtin_amdgcn_readfirstlane(tid >> 6), G = ogrid(), c0 = lane * 8, h = lane >> 3;
    const bf16* zr = (const bf16*)(a.ws + S_ZR); const bf16* L2 = (const bf16*)(a.ws + S_L2); bf16* vf = (bf16*)(a.ws + WS_VF);
    bf16* RR = (bf16*)(a.ws + S_RR); bf16* RK = (bf16*)(a.ws + S_RK); bf16* RV = (bf16*)(a.ws + S_RV); bf16* RA = (bf16*)(a.ws + S_RA); bf16* RB = (bf16*)(a.ws + S_RB); float* RW = (float*)(a.ws + S_RW); bf16* RG = (bf16*)(a.ws + S_RG);
    float* bscA = (float*)(a.ws + WS_CTL + C_BSC);
    float mur[8], muk[8], muv[8], w0[8], a0[8], kkc[8], kac[8], rkc[8], vb[8];
    ldf8(INF(5) + l * 1792 + c0, mur); ldf8(INF(5) + l * 1792 + 512 + c0, muk); ldf8(INF(5) + l * 1792 + 1024 + c0, muv);
    ldf8(INF(6) + l * 512 + c0, w0); ldf8(INF(8) + l * 512 + c0, a0); ldf8(INF(11) + l * 512 + c0, kkc); ldf8(INF(12) + l * 512 + c0, kac); ldf8(INF(13) + l * 512 + c0, rkc);
    if (l > 0) ldf8(INF(19) + (l - 1) * 512 + c0, vb);
    for (int g = bidx_ * NWV + wave; g < T / 8; g += G * NWV) { const int t0 = g * 8;
        float pr[8], pk[8], pv[8];
        if (t0 % SEQ == 0) {
#pragma unroll
            for (int e = 0; e < 8; ++e) { pr[e] = 0.f; pk[e] = 0.f; pv[e] = 0.f; } }
        else { ld8(zr + (size_t)(t0 - 1) * NZR + c0, pr); ld8(zr + (size_t)(t0 - 1) * NZR + 512 + c0, pk); ld8(zr + (size_t)(t0 - 1) * NZR + 1024 + c0, pv); }
#pragma unroll 2
        for (int i = 0; i < 8; ++i) { const size_t t = t0 + i; float zr_[8], zk_[8], zv_[8], lw[8], la[8], lg[8], lv[8], vfi[8];
            ld8(zr + t * NZR + c0, zr_); ld8(zr + t * NZR + 512 + c0, zk_); ld8(zr + t * NZR + 1024 + c0, zv_);
            ld8(L2 + t * N3 + c0, lw); ld8(L2 + t * N3 + 512 + c0, la); ld8(L2 + t * N3 + 1024 + c0, lg);
            if (l > 0) { ld8(L2 + t * N3 + 1536 + c0, lv); ld8(vf + t * HW + c0, vfi); }
            float r[8], kp[8], v[8], av[8], bv[8], dw[8]; float ssq = 0.f, bs = 0.f;
#pragma unroll
            for (int e = 0; e < 8; ++e) { r[e] = zr_[e] + (pr[e] - zr_[e]) * mur[e]; const float k = zk_[e] + (pk[e] - zk_[e]) * muk[e]; v[e] = zv_[e] + (pv[e] - zv_[e]) * muv[e];
                pr[e] = zr_[e]; pk[e] = zk_[e]; pv[e] = zv_[e];
                const float logw = -softplusf_(-(w0[e] + lw[e])) - 0.5f; dw[e] = -__expf(logw);
                const float iclr = sigmoidf_(a0[e] + la[e]);
                if (l > 0) v[e] = v[e] + (vfi[e] - v[e]) * sigmoidf_(vb[e] + lv[e]);
                const float kkr = k * kkc[e]; ssq += kkr * kkr; av[e] = kkr; bv[e] = iclr;
                kp[e] = k * (1.f + (iclr - 1.f) * kac[e]); bs += r[e] * kp[e] * rkc[e]; }
            ssq = sum8lanes(ssq); bs = sum8lanes(bs); const float rn = rsqrtf(ssq + 1e-12f);
#pragma unroll
            for (int e = 0; e < 8; ++e) { const float kk = av[e] * rn; av[e] = -kk; bv[e] = kk * bv[e]; }
            if (l == 0) st8(vf + t * HW + c0, v);
            st8(RR + t * HW + c0, r); st8(RK + t * HW + c0, kp); st8(RV + t * HW + c0, v); st8(RA + t * HW + c0, av); st8(RB + t * HW + c0, bv); st8(RG + t * HW + c0, lg);
            *(f32x4*)(RW + t * HW + c0) = (f32x4){dw[0], dw[1], dw[2], dw[3]}; *(f32x4*)(RW + t * HW + c0 + 4) = (f32x4){dw[4], dw[5], dw[6], dw[7]};
            if ((lane & 7) == 0) bscA[t * 8 + h] = bs; }
    }
}

__device__ __forceinline__ void phase_gdn_prep(const PArgs& a, int l) {
    const int bidx_ = obid();
    const int tid = otid(), lane = tid & 63, wave = __builtin_amdgcn_readfirstlane(tid >> 6), G = ogrid(), c0 = lane * 8, h = lane >> 3;
    const bf16* zq = (const bf16*)(a.ws + S_ZQ); const bf16* zm = (const bf16*)(a.ws + S_ZM);
    float* GAL = (float*)(a.ws + S_GAL); float* GBE = (float*)(a.ws + S_GBE);
    const float* cw = INF(26) + l * 4 * NZQ;
    for (int u = bidx_ * NWV + wave; u < 3 * (T / 8); u += G * NWV) { const int which = u / (T / 8), t0 = (u % (T / 8)) * 8;
        const int cc = which * 512 + c0; bf16* O = (bf16*)(a.ws + (which == 0 ? S_GQ : which == 1 ? S_GK : S_GV));
        float w[4][8];
#pragma unroll
        for (int j = 0; j < 4; ++j) ldf8(cw + j * NZQ + cc, w[j]);
        float x0[8], x1[8], x2[8];
        if (t0 % SEQ == 0) {
#pragma unroll
            for (int e = 0; e < 8; ++e) { x0[e] = 0.f; x1[e] = 0.f; x2[e] = 0.f; } }
        else { ld8(zq + (size_t)(t0 - 3) * NZQ + cc, x0); ld8(zq + (size_t)(t0 - 2) * NZQ + cc, x1); ld8(zq + (size_t)(t0 - 1) * NZQ + cc, x2); }
        float alog = 0.f, dtb = 0.f; if (which == 0 && lane < 8) { alog = INF(27)[l * 8 + lane]; dtb = INF(28)[l * 8 + lane]; }
#pragma unroll 2
        for (int i = 0; i < 8; ++i) { const size_t t = t0 + i; float x3[8], y[8]; ld8(zq + t * NZQ + cc, x3);
            float ss = 0.f;
#pragma unroll
            for (int e = 0; e < 8; ++e) { const float c = w[0][e] * x0[e] + w[1][e] * x1[e] + w[2][e] * x2[e] + w[3][e] * x3[e]; y[e] = siluf_(c); ss += y[e] * y[e]; x0[e] = x1[e]; x1[e] = x2[e]; x2[e] = x3[e]; }
            if (which < 2) { ss = sum8lanes(ss); const float rn = rsqrtf(ss + 1e-12f) * (which == 0 ? 0.125f : 1.f);
#pragma unroll
                for (int e = 0; e < 8; ++e) y[e] *= rn; }
            st8(O + t * HW + c0, y);
            if (which == 0 && lane < 8) { const float bl = bf2f(zm[t * NZM + 416 + lane]), al = bf2f(zm[t * NZM + 424 + lane]); GBE[t * 8 + lane] = sigmoidf_(bl); GAL[t * 8 + lane] = -__expf(alog) * softplusf_(al + dtb); } }
    }
}

__device__ __forceinline__ void phase_finish(const PArgs& a, int l) {
    const int bidx_ = obid();
    const int tid = otid(), lane = tid & 63, h = tid >> 6, G = ogrid(), c = tid;
    const bf16* YA = (const bf16*)(a.ws + S_YA); const bf16* YC = (const bf16*)(a.ws + S_YC); const bf16* RR = (const bf16*)(a.ws + S_RR); const bf16* RK = (const bf16*)(a.ws + S_RK); const bf16* RV = (const bf16*)(a.ws + S_RV); const bf16* RG = (const bf16*)(a.ws + S_RG);
    const bf16* zg = (const bf16*)(a.ws + S_ZG); bf16* OA = (bf16*)(a.ws + S_OA); bf16* OC = (bf16*)(a.ws + S_OC);
    const float rkc = INF(13)[l * 512 + c], lng = INF(14)[l * 512 + c], lnb = INF(15)[l * 512 + c], gng = INF(29)[l * 64 + lane];
    constexpr int TT = 4;
    for (int g = bidx_; g < T / TT; g += G) { const int t0 = g * TT; float ya[TT], yc[TT], r[TT], k[TT], v[TT], gt[TT], gg[TT];
#pragma unroll
        for (int i = 0; i < TT; ++i) { const size_t o = (size_t)(t0 + i) * HW + c; ya[i] = bf2f(YA[o]); yc[i] = bf2f(YC[o]); r[i] = bf2f(RR[o]); k[i] = bf2f(RK[o]); v[i] = bf2f(RV[o]); gt[i] = bf2f(RG[o]); gg[i] = bf2f(zg[o]); }
#pragma unroll
        for (int i = 0; i < TT; ++i) { const size_t o = (size_t)(t0 + i) * HW + c;
            const float mean = wave_sum(ya[i]) * (1.f / 64.f); const float d = ya[i] - mean; const float var = wave_sum(d * d) * (1.f / 64.f);
            const float bon = wave_sum(r[i] * k[i] * rkc) * v[i];
            const float y = d * rsqrtf(var + 64e-5f) * lng + lnb + bon;
            OA[o] = (bf16)f2bf(y * gt[i]);
            const float ms = wave_sum(yc[i] * yc[i]) * (1.f / 64.f);
            OC[o] = (bf16)f2bf(yc[i] * rsqrtf(ms + NORM_EPS) * gng * siluf_(gg[i])); }
    }
}
constexpr int AT_KP = 208, AT_VP = 136, AT_KB = 64 * AT_KP, AT_VB = 64 * AT_VP;
constexpr int AT_K0 = 0, AT_V0 = 2 * AT_KB;
template <int AV> __device__ __forceinline__ void attn_unit(const bf16* Q, const bf16* K, const bf16* Vt, bf16* OB, LAS unsigned char* lds, int b, int h, int qb) {
    const int tid = otid(), lane = tid & 63, wave = __builtin_amdgcn_readfirstlane(tid >> 6), ql = lane & 31, hh = lane >> 5;
    const int qrow0 = qb * 256 + wave * 32;
    const size_t bh = (size_t)(b * NH + h);
    bf16x8 qf[6];
    { const bf16* qp = Q + (bh * SEQ + qrow0 + ql) * QKD + 8 * hh;
#pragma unroll
      for (int s = 0; s < 6; ++s) qf[s] = *(const bf16x8*)(qp + 16 * s); }
    f32x16 o0, o1;
#pragma unroll
    for (int r = 0; r < 16; ++r) { o0[r] = 0.f; o1[r] = 0.f; }
    float mrun = -1e30f, lsum = 0.f;
    const int nkt = 4 * qb + 4;
    const unsigned char* Kb = (const unsigned char*)(K + bh * SEQ * QKD);
    const unsigned char* Vb = (const unsigned char*)(Vt + bh * 64 * SEQ);
    const int kr0 = tid / 12, kc0 = tid % 12, id1 = tid + 512, kr1 = id1 / 12, kc1 = id1 % 12; const bool k1v = id1 < 768;
    const int vr = tid >> 3, vc = tid & 7;
    u32x4 rk0, rk1, rv;
#define AT_LOADK(kt) do { const size_t key0 = (size_t)(kt) * 64; rk0 = *(const u32x4*)(Kb + (key0 + kr0) * (QKD * 2) + kc0 * 16); if (k1v) rk1 = *(const u32x4*)(Kb + (key0 + kr1) * (QKD * 2) + kc1 * 16); } while (0)
#define AT_LOADV(kt) do { rv = *(const u32x4*)(Vb + ((size_t)vr * SEQ + (size_t)(kt) * 64) * 2 + vc * 16); } while (0)
#define AT_STOREK(buf) do { LAS unsigned char* bp = lds + AT_K0 + (buf) * AT_KB; *(LAS u32x4*)(bp + kr0 * AT_KP + kc0 * 16) = rk0; if (k1v) *(LAS u32x4*)(bp + kr1 * AT_KP + kc1 * 16) = rk1; } while (0)
#define AT_STOREV(buf) do { LAS u32x2* vp = (LAS u32x2*)(lds + AT_V0 + (buf) * AT_VB + vr * AT_VP + vc * 16); vp[0] = (u32x2){rv.x, rv.y}; vp[1] = (u32x2){rv.z, rv.w}; } while (0)
#define AT_KFR(buf) do { const LAS unsigned char* kb = lds + AT_K0 + (buf) * AT_KB; \
        _Pragma("unroll") for (int s = 0; s < 6; ++s) { kfr[2 * s] = *(const LAS bf16x8*)(kb + ql * AT_KP + (16 * s + 8 * hh) * 2); kfr[2 * s + 1] = *(const LAS bf16x8*)(kb + (32 + ql) * AT_KP + (16 * s + 8 * hh) * 2); } } while (0)
#define AT_QK(dst0, dst1) do { \
        _Pragma("unroll") for (int r = 0; r < 16; ++r) { dst0[r] = 0.f; dst1[r] = 0.f; } \
        _Pragma("unroll") for (int s = 0; s < 6; ++s) { dst0 = __builtin_amdgcn_mfma_f32_32x32x16_bf16(kfr[2 * s], qf[s], dst0, 0, 0, 0); dst1 = __builtin_amdgcn_mfma_f32_32x32x16_bf16(kfr[2 * s + 1], qf[s], dst1, 0, 0, 0); } } while (0)
    bf16x8 kfr[12]; union VF { u32x4 u; bf16x8 v; } vfa[4], vfb[4];
    AT_LOADK(0); AT_LOADV(0); AT_STOREK(0); AT_STOREV(0); AT_LOADK(1); AT_STOREK(1);
    __syncthreads();
    f32x16 s0, s1;
    AT_KFR(0); AT_QK(s0, s1);
    for (int kt = 0; kt < nkt; ++kt) {
        const bool nx = kt + 1 < nkt;
        if (AV != 2) { if (kt + 2 < nkt) AT_LOADK(kt + 2);
        if (nx) AT_LOADV(kt + 1); }
        { const LAS unsigned char* vb = lds + AT_V0 + (kt & 1) * AT_VB;
#pragma unroll
          for (int q = 0; q < 4; ++q) { const int kofs = ((q >> 1) * 32 + 16 * (q & 1) + 4 * hh) * 2;
              { const u32x2 lo = *(const LAS u32x2*)(vb + ql * AT_VP + kofs), hi = *(const LAS u32x2*)(vb + ql * AT_VP + kofs + 16); vfa[q].u = (u32x4){lo.x, lo.y, hi.x, hi.y}; }
              { const u32x2 lo = *(const LAS u32x2*)(vb + (32 + ql) * AT_VP + kofs), hi = *(const LAS u32x2*)(vb + (32 + ql) * AT_VP + kofs + 16); vfb[q].u = (u32x4){lo.x, lo.y, hi.x, hi.y}; } } }
        f32x16 n0, n1;
        if (nx && wave < 4) { AT_KFR((kt + 1) & 1); AT_QK(n0, n1); }
        if (64 * kt + 63 > qrow0) { const int qi = qrow0 + ql, kbase = 64 * kt + 4 * hh;
#pragma unroll
            for (int r = 0; r < 16; ++r) { const int key = kbase + (r & 3) + 8 * (r >> 2); if (key > qi) s0[r] = -1e30f; if (key + 32 > qi) s1[r] = -1e30f; } }
        float mx = s0[0];
#pragma unroll
        for (int r = 1; r < 16; ++r) mx = fmaxf(mx, s0[r]);
#pragma unroll
        for (int r = 0; r < 16; ++r) mx = fmaxf(mx, s1[r]);
        mx = fmaxf(mx, __shfl_xor(mx, 32));
        const float mnew = fmaxf(mrun, mx), alpha = __builtin_amdgcn_exp2f(mrun - mnew); mrun = mnew;
        float ps = 0.f;
#pragma unroll
        for (int r = 0; r < 16; ++r) { if (AV == 1) { s0[r] = (s0[r] - mnew) * 1e-3f; s1[r] = (s1[r] - mnew) * 1e-3f; } else { s0[r] = __builtin_amdgcn_exp2f(s0[r] - mnew); s1[r] = __builtin_amdgcn_exp2f(s1[r] - mnew); } ps += s0[r] + s1[r]; }
        lsum = lsum * alpha + ps;
#pragma unroll
        for (int r = 0; r < 16; ++r) { o0[r] *= alpha; o1[r] *= alpha; }
#pragma unroll
        for (int q = 0; q < 4; ++q) { union { u32x4 u; bf16x8 v; } pf; const int s2 = q & 1;
            if (q < 2) { pf.u.x = pg8::cvt_pk_bf16(s0[8 * s2 + 0], s0[8 * s2 + 1]); pf.u.y = pg8::cvt_pk_bf16(s0[8 * s2 + 2], s0[8 * s2 + 3]); pf.u.z = pg8::cvt_pk_bf16(s0[8 * s2 + 4], s0[8 * s2 + 5]); pf.u.w = pg8::cvt_pk_bf16(s0[8 * s2 + 6], s0[8 * s2 + 7]); }
            else { pf.u.x = pg8::cvt_pk_bf16(s1[8 * s2 + 0], s1[8 * s2 + 1]); pf.u.y = pg8::cvt_pk_bf16(s1[8 * s2 + 2], s1[8 * s2 + 3]); pf.u.z = pg8::cvt_pk_bf16(s1[8 * s2 + 4], s1[8 * s2 + 5]); pf.u.w = pg8::cvt_pk_bf16(s1[8 * s2 + 6], s1[8 * s2 + 7]); }
            if (AV == 3) { o0[q] += bf2f(pf.u.x & 0xffffu) + bf2f(vfa[q].u.x); o1[q] += bf2f(pf.u.y >> 16) + bf2f(vfb[q].u.y); } else {
            o0 = __builtin_amdgcn_mfma_f32_32x32x16_bf16(vfa[q].v, pf.v, o0, 0, 0, 0); o1 = __builtin_amdgcn_mfma_f32_32x32x16_bf16(vfb[q].v, pf.v, o1, 0, 0, 0); } }
        if (nx && wave >= 4) { AT_KFR((kt + 1) & 1); AT_QK(n0, n1); }
        if (AV != 2) { if (kt + 2 < nkt) AT_STOREK(kt & 1);
        if (nx) AT_STOREV((kt + 1) & 1); }
        __syncthreads();
        if (nx) { s0 = n0; s1 = n1; }
    }
#undef AT_LOADK
#undef AT_LOADV
#undef AT_STOREK
#undef AT_STOREV
#undef AT_QK
#undef AT_KFR
    const float ltot = lsum + __shfl_xor(lsum, 32), inv = 1.f / ltot;
    bf16* op = OB + ((size_t)b * SEQ + qrow0 + ql) * HW + h * 64 + 4 * hh;
#pragma unroll
    for (int g = 0; g < 4; ++g) { u32x2 w0, w1; w0.x = pg8::cvt_pk_bf16(o0[4 * g] * inv, o0[4 * g + 1] * inv); w0.y = pg8::cvt_pk_bf16(o0[4 * g + 2] * inv, o0[4 * g + 3] * inv);
        w1.x = pg8::cvt_pk_bf16(o1[4 * g] * inv, o1[4 * g + 1] * inv); w1.y = pg8::cvt_pk_bf16(o1[4 * g + 2] * inv, o1[4 * g + 3] * inv);
        *(u32x2*)(op + 8 * g) = w0; *(u32x2*)(op + 32 + 8 * g) = w1; }
}
template <int AV> __device__ __forceinline__ void phase_attn(const PArgs& a, LAS unsigned char* lds) {
    const int bidx_ = obid();
    const bf16* Q = (const bf16*)(a.ws + S_Q); const bf16* K = (const bf16*)(a.ws + S_K); const bf16* Vt = (const bf16*)(a.ws + S_VT); bf16* OB = (bf16*)(a.ws + (AV == 0 ? S_OB : S_RG));
    for (int pi0 = bidx_; pi0 < NB * NH * 8; pi0 += ogrid()) { const int xg = pi0 & 7, ix = pi0 >> 3; const int pi = (ogrid() % 8 == 0 && pi0 < 256) ? ((xg * 4 + (ix >> 3)) * 8 + (ix & 7)) : pi0; const int bh = pi >> 3, j = pi & 7;
        attn_unit<AV>(Q, K, Vt, OB, lds, bh >> 3, bh & 7, 15 - j);
        attn_unit<AV>(Q, K, Vt, OB, lds, bh >> 3, bh & 7, j); }
}

constexpr int SC_STEPS = 16, SC_ROW = 5 * 64 + 16, SC_BUF = SC_STEPS * SC_ROW * 4;
__device__ __forceinline__ void scan_task(const PArgs& a, int task, LAS unsigned char* wlds) {
    const int lane = otid() & 63, i = lane >> 2, jq = lane & 3;
    const bool gdn = task >= 128; const int tt = gdn ? task - 128 : task; const int b = tt >> 5, h = (tt >> 2) & 7, rg = tt & 3;
    const bf16 *PR, *PK, *PV, *PA, *PB; const float* PW; const float *PAL, *PBE; bf16* Y;
    if (!gdn) { PR = (const bf16*)(a.ws + S_RR); PK = (const bf16*)(a.ws + S_RK); PV = (const bf16*)(a.ws + S_RV); PA = (const bf16*)(a.ws + S_RA); PB = (const bf16*)(a.ws + S_RB); PW = (const float*)(a.ws + S_RW); PAL = nullptr; PBE = nullptr; Y = (bf16*)(a.ws + S_YA); }
    else { PR = (const bf16*)(a.ws + S_GQ); PK = (const bf16*)(a.ws + S_GK); PV = (const bf16*)(a.ws + S_GV); PA = nullptr; PB = nullptr; PW = nullptr; PAL = (const float*)(a.ws + S_GAL); PBE = (const float*)(a.ws + S_GBE); Y = (bf16*)(a.ws + S_YC); }
    const size_t row0 = (size_t)b * SEQ; const int col0 = h * 64;
    const int bs = lane >> 3, be = 8 * (lane & 7);
    u32x4 gr[2], gk[2], ga[2], gb[2], gv; f32x4 gw[4]; float gal[2], gbe[2];
#define SC_LOAD(c) do { const size_t t0_ = row0 + (size_t)(c) * SC_STEPS; \
        _Pragma("unroll") for (int q = 0; q < 2; ++q) { const size_t o_ = (t0_ + bs + 8 * q) * HW + col0 + be; gr[q] = *(const u32x4*)(PR + o_); gk[q] = *(const u32x4*)(PK + o_); \
            if (!gdn) { ga[q] = *(const u32x4*)(PA + o_); gb[q] = *(const u32x4*)(PB + o_); } else { gal[q] = PAL[(t0_ + bs + 8 * q) * 8 + h]; gbe[q] = PBE[(t0_ + bs + 8 * q) * 8 + h]; } } \
        if (!gdn) { _Pragma("unroll") for (int q = 0; q < 4; ++q) gw[q] = *(const f32x4*)(PW + (t0_ + (lane >> 4) + 4 * q) * HW + col0 + 4 * (lane & 15)); } \
        if (lane < 32) gv = *(const u32x4*)(PV + (t0_ + (lane >> 1)) * HW + col0 + rg * 16 + (lane & 1) * 8); } while (0)
#define SC_STORE(buf) do { LAS float* B_ = (LAS float*)(wlds + (buf) * SC_BUF); \
        _Pragma("unroll") for (int q = 0; q < 2; ++q) { LAS float* R_ = B_ + (bs + 8 * q) * SC_ROW; float fr_[8], fk_[8]; unpack8(gr[q], fr_); unpack8(gk[q], fk_); \
            if (!gdn) { float fa_[8], fb_[8]; unpack8(ga[q], fa_); unpack8(gb[q], fb_); \
                *(LAS f32x4*)(R_ + 0 + be) = (f32x4){fa_[0], fa_[1], fa_[2], fa_[3]}; *(LAS f32x4*)(R_ + 0 + be + 4) = (f32x4){fa_[4], fa_[5], fa_[6], fa_[7]}; \
                *(LAS f32x4*)(R_ + 128 + be) = (f32x4){fb_[0], fb_[1], fb_[2], fb_[3]}; *(LAS f32x4*)(R_ + 128 + be + 4) = (f32x4){fb_[4], fb_[5], fb_[6], fb_[7]}; \
                *(LAS f32x4*)(R_ + 192 + be) = (f32x4){fk_[0], fk_[1], fk_[2], fk_[3]}; *(LAS f32x4*)(R_ + 192 + be + 4) = (f32x4){fk_[4], fk_[5], fk_[6], fk_[7]}; } \
            else { const float al_ = gal[q], be_ = gbe[q], nab_ = -al_ * be_; \
                *(LAS f32x4*)(R_ + 0 + be) = (f32x4){fk_[0], fk_[1], fk_[2], fk_[3]}; *(LAS f32x4*)(R_ + 0 + be + 4) = (f32x4){fk_[4], fk_[5], fk_[6], fk_[7]}; \
                *(LAS f32x4*)(R_ + 64 + be) = (f32x4){al_, al_, al_, al_}; *(LAS f32x4*)(R_ + 64 + be + 4) = (f32x4){al_, al_, al_, al_}; \
                *(LAS f32x4*)(R_ + 128 + be) = (f32x4){fk_[0] * nab_, fk_[1] * nab_, fk_[2] * nab_, fk_[3] * nab_}; *(LAS f32x4*)(R_ + 128 + be + 4) = (f32x4){fk_[4] * nab_, fk_[5] * nab_, fk_[6] * nab_, fk_[7] * nab_}; \
                *(LAS f32x4*)(R_ + 192 + be) = (f32x4){fk_[0] * be_, fk_[1] * be_, fk_[2] * be_, fk_[3] * be_}; *(LAS f32x4*)(R_ + 192 + be + 4) = (f32x4){fk_[4] * be_, fk_[5] * be_, fk_[6] * be_, fk_[7] * be_}; } \
            *(LAS f32x4*)(R_ + 256 + be) = (f32x4){fr_[0], fr_[1], fr_[2], fr_[3]}; *(LAS f32x4*)(R_ + 256 + be + 4) = (f32x4){fr_[4], fr_[5], fr_[6], fr_[7]}; } \
        if (!gdn) { _Pragma("unroll") for (int q = 0; q < 4; ++q) *(LAS f32x4*)(B_ + ((lane >> 4) + 4 * q) * SC_ROW + 64 + 4 * (lane & 15)) = gw[q]; } \
        if (lane < 32) { float fv_[8]; unpack8(gv, fv_); LAS float* V_ = B_ + (lane >> 1) * SC_ROW + 320 + (lane & 1) * 8; *(LAS f32x4*)(V_) = (f32x4){fv_[0], fv_[1], fv_[2], fv_[3]}; *(LAS f32x4*)(V_ + 4) = (f32x4){fv_[4], fv_[5], fv_[6], fv_[7]}; } } while (0)
    float st[16];
#pragma unroll
    for (int q = 0; q < 16; ++q) st[q] = 0.f;
    SC_LOAD(0); SC_STORE(0);
    constexpr int NCH = SEQ / SC_STEPS;
    for (int c = 0; c < NCH; ++c) {
        if (c + 1 < NCH) SC_LOAD(c + 1);
        const LAS float* B_ = (const LAS float*)(wlds + (c & 1) * SC_BUF);
        for (int s = 0; s < SC_STEPS; ++s) { const LAS float* R_ = B_ + s * SC_ROW + 16 * jq;
            float va[16], vw[16], vb[16], vk[16], vr[16];
#pragma unroll
            for (int q = 0; q < 4; ++q) { const f32x4 x0 = *(const LAS f32x4*)(R_ + 4 * q), x1 = *(const LAS f32x4*)(R_ + 64 + 4 * q), x2 = *(const LAS f32x4*)(R_ + 128 + 4 * q), x3 = *(const LAS f32x4*)(R_ + 192 + 4 * q), x4 = *(const LAS f32x4*)(R_ + 256 + 4 * q);
#pragma unroll
                for (int e = 0; e < 4; ++e) { va[4 * q + e] = x0[e]; vw[4 * q + e] = x1[e]; vb[4 * q + e] = x2[e]; vk[4 * q + e] = x3[e]; vr[4 * q + e] = x4[e]; } }
            const float vi = B_[s * SC_ROW + 320 + i];
            float sa = 0.f;
#pragma unroll
            for (int q = 0; q < 16; ++q) sa += st[q] * va[q];
            sa += __shfl_xor(sa, 1); sa += __shfl_xor(sa, 2);
            float y = 0.f;
#pragma unroll
            for (int q = 0; q < 16; ++q) { st[q] = st[q] * vw[q] + sa * vb[q] + vi * vk[q]; y += st[q] * vr[q]; }
            y += __shfl_xor(y, 1); y += __shfl_xor(y, 2);
            if (jq == 0) Y[(row0 + (size_t)c * SC_STEPS + s) * HW + col0 + rg * 16 + i] = (bf16)f2bf(y);
        }
        if (c + 1 < NCH) SC_STORE((c + 1) & 1);
    }
#undef SC_LOAD
#undef SC_STORE
}
__device__ __forceinline__ void phase_scan(const PArgs& a, LAS unsigned char* lds) {
    const int bidx_ = obid();
    const int wave = __builtin_amdgcn_readfirstlane(otid() >> 6), G = ogrid();
    if (wave < 3) for (int task = bidx_ + wave * G; task < 256; task += 3 * G) scan_task(a, task, lds + wave * (2 * SC_BUF));
}
constexpr int CK_TP = 144;
constexpr int CK_AT = 0, CK_BT = 9216, CK_KT = 18432, CK_RT = 27648, CK_BW = 36864, CK_KW = 46080, CK_V = 55296, CK_N = 64512, CK_LAK = 73728, CK_LRB = 82944, CK_LRK = 92160,
              CK_AW = 101376, CK_W1 = 110592, CK_AH = 119808, CK_LVT = 129024, CK_DD = 138240;
constexpr int CK_CUM = 147456, CK_CUMP = 147712, CK_PC = 147968, CK_WTOT = 148224;
constexpr int CM_ITEM = 32768;
typedef short s16x4 __attribute__((ext_vector_type(4)));
__device__ __forceinline__ bf16x8 ck_frag(const LAS unsigned char* tile, int row, int ks, int hh) { return *(const LAS bf16x8*)(tile + row * CK_TP + (16 * ks + 8 * hh) * 2); }
__device__ __forceinline__ int crow_(int r, int hh) { return (r & 3) + 8 * (r >> 2) + 4 * hh; }
struct CkIn { u32x4 r, k, v, a, b; f32x4 w0, w1; float g, be; };
__device__ __forceinline__ void ck_load(const PArgs& a, int item, int t, int j0, CkIn& o) {
    const bool gdn = item >= 2048; const int it = item & 2047, bh = it >> 6, ch = it & 63, b = bh >> 3, h = bh & 7;
    const size_t row = (size_t)b * SEQ + ch * 64 + t; const size_t eo = row * HW + h * 64 + j0;
    const bf16* pr = (const bf16*)(a.ws + (gdn ? S_GQ : S_RR)); const bf16* pk = (const bf16*)(a.ws + (gdn ? S_GK : S_RK)); const bf16* pv = (const bf16*)(a.ws + (gdn ? S_GV : S_RV));
    const bf16* pa = (const bf16*)(a.ws + (gdn ? S_GK : S_RA)); const bf16* pb = (const bf16*)(a.ws + (gdn ? S_GK : S_RB));
    o.r = *(const u32x4*)(pr + eo); o.k = *(const u32x4*)(pk + eo); o.v = *(const u32x4*)(pv + eo); o.a = *(const u32x4*)(pa + eo); o.b = *(const u32x4*)(pb + eo);
    o.w0 = *(const f32x4*)((const float*)(a.ws + S_RW) + eo); o.w1 = *(const f32x4*)((const float*)(a.ws + S_RW) + eo + 4);
    o.g = ((const float*)(a.ws + S_GAL))[row * 8 + h]; o.be = ((const float*)(a.ws + S_GBE))[row * 8 + h];
}
__device__ __forceinline__ void phase_cprep(const PArgs& a, LAS unsigned char* lds) {
    const int bidx_ = obid();
    const int tid = otid(), lane = tid & 63, wave = __builtin_amdgcn_readfirstlane(tid >> 6), G = ogrid(), ql = lane & 31, hh = lane >> 5;
    const int t = lane, j0 = wave * 8;
    LAS float* cumA = (LAS float*)(lds + CK_CUM); LAS float* cumpA = (LAS float*)(lds + CK_CUMP); LAS float* pcA = (LAS float*)(lds + CK_PC);
    CkIn in; if (bidx_ < 4096) ck_load(a, bidx_, t, j0, in);
#if PROBE_SUB >= 10
    volatile LAS unsigned* tmisc = (volatile LAS unsigned*)(lds + (163840 - 1024)) + 40; unsigned long long tprev = __builtin_amdgcn_s_memrealtime();
#define CKSTAMP(k) do { if (PROBE_SUB - 10 == (k)) { const unsigned long long tn_ = __builtin_amdgcn_s_memrealtime(); if (tid == 0) tmisc[0] += (unsigned)(tn_ - tprev); } tprev = __builtin_amdgcn_s_memrealtime(); } while (0)
#else
#define CKSTAMP(k) do { } while (0)
#endif
    for (int item = bidx_; item < 4096; item += G) {
        CKSTAMP(6);
        const bool gdn = item >= 2048; const int it = item & 2047;
        float fr[8], fk[8], fv[8], fa[8], fb[8], lw[8];
        unpack8(in.v, fv);
        if (!gdn) { unpack8(in.r, fr); unpack8(in.k, fk); unpack8(in.a, fa); unpack8(in.b, fb);
#pragma unroll
            for (int e = 0; e < 4; ++e) { lw[e] = in.w0[e]; lw[4 + e] = in.w1[e]; } }
        else { float fkk[8]; unpack8(in.r, fr); unpack8(in.k, fkk); const float g = in.g, be = in.be, al = __expf(g);
#pragma unroll
            for (int e = 0; e < 8; ++e) { fa[e] = fkk[e]; fb[e] = -al * be * fkk[e]; fk[e] = be * fkk[e]; lw[e] = g; } }
        if (item + G < 4096) ck_load(a, item + G, t, j0, in);
        float cum[8], pc[8];
#pragma unroll
        for (int e = 0; e < 8; ++e) { float x = lw[e];
#pragma unroll
            for (int d = 1; d < 64; d <<= 1) { const float y = __shfl_up(x, d); if (lane >= d) x += y; }
            cum[e] = x; pc[e] = __shfl(x, 63); }
        if (wave == 0) { cumA[t] = gdn ? cum[0] : 0.f; cumpA[t] = gdn ? cum[0] - lw[0] : 0.f; }
        if (lane == 0) {
#pragma unroll
            for (int e = 0; e < 8; ++e) pcA[j0 + e] = pc[e]; }
        { float xa[8], xr[8], xb[8], xk[8], yb[8], yk[8], ya[8];
#pragma unroll
          for (int e = 0; e < 8; ++e) { const float ecp_true = __expf(cum[e] - lw[e]); const float ec = gdn ? 1.f : __expf(cum[e]), ecp = gdn ? 1.f : ecp_true, eci = gdn ? 1.f : __expf(-cum[e]), et = __expf(pc[e] - cum[e]);
              xa[e] = fa[e] * ecp; xr[e] = fr[e] * ec; xb[e] = fb[e] * eci; xk[e] = fk[e] * eci; yb[e] = fb[e] * et; yk[e] = fk[e] * et; ya[e] = fa[e] * ecp_true; }
          const int ro = t * CK_TP + j0 * 2;
          *(LAS u32x4*)(lds + CK_AT + ro) = (u32x4){pk2(xa[0], xa[1]), pk2(xa[2], xa[3]), pk2(xa[4], xa[5]), pk2(xa[6], xa[7])};
          *(LAS u32x4*)(lds + CK_RT + ro) = (u32x4){pk2(xr[0], xr[1]), pk2(xr[2], xr[3]), pk2(xr[4], xr[5]), pk2(xr[6], xr[7])};
          *(LAS u32x4*)(lds + CK_BT + ro) = (u32x4){pk2(xb[0], xb[1]), pk2(xb[2], xb[3]), pk2(xb[4], xb[5]), pk2(xb[6], xb[7])};
          *(LAS u32x4*)(lds + CK_KT + ro) = (u32x4){pk2(xk[0], xk[1]), pk2(xk[2], xk[3]), pk2(xk[4], xk[5]), pk2(xk[6], xk[7])};
#pragma unroll
          for (int e = 0; e < 8; ++e) { const int to = (j0 + e) * CK_TP + t * 2; *(LAS unsigned short*)(lds + CK_BW + to) = (unsigned short)f2bf(yb[e]); *(LAS unsigned short*)(lds + CK_KW + to) = (unsigned short)f2bf(yk[e]);
              *(LAS unsigned short*)(lds + CK_V + to) = (unsigned short)f2bf(fv[e]); *(LAS unsigned short*)(lds + CK_AH + to) = (unsigned short)f2bf(ya[e]); } }
        __syncthreads();
        CKSTAMP(0);
#ifndef PROBE_CK
#define PROBE_CK 1
#endif
        for (int rep_ = 0; rep_ < PROBE_CK; ++rep_) {
        { const int p = wave >> 1, hf = wave & 1; const LAS unsigned char* At = lds + (p < 2 ? CK_AT : CK_RT); const LAS unsigned char* Bt = lds + ((p & 1) ? CK_KT : CK_BT);
          const LAS float* dA = (p < 2) ? cumpA : cumA; LAS unsigned char* Ot = lds + (p == 0 ? CK_N : p == 1 ? CK_LAK : p == 2 ? CK_LRB : CK_LRK); const int incl = (p >= 2) ? 1 : 0;
#pragma unroll
          for (int sq = 0; sq < 2; ++sq) { f32x16 acc;
#pragma unroll
              for (int r = 0; r < 16; ++r) acc[r] = 0.f;
              if (!(sq == 1 && hf == 0)) {
#pragma unroll
                  for (int ks = 0; ks < 4; ++ks) acc = __builtin_amdgcn_mfma_f32_32x32x16_bf16(ck_frag(At, 32 * hf + ql, ks, hh), ck_frag(Bt, 32 * sq + ql, ks, hh), acc, 0, 0, 0); }
              const int s = 32 * sq + ql; const float dBs = cumA[s];
#pragma unroll
              for (int r = 0; r < 16; ++r) { const int tt = 32 * hf + crow_(r, hh); const bool keep = s < tt + incl; const float val = keep ? acc[r] * __expf(dA[tt] - dBs) : 0.f;
                  *(LAS unsigned short*)(Ot + tt * CK_TP + s * 2) = (unsigned short)f2bf(val); } } }
        __syncthreads();
        CKSTAMP(1);
        if (wave >= 1 && wave <= 4) { const int w4 = wave - 1, tq = w4 >> 1, iq = w4 & 1; f32x16 acc;
#pragma unroll
            for (int r = 0; r < 16; ++r) acc[r] = 0.f;
#pragma unroll
            for (int ks = 0; ks < 4; ++ks) acc = __builtin_amdgcn_mfma_f32_32x32x16_bf16(ck_frag(lds + CK_LAK, 32 * tq + ql, ks, hh), ck_frag(lds + CK_V, 32 * iq + ql, ks, hh), acc, 0, 0, 0);
#pragma unroll
            for (int g4 = 0; g4 < 4; ++g4) *(LAS u32x2*)(lds + CK_LVT + (32 * iq + ql) * CK_TP + (32 * tq + 8 * g4 + 4 * hh) * 2) = (u32x2){pk2(acc[4 * g4], acc[4 * g4 + 1]), pk2(acc[4 * g4 + 2], acc[4 * g4 + 3])}; }
        else if (wave == 0) { const int I = lane >> 4, c = lane & 15; float d[16];
#pragma unroll
            for (int r = 0; r < 16; ++r) { float nr[16]; { float lo8[8], hi8[8]; unpack8(*(const LAS u32x4*)(lds + CK_N + (16 * I + r) * CK_TP + (16 * I) * 2), lo8); unpack8(*(const LAS u32x4*)(lds + CK_N + (16 * I + r) * CK_TP + (16 * I + 8) * 2), hi8);
#pragma unroll
                    for (int e = 0; e < 8; ++e) { nr[e] = lo8[e]; nr[8 + e] = hi8[e]; } }
                float v = (r == c) ? 1.f : 0.f;
#pragma unroll
                for (int s2 = 0; s2 < r; ++s2) v += nr[s2] * d[s2];
                d[r] = v; *(LAS unsigned short*)(lds + CK_DD + (16 * I + r) * CK_TP + (16 * I + c) * 2) = (unsigned short)f2bf(v); } }
        __syncthreads();
        CKSTAMP(2);
        { const int col = lane & 15, g = lane >> 4; const int rb = (wave < 4) ? (16 * wave + col) : (16 * (wave - 4) + col);
          const LAS unsigned char* RTt = lds + (wave < 4 ? CK_AH : CK_LVT) + rb * CK_TP; LAS unsigned char* XTt = lds + (wave < 4 ? CK_AW : CK_W1) + rb * CK_TP;
          s16x4 xb[4];
#pragma unroll
          for (int I = 0; I < 4; ++I) { f32x4 acc; { const u32x2 w = *(const LAS u32x2*)(RTt + (16 * I + 4 * g) * 2); acc[0] = bf2f(w.x & 0xffffu); acc[1] = bf2f(w.x >> 16); acc[2] = bf2f(w.y & 0xffffu); acc[3] = bf2f(w.y >> 16); }
#pragma unroll
              for (int J = 0; J < I; ++J) acc = __builtin_amdgcn_mfma_f32_16x16x16bf16_1k(*(const LAS s16x4*)(lds + CK_N + (16 * I + col) * CK_TP + (16 * J + 4 * g) * 2), xb[J], acc, 0, 0, 0);
              union { u32x2 u; s16x4 v; } zb; zb.u = (u32x2){pk2(acc[0], acc[1]), pk2(acc[2], acc[3])};
              f32x4 x = (f32x4){0.f, 0.f, 0.f, 0.f};
              x = __builtin_amdgcn_mfma_f32_16x16x16bf16_1k(*(const LAS s16x4*)(lds + CK_DD + (16 * I + col) * CK_TP + (16 * I + 4 * g) * 2), zb.v, x, 0, 0, 0);
              union { u32x2 u; s16x4 v; } xo; xo.u = (u32x2){pk2(x[0], x[1]), pk2(x[2], x[3])}; xb[I] = xo.v;
              *(LAS u32x2*)(XTt + (16 * I + 4 * g) * 2) = xo.u; } }
        __syncthreads();
        }
        CKSTAMP(3);
        { const int quad = wave & 3, rq = quad >> 1, cq = quad & 1; const bool lo = wave < 4;
          bf16* cm = (bf16*)(a.ws + (gdn ? S_CMG : S_CMR) + (size_t)it * CM_ITEM);
          const LAS unsigned char* A1 = lds + (lo ? CK_BW : CK_LRB); const LAS unsigned char* A2 = lds + (lo ? CK_KW : CK_LRK);
          f32x16 g1, g2;
#pragma unroll
          for (int r = 0; r < 16; ++r) { g1[r] = 0.f; g2[r] = 0.f; }
#pragma unroll
          for (int ks = 0; ks < 4; ++ks) { const bf16x8 af = ck_frag(A1, 32 * rq + ql, ks, hh);
              g1 = __builtin_amdgcn_mfma_f32_32x32x16_bf16(af, ck_frag(lds + CK_AW, 32 * cq + ql, ks, hh), g1, 0, 0, 0);
              g2 = __builtin_amdgcn_mfma_f32_32x32x16_bf16(af, ck_frag(lds + CK_W1, 32 * cq + ql, ks, hh), g2, 0, 0, 0); }
#pragma unroll
          for (int ks = 0; ks < 4; ++ks) g2 = __builtin_amdgcn_mfma_f32_32x32x16_bf16(ck_frag(A2, 32 * rq + ql, ks, hh), ck_frag(lds + CK_V, 32 * cq + ql, ks, hh), g2, 0, 0, 0);
          const int col = 32 * cq + ql;
          if (lo) { const float dg = __expf(pcA[col]);
#pragma unroll
              for (int r = 0; r < 16; ++r) { const int rw = 32 * rq + crow_(r, hh); *(LAS unsigned short*)(lds + CK_AT + rw * CK_TP + col * 2) = (unsigned short)f2bf(g1[r] + (rw == col ? dg : 0.f)); }
#pragma unroll
              for (int g4 = 0; g4 < 4; ++g4) *(LAS u32x2*)(lds + CK_BT + col * CK_TP + (32 * rq + 8 * g4 + 4 * hh) * 2) = (u32x2){pk2(g2[4 * g4], g2[4 * g4 + 1]), pk2(g2[4 * g4 + 2], g2[4 * g4 + 3])}; }
          else {
#pragma unroll
              for (int r = 0; r < 16; ++r) { const int rw = 32 * rq + crow_(r, hh); const float rh = bf2f(*(const LAS unsigned short*)(lds + CK_RT + rw * CK_TP + col * 2)) * __expf(cumA[rw]);
                  *(LAS unsigned short*)(lds + CK_KT + rw * CK_TP + col * 2) = (unsigned short)f2bf(g1[r] + rh); *(LAS unsigned short*)(lds + CK_N + rw * CK_TP + col * 2) = (unsigned short)f2bf(g2[r]); } }
          __syncthreads();
          CKSTAMP(4);
          { const int rr = tid >> 3, cc = (tid & 7) * 16; unsigned char* o = (unsigned char*)cm + rr * 128 + cc;
            *(u32x4*)(o) = *(const LAS u32x4*)(lds + CK_AT + rr * CK_TP + cc); *(u32x4*)(o + 8192) = *(const LAS u32x4*)(lds + CK_BT + rr * CK_TP + cc);
            *(u32x4*)(o + 16384) = *(const LAS u32x4*)(lds + CK_KT + rr * CK_TP + cc); *(u32x4*)(o + 24576) = *(const LAS u32x4*)(lds + CK_N + rr * CK_TP + cc); } }
        __syncthreads();
        CKSTAMP(5);
    }
}

__device__ __forceinline__ void phase_cscan(const PArgs& a, LAS unsigned char* lds) {
    const int bidx_ = obid();
    const int tid = otid(), lane = tid & 63, wave = __builtin_amdgcn_readfirstlane(tid >> 6), G = ogrid(), ql = lane & 31, hh = lane >> 5;
    for (int task = bidx_; task < 64; task += G) { const bool gdn = task >= 32; const int bh = task & 31;
        const bf16* cm = (const bf16*)(a.ws + (gdn ? S_CMG : S_CMR)) + (size_t)bh * 64 * (CM_ITEM / 2); bf16* s0 = (bf16*)(a.ws + (gdn ? S_S0G : S_S0R)) + (size_t)bh * 64 * 4096;
        const int rq = (wave >> 1) & 1, cq = wave & 1;
        for (int q = tid; q < 64 * CK_TP / 4; q += NTH) ((LAS unsigned*)lds)[q] = 0u;
        __syncthreads();
        bf16x8 ga[4][4]; u32x2 hc[4][4];
        if (wave < 4) {
#pragma unroll
            for (int u = 0; u < 4; ++u) { const bf16* cn = cm + (size_t)u * (CM_ITEM / 2);
#pragma unroll
                for (int ks = 0; ks < 4; ++ks) ga[u][ks] = *(const bf16x8*)(cn + (32 * rq + ql) * 64 + 16 * ks + 8 * hh);
#pragma unroll
                for (int g4 = 0; g4 < 4; ++g4) hc[u][g4] = *(const u32x2*)(cn + 4096 + (32 * cq + ql) * 64 + 32 * rq + 8 * g4 + 4 * hh); } }
        for (int c0 = 0; c0 < 64; c0 += 4) {
#pragma unroll
            for (int u = 0; u < 4; ++u) { const int c = c0 + u; const LAS unsigned char* sc = lds + (u & 1) * (64 * CK_TP); LAS unsigned char* sn = lds + ((u + 1) & 1) * (64 * CK_TP);
                { const int rr = tid >> 3, cc = (tid & 7) * 16; *(u32x4*)((unsigned char*)(s0 + (size_t)c * 4096) + rr * 128 + cc) = *(const LAS u32x4*)(sc + rr * CK_TP + cc); }
                if (wave < 4) { f32x16 acc;
#pragma unroll
                    for (int g4 = 0; g4 < 4; ++g4) { acc[4 * g4] = bf2f(hc[u][g4].x & 0xffffu); acc[4 * g4 + 1] = bf2f(hc[u][g4].x >> 16); acc[4 * g4 + 2] = bf2f(hc[u][g4].y & 0xffffu); acc[4 * g4 + 3] = bf2f(hc[u][g4].y >> 16); }
#pragma unroll
                    for (int ks = 0; ks < 4; ++ks) acc = __builtin_amdgcn_mfma_f32_32x32x16_bf16(ga[u][ks], ck_frag(sc, 32 * cq + ql, ks, hh), acc, 0, 0, 0);
                    if (c + 4 < 64) { const bf16* cn = cm + (size_t)(c + 4) * (CM_ITEM / 2);
#pragma unroll
                        for (int ks = 0; ks < 4; ++ks) ga[u][ks] = *(const bf16x8*)(cn + (32 * rq + ql) * 64 + 16 * ks + 8 * hh);
#pragma unroll
                        for (int g4 = 0; g4 < 4; ++g4) hc[u][g4] = *(const u32x2*)(cn + 4096 + (32 * cq + ql) * 64 + 32 * rq + 8 * g4 + 4 * hh); }
#pragma unroll
                    for (int g4 = 0; g4 < 4; ++g4) *(LAS u32x2*)(sn + (32 * cq + ql) * CK_TP + (32 * rq + 8 * g4 + 4 * hh) * 2) = (u32x2){pk2(acc[4 * g4], acc[4 * g4 + 1]), pk2(acc[4 * g4 + 2], acc[4 * g4 + 3])}; }
                __syncthreads();
            }
        }
    }
}

struct CoIn { bf16x8 sa[4], sb[4], qf[4]; u32x2 ya[4], yb[4]; };
__device__ __forceinline__ void co_load(const PArgs& a, int wt, int ql, int hh, CoIn& o) {
    const int item = wt >> 1, th = wt & 1; const bool gdn = item >= 2048; const int it = item & 2047;
    const bf16* cm = (const bf16*)(a.ws + (gdn ? S_CMG : S_CMR) + (size_t)it * CM_ITEM); const bf16* s0 = (const bf16*)(a.ws + (gdn ? S_S0G : S_S0R)) + (size_t)it * 4096;
    const bf16* yy = cm + 12288 + (32 * th + ql) * 64 + 4 * hh;
#pragma unroll
    for (int g4 = 0; g4 < 4; ++g4) { o.ya[g4] = *(const u32x2*)(yy + 8 * g4); o.yb[g4] = *(const u32x2*)(yy + 32 + 8 * g4); }
#pragma unroll
    for (int ks = 0; ks < 4; ++ks) { o.qf[ks] = *(const bf16x8*)(cm + 8192 + (32 * th + ql) * 64 + 16 * ks + 8 * hh); o.sa[ks] = *(const bf16x8*)(s0 + ql * 64 + 16 * ks + 8 * hh); o.sb[ks] = *(const bf16x8*)(s0 + (32 + ql) * 64 + 16 * ks + 8 * hh); }
}
__device__ __forceinline__ void phase_cout(const PArgs& a, int l) {
    const int bidx_ = obid();
    const int tid = otid(), lane = tid & 63, wave = __builtin_amdgcn_readfirstlane(tid >> 6), G = ogrid(), ql = lane & 31, hh = lane >> 5;
    CoIn in; { const int w0 = bidx_ * NWV + wave; if (w0 < 8192) co_load(a, w0, ql, hh, in); }
    for (int wt = bidx_ * NWV + wave; wt < 8192; wt += G * NWV) { const int item = wt >> 1, th = wt & 1; const bool gdn = item >= 2048; const int it = item & 2047, bh = it >> 6, ch = it & 63, b = bh >> 3, h = bh & 7;
        f32x16 y0, y1;
#pragma unroll
        for (int g4 = 0; g4 < 4; ++g4) { const u32x2 w0 = in.ya[g4], w1 = in.yb[g4];
            y0[4 * g4] = bf2f(w0.x & 0xffffu); y0[4 * g4 + 1] = bf2f(w0.x >> 16); y0[4 * g4 + 2] = bf2f(w0.y & 0xffffu); y0[4 * g4 + 3] = bf2f(w0.y >> 16);
            y1[4 * g4] = bf2f(w1.x & 0xffffu); y1[4 * g4 + 1] = bf2f(w1.x >> 16); y1[4 * g4 + 2] = bf2f(w1.y & 0xffffu); y1[4 * g4 + 3] = bf2f(w1.y >> 16); }
#pragma unroll
        for (int ks = 0; ks < 4; ++ks) { y0 = __builtin_amdgcn_mfma_f32_32x32x16_bf16(in.sa[ks], in.qf[ks], y0, 0, 0, 0); y1 = __builtin_amdgcn_mfma_f32_32x32x16_bf16(in.sb[ks], in.qf[ks], y1, 0, 0, 0); }
        if (wt + G * NWV < 8192) co_load(a, wt + G * NWV, ql, hh, in);
        const size_t tok = (size_t)b * SEQ + ch * 64 + 32 * th + ql; const size_t base = tok * HW + h * 64 + 4 * hh;
        float s1 = 0.f;
#pragma unroll
        for (int r = 0; r < 16; ++r) s1 += y0[r] + y1[r];
        u32x2 pv_[8], pg_[8]; f32x4 pa_[4], pb_[4]; float bsc = 0.f;
        if (!gdn) { const bf16* RV = (const bf16*)(a.ws + S_RV) + base; const bf16* RG = (const bf16*)(a.ws + S_RG) + base; const float* lng = INF(14) + l * 512 + h * 64 + 4 * hh; const float* lnb = INF(15) + l * 512 + h * 64 + 4 * hh;
            bsc = ((const float*)(a.ws + WS_CTL + C_BSC))[tok * 8 + h];
#pragma unroll
            for (int q = 0; q < 8; ++q) { const int co = 32 * (q >> 2) + 8 * (q & 3); pv_[q] = *(const u32x2*)(RV + co); pg_[q] = *(const u32x2*)(RG + co); if (q < 4) { pa_[q] = *(const f32x4*)(lng + co); pb_[q] = *(const f32x4*)(lnb + co); } } }
        else { const bf16* ZG = (const bf16*)(a.ws + S_ZG) + base; const float* gng = INF(29) + l * 64 + 4 * hh;
#pragma unroll
            for (int q = 0; q < 8; ++q) { const int co = 32 * (q >> 2) + 8 * (q & 3); pg_[q] = *(const u32x2*)(ZG + co); if (q < 4) pa_[q] = *(const f32x4*)(gng + co); } }
        if (!gdn) { s1 += __shfl_xor(s1, 32); const float mean = s1 * (1.f / 64.f); float s2 = 0.f;
#pragma unroll
            for (int r = 0; r < 16; ++r) { const float d0 = y0[r] - mean, d1 = y1[r] - mean; s2 += d0 * d0 + d1 * d1; }
            s2 += __shfl_xor(s2, 32); const float rstd = rsqrtf(s2 * (1.f / 64.f) + 64e-5f);
            bf16* OA = (bf16*)(a.ws + S_OA) + base;
#pragma unroll
            for (int q = 0; q < 8; ++q) { const int half = q >> 2, g4 = q & 3, co = 32 * half + 8 * g4; const u32x2 vw = pv_[q], gw = pg_[q]; const f32x4 lg = q < 4 ? pa_[q & 3] : *(const f32x4*)(INF(14) + l * 512 + h * 64 + 4 * hh + co), lb = q < 4 ? pb_[q & 3] : *(const f32x4*)(INF(15) + l * 512 + h * 64 + 4 * hh + co);
                const float vv[4] = {bf2f(vw.x & 0xffffu), bf2f(vw.x >> 16), bf2f(vw.y & 0xffffu), bf2f(vw.y >> 16)}, gg[4] = {bf2f(gw.x & 0xffffu), bf2f(gw.x >> 16), bf2f(gw.y & 0xffffu), bf2f(gw.y >> 16)}; float o[4];
#pragma unroll
                for (int e = 0; e < 4; ++e) { const float yv = half ? y1[4 * g4 + e] : y0[4 * g4 + e]; o[e] = ((yv - mean) * rstd * lg[e] + lb[e] + bsc * vv[e]) * gg[e]; }
                *(u32x2*)(OA + co) = (u32x2){pk2(o[0], o[1]), pk2(o[2], o[3])}; } }
        else { float s2 = 0.f;
#pragma unroll
            for (int r = 0; r < 16; ++r) s2 += y0[r] * y0[r] + y1[r] * y1[r];
            s2 += __shfl_xor(s2, 32); const float rstd = rsqrtf(s2 * (1.f / 64.f) + NORM_EPS);
            bf16* OC = (bf16*)(a.ws + S_OC) + base;
#pragma unroll
            for (int q = 0; q < 8; ++q) { const int half = q >> 2, g4 = q & 3, co = 32 * half + 8 * g4; const u32x2 gw = pg_[q]; const f32x4 ng = q < 4 ? pa_[q & 3] : *(const f32x4*)(INF(29) + l * 64 + 4 * hh + co);
                const float gg[4] = {bf2f(gw.x & 0xffffu), bf2f(gw.x >> 16), bf2f(gw.y & 0xffffu), bf2f(gw.y >> 16)}; float o[4];
#pragma unroll
                for (int e = 0; e < 4; ++e) { const float yv = half ? y1[4 * g4 + e] : y0[4 * g4 + e]; o[e] = yv * rstd * ng[e] * siluf_(gg[e]); }
                *(u32x2*)(OC + co) = (u32x2){pk2(o[0], o[1]), pk2(o[2], o[3])}; } }
    }
}
__device__ __forceinline__ void phase_router(const PArgs& a, LAS unsigned char* lds) {
    const int bidx_ = obid();
    const int tid = otid(), lane = tid & 63, wave = __builtin_amdgcn_readfirstlane(tid >> 6), G = ogrid();
    const int gw = bidx_ * NWV + wave, NGW = G * NWV;
    const float* gf = INF(34) + D; const float* wr = INF(38);
    int* sel = (int*)(a.ws + WS_CTL + C_SEL); float* wts = (float*)(a.ws + WS_CTL + C_WTS); int* rank = (int*)(a.ws + WS_CTL + C_RANK); float* rs1 = (float*)(a.ws + WS_CTL + C_RS1);
    unsigned* cnt = (unsigned*)(a.ws + WS_CTL + C_MOE);
    LAS float* wl = (LAS float*)lds;
    __syncthreads();
    for (int k = tid; k < D; k += NTH) { const float g = gf[k]; const f32x4 w0 = *(const f32x4*)(wr + (size_t)k * 8), w1 = *(const f32x4*)(wr + (size_t)k * 8 + 4);
        wl[0 * D + k] = w0[0] * g; wl[1 * D + k] = w0[1] * g; wl[2 * D + k] = w0[2] * g; wl[3 * D + k] = w0[3] * g; wl[4 * D + k] = w1[0] * g; wl[5 * D + k] = w1[1] * g; wl[6 * D + k] = w1[2] * g; wl[7 * D + k] = w1[3] * g; }
    __syncthreads();
    LAS unsigned* lcnt = (LAS unsigned*)(lds + 32768); LAS unsigned* gbase = lcnt + 8;
    for (int b0 = bidx_ * NWV; b0 < T / 8; b0 += G * NWV) { const int bi = b0 + wave; const bool act = bi < T / 8; int my_e0 = -1, my_e1 = -1;
        if (tid < 8) lcnt[tid] = 0u;
        if (act) {
        f32x4 xn[4];
        { const f32x4* hr = (const f32x4*)(a.out + (size_t)(bi * 8) * D) + lane;
#pragma unroll
          for (int q = 0; q < 4; ++q) xn[q] = hr[64 * q]; }
        for (int i = 0; i < 8; ++i) { const int t = bi * 8 + i;
            f32x4 x[4];
#pragma unroll
            for (int q = 0; q < 4; ++q) x[q] = xn[q];
            if (i + 1 < 8) { const f32x4* hr = (const f32x4*)(a.out + (size_t)(t + 1) * D) + lane;
#pragma unroll
                for (int q = 0; q < 4; ++q) xn[q] = hr[64 * q]; }
            float ssq = 0.f; float lg[8];
#pragma unroll
            for (int e = 0; e < 8; ++e) lg[e] = 0.f;
#pragma unroll
            for (int q = 0; q < 4; ++q) { ssq += (x[q][0] * x[q][0] + x[q][1] * x[q][1]) + (x[q][2] * x[q][2] + x[q][3] * x[q][3]);
#pragma unroll
                for (int e = 0; e < 8; ++e) { const f32x4 w = *(const LAS f32x4*)(wl + e * D + (lane + 64 * q) * 4); lg[e] += (x[q][0] * w[0] + x[q][1] * w[1]) + (x[q][2] * w[2] + x[q][3] * w[3]); } }
            ssq = wave_sum(ssq); const float rs = rsqrtf(ssq * (1.f / D) + NORM_EPS);
#pragma unroll
            for (int e = 0; e < 8; ++e) lg[e] = wave_sum(lg[e]) * rs;
            int e0 = 0; float l0 = lg[0];
#pragma unroll
            for (int e = 1; e < 8; ++e) if (lg[e] > l0) { l0 = lg[e]; e0 = e; }
            int e1 = -1; float l1 = -3.4e38f;
#pragma unroll
            for (int e = 0; e < 8; ++e) if (e != e0 && lg[e] > l1) { l1 = lg[e]; e1 = e; }
            const float wa = 1.f / (1.f + __expf(l1 - l0));
            if (lane == i) { my_e0 = e0; my_e1 = e1; sel[t * 2] = e0; sel[t * 2 + 1] = e1; wts[t * 2] = wa; wts[t * 2 + 1] = 1.f - wa; rs1[t] = rs; } } }
        __syncthreads();
        unsigned woff[2][8];
#pragma unroll
        for (int s = 0; s < 2; ++s) { const int me = s ? my_e1 : my_e0;
#pragma unroll
            for (int e = 0; e < 8; ++e) { const unsigned long long m = __ballot(me == e); const int n = __popcll(m); unsigned o = 0;
                if (n != 0 && lane == 0) o = __hip_atomic_fetch_add(lcnt + e, (unsigned)n, __ATOMIC_RELAXED, __HIP_MEMORY_SCOPE_WORKGROUP);
                woff[s][e] = __builtin_amdgcn_readfirstlane(o); } }
        __syncthreads();
        if (tid < 8) gbase[tid] = atomicAdd(cnt + tid, lcnt[tid]);
        __syncthreads();
        if (act && lane < 8) {
#pragma unroll
            for (int s = 0; s < 2; ++s) { const int me = s ? my_e1 : my_e0; unsigned r = 0;
#pragma unroll
                for (int e = 0; e < 8; ++e) { const unsigned long long m = __ballot(me == e); if (me == e) r = gbase[e] + woff[s][e] + (unsigned)__popcll(m & ((1ull << lane) - 1ull)); }
                rank[(bi * 8 + lane) * 2 + s] = (int)r; } }
        __syncthreads();
    }
    __syncthreads();
}
__device__ __forceinline__ void phase_assign(const PArgs& a) {
    const int bidx_ = obid();
    const int tid = otid(), lane = tid & 63, wave = __builtin_amdgcn_readfirstlane(tid >> 6), G = ogrid();
    const int gw = bidx_ * NWV + wave, NGW = G * NWV;
    const unsigned* cnt = (const unsigned*)(a.ws + WS_CTL + C_MOE);
    const int* sel = (const int*)(a.ws + WS_CTL + C_SEL); const int* rank = (const int*)(a.ws + WS_CTL + C_RANK); const float* rs1 = (const float*)(a.ws + WS_CTL + C_RS1);
    int* dest = (int*)(a.ws + WS_CTL + C_DEST); float* rsx = (float*)(a.ws + WS_CTL + C_RSX); int* blke = (int*)(a.ws + WS_CTL + C_BLKE);
    const bf16* hb = (const bf16*)(a.ws + WS_HB); bf16* xg = (bf16*)(a.ws + S_XG);
    int pstart[9]; pstart[0] = 0;
#pragma unroll
    for (int e = 0; e < 8; ++e) pstart[e + 1] = pstart[e] + (int)((cnt[e] + 255u) / 256u) * 256;
    if (bidx_ == 0 && tid < NBLK_MAX + 1) { if (tid == NBLK_MAX) blke[NBLK_MAX] = pstart[8] / 256; else { int e = 0;
#pragma unroll
            for (int q = 1; q < 8; ++q) if (tid * 256 >= pstart[q]) e = q;
            blke[tid] = e; } }
    for (int as = gw; as < T * 2; as += NGW) { const int t = as >> 1; const int e = sel[as];
        int ps = 0;
#pragma unroll
        for (int q = 0; q < 8; ++q) if (e == q) ps = pstart[q];
        const int d = ps + rank[as];
        if (lane == 0) { dest[as] = d; rsx[d] = rs1[t]; }
        const u32x4* src = (const u32x4*)(hb + (size_t)t * D); u32x4* dst = (u32x4*)(xg + (size_t)d * D);
        dst[lane] = src[lane]; dst[lane + 64] = src[lane + 64]; }
}
__device__ __forceinline__ void phase_combine(const PArgs& a) {
    const int bidx_ = obid();
    const int tid = otid(), lane = tid & 63, wave = __builtin_amdgcn_readfirstlane(tid >> 6), G = ogrid();
    const int gw = bidx_ * NWV + wave, NGW = G * NWV;
    const int* dest = (const int*)(a.ws + WS_CTL + C_DEST); const float* wts = (const float*)(a.ws + WS_CTL + C_WTS);
    const bf16* y = (const bf16*)(a.ws + S_XG); bf16* hb = (bf16*)(a.ws + WS_HB);
    for (int t = gw; t < T; t += NGW) { const int d0 = dest[t * 2], d1 = dest[t * 2 + 1]; const float w0 = wts[t * 2], w1 = wts[t * 2 + 1];
        f32x4* hr = (f32x4*)(a.out + (size_t)t * D); const u32x2* y0 = (const u32x2*)(y + (size_t)d0 * D); const u32x2* y1 = (const u32x2*)(y + (size_t)d1 * D); u32x2* hbr = (u32x2*)(hb + (size_t)t * D);
#pragma unroll
        for (int q = 0; q < 4; ++q) { const int ix = lane + 64 * q; f32x4 h = hr[ix]; const u32x2 a0 = y0[ix], a1 = y1[ix];
            h[0] += w0 * bf2f(a0.x & 0xffffu) + w1 * bf2f(a1.x & 0xffffu); h[1] += w0 * bf2f(a0.x >> 16) + w1 * bf2f(a1.x >> 16);
            h[2] += w0 * bf2f(a0.y & 0xffffu) + w1 * bf2f(a1.y & 0xffffu); h[3] += w0 * bf2f(a0.y >> 16) + w1 * bf2f(a1.y >> 16);
            hr[ix] = h; u32x2 w; w.x = pk2(h[0], h[1]); w.y = pk2(h[2], h[3]); hbr[ix] = w; } }
}
#ifndef PROBE_X
#define PROBE_X 0
#endif
#ifndef MK_ONE_LAUNCH
#define MK_ONE_LAUNCH 1
#endif
#define XB_TMO      128
#define XB_XCNT(j)  (256  + 64 * (j))
#define XB_XSUB(j)  (1280 + 64 * (j))
#define XB_XGEN(j)  (2304 + 64 * (j))
#define XB_TOP      3328
#define XB_TOPGEN   3392
#define XCD_BAR_WORDS 3456
#define XB_SPIN_CAP (1u << 22)
__device__ __forceinline__ unsigned xb_ld(unsigned* p)              { return __hip_atomic_load(p, __ATOMIC_RELAXED, __HIP_MEMORY_SCOPE_AGENT); }
__device__ __forceinline__ unsigned xb_add(unsigned* p, unsigned v) { return __hip_atomic_fetch_add(p, v, __ATOMIC_RELAXED, __HIP_MEMORY_SCOPE_AGENT); }
__device__ __forceinline__ unsigned xb_xcc_id() { return (unsigned)__builtin_amdgcn_s_getreg((3 << 11) | 20) & 0xFu; }
#define XB_SPIN(cond, bar) do { unsigned _sp = 0; while (cond) { __builtin_amdgcn_s_sleep(1); \
    if ((++_sp & 255u) == 0u) { if (xb_ld(&(bar)[XB_TMO])) break; if (_sp > XB_SPIN_CAP) { atomicAdd(&(bar)[XB_TMO], 1u); break; } } } } while (0)
struct XcdBarrier { unsigned* bar; unsigned x; volatile LAS unsigned* st; };
__device__ __forceinline__ XcdBarrier xcd_barrier_post(unsigned* bar, volatile LAS unsigned* st) {
    XcdBarrier b; b.bar = bar; b.x = xb_xcc_id(); b.st = st;
    if (threadIdx.x == 0) (void)xb_add(&bar[XB_XCNT(b.x)], 1u);
    return b;
}
__device__ __forceinline__ void xcd_barrier_complete(unsigned* bar, unsigned x, unsigned& nloc, unsigned& nx) {
    const unsigned G = gridDim.x * gridDim.y * gridDim.z;
    unsigned sum, cnt, mine, sp = 0u;
    for (;;) {
        sum = 0u; cnt = 0u; mine = 0u;
#pragma unroll
        for (unsigned j = 0; j < 16; ++j) { const unsigned c = xb_ld(&bar[XB_XCNT(j)]); sum += c; cnt += (c > 0u) ? 1u : 0u; mine = (j == x) ? c : mine; }
        if (sum == G) break;
        __builtin_amdgcn_s_sleep(1);
        if ((++sp & 255u) == 0u) { if (xb_ld(&bar[XB_TMO])) break; if (sp > XB_SPIN_CAP) { atomicAdd(&bar[XB_TMO], 1u); break; } }
    }
    nloc = mine > 0u ? mine : 1u; nx = cnt > 0u ? cnt : 1u;
}
__device__ __forceinline__ void xcd_barrier(const XcdBarrier& b_) {
    asm volatile("s_waitcnt vmcnt(0)" ::: "memory");
    __syncthreads();
    if (otid() == 0) {
        XcdBarrier b = b_; asm volatile("" : "+s"(b.bar)); b.x = xb_xcc_id();
        unsigned* bar = b.bar;
        __builtin_amdgcn_s_waitcnt(0);
        unsigned nloc = b.st[0], nx = b.st[1];
        if (nloc == 0u) { xcd_barrier_complete(bar, b.x, nloc, nx); b.st[0] = nloc; b.st[1] = nx; }
        const unsigned old = xb_add(&bar[XB_XSUB(b.x)], 1u);
        const unsigned gen = old / nloc;
        if (old + 1u == (gen + 1u) * nloc) {
            __builtin_amdgcn_fence(__ATOMIC_RELEASE, "agent");
            asm volatile("s_waitcnt vmcnt(0)" ::: "memory");
            const unsigned og = xb_add(&bar[XB_TOP], 1u);
            const unsigned tg = og / nx;
            if (og + 1u == (tg + 1u) * nx) xb_add(&bar[XB_TOPGEN], 1u);
            else XB_SPIN(xb_ld(&bar[XB_TOPGEN]) == tg, bar);
            __builtin_amdgcn_fence(__ATOMIC_ACQUIRE, "agent");
            xb_add(&bar[XB_XGEN(b.x)], 1u);
            asm volatile("s_waitcnt vmcnt(0)" ::: "memory");
        } else {
            XB_SPIN(xb_ld(&bar[XB_XGEN(b.x)]) == gen, bar);
            __builtin_amdgcn_fence(__ATOMIC_ACQUIRE, "agent");
            asm volatile("s_waitcnt vmcnt(0)" ::: "memory");
        }
    }
    __syncthreads();
}

enum PhaseKind { PK_PRO = 0, PK_G1A, PK_PRE, PK_G23, PK_MLAPOST, PK_ATT, PK_RGPREP, PK_SCAN, PK_FIN, PK_G1B, PK_MRG, PK_OUT, PK_FGU, PK_FD, PK_MOEA, PK_MOEB, PK_MGU0, PK_MD0, PK_MGU1, PK_MD1, PK_COMB, PK_PP, PK_PG, PK_COUT };
struct PhaseEnt { int kind, layer; };
__constant__ PhaseEnt g_prog[] = {
    {PK_PRO, 0},
    {PK_G1A, 0}, {PK_PRE, 0}, {PK_G23, 0}, {PK_MLAPOST, 0}, {PK_ATT, 0}, {PK_RGPREP, 0}, {PK_SCAN, 0}, {PK_FIN, 0}, {PK_COUT, 0}, {PK_G1B, 0}, {PK_MRG, 0}, {PK_OUT, 0}, {PK_FGU, 0}, {PK_FD, 0}, {PK_PP, 0}, {PK_PG, 0},
    {PK_G1A, 1}, {PK_PRE, 1}, {PK_G23, 1}, {PK_MLAPOST, 1}, {PK_ATT, 1}, {PK_RGPREP, 1}, {PK_SCAN, 1}, {PK_FIN, 1}, {PK_COUT, 1}, {PK_G1B, 1}, {PK_MRG, 1}, {PK_OUT, 1},
    {PK_MOEA, 1}, {PK_MOEB, 1}, {PK_MGU0, 1}, {PK_MD0, 1}, {PK_MGU1, 1}, {PK_MD1, 1}, {PK_COMB, 1}, {PK_PP, 1}, {PK_PG, 1},
};
constexpr int NPHASE = sizeof(g_prog) / sizeof(PhaseEnt);

constexpr int LDS_BYTES = 163840;
constexpr int LDS_MISC = 163840 - 1024;

template <int KINDT> __device__ __forceinline__ void run_phase(const Args& a_, int kind_rt, int l, LAS unsigned char* lds) {
    const int kind = KINDT >= 0 ? KINDT : kind_rt; const PArgs a = make_pargs(a_);
    const int G = ogrid(), c = obid();
    unsigned char* ws = a.ws;
    const bf16* Wl = (const bf16*)(ws + WS_W + (size_t)l * WL);
    float* SS0 = (float*)(ws + S_SSP0); float* SS1 = (float*)(ws + S_SSP1); float* SSE = (float*)(ws + S_SSP2);
    bf16* HB = (bf16*)(ws + WS_HB); const bf16* HBin = (const bf16*)(ws + (l == 0 ? WS_HB : WS_HB2));
    const bf16* Wp = (const bf16*)(ws + WS_W + W_PLE + (size_t)l * WPL);
    switch (kind) {
    case PK_PRO: phase_prologue(a, lds); break;
    case PK_G1A: { pg8::Gemm g{HBin, Wl + W_IN / 2, D, D, D}; pg8::StaticOrder S; S.init(T / 256, N1 / 256, G, c);
        EpiInProj E{(bf16*)(ws + S_ZR), (bf16*)(ws + S_ZQ), (bf16*)(ws + S_ZG), (bf16*)(ws + S_ZM), SS0}; pg8::gemm_phase(lds, g, S, E); } break;
    case PK_PRE: phase_pre(a, l); break;
    case PK_G23: { { pg8::Gemm g{(const bf16*)(ws + S_ZM), Wl + W_2 / 2, K2, NZM, K2}; pg8::StaticOrder S; S.init(T / 256, N2 / 256, G, c);
            EpiMla E{(bf16*)(ws + S_QRAW), (bf16*)(ws + S_KVRAW), (const float*)(ws + WS_CTL + C_RSQ), (const float*)(ws + WS_CTL + C_RSKV)}; pg8::gemm_phase(lds, g, S, E); }
        { pg8::Gemm g{(const bf16*)(ws + S_A2), Wl + W_3 / 2, K3, K3, K3}; pg8::StaticOrder S; S.init(T / 256, N3 / 256, G, c);
            EpiPlain E{(bf16*)(ws + S_L2), N3}; pg8::gemm_phase(lds, g, S, E); } } break;
    case PK_MLAPOST: phase_mla_post(a, l, lds); break;
    case PK_ATT: phase_attn<0>(a, lds);
#if PROBE_X >= 10
        phase_attn<PROBE_X - 10>(a, lds);
#endif
        break;
    case PK_RGPREP: phase_rwkv_post(a, l); phase_gdn_prep(a, l); break;
    case PK_SCAN: phase_cprep(a, lds); break;
    case PK_FIN: phase_cscan(a, lds); break;
    case PK_COUT: phase_cout(a, l); break;
    case PK_G1B: { pg8::Gemm g{HBin, Wl + W_GATE / 2, D, D, D}; pg8::StaticOrder S; S.init(T / 256, NGATE / 256, G, c);
        EpiGate E{(bf16*)(ws + S_ZS), SS0}; pg8::gemm_phase(lds, g, S, E); } break;
    case PK_MRG: { pg8::StaticOrder S; S.init(T / 256, D / 256, G, c);
        { pg8::Gemm g{(const bf16*)(ws + S_OA), Wl + W_BRA / 2, HW, HW, HW}; EpiMerge<true> E{(bf16*)(ws + S_M), (const bf16*)(ws + S_ZS), 0}; pg8::gemm_phase(lds, g, S, E); }
        { pg8::Gemm g{(const bf16*)(ws + S_OB), Wl + W_BRB / 2, HW, HW, HW}; EpiMerge<false> E{(bf16*)(ws + S_M), (const bf16*)(ws + S_ZS), 1}; pg8::gemm_phase(lds, g, S, E); }
        { pg8::Gemm g{(const bf16*)(ws + S_OC), Wl + W_BRC / 2, HW, HW, HW}; EpiMerge<false> E{(bf16*)(ws + S_M), (const bf16*)(ws + S_ZS), 2}; pg8::gemm_phase(lds, g, S, E); } } break;
    case PK_OUT: { pg8::Gemm g{(const bf16*)(ws + S_M), Wl + W_OUT / 2, D, D, D}; pg8::StaticOrder S; S.init(T / 256, D / 256, G, c);
#if PROBE_X == 1
        { EpiPlain E2{(bf16*)(ws + S_ZR), D}; pg8::gemm_phase(lds, g, S, E2); }
#endif
        EpiResid E{l == 0 ? INF(0) : (const float*)a.out, a.out, HB, SS1}; pg8::gemm_phase(lds, g, S, E); } break;
    case PK_FGU: { pg8::Gemm g{HB, (const bf16*)(ws + WS_W + W_FGU), D, D, D}; pg8::StaticOrder S; S.init(T / 256, 2 * FFD / 256, G, c);
        EpiSwiglu<false> E{(bf16*)(ws + S_ACT), FFD, SS1}; pg8::gemm_phase(lds, g, S, E); } break;
    case PK_FD: { pg8::Gemm g{(const bf16*)(ws + S_ACT), (const bf16*)(ws + WS_W + W_FD), FFD, FFD, FFD}; pg8::StaticOrder S; S.init(T / 256, D / 256, G, c);
#if PROBE_X == 2
        { EpiPlain E2{(bf16*)(ws + WS_S + 100 * MiB), D}; pg8::gemm_phase(lds, g, S, E2); }
#endif
        EpiResid E{a.out, a.out, HB, nullptr}; pg8::gemm_phase(lds, g, S, E); } break;
    case PK_MOEA: {
#if PROBE_SUB
        __syncthreads(); const unsigned long long ts0 = __builtin_amdgcn_s_memrealtime();
#endif
        phase_moe_cvt(a, lds);
#if PROBE_SUB
        __syncthreads(); const unsigned long long ts1 = __builtin_amdgcn_s_memrealtime();
#endif
        phase_router(a, lds);
#if PROBE_SUB
        __syncthreads(); const unsigned long long ts2 = __builtin_amdgcn_s_memrealtime();
        if (threadIdx.x == 0) ((volatile LAS unsigned*)(lds + LDS_MISC))[32] = (unsigned)((PROBE_SUB == 1) ? (ts1 - ts0) : (ts2 - ts1));
#endif
        } break;
    case PK_MOEB: phase_assign(a); break;
    case PK_MGU0: case PK_MGU1: { const int half = (kind == PK_MGU1); const int* blke = (const int*)(ws + WS_CTL + C_BLKE); const int nblk = __builtin_amdgcn_readfirstlane(blke[NBLK_MAX]);
        const int lo = half * HALF_BLK, hi = nblk < lo + HALF_BLK ? nblk : lo + HALF_BLK, nM = hi > lo ? hi - lo : 0;
        pg8::Gemm g{(const bf16*)(ws + S_XG), (const bf16*)(ws + S_MWGU), D, D, D}; pg8::StaticOrder S; S.init(nM, 2 * FFE / 256, G, c, lo, blke);
        EpiSwiglu<true> E{(bf16*)(ws + S_MACT) - (size_t)lo * 256 * FFE, FFE, (const float*)(ws + WS_CTL + C_RSX)}; pg8::gemm_phase(lds, g, S, E); } break;
    case PK_MD0: case PK_MD1: { const int half = (kind == PK_MD1); const int* blke = (const int*)(ws + WS_CTL + C_BLKE); const int nblk = __builtin_amdgcn_readfirstlane(blke[NBLK_MAX]);
        const int lo = half * HALF_BLK, hi = nblk < lo + HALF_BLK ? nblk : lo + HALF_BLK, nM = hi > lo ? hi - lo : 0;
        pg8::Gemm g{(const bf16*)(ws + S_MACT) - (size_t)lo * 256 * FFE, (const bf16*)(ws + S_MWD), FFE, FFE, FFE}; pg8::StaticOrder S; S.init(nM, D / 256, G, c, lo, blke);
        EpiPlain E{(bf16*)(ws + S_XG), D}; pg8::gemm_phase(lds, g, S, E); } break;
    case PK_COMB: phase_combine(a); break;
    case PK_PP: { pg8::Gemm g{(const bf16*)(ws + WS_PB) + (size_t)l * T * PLE, Wp + W_PP / 2, PLE, PLE, PLE}; pg8::StaticOrder S; S.init(T / 256, D / 256, G, c);
        EpiPleProj E{(bf16*)(ws + S_E), SSE}; pg8::gemm_phase(lds, g, S, E); } break;
    case PK_PG: { pg8::Gemm g{HB, Wp + W_PG / 2, D, D, D}; pg8::StaticOrder S; S.init(T / 256, D / 256, G, c);
#if PROBE_X == 3
        { EpiPlain E2{(bf16*)(ws + WS_S + 100 * MiB), D}; pg8::gemm_phase(lds, g, S, E2); }
#endif
        EpiPleGate E{a.out, l + 1 < NL ? (bf16*)(ws + WS_HB2) : nullptr, (const bf16*)(ws + S_E), SSE, INF(44) + l * D, l + 1 < NL ? SS0 : nullptr}; pg8::gemm_phase(lds, g, S, E); } break;
    default: break;
    }
}

template <int KINDT> __global__ void __launch_bounds__(NTH, 2) k_one(Args a, int l) {
    extern __shared__ __attribute__((aligned(16))) unsigned char lds_raw[];
    run_phase<KINDT>(a, KINDT, l, (LAS unsigned char*)lds_raw);
}
#if MK_ONE_LAUNCH
__global__ void __launch_bounds__(NTH, 2) k_fwd(Args a) {
    extern __shared__ __attribute__((aligned(16))) unsigned char lds_raw[];
    LAS unsigned char* lds = (LAS unsigned char*)lds_raw;
    volatile LAS unsigned* misc = (volatile LAS unsigned*)(lds + LDS_MISC);
    if (threadIdx.x < 64) misc[threadIdx.x] = 0u;
    __syncthreads();
    const XcdBarrier bar = xcd_barrier_post((unsigned*)(a.ws + WS_CTL + C_BAR), misc + 8);
#ifndef PROBE_MASK
#define PROBE_MASK 0u
#endif
#define BAR() xcd_barrier(bar)
#ifndef PROBE_T
#define PROBE_T 0u
#endif
#ifndef PROBE_TDIV
#define PROBE_TDIV 1000
#endif
#define RUN(K, l) do { if ((PROBE_MASK >> K) & 1u) { run_phase<K>(a, K, l, lds); BAR(); } \
    unsigned long long t0_ = 0; if ((PROBE_T >> K) & 1u) { BAR(); t0_ = __builtin_amdgcn_s_memrealtime(); } run_phase<K>(a, K, l, lds); if ((PROBE_T >> K) & 1u) { BAR(); tacc_ += __builtin_amdgcn_s_memrealtime() - t0_; } } while (0)
#ifdef PROBE_BARS
    for (int q = 0; q < PROBE_BARS; ++q) BAR();
#endif
    unsigned long long tacc_ = 0;
    RUN(PK_PRO, 0); BAR();
#define MIXER(l) RUN(PK_G1A, l); BAR(); RUN(PK_PRE, l); BAR(); RUN(PK_G23, l); BAR(); RUN(PK_MLAPOST, l); BAR(); RUN(PK_ATT, l); BAR(); RUN(PK_RGPREP, l); BAR(); \
        RUN(PK_SCAN, l); BAR(); RUN(PK_FIN, l); BAR(); RUN(PK_COUT, l); BAR(); RUN(PK_G1B, l); BAR(); RUN(PK_MRG, l); BAR(); RUN(PK_OUT, l); BAR();
    MIXER(0)
    RUN(PK_FGU, 0); BAR(); RUN(PK_FD, 0); RUN(PK_PP, 0); BAR();
    RUN(PK_PG, 0); BAR();
    MIXER(1)
    RUN(PK_MOEA, 1); BAR(); RUN(PK_MOEB, 1); BAR(); RUN(PK_MGU0, 1); BAR(); RUN(PK_MD0, 1); BAR(); RUN(PK_MGU1, 1); BAR(); RUN(PK_MD1, 1); RUN(PK_PP, 1); BAR(); RUN(PK_COMB, 1); BAR();
    RUN(PK_PG, 1);
#undef MIXER
    if (PROBE_T != 0u) { BAR(); if (blockIdx.x == 0 && threadIdx.x == 0) a.out[0] = (float)(tacc_ / PROBE_TDIV); }
#if PROBE_SUB
    BAR(); if (blockIdx.x == 0 && threadIdx.x == 0) a.out[0] = (float)(misc[PROBE_SUB >= 10 ? 40 : 32] / PROBE_TDIV);
#endif
#undef RUN
#undef BAR
}
#endif

#ifndef MK_ONE_LAUNCH
#define MK_ONE_LAUNCH 1
#endif
extern "C" void kernel_launch(void* const* d_in, const int* in_sizes, int n_in, void* d_out, int out_size, void* d_ws, size_t ws_size, hipStream_t stream) {
    static int grid = 0;
    if (grid == 0) {
        if (n_in != 45 || out_size != T * D || ws_size < WS_END) { fprintf(stderr, "kernel_launch: unexpected shapes: n_in %d out %d ws %zu (need %zu)\n", n_in, out_size, ws_size, (size_t)WS_END); grid = -1; return; }
        int dev = 0, cus = 0;
        if (hipGetDevice(&dev) != hipSuccess || hipDeviceGetAttribute(&cus, hipDeviceAttributeMultiprocessorCount, dev) != hipSuccess) { grid = -1; return; }
#if MK_ONE_LAUNCH
        if (hipFuncSetAttribute((const void*)k_fwd, hipFuncAttributeMaxDynamicSharedMemorySize, LDS_BYTES) != hipSuccess) { fprintf(stderr, "kernel_launch: hipFuncSetAttribute failed\n"); grid = -1; return; }
#else
#define SA(K) (void)hipFuncSetAttribute((const void*)k_one<K>, hipFuncAttributeMaxDynamicSharedMemorySize, LDS_BYTES);
        SA(PK_PRO) SA(PK_G1A) SA(PK_PRE) SA(PK_G23) SA(PK_MLAPOST) SA(PK_ATT) SA(PK_RGPREP) SA(PK_SCAN) SA(PK_FIN) SA(PK_G1B) SA(PK_MRG) SA(PK_OUT) SA(PK_FGU) SA(PK_FD) SA(PK_MOEA) SA(PK_MOEB) SA(PK_MGU0) SA(PK_MD0) SA(PK_MGU1) SA(PK_MD1) SA(PK_COMB) SA(PK_PP) SA(PK_PG) SA(PK_COUT)
#undef SA
#endif
        int per_cu = 0;
#if MK_ONE_LAUNCH
        if (hipOccupancyMaxActiveBlocksPerMultiprocessor(&per_cu, (const void*)k_fwd, NTH, LDS_BYTES) != hipSuccess || per_cu < 1) { fprintf(stderr, "kernel_launch: occupancy query says %d blocks/CU\n", per_cu); }
#endif
        (void)hipGetLastError();
        grid = cus;
    }
    if (grid < 0) return;
    (void)hipMemsetAsync((char*)d_ws + WS_CTL, 0, CTL_ZERO, stream);
    (void)hipMemsetAsync((char*)d_ws + WS_W, 0, 71 * MiB, stream);
    Args a{};
    for (int i = 0; i < 45; ++i) a.in[i] = d_in[i];
    a.out = (float*)d_out; a.ws = (unsigned char*)d_ws; a.layer = 0; a.pad = 0;
#if MK_ONE_LAUNCH
    hipLaunchKernelGGL(k_fwd, dim3(grid), dim3(NTH), LDS_BYTES, stream, a);
#else
    static const PhaseEnt prog_h[] = {
        {PK_PRO, 0},
        {PK_G1A, 0}, {PK_PRE, 0}, {PK_G23, 0}, {PK_MLAPOST, 0}, {PK_ATT, 0}, {PK_RGPREP, 0}, {PK_SCAN, 0}, {PK_FIN, 0}, {PK_COUT, 0}, {PK_G1B, 0}, {PK_MRG, 0}, {PK_OUT, 0}, {PK_FGU, 0}, {PK_FD, 0}, {PK_PP, 0}, {PK_PG, 0},
        {PK_G1A, 1}, {PK_PRE, 1}, {PK_G23, 1}, {PK_MLAPOST, 1}, {PK_ATT, 1}, {PK_RGPREP, 1}, {PK_SCAN, 1}, {PK_FIN, 1}, {PK_COUT, 1}, {PK_G1B, 1}, {PK_MRG, 1}, {PK_OUT, 1},
        {PK_MOEA, 1}, {PK_MOEB, 1}, {PK_MGU0, 1}, {PK_MD0, 1}, {PK_MGU1, 1}, {PK_MD1, 1}, {PK_COMB, 1}, {PK_PP, 1}, {PK_PG, 1} };
    for (int p = 0; p < (int)(sizeof(prog_h) / sizeof(prog_h[0])); ++p) { const int l = prog_h[p].layer;
#define LK(K) case K: hipLaunchKernelGGL(k_one<K>, dim3(grid), dim3(NTH), LDS_BYTES, stream, a, l); break;
        switch (prog_h[p].kind) { LK(PK_PRO) LK(PK_G1A) LK(PK_PRE) LK(PK_G23) LK(PK_MLAPOST) LK(PK_ATT) LK(PK_RGPREP) LK(PK_SCAN) LK(PK_FIN) LK(PK_G1B) LK(PK_MRG) LK(PK_OUT) LK(PK_FGU) LK(PK_FD) LK(PK_MOEA) LK(PK_MOEB) LK(PK_MGU0) LK(PK_MD0) LK(PK_MGU1) LK(PK_MD1) LK(PK_COMB) LK(PK_PP) LK(PK_PG) LK(PK_COUT) default: break; }
#undef LK
    }
#endif
}
```

```cpp
#include <hip/hip_runtime.h>
#include <cstdio>
#include <cstdint>
#ifndef PROBE_SUB
#define PROBE_SUB 0
#endif
__device__ __forceinline__ int otid() { int t = threadIdx.x; asm volatile("" : "+v"(t)); return t; }
__device__ __forceinline__ int obid() { int t = blockIdx.x; asm volatile("" : "+s"(t)); return t; }
__device__ __forceinline__ int ogrid() { int t = gridDim.x; asm volatile("" : "+s"(t)); return t; }
namespace pg8 {
#define PG8_LAS __attribute__((address_space(3)))
typedef unsigned short bf16_t;
typedef short bf16x8 __attribute__((ext_vector_type(8)));
typedef float f32x4 __attribute__((ext_vector_type(4)));
typedef unsigned u32x4 __attribute__((ext_vector_type(4)));
typedef unsigned u32x2 __attribute__((ext_vector_type(2)));
constexpr int BM = 256, BK = 64, HALF = 128, HTB = HALF * BK * 2, STAGE_BYTES = 8 * HTB, NXCD = 8, WGM = 8;

__host__ __device__ __forceinline__ int lds_byte(int r, int c) { const int st = (r >> 4) * 2 + (c >> 5), rr = r & 15, cc = c & 31, ob = rr * 64 + cc * 2; return st * 1024 + (ob ^ (((ob >> 9) & 1) << 5)); }
__host__ __device__ __forceinline__ void stage_rc(int b, int& R, int& C) { const int st = b / 1024, sb = b % 1024, swz = sb ^ (((sb >> 9) & 1) << 5); R = (st >> 1) * 16 + swz / 64; C = (st & 1) * 32 + (swz % 64) / 2; }
__host__ __device__ __forceinline__ int perm32(int rho) { const int n = rho >> 4, i = rho & 15; return 8 * (i >> 2) + 4 * n + (i & 3); }

struct Unit { int pm, pn, pb; };
struct Gemm { const bf16_t* A; const bf16_t* Bt; int K, lda, ldb; };

struct StaticOrder {
    int nM, nN, nwg, G, c, pm0; const int* blk_e;
    __device__ void init(int nM_, int nN_, int G_, int c_, int pm0_ = 0, const int* blk_e_ = nullptr) { nM = nM_; nN = nN_; nwg = nM * nN; G = G_; c = c_; pm0 = pm0_; blk_e = blk_e_; }
    __device__ bool next(int i, Unit& u) const {
        const long L = (long)i * G + c; if (L >= nwg) return false;
        int wgid = (int)L; { const int q = nwg / NXCD, r = nwg % NXCD, xcd = wgid % NXCD, off = wgid / NXCD; wgid = (xcd < r ? xcd * (q + 1) : r * (q + 1) + (xcd - r) * q) + off; }
        const int nig = WGM * nN, gid = wgid / nig, fm = gid * WGM, gsz = (nM - fm) < WGM ? (nM - fm) : WGM;
        u.pm = pm0 + fm + ((wgid % nig) % gsz); u.pn = (wgid % nig) / gsz;
        u.pb = blk_e ? (__builtin_amdgcn_readfirstlane(blk_e[u.pm]) * nN + u.pn) : u.pn;
        return true;
    }
};

typedef float cvt_f32x2 __attribute__((ext_vector_type(2)));
typedef __bf16 cvt_bf16x2 __attribute__((ext_vector_type(2)));
__device__ __forceinline__ unsigned cvt_pk_bf16(float lo, float hi) { const cvt_f32x2 v = {lo, hi}; return __builtin_bit_cast(unsigned, __builtin_convertvector(v, cvt_bf16x2)); }

template <class Epi, class Sched>
__device__ __forceinline__ void gemm_phase(PG8_LAS unsigned char* lds, const Gemm g, const Sched& S, const Epi& E) {
    const int tid = otid(), wid = __builtin_amdgcn_readfirstlane(tid >> 6), lane = tid & 63, wr = wid >> 2, wc = wid & 3, fr = lane & 15, fq = lane >> 4;
    const int K = g.K, nt = K / BK;
    unsigned voffA[2], voffB[2];
#pragma unroll
    for (int i = 0; i < 2; ++i) { int R, C; stage_rc(tid * 16 + i * 8192, R, C); const int Rb = Epi::PERM ? ((R & ~31) + perm32(R & 31)) : R;
        voffA[i] = (unsigned)(R * g.lda + C) * 2u; voffB[i] = (unsigned)(Rb * g.ldb + C) * 2u; }
    const size_t kstep = (size_t)(BK * 2);
    const size_t hA = (size_t)HALF * g.lda * 2, hB = (size_t)HALF * g.ldb * 2;
    const size_t tA = 2 * hA, tB = 2 * hB;
    const unsigned ldsw = (unsigned)wid * 1024u;
    const int aoff = lds_byte(wr * 64 + fr, fq * 8), boff = lds_byte(wc * 32 + fr, fq * 8);
#define PG8_SA(b, h) (((b) * 2 + (h)) * HTB)
#define PG8_SB(b, h) ((4 + (b) * 2 + (h)) * HTB)
#define PG8_STAGE(bufoff, gbase, voff) do { _Pragma("unroll") for (int _i = 0; _i < 2; ++_i) \
        __builtin_amdgcn_global_load_lds((const unsigned*)((const char*)(gbase) + (voff)[_i]), (PG8_LAS unsigned*)(lds + (bufoff) + ldsw + _i * 8192), 16, 0, 0); } while (0)
#define PG8_LDA(dst, b, h) do { _Pragma("unroll") for (int m = 0; m < 4; ++m) _Pragma("unroll") for (int k = 0; k < 2; ++k) dst[m][k] = *(const PG8_LAS bf16x8*)(lds + PG8_SA(b, h) + aoff + m * 2048 + k * 1024); } while (0)
#define PG8_LDB(dst, b, h) do { _Pragma("unroll") for (int n = 0; n < 2; ++n) _Pragma("unroll") for (int k = 0; k < 2; ++k) dst[n][k] = *(const PG8_LAS bf16x8*)(lds + PG8_SB(b, h) + boff + n * 2048 + k * 1024); } while (0)
#define PG8_MMA(ai, bj, At, Bt) do { __builtin_amdgcn_s_setprio(1); _Pragma("unroll") for (int m = 0; m < 4; ++m) _Pragma("unroll") for (int n = 0; n < 2; ++n) _Pragma("unroll") for (int k = 0; k < 2; ++k) \
        acc[ai][bj][m][n] = __builtin_amdgcn_mfma_f32_16x16x32_bf16(Bt[n][k], At[m][k], acc[ai][bj][m][n], 0, 0, 0); __builtin_amdgcn_s_setprio(0); } while (0)
#define PG8_WAIT_V(n) asm volatile("s_waitcnt vmcnt(" #n ")" ::: "memory")
#define PG8_WAIT_L(n) asm volatile("s_waitcnt lgkmcnt(" #n ")" ::: "memory")
#define PG8_BAR __builtin_amdgcn_s_barrier()
#define PG8_SCHED __builtin_amdgcn_sched_barrier(0)
    Unit cur, nxt; int ui = 0;
    if (!S.next(0, cur)) return;
    f32x4 acc[2][2][4][2];
#pragma unroll
    for (int a = 0; a < 2; ++a)
#pragma unroll
        for (int b = 0; b < 2; ++b)
#pragma unroll
            for (int m = 0; m < 4; ++m)
#pragma unroll
                for (int n = 0; n < 2; ++n) acc[a][b][m][n] = (f32x4){0.f, 0.f, 0.f, 0.f};
    bf16x8 At[4][2], B0[2][2], B1[2][2];
    const char* cA = (const char*)g.A + (size_t)cur.pm * tA; const char* cB = (const char*)g.Bt + (size_t)cur.pb * tB;
    PG8_STAGE(PG8_SB(0, 0), cB, voffB); PG8_STAGE(PG8_SB(0, 1), cB + hB, voffB); PG8_STAGE(PG8_SA(0, 0), cA, voffA); PG8_STAGE(PG8_SA(0, 1), cA + hA, voffA);
    if (wr == 1) PG8_BAR;
    PG8_WAIT_V(2); PG8_BAR;
    PG8_STAGE(PG8_SB(1, 0), cB + kstep, voffB); PG8_STAGE(PG8_SA(1, 0), cA + kstep, voffA); PG8_STAGE(PG8_SB(1, 1), cB + hB + kstep, voffB);
    PG8_WAIT_V(6); PG8_BAR;
    for (;;) {
        const bool has_next = S.next(ui + 1, nxt);
        const char* nA = has_next ? (const char*)g.A + (size_t)nxt.pm * tA : cA; const char* nB = has_next ? (const char*)g.Bt + (size_t)nxt.pb * tB : cB;
        for (int t = 0; t < nt; t += 2) {
            const bool last = (t == nt - 2);
            const char* a1 = cA + (size_t)(t + 1) * kstep;
            const char* a2 = last ? nA : cA + (size_t)(t + 2) * kstep; const char* b2 = last ? nB : cB + (size_t)(t + 2) * kstep;
            const char* a3 = a2 + kstep; const char* b3 = b2 + kstep;
            PG8_LDB(B0, 0, 0); PG8_LDB(B1, 0, 1); PG8_SCHED; PG8_LDA(At, 0, 0); PG8_STAGE(PG8_SA(1, 1), a1 + hA, voffA);
            PG8_WAIT_V(8); PG8_WAIT_L(0); PG8_BAR; PG8_MMA(0, 0, At, B0); PG8_MMA(0, 1, At, B1); PG8_BAR; PG8_SCHED;
            PG8_LDA(At, 0, 1); PG8_STAGE(PG8_SB(0, 0), b2, voffB); PG8_STAGE(PG8_SB(0, 1), b2 + hB, voffB); PG8_STAGE(PG8_SA(0, 0), a2, voffA);
            PG8_WAIT_V(8); PG8_WAIT_L(0); PG8_BAR; PG8_MMA(1, 0, At, B0); PG8_MMA(1, 1, At, B1); PG8_BAR; PG8_SCHED;
            PG8_LDB(B0, 1, 0); PG8_LDB(B1, 1, 1); PG8_SCHED; PG8_LDA(At, 1, 0); PG8_STAGE(PG8_SA(0, 1), a2 + hA, voffA);
            PG8_WAIT_V(8); PG8_WAIT_L(0); PG8_BAR; PG8_MMA(0, 0, At, B0); PG8_MMA(0, 1, At, B1); PG8_BAR; PG8_SCHED;
            PG8_LDA(At, 1, 1); PG8_STAGE(PG8_SB(1, 0), b3, voffB); PG8_STAGE(PG8_SB(1, 1), b3 + hB, voffB); PG8_STAGE(PG8_SA(1, 0), a3, voffA);
            PG8_WAIT_V(8); PG8_WAIT_L(0); PG8_BAR; PG8_MMA(1, 0, At, B0); PG8_MMA(1, 1, At, B1); PG8_BAR; PG8_SCHED;
        }
        if (wr == 0) PG8_BAR;
        E(acc, cur, wr, wc, fr, fq);
        if (!has_next) break;
#pragma unroll
        for (int a = 0; a < 2; ++a)
#pragma unroll
            for (int b = 0; b < 2; ++b)
#pragma unroll
                for (int m = 0; m < 4; ++m)
#pragma unroll
                    for (int n = 0; n < 2; ++n) acc[a][b][m][n] = (f32x4){0.f, 0.f, 0.f, 0.f};
        cur = nxt; cA = nA; cB = nB; ++ui;
        if (wr == 1) PG8_BAR;
    }
    PG8_WAIT_V(0);
    PG8_BAR;
#undef PG8_SA
#undef PG8_SB
#undef PG8_STAGE
#undef PG8_LDA
#undef PG8_LDB
#undef PG8_MMA
#undef PG8_WAIT_V
#undef PG8_WAIT_L
#undef PG8_BAR
#undef PG8_SCHED
}
}
#define GAS __attribute__((address_space(1)))
#define LAS __attribute__((address_space(3)))
typedef unsigned short bf16;
typedef float f32x4 __attribute__((ext_vector_type(4)));
typedef float f32x2 __attribute__((ext_vector_type(2)));
typedef float f32x16 __attribute__((ext_vector_type(16)));
typedef short bf16x8 __attribute__((ext_vector_type(8)));
typedef unsigned u32x4 __attribute__((ext_vector_type(4)));
typedef unsigned u32x2 __attribute__((ext_vector_type(2)));

constexpr int NB = 4, SEQ = 4096, T = NB * SEQ, D = 1024, NL = 2;
constexpr int NH = 8, HD = 64, HW = 512;
constexpr int N_IN = 7344, FFD = 2816, FFE = 3584, NE = 8, PLE = 256;
constexpr int N1 = 4352, NZR = 1792, NZQ = 1536, NZG = 512, NZM = 512, NGATE = 3072;
constexpr int K2 = 512, N2 = 1792, K3 = 384, N3 = 2048;
constexpr int QKD = 96;
constexpr int NBLK_MAX = 136, HALF_BLK = 68;
constexpr float NORM_EPS = 1e-6f;
constexpr int NTH = 512, NWV = 8;

constexpr size_t MiB = 1u << 20;
constexpr size_t WS_CTL = 0;
constexpr size_t WS_W = 2 * MiB;
constexpr size_t WS_HB = 73 * MiB;
constexpr size_t WS_PB = 105 * MiB;
constexpr size_t WS_VF = 121 * MiB;
constexpr size_t WS_S = 137 * MiB;
constexpr size_t WS_END = 553 * MiB;
constexpr size_t S_ZR = WS_S + 0 * MiB, S_ZQ = WS_S + 56 * MiB, S_ZG = WS_S + 104 * MiB, S_ZM = WS_S + 120 * MiB;
constexpr size_t S_A2 = WS_S + 136 * MiB, S_L2 = WS_S + 148 * MiB;
constexpr size_t S_QRAW = WS_S + 212 * MiB, S_KVRAW = WS_S + 236 * MiB, S_Q = WS_S + 268 * MiB, S_K = WS_S + 292 * MiB, S_VT = WS_S + 316 * MiB, S_OB = WS_S + 332 * MiB;
constexpr size_t S_RR = WS_S + 212 * MiB, S_RK = WS_S + 228 * MiB, S_RV = WS_S + 244 * MiB, S_RA = WS_S + 260 * MiB, S_RB = WS_S + 276 * MiB, S_RW = WS_S + 292 * MiB, S_RG = WS_S + 348 * MiB;
constexpr size_t S_GQ = WS_S + 364 * MiB, S_GK = WS_S + 380 * MiB, S_GV = WS_S + 396 * MiB, S_GAL = WS_S + 412 * MiB, S_GBE = WS_S + 412 * MiB + 524288;
constexpr size_t S_YA = WS_S + 148 * MiB, S_YC = WS_S + 164 * MiB, S_OA = WS_S + 212 * MiB, S_OC = WS_S + 228 * MiB;
constexpr size_t S_ZS = WS_S + 0 * MiB, S_M = WS_S + 348 * MiB;
constexpr size_t S_CMR = WS_S + 0 * MiB, S_S0R = WS_S + 64 * MiB, S_CMG = WS_S + 120 * MiB, S_S0G = WS_S + 184 * MiB;
constexpr size_t S_ACT = WS_S + 0 * MiB;
constexpr size_t S_MWGU = WS_S + 0 * MiB;
constexpr size_t S_MWD = WS_S + 112 * MiB;
constexpr size_t S_XG = WS_S + 168 * MiB;
constexpr size_t S_MACT = WS_S + 237 * MiB;
constexpr size_t S_E = WS_S + 358 * MiB;
constexpr size_t S_SSP0 = WS_S + 413 * MiB, S_SSP1 = WS_S + 414 * MiB, S_SSP2 = WS_S + 415 * MiB;
static_assert(S_SSP2 + MiB <= WS_END, "ws map");
static_assert(S_E + 32 * MiB <= WS_END, "ws map");
static_assert(S_MACT + (size_t)HALF_BLK * 256 * FFE * 2 <= S_E, "ws map");
static_assert(S_XG + (size_t)NBLK_MAX * 256 * D * 2 <= S_MACT, "ws map");
static_assert(S_GBE + 524288 <= WS_END, "ws map");

constexpr size_t WL = 41 * MiB;
constexpr size_t W_IN = 0, W_GATE = 9 * MiB, W_2 = 15 * MiB, W_3 = 17 * MiB, W_BRA = 19 * MiB, W_BRB = 20 * MiB, W_BRC = 21 * MiB, W_OUT = 22 * MiB;
constexpr size_t W_FGU = 24 * MiB, W_FD = 35 * MiB;
constexpr size_t W_PLE = 65 * MiB, WPL = 2 * MiB + 524288, W_PP = 0, W_PG = 524288;
static_assert(W_FD + (size_t)D * FFD * 2 <= WL && W_PLE + 2 * WPL <= 71 * MiB, "w map");
constexpr size_t WS_HB2 = WS_W;
constexpr size_t CTL_ZERO = 512 * 1024;
constexpr size_t C_BAR = 0;
constexpr size_t C_MOE = 16384;
constexpr size_t C_SS = 65536;
constexpr size_t C_RSQ = 512 * 1024, C_RSKV = C_RSQ + 65536;
constexpr size_t C_SEL = C_RSKV + 65536;
constexpr size_t C_WTS = C_SEL + 131072;
constexpr size_t C_RANK = C_WTS + 131072;
constexpr size_t C_DEST = C_RANK + 131072;
constexpr size_t C_RSX = C_DEST + 131072;
constexpr size_t C_BLKE = C_RSX + 139264;
constexpr size_t C_RS1 = C_BLKE + 1024;
constexpr size_t C_BSC = C_RS1 + 65536;
static_assert(C_BSC + 524288 <= 2 * MiB, "ctl map");

__device__ __forceinline__ float bf2f(unsigned v) { return __uint_as_float(v << 16); }
__device__ __forceinline__ unsigned f2bf(float f) { return pg8::cvt_pk_bf16(f, f) & 0xffffu; }
__device__ __forceinline__ unsigned pk2(float lo, float hi) { return pg8::cvt_pk_bf16(lo, hi); }
__device__ __forceinline__ float wave_sum(float v) {
#pragma unroll
    for (int o = 1; o < 64; o <<= 1) v += __shfl_xor(v, o);
    return v;
}
__device__ __forceinline__ float sigmoidf_(float x) { return __builtin_amdgcn_rcpf(1.f + __builtin_amdgcn_exp2f(-1.4426950408889634f * x)); }
__device__ __forceinline__ float sigmoid_fast_(float x) { return __builtin_amdgcn_rcpf(1.f + __builtin_amdgcn_exp2f(-1.4426950408889634f * x)); }
__device__ __forceinline__ float siluf_(float x) { return x * __builtin_amdgcn_rcpf(1.f + __builtin_amdgcn_exp2f(-1.4426950408889634f * x)); }
__device__ __forceinline__ float softplusf_(float x) { return fmaxf(x, 0.f) + log1pf(__expf(-fabsf(x))); }

struct Args { const void* in[45]; float* out; unsigned char* ws; int layer; int pad; };
typedef const void* gptr_t;
typedef const __attribute__((address_space(4))) gptr_t* kin_t;
struct PArgs { kin_t in; float* out; unsigned char* ws; };
__device__ __forceinline__ PArgs make_pargs(const Args& a) {
    PArgs p; p.in = (kin_t)__builtin_amdgcn_kernarg_segment_ptr();
    GAS float* o1 = (GAS float*)a.out; GAS unsigned char* w1 = (GAS unsigned char*)a.ws;
    asm volatile("" : "+s"(p.in), "+s"(o1), "+s"(w1)); p.out = (float*)o1; p.ws = (unsigned char*)w1; return p; }
#define INF(i) ((const float*)(const GAS float*)a.in[i])
#define EPI_ARGS const pg8::f32x4 (&acc)[2][2][4][2], const pg8::Unit& u, int wr, int wc, int fr, int fq
#define EPI_ROWS _Pragma("unroll") for (int ai = 0; ai < 2; ++ai) _Pragma("unroll") for (int m = 0; m < 4; ++m)
__device__ __forceinline__ u32x4 pack8(const f32x4 v0, const f32x4 v1) { u32x4 w; w.x = pg8::cvt_pk_bf16(v0[0], v0[1]); w.y = pg8::cvt_pk_bf16(v0[2], v0[3]); w.z = pg8::cvt_pk_bf16(v1[0], v1[1]); w.w = pg8::cvt_pk_bf16(v1[2], v1[3]); return w; }
__device__ __forceinline__ void unpack8(const u32x4 w, float (&f)[8]) { f[0] = bf2f(w.x & 0xffffu); f[1] = bf2f(w.x >> 16); f[2] = bf2f(w.y & 0xffffu); f[3] = bf2f(w.y >> 16); f[4] = bf2f(w.z & 0xffffu); f[5] = bf2f(w.z >> 16); f[6] = bf2f(w.w & 0xffffu); f[7] = bf2f(w.w >> 16); }

__device__ __forceinline__ float rowscale16(const float* ssp, int r) { const f32x4* p = (const f32x4*)(ssp + (size_t)r * 16); const f32x4 a = p[0], b = p[1], c = p[2], d = p[3];
    const float s = ((a[0] + a[1]) + (a[2] + a[3])) + ((b[0] + b[1]) + (b[2] + b[3])) + ((c[0] + c[1]) + (c[2] + c[3])) + ((d[0] + d[1]) + (d[2] + d[3])); return rsqrtf(s * (1.f / D) + NORM_EPS); }
__device__ __forceinline__ void rowscales16(const float* ssp, int row0, float (&s)[2][4]) {
#pragma unroll
    for (int ai = 0; ai < 2; ++ai)
#pragma unroll
        for (int mp = 0; mp < 2; ++mp) { f32x4 p[2][4];
#pragma unroll
            for (int mm = 0; mm < 2; ++mm) { const f32x4* q = (const f32x4*)(ssp + (size_t)(row0 + ai * 128 + (2 * mp + mm) * 16) * 16); p[mm][0] = q[0]; p[mm][1] = q[1]; p[mm][2] = q[2]; p[mm][3] = q[3]; }
#pragma unroll
            for (int mm = 0; mm < 2; ++mm) { const float t = ((p[mm][0][0] + p[mm][0][1]) + (p[mm][0][2] + p[mm][0][3])) + ((p[mm][1][0] + p[mm][1][1]) + (p[mm][1][2] + p[mm][1][3])) + ((p[mm][2][0] + p[mm][2][1]) + (p[mm][2][2] + p[mm][2][3])) + ((p[mm][3][0] + p[mm][3][1]) + (p[mm][3][2] + p[mm][3][3]));
                s[ai][2 * mp + mm] = rsqrtf(t * (1.f / D) + NORM_EPS); } }
}
__device__ __forceinline__ void rowvals(const float* rs, int row0, float (&s)[2][4]) {
#pragma unroll
    for (int ai = 0; ai < 2; ++ai)
#pragma unroll
        for (int m = 0; m < 4; ++m) s[ai][m] = rs[row0 + ai * 128 + m * 16];
}
struct EpiInProj {
    static constexpr bool PERM = true;
    bf16 *zr, *zq, *zg, *zm; const float* ss;
    __device__ __forceinline__ void operator()(EPI_ARGS) const {
        bf16* O; int ld, ct; const int pn = u.pn;
        if (pn < 7) { O = zr; ld = NZR; ct = pn * 256; } else if (pn < 13) { O = zq; ld = NZQ; ct = (pn - 7) * 256; } else if (pn < 15) { O = zg; ld = NZG; ct = (pn - 13) * 256; } else { O = zm; ld = NZM; ct = (pn - 15) * 256; }
        const int row0 = u.pm * 256 + wr * 64 + fr, col0 = ct + wc * 32 + 8 * fq;
        float sv[2][4]; rowscales16(ss, row0, sv);
        EPI_ROWS { const int r = row0 + ai * 128 + m * 16; const float s = sv[ai][m]; bf16* rowp = O + (size_t)r * ld + col0;
#pragma unroll
            for (int bj = 0; bj < 2; ++bj) *(u32x4*)(rowp + bj * 128) = pack8(acc[ai][bj][m][0] * s, acc[ai][bj][m][1] * s); }
    }
};
struct EpiGate {
    static constexpr bool PERM = true;
    bf16* O; const float* ss;
    __device__ __forceinline__ void operator()(EPI_ARGS) const {
        const int row0 = u.pm * 256 + wr * 64 + fr, col0 = u.pn * 256 + wc * 32 + 8 * fq;
        float sv[2][4]; rowscales16(ss, row0, sv);
        EPI_ROWS { const int r = row0 + ai * 128 + m * 16; const float s = sv[ai][m]; bf16* rowp = O + (size_t)r * NGATE + col0;
#pragma unroll
            for (int bj = 0; bj < 2; ++bj) { f32x4 v0 = acc[ai][bj][m][0] * s, v1 = acc[ai][bj][m][1] * s;
#pragma unroll
                for (int j = 0; j < 4; ++j) { v0[j] = sigmoid_fast_(v0[j]); v1[j] = sigmoid_fast_(v1[j]); }
                *(u32x4*)(rowp + bj * 128) = pack8(v0, v1); } }
    }
};
struct EpiMla {
    static constexpr bool PERM = true;
    bf16 *qraw, *kvraw; const float *rsq, *rskv;
    __device__ __forceinline__ void operator()(EPI_ARGS) const {
        const bool isq = u.pn < 3; bf16* O = isq ? qraw : kvraw; const int ld = isq ? 768 : 1024, ct = isq ? u.pn * 256 : (u.pn - 3) * 256; const float* rs = isq ? rsq : rskv;
        const int row0 = u.pm * 256 + wr * 64 + fr, col0 = ct + wc * 32 + 8 * fq;
        float sv[2][4]; rowvals(rs, row0, sv);
        EPI_ROWS { const int r = row0 + ai * 128 + m * 16; const float s = sv[ai][m]; bf16* rowp = O + (size_t)r * ld + col0;
#pragma unroll
            for (int bj = 0; bj < 2; ++bj) *(u32x4*)(rowp + bj * 128) = pack8(acc[ai][bj][m][0] * s, acc[ai][bj][m][1] * s); }
    }
};
struct EpiPlain {
    static constexpr bool PERM = true;
    bf16* O; int ld;
    __device__ __forceinline__ void operator()(EPI_ARGS) const {
        const int row0 = u.pm * 256 + wr * 64 + fr, col0 = u.pn * 256 + wc * 32 + 8 * fq;
        EPI_ROWS { const int r = row0 + ai * 128 + m * 16; bf16* rowp = O + (size_t)r * ld + col0;
#pragma unroll
            for (int bj = 0; bj < 2; ++bj) *(u32x4*)(rowp + bj * 128) = pack8(acc[ai][bj][m][0], acc[ai][bj][m][1]); }
    }
};
template <bool FIRST> struct EpiMerge {
    static constexpr bool PERM = true;
    bf16* M; const bf16* zs; int br;
    __device__ __forceinline__ void operator()(EPI_ARGS) const {
        const int row0 = u.pm * 256 + wr * 64 + fr, col0 = u.pn * 256 + wc * 32 + 8 * fq;
#pragma unroll
        for (int ai = 0; ai < 2; ++ai) { u32x4 gv[4][2], mv[4][2];
#pragma unroll
            for (int m = 0; m < 4; ++m)
#pragma unroll
                for (int bj = 0; bj < 2; ++bj) { const int r = row0 + ai * 128 + m * 16, c = col0 + bj * 128; gv[m][bj] = *(const u32x4*)(zs + (size_t)r * NGATE + br * 1024 + c); if (!FIRST) mv[m][bj] = *(const u32x4*)(M + (size_t)r * D + c); }
#pragma unroll
            for (int m = 0; m < 4; ++m)
#pragma unroll
                for (int bj = 0; bj < 2; ++bj) { const int r = row0 + ai * 128 + m * 16, c = col0 + bj * 128; float g[8], o[8]; unpack8(gv[m][bj], g); if (!FIRST) unpack8(mv[m][bj], o);
                    f32x4 v0, v1;
#pragma unroll
                    for (int j = 0; j < 4; ++j) { v0[j] = g[j] * acc[ai][bj][m][0][j] + (FIRST ? 0.f : o[j]); v1[j] = g[4 + j] * acc[ai][bj][m][1][j] + (FIRST ? 0.f : o[4 + j]); }
                    *(u32x4*)(M + (size_t)r * D + c) = pack8(v0, v1); }
            asm volatile("" ::: "memory"); }
    }
};
struct EpiResid {
    static constexpr bool PERM = false;
    const float* base; float* out; bf16* hb; float* ss;
    __device__ __forceinline__ void operator()(EPI_ARGS) const {
        const int row0 = u.pm * 256 + wr * 64 + fr, col0 = u.pn * 256 + wc * 32 + 4 * fq;
#pragma unroll
        for (int ai = 0; ai < 2; ++ai) { f32x4 bv[4][2][2];
#pragma unroll
            for (int m = 0; m < 4; ++m)
#pragma unroll
                for (int bj = 0; bj < 2; ++bj)
#pragma unroll
                    for (int n = 0; n < 2; ++n) bv[m][bj][n] = *(const f32x4*)(base + (size_t)(row0 + ai * 128 + m * 16) * D + col0 + bj * 128 + n * 16);
#pragma unroll
            for (int m = 0; m < 4; ++m) { const int r = row0 + ai * 128 + m * 16; float sq = 0.f;
#pragma unroll
                for (int bj = 0; bj < 2; ++bj)
#pragma unroll
                    for (int n = 0; n < 2; ++n) { const size_t off = (size_t)r * D + col0 + bj * 128 + n * 16; f32x4 h = bv[m][bj][n]; h += acc[ai][bj][m][n]; *(f32x4*)(out + off) = h;
                        u32x2 w; w.x = pg8::cvt_pk_bf16(h[0], h[1]); w.y = pg8::cvt_pk_bf16(h[2], h[3]); *(u32x2*)(hb + off) = w; sq += (h[0] * h[0] + h[1] * h[1]) + (h[2] * h[2] + h[3] * h[3]); }
                if (ss) { sq += __shfl_xor(sq, 16); sq += __shfl_xor(sq, 32); if (fq == 0) ss[(size_t)r * 16 + u.pn * 4 + wc] = sq; } }
            asm volatile("" ::: "memory"); }
    }
};
template <bool MOE> struct EpiSwiglu {
    static constexpr bool PERM = true;
    bf16* O; int ld; const float* rs;
    __device__ __forceinline__ void operator()(EPI_ARGS) const {
        const int row0 = u.pm * 256 + wr * 64 + fr, col0 = u.pn * 128 + wc * 32 + 8 * fq;
        float sv[2][4]; if (MOE) rowvals(rs, row0, sv); else rowscales16(rs, row0, sv);
        EPI_ROWS { const int r = row0 + ai * 128 + m * 16; const float s = sv[ai][m];
            f32x4 v0, v1;
#pragma unroll
            for (int j = 0; j < 4; ++j) { v0[j] = siluf_(acc[ai][0][m][0][j] * s) * (acc[ai][1][m][0][j] * s); v1[j] = siluf_(acc[ai][0][m][1][j] * s) * (acc[ai][1][m][1][j] * s); }
            *(u32x4*)(O + (size_t)r * ld + col0) = pack8(v0, v1); }
    }
};
struct EpiPleProj {
    static constexpr bool PERM = true;
    bf16* O; float* sse;
    __device__ __forceinline__ void operator()(EPI_ARGS) const {
        const int row0 = u.pm * 256 + wr * 64 + fr, col0 = u.pn * 256 + wc * 32 + 8 * fq;
        EPI_ROWS { const int r = row0 + ai * 128 + m * 16; float sq = 0.f;
#pragma unroll
            for (int bj = 0; bj < 2; ++bj) { const f32x4 v0 = acc[ai][bj][m][0], v1 = acc[ai][bj][m][1]; *(u32x4*)(O + (size_t)r * D + col0 + bj * 128) = pack8(v0, v1);
                sq += (v0[0] * v0[0] + v0[1] * v0[1]) + (v0[2] * v0[2] + v0[3] * v0[3]) + (v1[0] * v1[0] + v1[1] * v1[1]) + (v1[2] * v1[2] + v1[3] * v1[3]); }
            sq += __shfl_xor(sq, 16); sq += __shfl_xor(sq, 32); if (fq == 0) sse[(size_t)r * 16 + u.pn * 4 + wc] = sq; }
    }
};
struct EpiPleGate {
    static constexpr bool PERM = false;
    float* out; bf16* hb; const bf16* E; const float* sse; const float* png; float* ssn;
    __device__ __forceinline__ void operator()(EPI_ARGS) const {
        const int row0 = u.pm * 256 + wr * 64 + fr, col0 = u.pn * 256 + wc * 32 + 4 * fq;
        EPI_ROWS { const int r = row0 + ai * 128 + m * 16; float sq = 0.f; const float se = rowscale16(sse, r);
#pragma unroll
            for (int bj = 0; bj < 2; ++bj)
#pragma unroll
                for (int n = 0; n < 2; ++n) { const int c = col0 + bj * 128 + n * 16; const size_t off = (size_t)r * D + c; f32x4 h = *(const f32x4*)(out + off);
                    const u32x2 ew = *(const u32x2*)(E + off); const f32x4 g = *(const f32x4*)(png + c);
                    const float e0 = bf2f(ew.x & 0xffffu), e1 = bf2f(ew.x >> 16), e2 = bf2f(ew.y & 0xffffu), e3 = bf2f(ew.y >> 16);
                    const f32x4 a4 = acc[ai][bj][m][n];
                    h[0] += sigmoidf_(a4[0]) * (e0 * se * g[0]); h[1] += sigmoidf_(a4[1]) * (e1 * se * g[1]); h[2] += sigmoidf_(a4[2]) * (e2 * se * g[2]); h[3] += sigmoidf_(a4[3]) * (e3 * se * g[3]);
                    *(f32x4*)(out + off) = h; if (hb) { u32x2 w; w.x = pg8::cvt_pk_bf16(h[0], h[1]); w.y = pg8::cvt_pk_bf16(h[2], h[3]); *(u32x2*)(hb + off) = w; }
                    sq += (h[0] * h[0] + h[1] * h[1]) + (h[2] * h[2] + h[3] * h[3]); }
            if (ssn) { sq += __shfl_xor(sq, 16); sq += __shfl_xor(sq, 32); if (fq == 0) ssn[(size_t)r * 16 + u.pn * 4 + wc] = sq; } }
    }
};
struct TJob { int src, src_off, K, ldn, n0, ncnt; int dst_off, dst_ld, dst_k0, dst_row0, rowmode; int gain, gain_off, gain2, gain2_off, g2mode; };
#define WOFF(l, o) ((int)((l) * WL + (o)))
#define LAYER_JOBS(l) \
    {4, (l) * D * N_IN, D, N_IN, 0, 1792, WOFF(l, W_IN), D, 0, 0, 0, 3, (l) * D, -1, 0, 0}, \
    {4, (l) * D * N_IN, D, N_IN, 2208, 1536, WOFF(l, W_IN), D, 0, 1792, 0, 3, (l) * D, -1, 0, 0}, \
    {4, (l) * D * N_IN, D, N_IN, 3760, 512, WOFF(l, W_IN), D, 0, 3328, 0, 3, (l) * D, -1, 0, 0}, \
    {4, (l) * D * N_IN, D, N_IN, 1792, 416, WOFF(l, W_IN), D, 0, 3840, 0, 3, (l) * D, -1, 0, 0}, \
    {4, (l) * D * N_IN, D, N_IN, 3744, 16, WOFF(l, W_IN), D, 0, 3840 + 416, 0, 3, (l) * D, -1, 0, 0}, \
    {4, (l) * D * N_IN, D, N_IN, 4272, 3072, WOFF(l, W_GATE), D, 0, 0, 0, 3, (l) * D, -1, 0, 0}, \
    {7, (l) * 64 * 512, 64, 512, 0, 512, WOFF(l, W_3), K3, 0, 0, 0, -1, 0, -1, 0, 0}, \
    {9, (l) * 64 * 512, 64, 512, 0, 512, WOFF(l, W_3), K3, 64, 512, 0, -1, 0, -1, 0, 0}, \
    {10, (l) * 128 * 512, 128, 512, 0, 512, WOFF(l, W_3), K3, 128, 1024, 0, -1, 0, -1, 0, 0}, \
    {22, (l) * 256 * 768, 256, 768, 0, 768, WOFF(l, W_2), K2, 0, 0, 0, 20, (l) * 256, -1, 0, 0}, \
    {23, (l) * 128 * 1024, 128, 1024, 0, 1024, WOFF(l, W_2), K2, 256, 768, 0, 21, (l) * 128, -1, 0, 0}, \
    {30, (l) * 512 * 1024, 512, 1024, 0, 1024, WOFF(l, W_BRA), 512, 0, 0, 0, -1, 0, -1, 0, 0}, \
    {31, (l) * 512 * 1024, 512, 1024, 0, 1024, WOFF(l, W_BRB), 512, 0, 0, 0, -1, 0, -1, 0, 0}, \
    {32, (l) * 512 * 1024, 512, 1024, 0, 1024, WOFF(l, W_BRC), 512, 0, 0, 0, -1, 0, -1, 0, 0}, \
    {33, (l) * D * D, D, D, 0, D, WOFF(l, W_OUT), D, 0, 0, 0, -1, 0, -1, 0, 0}, \
    {42, (l) * PLE * D, PLE, D, 0, D, (int)(W_PLE + (l) * WPL + W_PP), PLE, 0, 0, 0, -1, 0, -1, 0, 0}, \
    {43, (l) * D * D, D, D, 0, D, (int)(W_PLE + (l) * WPL + W_PG), D, 0, 0, 0, -1, 0, -1, 0, 0}
__constant__ TJob g_jobs[] = {
    LAYER_JOBS(0), LAYER_JOBS(1),
    {17, 0, D, 32, 0, 32, WOFF(1, W_IN), D, 0, 3840 + 432, 0, 3, 1 * D, 16, 0, 1},
    {17, 0, D, 32, 0, 32, WOFF(1, W_IN), D, 0, 3840 + 464, 0, 3, 1 * D, 16, 0, 2},
    {18, 0, 32, 512, 0, 512, WOFF(1, W_3), K3, 256, 1536, 0, -1, 0, -1, 0, 0},
    {35, 0, D, FFD, 0, FFD, (int)W_FGU, D, 0, 0, 1, 34, 0, -1, 0, 0},
    {36, 0, D, FFD, 0, FFD, (int)W_FGU, D, 0, 0, 2, 34, 0, -1, 0, 0},
    {37, 0, FFD, D, 0, D, (int)W_FD, FFD, 0, 0, 0, -1, 0, -1, 0, 0},
};
constexpr int NJOBS = sizeof(g_jobs) / sizeof(TJob);

__device__ __forceinline__ void tr_load(const PArgs& a, const TJob& j, int item, int lane, float (&v)[32], float (&gn)[8]) {
    const float* W = INF(j.src) + j.src_off;
    const int nblk = (j.ncnt + 31) / 32, kb = item / nblk, nb = item % nblk, k0 = 64 * kb, nl0 = 32 * nb;
    const int nl = nl0 + (lane & 31);
#pragma unroll
    for (int i = 0; i < 32; ++i) { const int k = k0 + 2 * i + (lane >> 5); v[i] = (k < j.K && nl < j.ncnt) ? W[(size_t)k * j.ldn + j.n0 + nl] : 0.f; }
    const int c = lane & 7;
#pragma unroll
    for (int e = 0; e < 8; ++e) gn[e] = 1.f;
    if (k0 + 8 * c < j.K) {
        if (j.gain >= 0) { const float* G1 = INF(j.gain) + j.gain_off + k0 + 8 * c; const f32x4 g0 = *(const f32x4*)G1, g1 = *(const f32x4*)(G1 + 4);
#pragma unroll
            for (int e = 0; e < 4; ++e) { gn[e] = g0[e]; gn[4 + e] = g1[e]; } }
        if (j.gain2 >= 0) { const float* G2 = INF(j.gain2) + j.gain2_off + k0 + 8 * c; const f32x4 g0 = *(const f32x4*)G2, g1 = *(const f32x4*)(G2 + 4);
#pragma unroll
            for (int e = 0; e < 4; ++e) { gn[e] *= (j.g2mode == 1) ? (1.f - g0[e]) : g0[e]; gn[4 + e] *= (j.g2mode == 1) ? (1.f - g1[e]) : g1[e]; } } }
}
__device__ __forceinline__ void tr_finish(const TJob& j, bf16* dstbase, LAS float* scr, int item, int lane, const float (&v)[32], const float (&gn)[8]) {
    const int nblk = (j.ncnt + 31) / 32, kb = item / nblk, nb = item % nblk, k0 = 64 * kb, nl0 = 32 * nb, c = lane & 7;
#pragma unroll
    for (int i = 0; i < 32; ++i) scr[(2 * i + (lane >> 5)) * 33 + (lane & 31)] = v[i];
    asm volatile("s_waitcnt lgkmcnt(0)" ::: "memory");
    if (k0 + 8 * c < j.K) {
#pragma unroll
        for (int q = 0; q < 4; ++q) { const int nloc = (lane >> 3) + 8 * q, n = nl0 + nloc; if (n < j.ncnt) { const LAS float* s = scr + (8 * c) * 33 + nloc;
            u32x4 o; o.x = pk2(s[0 * 33] * gn[0], s[1 * 33] * gn[1]); o.y = pk2(s[2 * 33] * gn[2], s[3 * 33] * gn[3]); o.z = pk2(s[4 * 33] * gn[4], s[5 * 33] * gn[5]); o.w = pk2(s[6 * 33] * gn[6], s[7 * 33] * gn[7]);
            const int row = j.dst_row0 + (j.rowmode == 0 ? n : (n / 128) * 256 + (n % 128) + (j.rowmode == 2 ? 128 : 0));
            *(u32x4*)(dstbase + (size_t)row * j.dst_ld + j.dst_k0 + k0 + 8 * c) = o; } }
    }
    asm volatile("s_waitcnt lgkmcnt(0)" ::: "memory");
}

__device__ __forceinline__ void phase_prologue(const PArgs& a, LAS unsigned char* lds) {
    const int bidx_ = obid();
    const int tid = otid(), lane = tid & 63, wave = __builtin_amdgcn_readfirstlane(tid >> 6), G = ogrid();
    const int gw = bidx_ * NWV + wave, NGW = G * NWV;
    LAS float* scr = (LAS float*)(lds + wave * 16384);
    { int ji = 0, base = 0, nit = ((g_jobs[0].K + 63) / 64) * ((g_jobs[0].ncnt + 31) / 32);
#define PJ_FIND(it_) do { while (ji < NJOBS && (it_) >= base + nit) { base += nit; ++ji; if (ji < NJOBS) nit = ((g_jobs[ji].K + 63) / 64) * ((g_jobs[ji].ncnt + 31) / 32); } } while (0)
      float v[32], gn[8]; int it = gw; PJ_FIND(it); bool have = ji < NJOBS; TJob jc; int ic = 0;
      if (have) { jc = g_jobs[ji]; ic = it - base; tr_load(a, jc, ic, lane, v, gn); }
      while (have) { const int itn = it + NGW; PJ_FIND(itn); const bool hn = ji < NJOBS; TJob jn; int in_ = 0; float vn[32], gnn[8];
          if (hn) { jn = g_jobs[ji]; in_ = itn - base; tr_load(a, jn, in_, lane, vn, gnn); }
          tr_finish(jc, (bf16*)(a.ws + WS_W + jc.dst_off), scr, ic, lane, v, gn);
          if (hn) { jc = jn; ic = in_;
#pragma unroll
              for (int i = 0; i < 32; ++i) v[i] = vn[i];
#pragma unroll
              for (int e = 0; e < 8; ++e) gn[e] = gnn[e]; }
          have = hn; it = itn; }
#undef PJ_FIND
    }
    const float* x = INF(0); bf16* hb = (bf16*)(a.ws + WS_HB); float* ss0 = (float*)(a.ws + S_SSP0);
    for (int m = gw; m < T; m += NGW) { const f32x4* xr = (const f32x4*)(x + (size_t)m * D) + lane; u32x2* hrow = (u32x2*)(hb + (size_t)m * D) + lane;
        float s = 0.f;
#pragma unroll
        for (int q = 0; q < 4; ++q) { const f32x4 v = xr[64 * q]; u32x2 w; w.x = pk2(v[0], v[1]); w.y = pk2(v[2], v[3]); hrow[64 * q] = w; s += (v[0] * v[0] + v[1] * v[1]) + (v[2] * v[2] + v[3] * v[3]); }
        s = wave_sum(s); if (lane < 16) ss0[(size_t)m * 16 + lane] = lane == 0 ? s : 0.f; }
    const f32x4* p4 = (const f32x4*)INF(1); u32x2* pb = (u32x2*)(a.ws + WS_PB);
    for (size_t i = (size_t)bidx_ * NTH + tid; i < (size_t)NL * T * PLE / 4; i += (size_t)G * NTH) { const f32x4 v = p4[i]; u32x2 w; w.x = pk2(v[0], v[1]); w.y = pk2(v[2], v[3]); pb[i] = w; }
}

__device__ __forceinline__ void phase_moe_cvt(const PArgs& a, LAS unsigned char* lds) {
    const int bidx_ = obid();
    const int tid = otid(), lane = tid & 63, wave = __builtin_amdgcn_readfirstlane(tid >> 6), G = ogrid();
    const int gw = bidx_ * NWV + wave, NGW = G * NWV;
    LAS float* scr = (LAS float*)(lds + wave * 16384);
    constexpr int IT_GU = (D / 64) * (FFE / 32), IT_D = (FFE / 64) * (D / 32);
    constexpr int PER_E = 2 * IT_GU + IT_D;
#define MJ_MAKE(it_, j, item_, dst_) do { const int e_ = (it_) / PER_E; int r_ = (it_) % PER_E; j.gain2 = -1; j.gain2_off = 0; j.g2mode = 0; j.n0 = 0; j.dst_k0 = 0; j.dst_off = 0; \
        if (r_ < 2 * IT_GU) { const int up_ = r_ >= IT_GU; if (up_) r_ -= IT_GU; j.src = up_ ? 40 : 39; j.src_off = e_ * D * FFE; j.K = D; j.ldn = FFE; j.ncnt = FFE; j.dst_ld = D; j.dst_row0 = e_ * 2 * FFE; j.rowmode = up_ ? 2 : 1; j.gain = 34; j.gain_off = D; dst_ = (bf16*)(a.ws + S_MWGU); } \
        else { r_ -= 2 * IT_GU; j.src = 41; j.src_off = e_ * FFE * D; j.K = FFE; j.ldn = D; j.ncnt = D; j.dst_ld = FFE; j.dst_row0 = e_ * D; j.rowmode = 0; j.gain = -1; j.gain_off = 0; dst_ = (bf16*)(a.ws + S_MWD); } item_ = r_; } while (0)
    { float v[32], gn[8]; TJob jc; int ic = 0; bf16* dc = nullptr; int it = gw; bool have = it < NE * PER_E;
      if (have) { MJ_MAKE(it, jc, ic, dc); tr_load(a, jc, ic, lane, v, gn); }
      while (have) { const int itn = it + NGW; const bool hn = itn < NE * PER_E; TJob jn; int in_ = 0; bf16* dn = nullptr; float vn[32], gnn[8];
          if (hn) { MJ_MAKE(itn, jn, in_, dn); tr_load(a, jn, in_, lane, vn, gnn); }
          tr_finish(jc, dc, scr, ic, lane, v, gn);
          if (hn) { jc = jn; ic = in_; dc = dn;
#pragma unroll
              for (int i = 0; i < 32; ++i) v[i] = vn[i];
#pragma unroll
              for (int e = 0; e < 8; ++e) gn[e] = gnn[e]; }
          have = hn; it = itn; } }
#undef MJ_MAKE
}
__device__ __forceinline__ void phase_pre(const PArgs& a, int l) {
    const int bidx_ = obid();
    const int tid = otid(), lane = tid & 63, wave = tid >> 6, G = ogrid();
    const bf16* zr = (const bf16*)(a.ws + S_ZR); const bf16* zm = (const bf16*)(a.ws + S_ZM); bf16* A2 = (bf16*)(a.ws + S_A2);
    float* rsq = (float*)(a.ws + WS_CTL + C_RSQ); float* rskv = (float*)(a.ws + WS_CTL + C_RSKV);
    constexpr int TT = 8;
    const float mu = tid < 256 ? INF(5)[l * 1792 + 1536 + tid] : 0.f;
    for (int g = bidx_; g < T / TT; g += G) { const int t0 = g * TT;
        if (tid < 256) { const int col = 1536 + tid; float v[TT + 1];
            v[0] = (t0 % SEQ == 0) ? 0.f : bf2f(zr[(size_t)(t0 - 1) * NZR + col]);
#pragma unroll
            for (int i = 0; i < TT; ++i) v[i + 1] = bf2f(zr[(size_t)(t0 + i) * NZR + col]);
#pragma unroll
            for (int i = 0; i < TT; ++i) { float x = v[i + 1] + (v[i] - v[i + 1]) * mu; if (tid < 64) x = tanhf(x); else if (tid >= 128) x = sigmoidf_(x); A2[(size_t)(t0 + i) * K3 + tid] = (bf16)f2bf(x); }
        } else if (tid < 288) { const int jx = tid - 256; float c1[TT], c2[TT + 1];
            c2[0] = (t0 % SEQ == 0) ? 0.f : bf2f(zm[(size_t)(t0 - 1) * NZM + 464 + jx]);
#pragma unroll
            for (int i = 0; i < TT; ++i) { c1[i] = bf2f(zm[(size_t)(t0 + i) * NZM + 432 + jx]); c2[i + 1] = bf2f(zm[(size_t)(t0 + i) * NZM + 464 + jx]); }
#pragma unroll
            for (int i = 0; i < TT; ++i) A2[(size_t)(t0 + i) * K3 + tid] = (bf16)f2bf(c1[i] + c2[i]);
        } else if (tid < 384) {
#pragma unroll
            for (int i = 0; i < TT; ++i) A2[(size_t)(t0 + i) * K3 + tid] = 0;
        } else if (wave == 6) { float s[TT];
#pragma unroll
            for (int i = 0; i < TT; ++i) { const u32x2 w = *(const u32x2*)(zm + (size_t)(t0 + i) * NZM + lane * 4); const float f0 = bf2f(w.x & 0xffffu), f1 = bf2f(w.x >> 16), f2 = bf2f(w.y & 0xffffu), f3 = bf2f(w.y >> 16); s[i] = f0 * f0 + f1 * f1 + f2 * f2 + f3 * f3; }
#pragma unroll
            for (int i = 0; i < TT; ++i) { const float q = wave_sum(s[i]); if (lane == 0) rsq[t0 + i] = rsqrtf(q * (1.f / 256.f) + NORM_EPS); }
        } else { float s[TT];
#pragma unroll
            for (int i = 0; i < TT; ++i) { const unsigned w = *(const unsigned*)(zm + (size_t)(t0 + i) * NZM + 256 + lane * 2); const float f0 = bf2f(w & 0xffffu), f1 = bf2f(w >> 16); s[i] = f0 * f0 + f1 * f1; }
#pragma unroll
            for (int i = 0; i < TT; ++i) { const float q = wave_sum(s[i]); if (lane == 0) rskv[t0 + i] = rsqrtf(q * (1.f / 128.f) + NORM_EPS); }
        }
    }
}

__device__ __forceinline__ void ld8(const bf16* p, float (&f)[8]) { unpack8(*(const u32x4*)p, f); }
__device__ __forceinline__ void st8(bf16* p, const float (&f)[8]) { *(u32x4*)p = (u32x4){pk2(f[0], f[1]), pk2(f[2], f[3]), pk2(f[4], f[5]), pk2(f[6], f[7])}; }
__device__ __forceinline__ void ldf8(const float* p, float (&f)[8]) { const f32x4 a = *(const f32x4*)p, b = *(const f32x4*)(p + 4); f[0] = a[0]; f[1] = a[1]; f[2] = a[2]; f[3] = a[3]; f[4] = b[0]; f[5] = b[1]; f[6] = b[2]; f[7] = b[3]; }
__device__ __forceinline__ float sum8lanes(float v) { v += __shfl_xor(v, 1); v += __shfl_xor(v, 2); v += __shfl_xor(v, 4); return v; }
__device__ __forceinline__ void phase_mla_post(const PArgs& a, int l, LAS unsigned char* lds) {
    const int bidx_ = obid();
    const int tid = otid(), lane = tid & 63, wave = __builtin_amdgcn_readfirstlane(tid >> 6), G = ogrid(), h = lane >> 3, sub = lane & 7;
    const bf16* qraw = (const bf16*)(a.ws + S_QRAW); const bf16* kvraw = (const bf16*)(a.ws + S_KVRAW); const bf16* zm = (const bf16*)(a.ws + S_ZM);
    bf16* Q = (bf16*)(a.ws + S_Q); bf16* Kk = (bf16*)(a.ws + S_K); bf16* Vt = (bf16*)(a.ws + S_VT);
    const int* pos = (const int*)(const GAS int*)a.in[2];
    const bool rp = sub < 4;
    float gq0[8], gk0[8], gq1[8], gk1[8], invf[8];
    ldf8(INF(24) + l * QKD + 8 * sub, gq0); ldf8(INF(25) + l * QKD + 8 * sub, gk0);
    ldf8(INF(24) + l * QKD + 64 + 8 * (sub & 3), gq1); ldf8(INF(25) + l * QKD + 64 + 8 * (sub & 3), gk1);
#pragma unroll
    for (int e = 0; e < 8; ++e) invf[e] = exp2f(-(float)(8 * (sub & 1) + e) * (13.287712379549449f / 16.f));
    const float qscale = 0.10206207261596577f * 1.4426950408889634f;
    for (int g = bidx_ * NWV + wave; g < T / 8; g += G * NWV) { const int t0 = g * 8, b = t0 / SEQ, s0 = t0 % SEQ;
        unsigned vtr[8][4];
        u32x4 nq0, nk0, nvw, nq1 = (u32x4){0u, 0u, 0u, 0u}, nk1 = (u32x4){0u, 0u, 0u, 0u}; int npos;
#define ML_LOAD(tt) do { const size_t t_ = (tt); nq0 = *(const u32x4*)(qraw + t_ * 768 + h * 96 + 8 * sub); nk0 = *(const u32x4*)(kvraw + t_ * 1024 + h * 128 + 8 * sub); nvw = *(const u32x4*)(kvraw + t_ * 1024 + h * 128 + 64 + 8 * sub); \
            if (rp) { nq1 = *(const u32x4*)(qraw + t_ * 768 + h * 96 + 64 + 8 * sub); nk1 = *(const u32x4*)(zm + t_ * NZM + 384 + 8 * sub); } npos = pos[t_]; } while (0)
        ML_LOAD(t0);
        for (int i = 0; i < 8; ++i) { const size_t t = t0 + i; float q0[8], q1[8], k0[8], k1[8];
            unpack8(nq0, q0); unpack8(nk0, k0); unpack8(nq1, q1); unpack8(nk1, k1); const u32x4 vw = nvw; const float ps = (float)npos;
            if (i + 1 < 8) ML_LOAD(t + 1);
            float sq = 0.f, sk = 0.f;
#pragma unroll
            for (int e = 0; e < 8; ++e) { sq += q0[e] * q0[e] + q1[e] * q1[e]; sk += k0[e] * k0[e] + k1[e] * k1[e]; }
            sq = sum8lanes(sq); sk = sum8lanes(sk);
            const float rq = rsqrtf(sq * (1.f / QKD) + NORM_EPS), rk = rsqrtf(sk * (1.f / QKD) + NORM_EPS);
            float qo[8], ko[8], qr[8], kr[8];
#pragma unroll
            for (int e = 0; e < 8; ++e) { qo[e] = q0[e] * rq * gq0[e] * qscale; ko[e] = k0[e] * rk * gk0[e]; q1[e] = q1[e] * rq * gq1[e]; k1[e] = k1[e] * rk * gk1[e]; }
#pragma unroll
            for (int e = 0; e < 8; ++e) { const float qp = __shfl_xor(q1[e], 2), kp = __shfl_xor(k1[e], 2);
                const double rev = (double)(ps * invf[e]) * 0.15915494309189535; const float fr = (float)(rev - rint(rev));
                const float sn = __builtin_amdgcn_sinf(fr), cs = __builtin_amdgcn_cosf(fr);
                qr[e] = ((sub & 2) ? (q1[e] * cs + qp * sn) : (q1[e] * cs - qp * sn)) * qscale; kr[e] = (sub & 2) ? (k1[e] * cs + kp * sn) : (k1[e] * cs - kp * sn); }
            const size_t ro = ((size_t)(b * NH + h) * SEQ + s0 + i) * QKD;
            st8(Q + ro + 8 * sub, qo); st8(Kk + ro + 8 * sub, ko);
            if (rp) { st8(Q + ro + 64 + 8 * sub, qr); st8(Kk + ro + 64 + 8 * sub, kr); }
            vtr[i][0] = vw.x; vtr[i][1] = vw.y; vtr[i][2] = vw.z; vtr[i][3] = vw.w; }
#undef ML_LOAD
#pragma unroll
        for (int e = 0; e < 8; ++e) { u32x4 o;
            const unsigned x0 = (e & 1) ? (vtr[0][e >> 1] >> 16) : (vtr[0][e >> 1] & 0xffffu), x1 = (e & 1) ? (vtr[1][e >> 1] >> 16) : (vtr[1][e >> 1] & 0xffffu);
            const unsigned x2 = (e & 1) ? (vtr[2][e >> 1] >> 16) : (vtr[2][e >> 1] & 0xffffu), x3 = (e & 1) ? (vtr[3][e >> 1] >> 16) : (vtr[3][e >> 1] & 0xffffu);
            const unsigned x4 = (e & 1) ? (vtr[4][e >> 1] >> 16) : (vtr[4][e >> 1] & 0xffffu), x5 = (e & 1) ? (vtr[5][e >> 1] >> 16) : (vtr[5][e >> 1] & 0xffffu);
            const unsigned x6 = (e & 1) ? (vtr[6][e >> 1] >> 16) : (vtr[6][e >> 1] & 0xffffu), x7 = (e & 1) ? (vtr[7][e >> 1] >> 16) : (vtr[7][e >> 1] & 0xffffu);
            o.x = x0 | (x1 << 16); o.y = x2 | (x3 << 16); o.z = x4 | (x5 << 16); o.w = x6 | (x7 << 16);
            *(u32x4*)(Vt + ((size_t)(b * NH + h) * 64 + 8 * sub + e) * SEQ + s0) = o; }
    }
}

__device__ __forceinline__ void phase_rwkv_post(const PArgs& a, int l) {
    const int bidx_ = obid();
    const int tid = otid(), lane = tid & 63, wave = __builtin_amdgcn_readfirstlane(tid >> 6), G = ogrid(), c0 = lane * 8, h = lane >> 3;
    const bf16* zr = (const bf16*)(a.ws + S_ZR); const bf16* L2 = (const bf16*)(a.ws + S_L2); bf16* vf = (bf16*)(a.ws + WS_VF);
    bf16* RR = (bf16*)(a.ws + S_RR); bf16* RK = (bf16*)(a.ws + S_RK); bf16* RV = (bf16*)(a.ws + S_RV); bf16* RA = (bf16*)(a.ws + S_RA); bf16* RB = (bf16*)(a.ws + S_RB); float* RW = (float*)(a.ws + S_RW); bf16* RG = (bf16*)(a.ws + S_RG);
    float* bscA = (float*)(a.ws + WS_CTL + C_BSC);
    float mur[8], muk[8], muv[8], w0[8], a0[8], kkc[8], kac[8], rkc[8], vb[8];
    ldf8(INF(5) + l * 1792 + c0, mur); ldf8(INF(5) + l * 1792 + 512 + c0, muk); ldf8(INF(5) + l * 1792 + 1024 + c0, muv);
    ldf8(INF(6) + l * 512 + c0, w0); ldf8(INF(8) + l * 512 + c0, a0); ldf8(INF(11) + l * 512 + c0, kkc); ldf8(INF(12) + l * 512 + c0, kac); ldf8(INF(13) + l * 512 + c0, rkc);
    if (l > 0) ldf8(INF(19) + (l - 1) * 512 + c0, vb);
    for (int g = bidx_ * NWV + wave; g < T / 8; g += G * NWV) { const int t0 = g * 8;
        float pr[8], pk[8], pv[8];
        if (t0 % SEQ == 0) {
#pragma unroll
            for (int e = 0; e < 8; ++e) { pr[e] = 0.f; pk[e] = 0.f; pv[e] = 0.f; } }
        else { ld8(zr + (size_t)(t0 - 1) * NZR + c0, pr); ld8(zr + (size_t)(t0 - 1) * NZR + 512 + c0, pk); ld8(zr + (size_t)(t0 - 1) * NZR + 1024 + c0, pv); }
        u32x4 nzr, nzk, nzv, nlw, nla, nlg, nlv, nvf;
#define RW_LOAD(tt) do { const size_t t_ = (tt); nzr = *(const u32x4*)(zr + t_ * NZR + c0); nzk = *(const u32x4*)(zr + t_ * NZR + 512 + c0); nzv = *(const u32x4*)(zr + t_ * NZR + 1024 + c0); \
            nlw = *(const u32x4*)(L2 + t_ * N3 + c0); nla = *(const u32x4*)(L2 + t_ * N3 + 512 + c0); nlg = *(const u32x4*)(L2 + t_ * N3 + 1024 + c0); \
            if (l > 0) { nlv = *(const u32x4*)(L2 + t_ * N3 + 1536 + c0); nvf = *(const u32x4*)(vf + t_ * HW + c0); } } while (0)
        RW_LOAD(t0);
        for (int i = 0; i < 8; ++i) { const size_t t = t0 + i; float zr_[8], zk_[8], zv_[8], lw[8], la[8], lg[8], lv[8], vfi[8];
            unpack8(nzr, zr_); unpack8(nzk, zk_); unpack8(nzv, zv_); unpack8(nlw, lw); unpack8(nla, la); unpack8(nlg, lg);
            if (l > 0) { unpack8(nlv, lv); unpack8(nvf, vfi); }
            if (i + 1 < 8) RW_LOAD(t + 1);
            float r[8], kp[8], v[8], av[8], bv[8], dw[8]; float ssq = 0.f, bs = 0.f;
#pragma unroll
            for (int e = 0; e < 8; ++e) { r[e] = zr_[e] + (pr[e] - zr_[e]) * mur[e]; const float k = zk_[e] + (pk[e] - zk_[e]) * muk[e]; v[e] = zv_[e] + (pv[e] - zv_[e]) * muv[e];
                pr[e] = zr_[e]; pk[e] = zk_[e]; pv[e] = zv_[e];
                const float logw = -softplusf_(-(w0[e] + lw[e])) - 0.5f; dw[e] = -__expf(logw);
                const float iclr = sigmoidf_(a0[e] + la[e]);
                if (l > 0) v[e] = v[e] + (vfi[e] - v[e]) * sigmoidf_(vb[e] + lv[e]);
                const float kkr = k * kkc[e]; ssq += kkr * kkr; av[e] = kkr; bv[e] = iclr;
                kp[e] = k * (1.f + (iclr - 1.f) * kac[e]); bs += r[e] * kp[e] * rkc[e]; }
            ssq = sum8lanes(ssq); bs = sum8lanes(bs); const float rn = rsqrtf(ssq + 1e-12f);
#pragma unroll
            for (int e = 0; e < 8; ++e) { const float kk = av[e] * rn; av[e] = -kk; bv[e] = kk * bv[e]; }
            if (l == 0) st8(vf + t * HW + c0, v);
            st8(RR + t * HW + c0, r); st8(RK + t * HW + c0, kp); st8(RV + t * HW + c0, v); st8(RA + t * HW + c0, av); st8(RB + t * HW + c0, bv); st8(RG + t * HW + c0, lg);
            *(f32x4*)(RW + t * HW + c0) = (f32x4){dw[0], dw[1], dw[2], dw[3]}; *(f32x4*)(RW + t * HW + c0 + 4) = (f32x4){dw[4], dw[5], dw[6], dw[7]};
            if ((lane & 7) == 0) bscA[t * 8 + h] = bs; }
#undef RW_LOAD
    }
}

__device__ __forceinline__ void phase_gdn_prep(const PArgs& a, int l) {
    const int bidx_ = obid();
    const int tid = otid(), lane = tid & 63, wave = __builtin_amdgcn_readfirstlane(tid >> 6), G = ogrid(), c0 = lane * 8, h = lane >> 3;
    const bf16* zq = (const bf16*)(a.ws + S_ZQ); const bf16* zm = (const bf16*)(a.ws + S_ZM);
    float* GAL = (float*)(a.ws + S_GAL); float* GBE = (float*)(a.ws + S_GBE);
    const float* cw = INF(26) + l * 4 * NZQ;
    for (int u = bidx_ * NWV + wave; u < 3 * (T / 8); u += G * NWV) { const int which = u / (T / 8), t0 = (u % (T / 8)) * 8;
        const int cc = which * 512 + c0; bf16* O = (bf16*)(a.ws + (which == 0 ? S_GQ : which == 1 ? S_GK : S_GV));
        float w[4][8];
#pragma unroll
        for (int j = 0; j < 4; ++j) ldf8(cw + j * NZQ + cc, w[j]);
        float x0[8], x1[8], x2[8];
        if (t0 % SEQ == 0) {
#pragma unroll
            for (int e = 0; e < 8; ++e) { x0[e] = 0.f; x1[e] = 0.f; x2[e] = 0.f; } }
        else { ld8(zq + (size_t)(t0 - 3) * NZQ + cc, x0); ld8(zq + (size_t)(t0 - 2) * NZQ + cc, x1); ld8(zq + (size_t)(t0 - 1) * NZQ + cc, x2); }
        float alog = 0.f, dtb = 0.f; if (which == 0 && lane < 8) { alog = INF(27)[l * 8 + lane]; dtb = INF(28)[l * 8 + lane]; }
        u32x4 nx3 = *(const u32x4*)(zq + (size_t)t0 * NZQ + cc); float nbl = 0.f, nal = 0.f; if (which == 0 && lane < 8) { nbl = bf2f(zm[(size_t)t0 * NZM + 416 + lane]); nal = bf2f(zm[(size_t)t0 * NZM + 424 + lane]); }
        for (int i = 0; i < 8; ++i) { const size_t t = t0 + i; float x3[8], y[8]; unpack8(nx3, x3); const float bl = nbl, al = nal;
            if (i + 1 < 8) { nx3 = *(const u32x4*)(zq + (t + 1) * NZQ + cc); if (which == 0 && lane < 8) { nbl = bf2f(zm[(t + 1) * NZM + 416 + lane]); nal = bf2f(zm[(t + 1) * NZM + 424 + lane]); } }
            float ss = 0.f;
#pragma unroll
            for (int e = 0; e < 8; ++e) { const float c = w[0][e] * x0[e] + w[1][e] * x1[e] + w[2][e] * x2[e] + w[3][e] * x3[e]; y[e] = siluf_(c); ss += y[e] * y[e]; x0[e] = x1[e]; x1[e] = x2[e]; x2[e] = x3[e]; }
            if (which < 2) { ss = sum8lanes(ss); const float rn = rsqrtf(ss + 1e-12f) * (which == 0 ? 0.125f : 1.f);
#pragma unroll
                for (int e = 0; e < 8; ++e) y[e] *= rn; }
            st8(O + t * HW + c0, y);
            if (which == 0 && lane < 8) { GBE[t * 8 + lane] = sigmoidf_(bl); GAL[t * 8 + lane] = -__expf(alog) * softplusf_(al + dtb); } }
    }
}

__device__ __forceinline__ void phase_finish(const PArgs& a, int l) {
    const int bidx_ = obid();
    const int tid = otid(), lane = tid & 63, h = tid >> 6, G = ogrid(), c = tid;
    const bf16* YA = (const bf16*)(a.ws + S_YA); const bf16* YC = (const bf16*)(a.ws + S_YC); const bf16* RR = (const bf16*)(a.ws + S_RR); const bf16* RK = (const bf16*)(a.ws + S_RK); const bf16* RV = (const bf16*)(a.ws + S_RV); const bf16* RG = (const bf16*)(a.ws + S_RG);
    const bf16* zg = (const bf16*)(a.ws + S_ZG); bf16* OA = (bf16*)(a.ws + S_OA); bf16* OC = (bf16*)(a.ws + S_OC);
    const float rkc = INF(13)[l * 512 + c], lng = INF(14)[l * 512 + c], lnb = INF(15)[l * 512 + c], gng = INF(29)[l * 64 + lane];
    constexpr int TT = 4;
    for (int g = bidx_; g < T / TT; g += G) { const int t0 = g * TT; float ya[TT], yc[TT], r[TT], k[TT], v[TT], gt[TT], gg[TT];
#pragma unroll
        for (int i = 0; i < TT; ++i) { const size_t o = (size_t)(t0 + i) * HW + c; ya[i] = bf2f(YA[o]); yc[i] = bf2f(YC[o]); r[i] = bf2f(RR[o]); k[i] = bf2f(RK[o]); v[i] = bf2f(RV[o]); gt[i] = bf2f(RG[o]); gg[i] = bf2f(zg[o]); }
#pragma unroll
        for (int i = 0; i < TT; ++i) { const size_t o = (size_t)(t0 + i) * HW + c;
            const float mean = wave_sum(ya[i]) * (1.f / 64.f); const float d = ya[i] - mean; const float var = wave_sum(d * d) * (1.f / 64.f);
            const float bon = wave_sum(r[i] * k[i] * rkc) * v[i];
            const float y = d * rsqrtf(var + 64e-5f) * lng + lnb + bon;
            OA[o] = (bf16)f2bf(y * gt[i]);
            const float ms = wave_sum(yc[i] * yc[i]) * (1.f / 64.f);
            OC[o] = (bf16)f2bf(yc[i] * rsqrtf(ms + NORM_EPS) * gng * siluf_(gg[i])); }
    }
}
constexpr int AT_KP = 208, AT_VP = 136, AT_KB = 64 * AT_KP, AT_VB = 64 * AT_VP;
constexpr int AT_K0 = 0, AT_V0 = 2 * AT_KB;
template <int AV> __device__ __forceinline__ void attn_unit(const bf16* Q, const bf16* K, const bf16* Vt, bf16* OB, LAS unsigned char* lds, int b, int h, int qb) {
    const int tid = otid(), lane = tid & 63, wave = __builtin_amdgcn_readfirstlane(tid >> 6), ql = lane & 31, hh = lane >> 5;
    const int qrow0 = qb * 256 + wave * 32;
    const size_t bh = (size_t)(b * NH + h);
    bf16x8 qf[6];
    { const bf16* qp = Q + (bh * SEQ + qrow0 + ql) * QKD + 8 * hh;
#pragma unroll
      for (int s = 0; s < 6; ++s) qf[s] = *(const bf16x8*)(qp + 16 * s); }
    f32x16 o0, o1;
#pragma unroll
    for (int r = 0; r < 16; ++r) { o0[r] = 0.f; o1[r] = 0.f; }
    float mrun = -1e30f, lsum = 0.f;
    const int nkt = 4 * qb + 4;
    const unsigned char* Kb = (const unsigned char*)(K + bh * SEQ * QKD);
    const unsigned char* Vb = (const unsigned char*)(Vt + bh * 64 * SEQ);
    const int kr0 = tid / 12, kc0 = tid % 12, id1 = tid + 512, kr1 = id1 / 12, kc1 = id1 % 12; const bool k1v = id1 < 768;
    const int vr = tid >> 3, vc = tid & 7;
    u32x4 rk0, rk1, rv;
#define AT_LOADK(kt) do { const size_t key0 = (size_t)(kt) * 64; rk0 = *(const u32x4*)(Kb + (key0 + kr0) * (QKD * 2) + kc0 * 16); if (k1v) rk1 = *(const u32x4*)(Kb + (key0 + kr1) * (QKD * 2) + kc1 * 16); } while (0)
#define AT_LOADV(kt) do { rv = *(const u32x4*)(Vb + ((size_t)vr * SEQ + (size_t)(kt) * 64) * 2 + vc * 16); } while (0)
#define AT_STOREK(buf) do { LAS unsigned char* bp = lds + AT_K0 + (buf) * AT_KB; *(LAS u32x4*)(bp + kr0 * AT_KP + kc0 * 16) = rk0; if (k1v) *(LAS u32x4*)(bp + kr1 * AT_KP + kc1 * 16) = rk1; } while (0)
#define AT_STOREV(buf) do { LAS u32x2* vp = (LAS u32x2*)(lds + AT_V0 + (buf) * AT_VB + vr * AT_VP + vc * 16); vp[0] = (u32x2){rv.x, rv.y}; vp[1] = (u32x2){rv.z, rv.w}; } while (0)
#define AT_KFR(buf) do { const LAS unsigned char* kb = lds + AT_K0 + (buf) * AT_KB; \
        _Pragma("unroll") for (int s = 0; s < 6; ++s) { kfr[2 * s] = *(const LAS bf16x8*)(kb + ql * AT_KP + (16 * s + 8 * hh) * 2); kfr[2 * s + 1] = *(const LAS bf16x8*)(kb + (32 + ql) * AT_KP + (16 * s + 8 * hh) * 2); } } while (0)
#define AT_QK(dst0, dst1) do { \
        _Pragma("unroll") for (int r = 0; r < 16; ++r) { dst0[r] = 0.f; dst1[r] = 0.f; } \
        _Pragma("unroll") for (int s = 0; s < 6; ++s) { dst0 = __builtin_amdgcn_mfma_f32_32x32x16_bf16(kfr[2 * s], qf[s], dst0, 0, 0, 0); dst1 = __builtin_amdgcn_mfma_f32_32x32x16_bf16(kfr[2 * s + 1], qf[s], dst1, 0, 0, 0); } } while (0)
    bf16x8 kfr[12]; union VF { u32x4 u; bf16x8 v; } vfa[4], vfb[4];
    AT_LOADK(0); AT_LOADV(0); AT_STOREK(0); AT_STOREV(0); AT_LOADK(1); AT_STOREK(1);
    __syncthreads();
    f32x16 s0, s1;
    AT_KFR(0); AT_QK(s0, s1);
    for (int kt = 0; kt < nkt; ++kt) {
        const bool nx = kt + 1 < nkt;
        if (AV != 2) { if (kt + 2 < nkt) AT_LOADK(kt + 2);
        if (nx) AT_LOADV(kt + 1); }
        { const LAS unsigned char* vb = lds + AT_V0 + (kt & 1) * AT_VB;
#pragma unroll
          for (int q = 0; q < 4; ++q) { const int kofs = ((q >> 1) * 32 + 16 * (q & 1) + 4 * hh) * 2;
              { const u32x2 lo = *(const LAS u32x2*)(vb + ql * AT_VP + kofs), hi = *(const LAS u32x2*)(vb + ql * AT_VP + kofs + 16); vfa[q].u = (u32x4){lo.x, lo.y, hi.x, hi.y}; }
              { const u32x2 lo = *(const LAS u32x2*)(vb + (32 + ql) * AT_VP + kofs), hi = *(const LAS u32x2*)(vb + (32 + ql) * AT_VP + kofs + 16); vfb[q].u = (u32x4){lo.x, lo.y, hi.x, hi.y}; } } }
        f32x16 n0, n1;
        if (nx && wave < 4) { AT_KFR((kt + 1) & 1); AT_QK(n0, n1); }
        if (64 * kt + 63 > qrow0) { const int qi = qrow0 + ql, kbase = 64 * kt + 4 * hh;
#pragma unroll
            for (int r = 0; r < 16; ++r) { const int key = kbase + (r & 3) + 8 * (r >> 2); if (key > qi) s0[r] = -1e30f; if (key + 32 > qi) s1[r] = -1e30f; } }
        float mx = s0[0];
#pragma unroll
        for (int r = 1; r < 16; ++r) mx = fmaxf(mx, s0[r]);
#pragma unroll
        for (int r = 0; r < 16; ++r) mx = fmaxf(mx, s1[r]);
        mx = fmaxf(mx, __shfl_xor(mx, 32));
        const float mnew = fmaxf(mrun, mx), alpha = __builtin_amdgcn_exp2f(mrun - mnew); mrun = mnew;
        float ps = 0.f;
#pragma unroll
        for (int r = 0; r < 16; ++r) { if (AV == 1) { s0[r] = (s0[r] - mnew) * 1e-3f; s1[r] = (s1[r] - mnew) * 1e-3f; } else { s0[r] = __builtin_amdgcn_exp2f(s0[r] - mnew); s1[r] = __builtin_amdgcn_exp2f(s1[r] - mnew); } ps += s0[r] + s1[r]; }
        lsum = lsum * alpha + ps;
#pragma unroll
        for (int r = 0; r < 16; ++r) { o0[r] *= alpha; o1[r] *= alpha; }
#pragma unroll
        for (int q = 0; q < 4; ++q) { union { u32x4 u; bf16x8 v; } pf; const int s2 = q & 1;
            if (q < 2) { pf.u.x = pg8::cvt_pk_bf16(s0[8 * s2 + 0], s0[8 * s2 + 1]); pf.u.y = pg8::cvt_pk_bf16(s0[8 * s2 + 2], s0[8 * s2 + 3]); pf.u.z = pg8::cvt_pk_bf16(s0[8 * s2 + 4], s0[8 * s2 + 5]); pf.u.w = pg8::cvt_pk_bf16(s0[8 * s2 + 6], s0[8 * s2 + 7]); }
            else { pf.u.x = pg8::cvt_pk_bf16(s1[8 * s2 + 0], s1[8 * s2 + 1]); pf.u.y = pg8::cvt_pk_bf16(s1[8 * s2 + 2], s1[8 * s2 + 3]); pf.u.z = pg8::cvt_pk_bf16(s1[8 * s2 + 4], s1[8 * s2 + 5]); pf.u.w = pg8::cvt_pk_bf16(s1[8 * s2 + 6], s1[8 * s2 + 7]); }
            if (AV == 3) { o0[q] += bf2f(pf.u.x & 0xffffu) + bf2f(vfa[q].u.x); o1[q] += bf2f(pf.u.y >> 16) + bf2f(vfb[q].u.y); } else {
            o0 = __builtin_amdgcn_mfma_f32_32x32x16_bf16(vfa[q].v, pf.v, o0, 0, 0, 0); o1 = __builtin_amdgcn_mfma_f32_32x32x16_bf16(vfb[q].v, pf.v, o1, 0, 0, 0); } }
        if (nx && wave >= 4) { AT_KFR((kt + 1) & 1); AT_QK(n0, n1); }
        if (AV != 2) { if (kt + 2 < nkt) AT_STOREK(kt & 1);
        if (nx) AT_STOREV((kt + 1) & 1); }
        __syncthreads();
        if (nx) { s0 = n0; s1 = n1; }
    }
#undef AT_LOADK
#undef AT_LOADV
#undef AT_STOREK
#undef AT_STOREV
#undef AT_QK
#undef AT_KFR
    const float ltot = lsum + __shfl_xor(lsum, 32), inv = 1.f / ltot;
    bf16* op = OB + ((size_t)b * SEQ + qrow0 + ql) * HW + h * 64 + 4 * hh;
#pragma unroll
    for (int g = 0; g < 4; ++g) { u32x2 w0, w1; w0.x = pg8::cvt_pk_bf16(o0[4 * g] * inv, o0[4 * g + 1] * inv); w0.y = pg8::cvt_pk_bf16(o0[4 * g + 2] * inv, o0[4 * g + 3] * inv);
        w1.x = pg8::cvt_pk_bf16(o1[4 * g] * inv, o1[4 * g + 1] * inv); w1.y = pg8::cvt_pk_bf16(o1[4 * g + 2] * inv, o1[4 * g + 3] * inv);
        *(u32x2*)(op + 8 * g) = w0; *(u32x2*)(op + 32 + 8 * g) = w1; }
}
template <int AV> __device__ __forceinline__ void phase_attn(const PArgs& a, LAS unsigned char* lds) {
    const int bidx_ = obid();
    const bf16* Q = (const bf16*)(a.ws + S_Q); const bf16* K = (const bf16*)(a.ws + S_K); const bf16* Vt = (const bf16*)(a.ws + S_VT); bf16* OB = (bf16*)(a.ws + (AV == 0 ? S_OB : S_RG));
    for (int pi0 = bidx_; pi0 < NB * NH * 8; pi0 += ogrid()) { const int xg = pi0 & 7, ix = pi0 >> 3; const int pi = (ogrid() % 8 == 0 && pi0 < 256) ? ((xg * 4 + (ix >> 3)) * 8 + (ix & 7)) : pi0; const int bh = pi >> 3, j = pi & 7;
        attn_unit<AV>(Q, K, Vt, OB, lds, bh >> 3, bh & 7, 15 - j);
        attn_unit<AV>(Q, K, Vt, OB, lds, bh >> 3, bh & 7, j); }
}

constexpr int SC_STEPS = 16, SC_ROW = 5 * 64 + 16, SC_BUF = SC_STEPS * SC_ROW * 4;
__device__ __forceinline__ void scan_task(const PArgs& a, int task, LAS unsigned char* wlds) {
    const int lane = otid() & 63, i = lane >> 2, jq = lane & 3;
    const bool gdn = task >= 128; const int tt = gdn ? task - 128 : task; const int b = tt >> 5, h = (tt >> 2) & 7, rg = tt & 3;
    const bf16 *PR, *PK, *PV, *PA, *PB; const float* PW; const float *PAL, *PBE; bf16* Y;
    if (!gdn) { PR = (const bf16*)(a.ws + S_RR); PK = (const bf16*)(a.ws + S_RK); PV = (const bf16*)(a.ws + S_RV); PA = (const bf16*)(a.ws + S_RA); PB = (const bf16*)(a.ws + S_RB); PW = (const float*)(a.ws + S_RW); PAL = nullptr; PBE = nullptr; Y = (bf16*)(a.ws + S_YA); }
    else { PR = (const bf16*)(a.ws + S_GQ); PK = (const bf16*)(a.ws + S_GK); PV = (const bf16*)(a.ws + S_GV); PA = nullptr; PB = nullptr; PW = nullptr; PAL = (const float*)(a.ws + S_GAL); PBE = (const float*)(a.ws + S_GBE); Y = (bf16*)(a.ws + S_YC); }
    const size_t row0 = (size_t)b * SEQ; const int col0 = h * 64;
    const int bs = lane >> 3, be = 8 * (lane & 7);
    u32x4 gr[2], gk[2], ga[2], gb[2], gv; f32x4 gw[4]; float gal[2], gbe[2];
#define SC_LOAD(c) do { const size_t t0_ = row0 + (size_t)(c) * SC_STEPS; \
        _Pragma("unroll") for (int q = 0; q < 2; ++q) { const size_t o_ = (t0_ + bs + 8 * q) * HW + col0 + be; gr[q] = *(const u32x4*)(PR + o_); gk[q] = *(const u32x4*)(PK + o_); \
            if (!gdn) { ga[q] = *(const u32x4*)(PA + o_); gb[q] = *(const u32x4*)(PB + o_); } else { gal[q] = PAL[(t0_ + bs + 8 * q) * 8 + h]; gbe[q] = PBE[(t0_ + bs + 8 * q) * 8 + h]; } } \
        if (!gdn) { _Pragma("unroll") for (int q = 0; q < 4; ++q) gw[q] = *(const f32x4*)(PW + (t0_ + (lane >> 4) + 4 * q) * HW + col0 + 4 * (lane & 15)); } \
        if (lane < 32) gv = *(const u32x4*)(PV + (t0_ + (lane >> 1)) * HW + col0 + rg * 16 + (lane & 1) * 8); } while (0)
#define SC_STORE(buf) do { LAS float* B_ = (LAS float*)(wlds + (buf) * SC_BUF); \
        _Pragma("unroll") for (int q = 0; q < 2; ++q) { LAS float* R_ = B_ + (bs + 8 * q) * SC_ROW; float fr_[8], fk_[8]; unpack8(gr[q], fr_); unpack8(gk[q], fk_); \
            if (!gdn) { float fa_[8], fb_[8]; unpack8(ga[q], fa_); unpack8(gb[q], fb_); \
                *(LAS f32x4*)(R_ + 0 + be) = (f32x4){fa_[0], fa_[1], fa_[2], fa_[3]}; *(LAS f32x4*)(R_ + 0 + be + 4) = (f32x4){fa_[4], fa_[5], fa_[6], fa_[7]}; \
                *(LAS f32x4*)(R_ + 128 + be) = (f32x4){fb_[0], fb_[1], fb_[2], fb_[3]}; *(LAS f32x4*)(R_ + 128 + be + 4) = (f32x4){fb_[4], fb_[5], fb_[6], fb_[7]}; \
                *(LAS f32x4*)(R_ + 192 + be) = (f32x4){fk_[0], fk_[1], fk_[2], fk_[3]}; *(LAS f32x4*)(R_ + 192 + be + 4) = (f32x4){fk_[4], fk_[5], fk_[6], fk_[7]}; } \
            else { const float al_ = gal[q], be_ = gbe[q], nab_ = -al_ * be_; \
                *(LAS f32x4*)(R_ + 0 + be) = (f32x4){fk_[0], fk_[1], fk_[2], fk_[3]}; *(LAS f32x4*)(R_ + 0 + be + 4) = (f32x4){fk_[4], fk_[5], fk_[6], fk_[7]}; \
                *(LAS f32x4*)(R_ + 64 + be) = (f32x4){al_, al_, al_, al_}; *(LAS f32x4*)(R_ + 64 + be + 4) = (f32x4){al_, al_, al_, al_}; \
                *(LAS f32x4*)(R_ + 128 + be) = (f32x4){fk_[0] * nab_, fk_[1] * nab_, fk_[2] * nab_, fk_[3] * nab_}; *(LAS f32x4*)(R_ + 128 + be + 4) = (f32x4){fk_[4] * nab_, fk_[5] * nab_, fk_[6] * nab_, fk_[7] * nab_}; \
                *(LAS f32x4*)(R_ + 192 + be) = (f32x4){fk_[0] * be_, fk_[1] * be_, fk_[2] * be_, fk_[3] * be_}; *(LAS f32x4*)(R_ + 192 + be + 4) = (f32x4){fk_[4] * be_, fk_[5] * be_, fk_[6] * be_, fk_[7] * be_}; } \
            *(LAS f32x4*)(R_ + 256 + be) = (f32x4){fr_[0], fr_[1], fr_[2], fr_[3]}; *(LAS f32x4*)(R_ + 256 + be + 4) = (f32x4){fr_[4], fr_[5], fr_[6], fr_[7]}; } \
        if (!gdn) { _Pragma("unroll") for (int q = 0; q < 4; ++q) *(LAS f32x4*)(B_ + ((lane >> 4) + 4 * q) * SC_ROW + 64 + 4 * (lane & 15)) = gw[q]; } \
        if (lane < 32) { float fv_[8]; unpack8(gv, fv_); LAS float* V_ = B_ + (lane >> 1) * SC_ROW + 320 + (lane & 1) * 8; *(LAS f32x4*)(V_) = (f32x4){fv_[0], fv_[1], fv_[2], fv_[3]}; *(LAS f32x4*)(V_ + 4) = (f32x4){fv_[4], fv_[5], fv_[6], fv_[7]}; } } while (0)
    float st[16];
#pragma unroll
    for (int q = 0; q < 16; ++q) st[q] = 0.f;
    SC_LOAD(0); SC_STORE(0);
    constexpr int NCH = SEQ / SC_STEPS;
    for (int c = 0; c < NCH; ++c) {
        if (c + 1 < NCH) SC_LOAD(c + 1);
        const LAS float* B_ = (const LAS float*)(wlds + (c & 1) * SC_BUF);
        for (int s = 0; s < SC_STEPS; ++s) { const LAS float* R_ = B_ + s * SC_ROW + 16 * jq;
            float va[16], vw[16], vb[16], vk[16], vr[16];
#pragma unroll
            for (int q = 0; q < 4; ++q) { const f32x4 x0 = *(const LAS f32x4*)(R_ + 4 * q), x1 = *(const LAS f32x4*)(R_ + 64 + 4 * q), x2 = *(const LAS f32x4*)(R_ + 128 + 4 * q), x3 = *(const LAS f32x4*)(R_ + 192 + 4 * q), x4 = *(const LAS f32x4*)(R_ + 256 + 4 * q);
#pragma unroll
                for (int e = 0; e < 4; ++e) { va[4 * q + e] = x0[e]; vw[4 * q + e] = x1[e]; vb[4 * q + e] = x2[e]; vk[4 * q + e] = x3[e]; vr[4 * q + e] = x4[e]; } }
            const float vi = B_[s * SC_ROW + 320 + i];
            float sa = 0.f;
#pragma unroll
            for (int q = 0; q < 16; ++q) sa += st[q] * va[q];
            sa += __shfl_xor(sa, 1); sa += __shfl_xor(sa, 2);
            float y = 0.f;
#pragma unroll
            for (int q = 0; q < 16; ++q) { st[q] = st[q] * vw[q] + sa * vb[q] + vi * vk[q]; y += st[q] * vr[q]; }
            y += __shfl_xor(y, 1); y += __shfl_xor(y, 2);
            if (jq == 0) Y[(row0 + (size_t)c * SC_STEPS + s) * HW + col0 + rg * 16 + i] = (bf16)f2bf(y);
        }
        if (c + 1 < NCH) SC_STORE((c + 1) & 1);
    }
#undef SC_LOAD
#undef SC_STORE
}
__device__ __forceinline__ void phase_scan(const PArgs& a, LAS unsigned char* lds) {
    const int bidx_ = obid();
    const int wave = __builtin_amdgcn_readfirstlane(otid() >> 6), G = ogrid();
    if (wave < 3) for (int task = bidx_ + wave * G; task < 256; task += 3 * G) scan_task(a, task, lds + wave * (2 * SC_BUF));
}
constexpr int CK_TP = 144;
constexpr int CK_AT = 0, CK_BT = 9216, CK_KT = 18432, CK_RT = 27648, CK_BW = 36864, CK_KW = 46080, CK_V = 55296, CK_N = 64512, CK_LAK = 73728, CK_LRB = 82944, CK_LRK = 92160,
              CK_AW = 101376, CK_W1 = 110592, CK_AH = 119808, CK_LVT = 129024, CK_DD = 138240;
constexpr int CK_CUM = 147456, CK_CUMP = 147712, CK_PC = 147968, CK_WTOT = 148224;
constexpr int CM_ITEM = 32768;
typedef short s16x4 __attribute__((ext_vector_type(4)));
__device__ __forceinline__ bf16x8 ck_frag(const LAS unsigned char* tile, int row, int ks, int hh) { return *(const LAS bf16x8*)(tile + row * CK_TP + (16 * ks + 8 * hh) * 2); }
__device__ __forceinline__ int crow_(int r, int hh) { return (r & 3) + 8 * (r >> 2) + 4 * hh; }
struct CkIn { u32x4 r, k, v, a, b; f32x4 w0, w1; float g, be; };
__device__ __forceinline__ void ck_load(const PArgs& a, int item, int t, int j0, CkIn& o) {
    const bool gdn = item >= 2048; const int it = item & 2047, bh = it >> 6, ch = it & 63, b = bh >> 3, h = bh & 7;
    const size_t row = (size_t)b * SEQ + ch * 64 + t; const size_t eo = row * HW + h * 64 + j0;
    const bf16* pr = (const bf16*)(a.ws + (gdn ? S_GQ : S_RR)); const bf16* pk = (const bf16*)(a.ws + (gdn ? S_GK : S_RK)); const bf16* pv = (const bf16*)(a.ws + (gdn ? S_GV : S_RV));
    const bf16* pa = (const bf16*)(a.ws + (gdn ? S_GK : S_RA)); const bf16* pb = (const bf16*)(a.ws + (gdn ? S_GK : S_RB));
    o.r = *(const u32x4*)(pr + eo); o.k = *(const u32x4*)(pk + eo); o.v = *(const u32x4*)(pv + eo); o.a = *(const u32x4*)(pa + eo); o.b = *(const u32x4*)(pb + eo);
    o.w0 = *(const f32x4*)((const float*)(a.ws + S_RW) + eo); o.w1 = *(const f32x4*)((const float*)(a.ws + S_RW) + eo + 4);
    o.g = ((const float*)(a.ws + S_GAL))[row * 8 + h]; o.be = ((const float*)(a.ws + S_GBE))[row * 8 + h];
}
__device__ __forceinline__ void phase_cprep(const PArgs& a, LAS unsigned char* lds) {
    const int bidx_ = obid();
    const int tid = otid(), lane = tid & 63, wave = __builtin_amdgcn_readfirstlane(tid >> 6), G = ogrid(), ql = lane & 31, hh = lane >> 5;
    const int t = lane, j0 = wave * 8;
    LAS float* cumA = (LAS float*)(lds + CK_CUM); LAS float* cumpA = (LAS float*)(lds + CK_CUMP); LAS float* pcA = (LAS float*)(lds + CK_PC);
    CkIn in; if (bidx_ < 4096) ck_load(a, bidx_, t, j0, in);
#if PROBE_SUB >= 10
    volatile LAS unsigned* tmisc = (volatile LAS unsigned*)(lds + (163840 - 1024)) + 40; unsigned long long tprev = __builtin_amdgcn_s_memrealtime();
#define CKSTAMP(k) do { if (PROBE_SUB - 10 == (k)) { const unsigned long long tn_ = __builtin_amdgcn_s_memrealtime(); if (tid == 0) tmisc[0] += (unsigned)(tn_ - tprev); } tprev = __builtin_amdgcn_s_memrealtime(); } while (0)
#else
#define CKSTAMP(k) do { } while (0)
#endif
    for (int item = bidx_; item < 4096; item += G) {
        CKSTAMP(6);
        const bool gdn = item >= 2048; const int it = item & 2047;
        float fr[8], fk[8], fv[8], fa[8], fb[8], lw[8];
        unpack8(in.v, fv);
        if (!gdn) { unpack8(in.r, fr); unpack8(in.k, fk); unpack8(in.a, fa); unpack8(in.b, fb);
#pragma unroll
            for (int e = 0; e < 4; ++e) { lw[e] = in.w0[e]; lw[4 + e] = in.w1[e]; } }
        else { float fkk[8]; unpack8(in.r, fr); unpack8(in.k, fkk); const float g = in.g, be = in.be, al = __expf(g);
#pragma unroll
            for (int e = 0; e < 8; ++e) { fa[e] = fkk[e]; fb[e] = -al * be * fkk[e]; fk[e] = be * fkk[e]; lw[e] = g; } }
        if (item + G < 4096) ck_load(a, item + G, t, j0, in);
        float cum[8], pc[8];
#pragma unroll
        for (int e = 0; e < 8; ++e) { float x = lw[e];
#pragma unroll
            for (int d = 1; d < 64; d <<= 1) { const float y = __shfl_up(x, d); if (lane >= d) x += y; }
            cum[e] = x; pc[e] = __shfl(x, 63); }
        if (wave == 0) { cumA[t] = gdn ? cum[0] : 0.f; cumpA[t] = gdn ? cum[0] - lw[0] : 0.f; }
        if (lane == 0) {
#pragma unroll
            for (int e = 0; e < 8; ++e) pcA[j0 + e] = pc[e]; }
        { float xa[8], xr[8], xb[8], xk[8], yb[8], yk[8], ya[8];
#pragma unroll
          for (int e = 0; e < 8; ++e) { const float ecp_true = __expf(cum[e] - lw[e]); const float ec = gdn ? 1.f : __expf(cum[e]), ecp = gdn ? 1.f : ecp_true, eci = gdn ? 1.f : __expf(-cum[e]), et = __expf(pc[e] - cum[e]);
              xa[e] = fa[e] * ecp; xr[e] = fr[e] * ec; xb[e] = fb[e] * eci; xk[e] = fk[e] * eci; yb[e] = fb[e] * et; yk[e] = fk[e] * et; ya[e] = fa[e] * ecp_true; }
          const int ro = t * CK_TP + j0 * 2;
          *(LAS u32x4*)(lds + CK_AT + ro) = (u32x4){pk2(xa[0], xa[1]), pk2(xa[2], xa[3]), pk2(xa[4], xa[5]), pk2(xa[6], xa[7])};
          *(LAS u32x4*)(lds + CK_RT + ro) = (u32x4){pk2(xr[0], xr[1]), pk2(xr[2], xr[3]), pk2(xr[4], xr[5]), pk2(xr[6], xr[7])};
          *(LAS u32x4*)(lds + CK_BT + ro) = (u32x4){pk2(xb[0], xb[1]), pk2(xb[2], xb[3]), pk2(xb[4], xb[5]), pk2(xb[6], xb[7])};
          *(LAS u32x4*)(lds + CK_KT + ro) = (u32x4){pk2(xk[0], xk[1]), pk2(xk[2], xk[3]), pk2(xk[4], xk[5]), pk2(xk[6], xk[7])};
#pragma unroll
          for (int e = 0; e < 8; ++e) { const int to = (j0 + e) * CK_TP + t * 2; *(LAS unsigned short*)(lds + CK_BW + to) = (unsigned short)f2bf(yb[e]); *(LAS unsigned short*)(lds + CK_KW + to) = (unsigned short)f2bf(yk[e]);
              *(LAS unsigned short*)(lds + CK_V + to) = (unsigned short)f2bf(fv[e]); *(LAS unsigned short*)(lds + CK_AH + to) = (unsigned short)f2bf(ya[e]); } }
        __syncthreads();
        CKSTAMP(0);
#ifndef PROBE_CK
#define PROBE_CK 1
#endif
        for (int rep_ = 0; rep_ < PROBE_CK; ++rep_) {
        { const int p = wave >> 1, hf = wave & 1; const LAS unsigned char* At = lds + (p < 2 ? CK_AT : CK_RT); const LAS unsigned char* Bt = lds + ((p & 1) ? CK_KT : CK_BT);
          const LAS float* dA = (p < 2) ? cumpA : cumA; LAS unsigned char* Ot = lds + (p == 0 ? CK_N : p == 1 ? CK_LAK : p == 2 ? CK_LRB : CK_LRK); const int incl = (p >= 2) ? 1 : 0;
#pragma unroll
          for (int sq = 0; sq < 2; ++sq) { f32x16 acc;
#pragma unroll
              for (int r = 0; r < 16; ++r) acc[r] = 0.f;
              if (!(sq == 1 && hf == 0)) {
#pragma unroll
                  for (int ks = 0; ks < 4; ++ks) acc = __builtin_amdgcn_mfma_f32_32x32x16_bf16(ck_frag(At, 32 * hf + ql, ks, hh), ck_frag(Bt, 32 * sq + ql, ks, hh), acc, 0, 0, 0); }
              const int s = 32 * sq + ql; const float dBs = cumA[s];
#pragma unroll
              for (int r = 0; r < 16; ++r) { const int tt = 32 * hf + crow_(r, hh); const bool keep = s < tt + incl; const float val = keep ? acc[r] * __expf(dA[tt] - dBs) : 0.f;
                  *(LAS unsigned short*)(Ot + tt * CK_TP + s * 2) = (unsigned short)f2bf(val); } } }
        __syncthreads();
        CKSTAMP(1);
        if (wave >= 1 && wave <= 4) { const int w4 = wave - 1, tq = w4 >> 1, iq = w4 & 1; f32x16 acc;
#pragma unroll
            for (int r = 0; r < 16; ++r) acc[r] = 0.f;
#pragma unroll
            for (int ks = 0; ks < 4; ++ks) acc = __builtin_amdgcn_mfma_f32_32x32x16_bf16(ck_frag(lds + CK_LAK, 32 * tq + ql, ks, hh), ck_frag(lds + CK_V, 32 * iq + ql, ks, hh), acc, 0, 0, 0);
#pragma unroll
            for (int g4 = 0; g4 < 4; ++g4) *(LAS u32x2*)(lds + CK_LVT + (32 * iq + ql) * CK_TP + (32 * tq + 8 * g4 + 4 * hh) * 2) = (u32x2){pk2(acc[4 * g4], acc[4 * g4 + 1]), pk2(acc[4 * g4 + 2], acc[4 * g4 + 3])}; }
        else if (wave == 0) { const int I = lane >> 4, c = lane & 15; float d[16];
#pragma unroll
            for (int r = 0; r < 16; ++r) { float nr[16]; { float lo8[8], hi8[8]; unpack8(*(const LAS u32x4*)(lds + CK_N + (16 * I + r) * CK_TP + (16 * I) * 2), lo8); unpack8(*(const LAS u32x4*)(lds + CK_N + (16 * I + r) * CK_TP + (16 * I + 8) * 2), hi8);
#pragma unroll
                    for (int e = 0; e < 8; ++e) { nr[e] = lo8[e]; nr[8 + e] = hi8[e]; } }
                float v = (r == c) ? 1.f : 0.f;
#pragma unroll
                for (int s2 = 0; s2 < r; ++s2) v += nr[s2] * d[s2];
                d[r] = v; *(LAS unsigned short*)(lds + CK_DD + (16 * I + r) * CK_TP + (16 * I + c) * 2) = (unsigned short)f2bf(v); } }
        __syncthreads();
        CKSTAMP(2);
        { const int col = lane & 15, g = lane >> 4; const int rb = (wave < 4) ? (16 * wave + col) : (16 * (wave - 4) + col);
          const LAS unsigned char* RTt = lds + (wave < 4 ? CK_AH : CK_LVT) + rb * CK_TP; LAS unsigned char* XTt = lds + (wave < 4 ? CK_AW : CK_W1) + rb * CK_TP;
          s16x4 xb[4];
#pragma unroll
          for (int I = 0; I < 4; ++I) { f32x4 acc; { const u32x2 w = *(const LAS u32x2*)(RTt + (16 * I + 4 * g) * 2); acc[0] = bf2f(w.x & 0xffffu); acc[1] = bf2f(w.x >> 16); acc[2] = bf2f(w.y & 0xffffu); acc[3] = bf2f(w.y >> 16); }
#pragma unroll
              for (int J = 0; J < I; ++J) acc = __builtin_amdgcn_mfma_f32_16x16x16bf16_1k(*(const LAS s16x4*)(lds + CK_N + (16 * I + col) * CK_TP + (16 * J + 4 * g) * 2), xb[J], acc, 0, 0, 0);
              union { u32x2 u; s16x4 v; } zb; zb.u = (u32x2){pk2(acc[0], acc[1]), pk2(acc[2], acc[3])};
              f32x4 x = (f32x4){0.f, 0.f, 0.f, 0.f};
              x = __builtin_amdgcn_mfma_f32_16x16x16bf16_1k(*(const LAS s16x4*)(lds + CK_DD + (16 * I + col) * CK_TP + (16 * I + 4 * g) * 2), zb.v, x, 0, 0, 0);
              union { u32x2 u; s16x4 v; } xo; xo.u = (u32x2){pk2(x[0], x[1]), pk2(x[2], x[3])}; xb[I] = xo.v;
              *(LAS u32x2*)(XTt + (16 * I + 4 * g) * 2) = xo.u; } }
        __syncthreads();
        }
        CKSTAMP(3);
        { const int quad = wave & 3, rq = quad >> 1, cq = quad & 1; const bool lo = wave < 4;
          bf16* cm = (bf16*)(a.ws + (gdn ? S_CMG : S_CMR) + (size_t)it * CM_ITEM);
          const LAS unsigned char* A1 = lds + (lo ? CK_BW : CK_LRB); const LAS unsigned char* A2 = lds + (lo ? CK_KW : CK_LRK);
          f32x16 g1, g2;
#pragma unroll
          for (int r = 0; r < 16; ++r) { g1[r] = 0.f; g2[r] = 0.f; }
#pragma unroll
          for (int ks = 0; ks < 4; ++ks) { const bf16x8 af = ck_frag(A1, 32 * rq + ql, ks, hh);
              g1 = __builtin_amdgcn_mfma_f32_32x32x16_bf16(af, ck_frag(lds + CK_AW, 32 * cq + ql, ks, hh), g1, 0, 0, 0);
              g2 = __builtin_amdgcn_mfma_f32_32x32x16_bf16(af, ck_frag(lds + CK_W1, 32 * cq + ql, ks, hh), g2, 0, 0, 0); }
#pragma unroll
          for (int ks = 0; ks < 4; ++ks) g2 = __builtin_amdgcn_mfma_f32_32x32x16_bf16(ck_frag(A2, 32 * rq + ql, ks, hh), ck_frag(lds + CK_V, 32 * cq + ql, ks, hh), g2, 0, 0, 0);
          const int col = 32 * cq + ql;
          if (lo) { const float dg = __expf(pcA[col]);
#pragma unroll
              for (int r = 0; r < 16; ++r) { const int rw = 32 * rq + crow_(r, hh); *(LAS unsigned short*)(lds + CK_AT + rw * CK_TP + col * 2) = (unsigned short)f2bf(g1[r] + (rw == col ? dg : 0.f)); }
#pragma unroll
              for (int g4 = 0; g4 < 4; ++g4) *(LAS u32x2*)(lds + CK_BT + col * CK_TP + (32 * rq + 8 * g4 + 4 * hh) * 2) = (u32x2){pk2(g2[4 * g4], g2[4 * g4 + 1]), pk2(g2[4 * g4 + 2], g2[4 * g4 + 3])}; }
          else {
#pragma unroll
              for (int r = 0; r < 16; ++r) { const int rw = 32 * rq + crow_(r, hh); const float rh = bf2f(*(const LAS unsigned short*)(lds + CK_RT + rw * CK_TP + col * 2)) * __expf(cumA[rw]);
                  *(LAS unsigned short*)(lds + CK_KT + rw * CK_TP + col * 2) = (unsigned short)f2bf(g1[r] + rh); *(LAS unsigned short*)(lds + CK_N + rw * CK_TP + col * 2) = (unsigned short)f2bf(g2[r]); } }
          __syncthreads();
          CKSTAMP(4);
          { const int rr = tid >> 3, cc = (tid & 7) * 16; unsigned char* o = (unsigned char*)cm + rr * 128 + cc;
            *(u32x4*)(o) = *(const LAS u32x4*)(lds + CK_AT + rr * CK_TP + cc); *(u32x4*)(o + 8192) = *(const LAS u32x4*)(lds + CK_BT + rr * CK_TP + cc);
            *(u32x4*)(o + 16384) = *(const LAS u32x4*)(lds + CK_KT + rr * CK_TP + cc); *(u32x4*)(o + 24576) = *(const LAS u32x4*)(lds + CK_N + rr * CK_TP + cc); } }
        __syncthreads();
        CKSTAMP(5);
    }
}

__device__ __forceinline__ void phase_cscan(const PArgs& a, LAS unsigned char* lds) {
    const int bidx_ = obid();
    const int tid = otid(), lane = tid & 63, wave = __builtin_amdgcn_readfirstlane(tid >> 6), G = ogrid(), ql = lane & 31, hh = lane >> 5;
    for (int task = bidx_; task < 64; task += G) { const bool gdn = task >= 32; const int bh = task & 31;
        const bf16* cm = (const bf16*)(a.ws + (gdn ? S_CMG : S_CMR)) + (size_t)bh * 64 * (CM_ITEM / 2); bf16* s0 = (bf16*)(a.ws + (gdn ? S_S0G : S_S0R)) + (size_t)bh * 64 * 4096;
        const int rq = (wave >> 1) & 1, cq = wave & 1;
        for (int q = tid; q < 64 * CK_TP / 4; q += NTH) ((LAS unsigned*)lds)[q] = 0u;
        __syncthreads();
        bf16x8 ga[4][4]; u32x2 hc[4][4];
        if (wave < 4) {
#pragma unroll
            for (int u = 0; u < 4; ++u) { const bf16* cn = cm + (size_t)u * (CM_ITEM / 2);
#pragma unroll
                for (int ks = 0; ks < 4; ++ks) ga[u][ks] = *(const bf16x8*)(cn + (32 * rq + ql) * 64 + 16 * ks + 8 * hh);
#pragma unroll
                for (int g4 = 0; g4 < 4; ++g4) hc[u][g4] = *(const u32x2*)(cn + 4096 + (32 * cq + ql) * 64 + 32 * rq + 8 * g4 + 4 * hh); } }
        for (int c0 = 0; c0 < 64; c0 += 4) {
#pragma unroll
            for (int u = 0; u < 4; ++u) { const int c = c0 + u; const LAS unsigned char* sc = lds + (u & 1) * (64 * CK_TP); LAS unsigned char* sn = lds + ((u + 1) & 1) * (64 * CK_TP);
                { const int rr = tid >> 3, cc = (tid & 7) * 16; *(u32x4*)((unsigned char*)(s0 + (size_t)c * 4096) + rr * 128 + cc) = *(const LAS u32x4*)(sc + rr * CK_TP + cc); }
                if (wave < 4) { f32x16 acc;
#pragma unroll
                    for (int g4 = 0; g4 < 4; ++g4) { acc[4 * g4] = bf2f(hc[u][g4].x & 0xffffu); acc[4 * g4 + 1] = bf2f(hc[u][g4].x >> 16); acc[4 * g4 + 2] = bf2f(hc[u][g4].y & 0xffffu); acc[4 * g4 + 3] = bf2f(hc[u][g4].y >> 16); }
#pragma unroll
                    for (int ks = 0; ks < 4; ++ks) acc = __builtin_amdgcn_mfma_f32_32x32x16_bf16(ga[u][ks], ck_frag(sc, 32 * cq + ql, ks, hh), acc, 0, 0, 0);
                    if (c + 4 < 64) { const bf16* cn = cm + (size_t)(c + 4) * (CM_ITEM / 2);
#pragma unroll
                        for (int ks = 0; ks < 4; ++ks) ga[u][ks] = *(const bf16x8*)(cn + (32 * rq + ql) * 64 + 16 * ks + 8 * hh);
#pragma unroll
                        for (int g4 = 0; g4 < 4; ++g4) hc[u][g4] = *(const u32x2*)(cn + 4096 + (32 * cq + ql) * 64 + 32 * rq + 8 * g4 + 4 * hh); }
#pragma unroll
                    for (int g4 = 0; g4 < 4; ++g4) *(LAS u32x2*)(sn + (32 * cq + ql) * CK_TP + (32 * rq + 8 * g4 + 4 * hh) * 2) = (u32x2){pk2(acc[4 * g4], acc[4 * g4 + 1]), pk2(acc[4 * g4 + 2], acc[4 * g4 + 3])}; }
                __syncthreads();
            }
        }
    }
}

struct CoIn { bf16x8 sa[4], sb[4], qf[4]; u32x2 ya[4], yb[4]; };
__device__ __forceinline__ void co_load(const PArgs& a, int wt, int ql, int hh, CoIn& o) {
    const int item = wt >> 1, th = wt & 1; const bool gdn = item >= 2048; const int it = item & 2047;
    const bf16* cm = (const bf16*)(a.ws + (gdn ? S_CMG : S_CMR) + (size_t)it * CM_ITEM); const bf16* s0 = (const bf16*)(a.ws + (gdn ? S_S0G : S_S0R)) + (size_t)it * 4096;
    const bf16* yy = cm + 12288 + (32 * th + ql) * 64 + 4 * hh;
#pragma unroll
    for (int g4 = 0; g4 < 4; ++g4) { o.ya[g4] = *(const u32x2*)(yy + 8 * g4); o.yb[g4] = *(const u32x2*)(yy + 32 + 8 * g4); }
#pragma unroll
    for (int ks = 0; ks < 4; ++ks) { o.qf[ks] = *(const bf16x8*)(cm + 8192 + (32 * th + ql) * 64 + 16 * ks + 8 * hh); o.sa[ks] = *(const bf16x8*)(s0 + ql * 64 + 16 * ks + 8 * hh); o.sb[ks] = *(const bf16x8*)(s0 + (32 + ql) * 64 + 16 * ks + 8 * hh); }
}
__device__ __forceinline__ void phase_cout(const PArgs& a, int l) {
    const int bidx_ = obid();
    const int tid = otid(), lane = tid & 63, wave = __builtin_amdgcn_readfirstlane(tid >> 6), G = ogrid(), ql = lane & 31, hh = lane >> 5;
    CoIn in; { const int w0 = bidx_ * NWV + wave; if (w0 < 8192) co_load(a, w0, ql, hh, in); }
    for (int wt = bidx_ * NWV + wave; wt < 8192; wt += G * NWV) { const int item = wt >> 1, th = wt & 1; const bool gdn = item >= 2048; const int it = item & 2047, bh = it >> 6, ch = it & 63, b = bh >> 3, h = bh & 7;
        f32x16 y0, y1;
#pragma unroll
        for (int g4 = 0; g4 < 4; ++g4) { const u32x2 w0 = in.ya[g4], w1 = in.yb[g4];
            y0[4 * g4] = bf2f(w0.x & 0xffffu); y0[4 * g4 + 1] = bf2f(w0.x >> 16); y0[4 * g4 + 2] = bf2f(w0.y & 0xffffu); y0[4 * g4 + 3] = bf2f(w0.y >> 16);
            y1[4 * g4] = bf2f(w1.x & 0xffffu); y1[4 * g4 + 1] = bf2f(w1.x >> 16); y1[4 * g4 + 2] = bf2f(w1.y & 0xffffu); y1[4 * g4 + 3] = bf2f(w1.y >> 16); }
#pragma unroll
        for (int ks = 0; ks < 4; ++ks) { y0 = __builtin_amdgcn_mfma_f32_32x32x16_bf16(in.sa[ks], in.qf[ks], y0, 0, 0, 0); y1 = __builtin_amdgcn_mfma_f32_32x32x16_bf16(in.sb[ks], in.qf[ks], y1, 0, 0, 0); }
        if (wt + G * NWV < 8192) co_load(a, wt + G * NWV, ql, hh, in);
        const size_t tok = (size_t)b * SEQ + ch * 64 + 32 * th + ql; const size_t base = tok * HW + h * 64 + 4 * hh;
        float s1 = 0.f;
#pragma unroll
        for (int r = 0; r < 16; ++r) s1 += y0[r] + y1[r];
        if (!gdn) { s1 += __shfl_xor(s1, 32); const float mean = s1 * (1.f / 64.f); float s2 = 0.f;
#pragma unroll
            for (int r = 0; r < 16; ++r) { const float d0 = y0[r] - mean, d1 = y1[r] - mean; s2 += d0 * d0 + d1 * d1; }
            s2 += __shfl_xor(s2, 32); const float rstd = rsqrtf(s2 * (1.f / 64.f) + 64e-5f); const float bsc = ((const float*)(a.ws + WS_CTL + C_BSC))[tok * 8 + h];
            const bf16* RV = (const bf16*)(a.ws + S_RV) + base; const bf16* RG = (const bf16*)(a.ws + S_RG) + base; bf16* OA = (bf16*)(a.ws + S_OA) + base;
            const float* lng = INF(14) + l * 512 + h * 64 + 4 * hh; const float* lnb = INF(15) + l * 512 + h * 64 + 4 * hh;
#pragma unroll
            for (int half = 0; half < 2; ++half)
#pragma unroll
                for (int g4 = 0; g4 < 4; ++g4) { const int co = 32 * half + 8 * g4; const u32x2 vw = *(const u32x2*)(RV + co), gw = *(const u32x2*)(RG + co); const f32x4 lg = *(const f32x4*)(lng + co), lb = *(const f32x4*)(lnb + co);
                    const float vv[4] = {bf2f(vw.x & 0xffffu), bf2f(vw.x >> 16), bf2f(vw.y & 0xffffu), bf2f(vw.y >> 16)}, gg[4] = {bf2f(gw.x & 0xffffu), bf2f(gw.x >> 16), bf2f(gw.y & 0xffffu), bf2f(gw.y >> 16)}; float o[4];
#pragma unroll
                    for (int e = 0; e < 4; ++e) { const float yv = half ? y1[4 * g4 + e] : y0[4 * g4 + e]; o[e] = ((yv - mean) * rstd * lg[e] + lb[e] + bsc * vv[e]) * gg[e]; }
                    *(u32x2*)(OA + co) = (u32x2){pk2(o[0], o[1]), pk2(o[2], o[3])}; } }
        else { float s2 = 0.f;
#pragma unroll
            for (int r = 0; r < 16; ++r) s2 += y0[r] * y0[r] + y1[r] * y1[r];
            s2 += __shfl_xor(s2, 32); const float rstd = rsqrtf(s2 * (1.f / 64.f) + NORM_EPS);
            const bf16* ZG = (const bf16*)(a.ws + S_ZG) + base; bf16* OC = (bf16*)(a.ws + S_OC) + base; const float* gng = INF(29) + l * 64 + 4 * hh;
#pragma unroll
            for (int half = 0; half < 2; ++half)
#pragma unroll
                for (int g4 = 0; g4 < 4; ++g4) { const int co = 32 * half + 8 * g4; const u32x2 gw = *(const u32x2*)(ZG + co); const f32x4 ng = *(const f32x4*)(gng + co);
                    const float gg[4] = {bf2f(gw.x & 0xffffu), bf2f(gw.x >> 16), bf2f(gw.y & 0xffffu), bf2f(gw.y >> 16)}; float o[4];
#pragma unroll
                    for (int e = 0; e < 4; ++e) { const float yv = half ? y1[4 * g4 + e] : y0[4 * g4 + e]; o[e] = yv * rstd * ng[e] * siluf_(gg[e]); }
                    *(u32x2*)(OC + co) = (u32x2){pk2(o[0], o[1]), pk2(o[2], o[3])}; } }
    }
}
__device__ __forceinline__ void phase_router(const PArgs& a, LAS unsigned char* lds) {
    const int bidx_ = obid();
    const int tid = otid(), lane = tid & 63, wave = __builtin_amdgcn_readfirstlane(tid >> 6), G = ogrid();
    const int gw = bidx_ * NWV + wave, NGW = G * NWV;
    const float* gf = INF(34) + D; const float* wr = INF(38);
    int* sel = (int*)(a.ws + WS_CTL + C_SEL); float* wts = (float*)(a.ws + WS_CTL + C_WTS); int* rank = (int*)(a.ws + WS_CTL + C_RANK); float* rs1 = (float*)(a.ws + WS_CTL + C_RS1);
    unsigned* cnt = (unsigned*)(a.ws + WS_CTL + C_MOE);
    LAS float* wl = (LAS float*)lds;
    __syncthreads();
    for (int k = tid; k < D; k += NTH) { const float g = gf[k]; const f32x4 w0 = *(const f32x4*)(wr + (size_t)k * 8), w1 = *(const f32x4*)(wr + (size_t)k * 8 + 4);
        wl[0 * D + k] = w0[0] * g; wl[1 * D + k] = w0[1] * g; wl[2 * D + k] = w0[2] * g; wl[3 * D + k] = w0[3] * g; wl[4 * D + k] = w1[0] * g; wl[5 * D + k] = w1[1] * g; wl[6 * D + k] = w1[2] * g; wl[7 * D + k] = w1[3] * g; }
    __syncthreads();
    LAS unsigned* lcnt = (LAS unsigned*)(lds + 32768); LAS unsigned* gbase = lcnt + 8;
    for (int b0 = bidx_ * NWV; b0 < T / 8; b0 += G * NWV) { const int bi = b0 + wave; const bool act = bi < T / 8; int my_e0 = -1, my_e1 = -1;
        if (tid < 8) lcnt[tid] = 0u;
        if (act) {
        f32x4 xn[4];
        { const f32x4* hr = (const f32x4*)(a.out + (size_t)(bi * 8) * D) + lane;
#pragma unroll
          for (int q = 0; q < 4; ++q) xn[q] = hr[64 * q]; }
        for (int i = 0; i < 8; ++i) { const int t = bi * 8 + i;
            f32x4 x[4];
#pragma unroll
            for (int q = 0; q < 4; ++q) x[q] = xn[q];
            if (i + 1 < 8) { const f32x4* hr = (const f32x4*)(a.out + (size_t)(t + 1) * D) + lane;
#pragma unroll
                for (int q = 0; q < 4; ++q) xn[q] = hr[64 * q]; }
            float ssq = 0.f; float lg[8];
#pragma unroll
            for (int e = 0; e < 8; ++e) lg[e] = 0.f;
#pragma unroll
            for (int q = 0; q < 4; ++q) { ssq += (x[q][0] * x[q][0] + x[q][1] * x[q][1]) + (x[q][2] * x[q][2] + x[q][3] * x[q][3]);
#pragma unroll
                for (int e = 0; e < 8; ++e) { const f32x4 w = *(const LAS f32x4*)(wl + e * D + (lane + 64 * q) * 4); lg[e] += (x[q][0] * w[0] + x[q][1] * w[1]) + (x[q][2] * w[2] + x[q][3] * w[3]); } }
            ssq = wave_sum(ssq); const float rs = rsqrtf(ssq * (1.f / D) + NORM_EPS);
#pragma unroll
            for (int e = 0; e < 8; ++e) lg[e] = wave_sum(lg[e]) * rs;
            int e0 = 0; float l0 = lg[0];
#pragma unroll
            for (int e = 1; e < 8; ++e) if (lg[e] > l0) { l0 = lg[e]; e0 = e; }
            int e1 = -1; float l1 = -3.4e38f;
#pragma unroll
            for (int e = 0; e < 8; ++e) if (e != e0 && lg[e] > l1) { l1 = lg[e]; e1 = e; }
            const float wa = 1.f / (1.f + __expf(l1 - l0));
            if (lane == i) { my_e0 = e0; my_e1 = e1; sel[t * 2] = e0; sel[t * 2 + 1] = e1; wts[t * 2] = wa; wts[t * 2 + 1] = 1.f - wa; rs1[t] = rs; } } }
        __syncthreads();
        unsigned woff[2][8];
#pragma unroll
        for (int s = 0; s < 2; ++s) { const int me = s ? my_e1 : my_e0;
#pragma unroll
            for (int e = 0; e < 8; ++e) { const unsigned long long m = __ballot(me == e); const int n = __popcll(m); unsigned o = 0;
                if (n != 0 && lane == 0) o = __hip_atomic_fetch_add(lcnt + e, (unsigned)n, __ATOMIC_RELAXED, __HIP_MEMORY_SCOPE_WORKGROUP);
                woff[s][e] = __builtin_amdgcn_readfirstlane(o); } }
        __syncthreads();
        if (tid < 8) gbase[tid] = atomicAdd(cnt + tid, lcnt[tid]);
        __syncthreads();
        if (act && lane < 8) {
#pragma unroll
            for (int s = 0; s < 2; ++s) { const int me = s ? my_e1 : my_e0; unsigned r = 0;
#pragma unroll
                for (int e = 0; e < 8; ++e) { const unsigned long long m = __ballot(me == e); if (me == e) r = gbase[e] + woff[s][e] + (unsigned)__popcll(m & ((1ull << lane) - 1ull)); }
                rank[(bi * 8 + lane) * 2 + s] = (int)r; } }
        __syncthreads();
    }
    __syncthreads();
}
__device__ __forceinline__ void phase_assign(const PArgs& a) {
    const int bidx_ = obid();
    const int tid = otid(), lane = tid & 63, wave = __builtin_amdgcn_readfirstlane(tid >> 6), G = ogrid();
    const int gw = bidx_ * NWV + wave, NGW = G * NWV;
    const unsigned* cnt = (const unsigned*)(a.ws + WS_CTL + C_MOE);
    const int* sel = (const int*)(a.ws + WS_CTL + C_SEL); const int* rank = (const int*)(a.ws + WS_CTL + C_RANK); const float* rs1 = (const float*)(a.ws + WS_CTL + C_RS1);
    int* dest = (int*)(a.ws + WS_CTL + C_DEST); float* rsx = (float*)(a.ws + WS_CTL + C_RSX); int* blke = (int*)(a.ws + WS_CTL + C_BLKE);
    const bf16* hb = (const bf16*)(a.ws + WS_HB); bf16* xg = (bf16*)(a.ws + S_XG);
    int pstart[9]; pstart[0] = 0;
#pragma unroll
    for (int e = 0; e < 8; ++e) pstart[e + 1] = pstart[e] + (int)((cnt[e] + 255u) / 256u) * 256;
    if (bidx_ == 0 && tid < NBLK_MAX + 1) { if (tid == NBLK_MAX) blke[NBLK_MAX] = pstart[8] / 256; else { int e = 0;
#pragma unroll
            for (int q = 1; q < 8; ++q) if (tid * 256 >= pstart[q]) e = q;
            blke[tid] = e; } }
    u32x4 nr0 = (u32x4){0u, 0u, 0u, 0u}, nr1 = nr0; int ne = 0, nrk = 0; float nrs = 0.f;
#define AS_LOAD(aa) do { const int as_ = (aa), t_ = as_ >> 1; ne = sel[as_]; nrk = rank[as_]; nrs = rs1[t_]; const u32x4* src_ = (const u32x4*)(hb + (size_t)t_ * D); nr0 = src_[lane]; nr1 = src_[lane + 64]; } while (0)
    if (gw < T * 2) AS_LOAD(gw);
    for (int as = gw; as < T * 2; as += NGW) { const int e = ne, rk = nrk; const float rsv = nrs; const u32x4 r0 = nr0, r1 = nr1;
        if (as + NGW < T * 2) AS_LOAD(as + NGW);
        int ps = 0;
#pragma unroll
        for (int q = 0; q < 8; ++q) if (e == q) ps = pstart[q];
        const int d = ps + rk;
        if (lane == 0) { dest[as] = d; rsx[d] = rsv; }
        u32x4* dst = (u32x4*)(xg + (size_t)d * D);
        dst[lane] = r0; dst[lane + 64] = r1; }
#undef AS_LOAD
}
__device__ __forceinline__ void phase_combine(const PArgs& a) {
    const int bidx_ = obid();
    const int tid = otid(), lane = tid & 63, wave = __builtin_amdgcn_readfirstlane(tid >> 6), G = ogrid();
    const int gw = bidx_ * NWV + wave, NGW = G * NWV;
    const int* dest = (const int*)(a.ws + WS_CTL + C_DEST); const float* wts = (const float*)(a.ws + WS_CTL + C_WTS);
    const bf16* y = (const bf16*)(a.ws + S_XG); bf16* hb = (bf16*)(a.ws + WS_HB);
    f32x4 nh[4]; u32x2 na[4], nb[4]; float nw0 = 0.f, nw1 = 0.f;
#define CB_LOAD(tt) do { const int t_ = (tt); const int d0_ = dest[t_ * 2], d1_ = dest[t_ * 2 + 1]; nw0 = wts[t_ * 2]; nw1 = wts[t_ * 2 + 1]; \
        const f32x4* hr_ = (const f32x4*)(a.out + (size_t)t_ * D); const u32x2* y0_ = (const u32x2*)(y + (size_t)d0_ * D); const u32x2* y1_ = (const u32x2*)(y + (size_t)d1_ * D); \
        _Pragma("unroll") for (int q = 0; q < 4; ++q) { nh[q] = hr_[lane + 64 * q]; na[q] = y0_[lane + 64 * q]; nb[q] = y1_[lane + 64 * q]; } } while (0)
    if (gw < T) CB_LOAD(gw);
    for (int t = gw; t < T; t += NGW) { f32x4 ch[4]; u32x2 ca[4], cb2[4]; const float w0 = nw0, w1 = nw1;
#pragma unroll
        for (int q = 0; q < 4; ++q) { ch[q] = nh[q]; ca[q] = na[q]; cb2[q] = nb[q]; }
        if (t + NGW < T) CB_LOAD(t + NGW);
        f32x4* hr = (f32x4*)(a.out + (size_t)t * D); u32x2* hbr = (u32x2*)(hb + (size_t)t * D);
#pragma unroll
        for (int q = 0; q < 4; ++q) { const int ix = lane + 64 * q; f32x4 h = ch[q]; const u32x2 a0 = ca[q], a1 = cb2[q];
            h[0] += w0 * bf2f(a0.x & 0xffffu) + w1 * bf2f(a1.x & 0xffffu); h[1] += w0 * bf2f(a0.x >> 16) + w1 * bf2f(a1.x >> 16);
            h[2] += w0 * bf2f(a0.y & 0xffffu) + w1 * bf2f(a1.y & 0xffffu); h[3] += w0 * bf2f(a0.y >> 16) + w1 * bf2f(a1.y >> 16);
            hr[ix] = h; u32x2 w; w.x = pk2(h[0], h[1]); w.y = pk2(h[2], h[3]); hbr[ix] = w; } }
#undef CB_LOAD
}
#ifndef PROBE_X
#define PROBE_X 0
#endif
#ifndef MK_ONE_LAUNCH
#define MK_ONE_LAUNCH 1
#endif
#define XB_TMO      128
#define XB_XCNT(j)  (256  + 64 * (j))
#define XB_XSUB(j)  (1280 + 64 * (j))
#define XB_XGEN(j)  (2304 + 64 * (j))
#define XB_TOP      3328
#define XB_TOPGEN   3392
#define XCD_BAR_WORDS 3456
#define XB_SPIN_CAP (1u << 22)
__device__ __forceinline__ unsigned xb_ld(unsigned* p)              { return __hip_atomic_load(p, __ATOMIC_RELAXED, __HIP_MEMORY_SCOPE_AGENT); }
__device__ __forceinline__ unsigned xb_add(unsigned* p, unsigned v) { return __hip_atomic_fetch_add(p, v, __ATOMIC_RELAXED, __HIP_MEMORY_SCOPE_AGENT); }
__device__ __forceinline__ unsigned xb_xcc_id() { return (unsigned)__builtin_amdgcn_s_getreg((3 << 11) | 20) & 0xFu; }
#define XB_SPIN(cond, bar) do { unsigned _sp = 0; while (cond) { __builtin_amdgcn_s_sleep(1); \
    if ((++_sp & 255u) == 0u) { if (xb_ld(&(bar)[XB_TMO])) break; if (_sp > XB_SPIN_CAP) { atomicAdd(&(bar)[XB_TMO], 1u); break; } } } } while (0)
struct XcdBarrier { unsigned* bar; unsigned x; volatile LAS unsigned* st; };
__device__ __forceinline__ XcdBarrier xcd_barrier_post(unsigned* bar, volatile LAS unsigned* st) {
    XcdBarrier b; b.bar = bar; b.x = xb_xcc_id(); b.st = st;
    if (threadIdx.x == 0) (void)xb_add(&bar[XB_XCNT(b.x)], 1u);
    return b;
}
__device__ __forceinline__ void xcd_barrier_complete(unsigned* bar, unsigned x, unsigned& nloc, unsigned& nx) {
    const unsigned G = gridDim.x * gridDim.y * gridDim.z;
    unsigned sum, cnt, mine, sp = 0u;
    for (;;) {
        sum = 0u; cnt = 0u; mine = 0u;
#pragma unroll
        for (unsigned j = 0; j < 16; ++j) { const unsigned c = xb_ld(&bar[XB_XCNT(j)]); sum += c; cnt += (c > 0u) ? 1u : 0u; mine = (j == x) ? c : mine; }
        if (sum == G) break;
        __builtin_amdgcn_s_sleep(1);
        if ((++sp & 255u) == 0u) { if (xb_ld(&bar[XB_TMO])) break; if (sp > XB_SPIN_CAP) { atomicAdd(&bar[XB_TMO], 1u); break; } }
    }
    nloc = mine > 0u ? mine : 1u; nx = cnt > 0u ? cnt : 1u;
}
__device__ __forceinline__ void xcd_barrier(const XcdBarrier& b_) {
    asm volatile("s_waitcnt vmcnt(0)" ::: "memory");
    __syncthreads();
    if (otid() == 0) {
        XcdBarrier b = b_; asm volatile("" : "+s"(b.bar)); b.x = xb_xcc_id();
        unsigned* bar = b.bar;
        __builtin_amdgcn_s_waitcnt(0);
        unsigned nloc = b.st[0], nx = b.st[1];
        if (nloc == 0u) { xcd_barrier_complete(bar, b.x, nloc, nx); b.st[0] = nloc; b.st[1] = nx; }
        const unsigned old = xb_add(&bar[XB_XSUB(b.x)], 1u);
        const unsigned gen = old / nloc;
        if (old + 1u == (gen + 1u) * nloc) {
            __builtin_amdgcn_fence(__ATOMIC_RELEASE, "agent");
            asm volatile("s_waitcnt vmcnt(0)" ::: "memory");
            const unsigned og = xb_add(&bar[XB_TOP], 1u);
            const unsigned tg = og / nx;
            if (og + 1u == (tg + 1u) * nx) xb_add(&bar[XB_TOPGEN], 1u);
            else XB_SPIN(xb_ld(&bar[XB_TOPGEN]) == tg, bar);
            __builtin_amdgcn_fence(__ATOMIC_ACQUIRE, "agent");
            xb_add(&bar[XB_XGEN(b.x)], 1u);
            asm volatile("s_waitcnt vmcnt(0)" ::: "memory");
        } else {
            XB_SPIN(xb_ld(&bar[XB_XGEN(b.x)]) == gen, bar);
            __builtin_amdgcn_fence(__ATOMIC_ACQUIRE, "agent");
            asm volatile("s_waitcnt vmcnt(0)" ::: "memory");
        }
    }
    __syncthreads();
}

enum PhaseKind { PK_PRO = 0, PK_G1A, PK_PRE, PK_G23, PK_MLAPOST, PK_ATT, PK_RGPREP, PK_SCAN, PK_FIN, PK_G1B, PK_MRG, PK_OUT, PK_FGU, PK_FD, PK_MOEA, PK_MOEB, PK_MGU0, PK_MD0, PK_MGU1, PK_MD1, PK_COMB, PK_PP, PK_PG, PK_COUT };
struct PhaseEnt { int kind, layer; };
__constant__ PhaseEnt g_prog[] = {
    {PK_PRO, 0},
    {PK_G1A, 0}, {PK_PRE, 0}, {PK_G23, 0}, {PK_MLAPOST, 0}, {PK_ATT, 0}, {PK_RGPREP, 0}, {PK_SCAN, 0}, {PK_FIN, 0}, {PK_COUT, 0}, {PK_G1B, 0}, {PK_MRG, 0}, {PK_OUT, 0}, {PK_FGU, 0}, {PK_FD, 0}, {PK_PP, 0}, {PK_PG, 0},
    {PK_G1A, 1}, {PK_PRE, 1}, {PK_G23, 1}, {PK_MLAPOST, 1}, {PK_ATT, 1}, {PK_RGPREP, 1}, {PK_SCAN, 1}, {PK_FIN, 1}, {PK_COUT, 1}, {PK_G1B, 1}, {PK_MRG, 1}, {PK_OUT, 1},
    {PK_MOEA, 1}, {PK_MOEB, 1}, {PK_MGU0, 1}, {PK_MD0, 1}, {PK_MGU1, 1}, {PK_MD1, 1}, {PK_COMB, 1}, {PK_PP, 1}, {PK_PG, 1},
};
constexpr int NPHASE = sizeof(g_prog) / sizeof(PhaseEnt);

constexpr int LDS_BYTES = 163840;
constexpr int LDS_MISC = 163840 - 1024;

template <int KINDT> __device__ __forceinline__ void run_phase(const Args& a_, int kind_rt, int l, LAS unsigned char* lds) {
    const int kind = KINDT >= 0 ? KINDT : kind_rt; const PArgs a = make_pargs(a_);
    const int G = ogrid(), c = obid();
    unsigned char* ws = a.ws;
    const bf16* Wl = (const bf16*)(ws + WS_W + (size_t)l * WL);
    float* SS0 = (float*)(ws + S_SSP0); float* SS1 = (float*)(ws + S_SSP1); float* SSE = (float*)(ws + S_SSP2);
    bf16* HB = (bf16*)(ws + WS_HB); const bf16* HBin = (const bf16*)(ws + (l == 0 ? WS_HB : WS_HB2));
    const bf16* Wp = (const bf16*)(ws + WS_W + W_PLE + (size_t)l * WPL);
    switch (kind) {
    case PK_PRO: phase_prologue(a, lds); break;
    case PK_G1A: { pg8::Gemm g{HBin, Wl + W_IN / 2, D, D, D}; pg8::StaticOrder S; S.init(T / 256, N1 / 256, G, c);
        EpiInProj E{(bf16*)(ws + S_ZR), (bf16*)(ws + S_ZQ), (bf16*)(ws + S_ZG), (bf16*)(ws + S_ZM), SS0}; pg8::gemm_phase(lds, g, S, E); } break;
    case PK_PRE: phase_pre(a, l); break;
    case PK_G23: { { pg8::Gemm g{(const bf16*)(ws + S_ZM), Wl + W_2 / 2, K2, NZM, K2}; pg8::StaticOrder S; S.init(T / 256, N2 / 256, G, c);
            EpiMla E{(bf16*)(ws + S_QRAW), (bf16*)(ws + S_KVRAW), (const float*)(ws + WS_CTL + C_RSQ), (const float*)(ws + WS_CTL + C_RSKV)}; pg8::gemm_phase(lds, g, S, E); }
        { pg8::Gemm g{(const bf16*)(ws + S_A2), Wl + W_3 / 2, K3, K3, K3}; pg8::StaticOrder S; S.init(T / 256, N3 / 256, G, c);
            EpiPlain E{(bf16*)(ws + S_L2), N3}; pg8::gemm_phase(lds, g, S, E); } } break;
    case PK_MLAPOST: phase_mla_post(a, l, lds); break;
    case PK_ATT: phase_attn<0>(a, lds);
#if PROBE_X >= 10
        phase_attn<PROBE_X - 10>(a, lds);
#endif
        break;
    case PK_RGPREP: phase_rwkv_post(a, l); phase_gdn_prep(a, l); break;
    case PK_SCAN: phase_cprep(a, lds); break;
    case PK_FIN: phase_cscan(a, lds); break;
    case PK_COUT: phase_cout(a, l); break;
    case PK_G1B: { pg8::Gemm g{HBin, Wl + W_GATE / 2, D, D, D}; pg8::StaticOrder S; S.init(T / 256, NGATE / 256, G, c);
        EpiGate E{(bf16*)(ws + S_ZS), SS0}; pg8::gemm_phase(lds, g, S, E); } break;
    case PK_MRG: { pg8::StaticOrder S; S.init(T / 256, D / 256, G, c);
        { pg8::Gemm g{(const bf16*)(ws + S_OA), Wl + W_BRA / 2, HW, HW, HW}; EpiMerge<true> E{(bf16*)(ws + S_M), (const bf16*)(ws + S_ZS), 0}; pg8::gemm_phase(lds, g, S, E); }
        { pg8::Gemm g{(const bf16*)(ws + S_OB), Wl + W_BRB / 2, HW, HW, HW}; EpiMerge<false> E{(bf16*)(ws + S_M), (const bf16*)(ws + S_ZS), 1}; pg8::gemm_phase(lds, g, S, E); }
        { pg8::Gemm g{(const bf16*)(ws + S_OC), Wl + W_BRC / 2, HW, HW, HW}; EpiMerge<false> E{(bf16*)(ws + S_M), (const bf16*)(ws + S_ZS), 2}; pg8::gemm_phase(lds, g, S, E); } } break;
    case PK_OUT: { pg8::Gemm g{(const bf16*)(ws + S_M), Wl + W_OUT / 2, D, D, D}; pg8::StaticOrder S; S.init(T / 256, D / 256, G, c);
#if PROBE_X == 1
        { EpiPlain E2{(bf16*)(ws + S_ZR), D}; pg8::gemm_phase(lds, g, S, E2); }
#endif
        EpiResid E{l == 0 ? INF(0) : (const float*)a.out, a.out, HB, SS1}; pg8::gemm_phase(lds, g, S, E); } break;
    case PK_FGU: { pg8::Gemm g{HB, (const bf16*)(ws + WS_W + W_FGU), D, D, D}; pg8::StaticOrder S; S.init(T / 256, 2 * FFD / 256, G, c);
        EpiSwiglu<false> E{(bf16*)(ws + S_ACT), FFD, SS1}; pg8::gemm_phase(lds, g, S, E); } break;
    case PK_FD: { pg8::Gemm g{(const bf16*)(ws + S_ACT), (const bf16*)(ws + WS_W + W_FD), FFD, FFD, FFD}; pg8::StaticOrder S; S.init(T / 256, D / 256, G, c);
#if PROBE_X == 2
        { EpiPlain E2{(bf16*)(ws + WS_S + 100 * MiB), D}; pg8::gemm_phase(lds, g, S, E2); }
#endif
        EpiResid E{a.out, a.out, HB, nullptr}; pg8::gemm_phase(lds, g, S, E); } break;
    case PK_MOEA: {
#if PROBE_SUB
        __syncthreads(); const unsigned long long ts0 = __builtin_amdgcn_s_memrealtime();
#endif
        phase_moe_cvt(a, lds);
#if PROBE_SUB
        __syncthreads(); const unsigned long long ts1 = __builtin_amdgcn_s_memrealtime();
#endif
        phase_router(a, lds);
#if PROBE_SUB
        __syncthreads(); const unsigned long long ts2 = __builtin_amdgcn_s_memrealtime();
        if (threadIdx.x == 0) ((volatile LAS unsigned*)(lds + LDS_MISC))[32] = (unsigned)((PROBE_SUB == 1) ? (ts1 - ts0) : (ts2 - ts1));
#endif
        } break;
    case PK_MOEB: phase_assign(a); break;
    case PK_MGU0: case PK_MGU1: { const int half = (kind == PK_MGU1); const int* blke = (const int*)(ws + WS_CTL + C_BLKE); const int nblk = __builtin_amdgcn_readfirstlane(blke[NBLK_MAX]);
        const int lo = half * HALF_BLK, hi = nblk < lo + HALF_BLK ? nblk : lo + HALF_BLK, nM = hi > lo ? hi - lo : 0;
        pg8::Gemm g{(const bf16*)(ws + S_XG), (const bf16*)(ws + S_MWGU), D, D, D}; pg8::StaticOrder S; S.init(nM, 2 * FFE / 256, G, c, lo, blke);
        EpiSwiglu<true> E{(bf16*)(ws + S_MACT) - (size_t)lo * 256 * FFE, FFE, (const float*)(ws + WS_CTL + C_RSX)}; pg8::gemm_phase(lds, g, S, E); } break;
    case PK_MD0: case PK_MD1: { const int half = (kind == PK_MD1); const int* blke = (const int*)(ws + WS_CTL + C_BLKE); const int nblk = __builtin_amdgcn_readfirstlane(blke[NBLK_MAX]);
        const int lo = half * HALF_BLK, hi = nblk < lo + HALF_BLK ? nblk : lo + HALF_BLK, nM = hi > lo ? hi - lo : 0;
        pg8::Gemm g{(const bf16*)(ws + S_MACT) - (size_t)lo * 256 * FFE, (const bf16*)(ws + S_MWD), FFE, FFE, FFE}; pg8::StaticOrder S; S.init(nM, D / 256, G, c, lo, blke);
        EpiPlain E{(bf16*)(ws + S_XG), D}; pg8::gemm_phase(lds, g, S, E); } break;
    case PK_COMB: phase_combine(a); break;
    case PK_PP: { pg8::Gemm g{(const bf16*)(ws + WS_PB) + (size_t)l * T * PLE, Wp + W_PP / 2, PLE, PLE, PLE}; pg8::StaticOrder S; S.init(T / 256, D / 256, G, c);
        EpiPleProj E{(bf16*)(ws + S_E), SSE}; pg8::gemm_phase(lds, g, S, E); } break;
    case PK_PG: { pg8::Gemm g{HB, Wp + W_PG / 2, D, D, D}; pg8::StaticOrder S; S.init(T / 256, D / 256, G, c);
#if PROBE_X == 3
        { EpiPlain E2{(bf16*)(ws + WS_S + 100 * MiB), D}; pg8::gemm_phase(lds, g, S, E2); }
#endif
        EpiPleGate E{a.out, l + 1 < NL ? (bf16*)(ws + WS_HB2) : nullptr, (const bf16*)(ws + S_E), SSE, INF(44) + l * D, l + 1 < NL ? SS0 : nullptr}; pg8::gemm_phase(lds, g, S, E); } break;
    default: break;
    }
}

template <int KINDT> __global__ void __launch_bounds__(NTH, 2) k_one(Args a, int l) {
    extern __shared__ __attribute__((aligned(16))) unsigned char lds_raw[];
    run_phase<KINDT>(a, KINDT, l, (LAS unsigned char*)lds_raw);
}
#if MK_ONE_LAUNCH
__global__ void __launch_bounds__(NTH, 2) k_fwd(Args a) {
    extern __shared__ __attribute__((aligned(16))) unsigned char lds_raw[];
    LAS unsigned char* lds = (LAS unsigned char*)lds_raw;
    volatile LAS unsigned* misc = (volatile LAS unsigned*)(lds + LDS_MISC);
    if (threadIdx.x < 64) misc[threadIdx.x] = 0u;
    __syncthreads();
    const XcdBarrier bar = xcd_barrier_post((unsigned*)(a.ws + WS_CTL + C_BAR), misc + 8);
#ifndef PROBE_MASK
#define PROBE_MASK 0u
#endif
#define BAR() xcd_barrier(bar)
#ifndef PROBE_T
#define PROBE_T 0u
#endif
#ifndef PROBE_TDIV
#define PROBE_TDIV 1000
#endif
#define RUN(K, l) do { if ((PROBE_MASK >> K) & 1u) { run_phase<K>(a, K, l, lds); BAR(); } \
    unsigned long long t0_ = 0; if ((PROBE_T >> K) & 1u) { BAR(); t0_ = __builtin_amdgcn_s_memrealtime(); } run_phase<K>(a, K, l, lds); if ((PROBE_T >> K) & 1u) { BAR(); tacc_ += __builtin_amdgcn_s_memrealtime() - t0_; } } while (0)
#ifdef PROBE_BARS
    for (int q = 0; q < PROBE_BARS; ++q) BAR();
#endif
    unsigned long long tacc_ = 0;
    RUN(PK_PRO, 0); BAR();
#define MIXER(l) RUN(PK_G1A, l); BAR(); RUN(PK_PRE, l); BAR(); RUN(PK_G23, l); BAR(); RUN(PK_MLAPOST, l); BAR(); RUN(PK_ATT, l); BAR(); RUN(PK_RGPREP, l); BAR(); \
        RUN(PK_SCAN, l); BAR(); RUN(PK_FIN, l); BAR(); RUN(PK_COUT, l); BAR(); RUN(PK_G1B, l); BAR(); RUN(PK_MRG, l); BAR(); RUN(PK_OUT, l); BAR();
    MIXER(0)
    RUN(PK_FGU, 0); BAR(); RUN(PK_FD, 0); RUN(PK_PP, 0); BAR();
    RUN(PK_PG, 0); BAR();
    MIXER(1)
    RUN(PK_MOEA, 1); BAR(); RUN(PK_MOEB, 1); BAR(); RUN(PK_MGU0, 1); BAR(); RUN(PK_MD0, 1); BAR(); RUN(PK_MGU1, 1); BAR(); RUN(PK_MD1, 1); RUN(PK_PP, 1); BAR(); RUN(PK_COMB, 1); BAR();
    RUN(PK_PG, 1);
#undef MIXER
    if (PROBE_T != 0u) { BAR(); if (blockIdx.x == 0 && threadIdx.x == 0) a.out[0] = (float)(tacc_ / PROBE_TDIV); }
#if PROBE_SUB
    BAR(); if (blockIdx.x == 0 && threadIdx.x == 0) a.out[0] = (float)(misc[PROBE_SUB >= 10 ? 40 : 32] / PROBE_TDIV);
#endif
#undef RUN
#undef BAR
}
#endif

#ifndef MK_ONE_LAUNCH
#define MK_ONE_LAUNCH 1
#endif
extern "C" void kernel_launch(void* const* d_in, const int* in_sizes, int n_in, void* d_out, int out_size, void* d_ws, size_t ws_size, hipStream_t stream) {
    static int grid = 0;
    if (grid == 0) {
        if (n_in != 45 || out_size != T * D || ws_size < WS_END) { fprintf(stderr, "kernel_launch: unexpected shapes: n_in %d out %d ws %zu (need %zu)\n", n_in, out_size, ws_size, (size_t)WS_END); grid = -1; return; }
        int dev = 0, cus = 0;
        if (hipGetDevice(&dev) != hipSuccess || hipDeviceGetAttribute(&cus, hipDeviceAttributeMultiprocessorCount, dev) != hipSuccess) { grid = -1; return; }
#if MK_ONE_LAUNCH
        if (hipFuncSetAttribute((const void*)k_fwd, hipFuncAttributeMaxDynamicSharedMemorySize, LDS_BYTES) != hipSuccess) { fprintf(stderr, "kernel_launch: hipFuncSetAttribute failed\n"); grid = -1; return; }
#else
#define SA(K) (void)hipFuncSetAttribute((const void*)k_one<K>, hipFuncAttributeMaxDynamicSharedMemorySize, LDS_BYTES);
        SA(PK_PRO) SA(PK_G1A) SA(PK_PRE) SA(PK_G23) SA(PK_MLAPOST) SA(PK_ATT) SA(PK_RGPREP) SA(PK_SCAN) SA(PK_FIN) SA(PK_G1B) SA(PK_MRG) SA(PK_OUT) SA(PK_FGU) SA(PK_FD) SA(PK_MOEA) SA(PK_MOEB) SA(PK_MGU0) SA(PK_MD0) SA(PK_MGU1) SA(PK_MD1) SA(PK_COMB) SA(PK_PP) SA(PK_PG) SA(PK_COUT)
#undef SA
#endif
        int per_cu = 0;
#if MK_ONE_LAUNCH
        if (hipOccupancyMaxActiveBlocksPerMultiprocessor(&per_cu, (const void*)k_fwd, NTH, LDS_BYTES) != hipSuccess || per_cu < 1) { fprintf(stderr, "kernel_launch: occupancy query says %d blocks/CU\n", per_cu); }
#endif
        (void)hipGetLastError();
        grid = cus;
    }
    if (grid < 0) return;
    (void)hipMemsetAsync((char*)d_ws + WS_CTL, 0, CTL_ZERO, stream);
    (void)hipMemsetAsync((char*)d_ws + WS_W, 0, 71 * MiB, stream);
    Args a{};
    for (int i = 0; i < 45; ++i) a.in[i] = d_in[i];
    a.out = (float*)d_out; a.ws = (unsigned char*)d_ws; a.layer = 0; a.pad = 0;
#if MK_ONE_LAUNCH
    hipLaunchKernelGGL(k_fwd, dim3(grid), dim3(NTH), LDS_BYTES, stream, a);
#else
    static const PhaseEnt prog_h[] = {
        {PK_PRO, 0},
        {PK_G1A, 0}, {PK_PRE, 0}, {PK_G23, 0}, {PK_MLAPOST, 0}, {PK_ATT, 0}, {PK_RGPREP, 0}, {PK_SCAN, 0}, {PK_FIN, 0}, {PK_COUT, 0}, {PK_G1B, 0}, {PK_MRG, 0}, {PK_OUT, 0}, {PK_FGU, 0}, {PK_FD, 0}, {PK_PP, 0}, {PK_PG, 0},
        {PK_G1A, 1}, {PK_PRE, 1}, {PK_G23, 1}, {PK_MLAPOST, 1}, {PK_ATT, 1}, {PK_RGPREP, 1}, {PK_SCAN, 1}, {PK_FIN, 1}, {PK_COUT, 1}, {PK_G1B, 1}, {PK_MRG, 1}, {PK_OUT, 1},
        {PK_MOEA, 1}, {PK_MOEB, 1}, {PK_MGU0, 1}, {PK_MD0, 1}, {PK_MGU1, 1}, {PK_MD1, 1}, {PK_COMB, 1}, {PK_PP, 1}, {PK_PG, 1} };
    for (int p = 0; p < (int)(sizeof(prog_h) / sizeof(prog_h[0])); ++p) { const int l = prog_h[p].layer;
#define LK(K) case K: hipLaunchKernelGGL(k_one<K>, dim3(grid), dim3(NTH), LDS_BYTES, stream, a, l); break;
        switch (prog_h[p].kind) { LK(PK_PRO) LK(PK_G1A) LK(PK_PRE) LK(PK_G23) LK(PK_MLAPOST) LK(PK_ATT) LK(PK_RGPREP) LK(PK_SCAN) LK(PK_FIN) LK(PK_G1B) LK(PK_MRG) LK(PK_OUT) LK(PK_FGU) LK(PK_FD) LK(PK_MOEA) LK(PK_MOEB) LK(PK_MGU0) LK(PK_MD0) LK(PK_MGU1) LK(PK_MD1) LK(PK_COMB) LK(PK_PP) LK(PK_PG) LK(PK_COUT) default: break; }
#undef LK
    }
#endif
}
```

```cpp
#include <hip/hip_runtime.h>
#include <cstdio>
#include <cstdint>
#ifndef PROBE_SUB
#define PROBE_SUB 0
#endif
__device__ __forceinline__ int otid() { int t = threadIdx.x; asm volatile("" : "+v"(t)); return t; }
__device__ __forceinline__ int obid() { int t = blockIdx.x; asm volatile("" : "+s"(t)); return t; }
__device__ __forceinline__ int ogrid() { int t = gridDim.x; asm volatile("" : "+s"(t)); return t; }
namespace pg8 {
#define PG8_LAS __attribute__((address_space(3)))
typedef unsigned short bf16_t;
typedef short bf16x8 __attribute__((ext_vector_type(8)));
typedef float f32x4 __attribute__((ext_vector_type(4)));
typedef unsigned u32x4 __attribute__((ext_vector_type(4)));
typedef unsigned u32x2 __attribute__((ext_vector_type(2)));
constexpr int BM = 256, BK = 64, HALF = 128, HTB = HALF * BK * 2, STAGE_BYTES = 8 * HTB, NXCD = 8, WGM = 8;

__host__ __device__ __forceinline__ int lds_byte(int r, int c) { const int st = (r >> 4) * 2 + (c >> 5), rr = r & 15, cc = c & 31, ob = rr * 64 + cc * 2; return st * 1024 + (ob ^ (((ob >> 9) & 1) << 5)); }
__host__ __device__ __forceinline__ void stage_rc(int b, int& R, int& C) { const int st = b / 1024, sb = b % 1024, swz = sb ^ (((sb >> 9) & 1) << 5); R = (st >> 1) * 16 + swz / 64; C = (st & 1) * 32 + (swz % 64) / 2; }
__host__ __device__ __forceinline__ int perm32(int rho) { const int n = rho >> 4, i = rho & 15; return 8 * (i >> 2) + 4 * n + (i & 3); }

struct Unit { int pm, pn, pb; };
struct Gemm { const bf16_t* A; const bf16_t* Bt; int K, lda, ldb; };

struct StaticOrder {
    int nM, nN, nwg, G, c, pm0; const int* blk_e;
    __device__ void init(int nM_, int nN_, int G_, int c_, int pm0_ = 0, const int* blk_e_ = nullptr) { nM = nM_; nN = nN_; nwg = nM * nN; G = G_; c = c_; pm0 = pm0_; blk_e = blk_e_; }
    __device__ bool next(int i, Unit& u) const {
        const long L = (long)i * G + c; if (L >= nwg) return false;
        int wgid = (int)L; { const int q = nwg / NXCD, r = nwg % NXCD, xcd = wgid % NXCD, off = wgid / NXCD; wgid = (xcd < r ? xcd * (q + 1) : r * (q + 1) + (xcd - r) * q) + off; }
        const int nig = WGM * nN, gid = wgid / nig, fm = gid * WGM, gsz = (nM - fm) < WGM ? (nM - fm) : WGM;
        u.pm = pm0 + fm + ((wgid % nig) % gsz); u.pn = (wgid % nig) / gsz;
        u.pb = blk_e ? (__builtin_amdgcn_readfirstlane(blk_e[u.pm]) * nN + u.pn) : u.pn;
        return true;
    }
};

typedef float cvt_f32x2 __attribute__((ext_vector_type(2)));
typedef __bf16 cvt_bf16x2 __attribute__((ext_vector_type(2)));
__device__ __forceinline__ unsigned cvt_pk_bf16(float lo, float hi) { const cvt_f32x2 v = {lo, hi}; return __builtin_bit_cast(unsigned, __builtin_convertvector(v, cvt_bf16x2)); }

template <class Epi, class Sched>
__device__ __forceinline__ void gemm_phase(PG8_LAS unsigned char* lds, const Gemm g, const Sched& S, const Epi& E) {
    const int tid = otid(), wid = __builtin_amdgcn_readfirstlane(tid >> 6), lane = tid & 63, wr = wid >> 2, wc = wid & 3, fr = lane & 15, fq = lane >> 4;
    const int K = g.K, nt = K / BK;
    unsigned voffA[2], voffB[2];
#pragma unroll
    for (int i = 0; i < 2; ++i) { int R, C; stage_rc(tid * 16 + i * 8192, R, C); const int Rb = Epi::PERM ? ((R & ~31) + perm32(R & 31)) : R;
        voffA[i] = (unsigned)(R * g.lda + C) * 2u; voffB[i] = (unsigned)(Rb * g.ldb + C) * 2u; }
    const size_t kstep = (size_t)(BK * 2);
    const size_t hA = (size_t)HALF * g.lda * 2, hB = (size_t)HALF * g.ldb * 2;
    const size_t tA = 2 * hA, tB = 2 * hB;
    const unsigned ldsw = (unsigned)wid * 1024u;
    const int aoff = lds_byte(wr * 64 + fr, fq * 8), boff = lds_byte(wc * 32 + fr, fq * 8);
#define PG8_SA(b, h) (((b) * 2 + (h)) * HTB)
#define PG8_SB(b, h) ((4 + (b) * 2 + (h)) * HTB)
#define PG8_STAGE(bufoff, gbase, voff) do { _Pragma("unroll") for (int _i = 0; _i < 2; ++_i) \
        __builtin_amdgcn_global_load_lds((const unsigned*)((const char*)(gbase) + (voff)[_i]), (PG8_LAS unsigned*)(lds + (bufoff) + ldsw + _i * 8192), 16, 0, 0); } while (0)
#define PG8_LDA(dst, b, h) do { _Pragma("unroll") for (int m = 0; m < 4; ++m) _Pragma("unroll") for (int k = 0; k < 2; ++k) dst[m][k] = *(const PG8_LAS bf16x8*)(lds + PG8_SA(b, h) + aoff + m * 2048 + k * 1024); } while (0)
#define PG8_LDB(dst, b, h) do { _Pragma("unroll") for (int n = 0; n < 2; ++n) _Pragma("unroll") for (int k = 0; k < 2; ++k) dst[n][k] = *(const PG8_LAS bf16x8*)(lds + PG8_SB(b, h) + boff + n * 2048 + k * 1024); } while (0)
#define PG8_MMA(ai, bj, At, Bt) do { __builtin_amdgcn_s_setprio(1); _Pragma("unroll") for (int m = 0; m < 4; ++m) _Pragma("unroll") for (int n = 0; n < 2; ++n) _Pragma("unroll") for (int k = 0; k < 2; ++k) \
        acc[ai][bj][m][n] = __builtin_amdgcn_mfma_f32_16x16x32_bf16(Bt[n][k], At[m][k], acc[ai][bj][m][n], 0, 0, 0); __builtin_amdgcn_s_setprio(0); } while (0)
#define PG8_WAIT_V(n) asm volatile("s_waitcnt vmcnt(" #n ")" ::: "memory")
#define PG8_WAIT_L(n) asm volatile("s_waitcnt lgkmcnt(" #n ")" ::: "memory")
#define PG8_BAR __builtin_amdgcn_s_barrier()
#define PG8_SCHED __builtin_amdgcn_sched_barrier(0)
    Unit cur, nxt; int ui = 0;
    if (!S.next(0, cur)) return;
    f32x4 acc[2][2][4][2];
#pragma unroll
    for (int a = 0; a < 2; ++a)
#pragma unroll
        for (int b = 0; b < 2; ++b)
#pragma unroll
            for (int m = 0; m < 4; ++m)
#pragma unroll
                for (int n = 0; n < 2; ++n) acc[a][b][m][n] = (f32x4){0.f, 0.f, 0.f, 0.f};
    bf16x8 At[4][2], B0[2][2], B1[2][2];
    const char* cA = (const char*)g.A + (size_t)cur.pm * tA; const char* cB = (const char*)g.Bt + (size_t)cur.pb * tB;
    PG8_STAGE(PG8_SB(0, 0), cB, voffB); PG8_STAGE(PG8_SB(0, 1), cB + hB, voffB); PG8_STAGE(PG8_SA(0, 0), cA, voffA); PG8_STAGE(PG8_SA(0, 1), cA + hA, voffA);
    if (wr == 1) PG8_BAR;
    PG8_WAIT_V(2); PG8_BAR;
    PG8_STAGE(PG8_SB(1, 0), cB + kstep, voffB); PG8_STAGE(PG8_SA(1, 0), cA + kstep, voffA); PG8_STAGE(PG8_SB(1, 1), cB + hB + kstep, voffB);
    PG8_WAIT_V(6); PG8_BAR;
    for (;;) {
        const bool has_next = S.next(ui + 1, nxt);
        const char* nA = has_next ? (const char*)g.A + (size_t)nxt.pm * tA : cA; const char* nB = has_next ? (const char*)g.Bt + (size_t)nxt.pb * tB : cB;
        for (int t = 0; t < nt; t += 2) {
            const bool last = (t == nt - 2);
            const char* a1 = cA + (size_t)(t + 1) * kstep;
            const char* a2 = last ? nA : cA + (size_t)(t + 2) * kstep; const char* b2 = last ? nB : cB + (size_t)(t + 2) * kstep;
            const char* a3 = a2 + kstep; const char* b3 = b2 + kstep;
            PG8_LDB(B0, 0, 0); PG8_LDB(B1, 0, 1); PG8_SCHED; PG8_LDA(At, 0, 0); PG8_STAGE(PG8_SA(1, 1), a1 + hA, voffA);
            PG8_WAIT_V(8); PG8_WAIT_L(0); PG8_BAR; PG8_MMA(0, 0, At, B0); PG8_MMA(0, 1, At, B1); PG8_BAR; PG8_SCHED;
            PG8_LDA(At, 0, 1); PG8_STAGE(PG8_SB(0, 0), b2, voffB); PG8_STAGE(PG8_SB(0, 1), b2 + hB, voffB); PG8_STAGE(PG8_SA(0, 0), a2, voffA);
            PG8_WAIT_V(8); PG8_WAIT_L(0); PG8_BAR; PG8_MMA(1, 0, At, B0); PG8_MMA(1, 1, At, B1); PG8_BAR; PG8_SCHED;
            PG8_LDB(B0, 1, 0); PG8_LDB(B1, 1, 1); PG8_SCHED; PG8_LDA(At, 1, 0); PG8_STAGE(PG8_SA(0, 1), a2 + hA, voffA);
            PG8_WAIT_V(8); PG8_WAIT_L(0); PG8_BAR; PG8_MMA(0, 0, At, B0); PG8_MMA(0, 1, At, B1); PG8_BAR; PG8_SCHED;
            PG8_LDA(At, 1, 1); PG8_STAGE(PG8_SB(1, 0), b3, voffB); PG8_STAGE(PG8_SB(1, 1), b3 + hB, voffB); PG8_STAGE(PG8_SA(1, 0), a3, voffA);
            PG8_WAIT_V(8); PG8_WAIT_L(0); PG8_BAR; PG8_MMA(1, 0, At, B0); PG8_MMA(1, 1, At, B1); PG8_BAR; PG8_SCHED;
        }
        if (wr == 0) PG8_BAR;
        E(acc, cur, wr, wc, fr, fq);
        if (!has_next) break;
#pragma unroll
        for (int a = 0; a < 2; ++a)
#pragma unroll
            for (int b = 0; b < 2; ++b)
#pragma unroll
                for (int m = 0; m < 4; ++m)
#pragma unroll
                    for (int n = 0; n < 2; ++n) acc[a][b][m][n] = (f32x4){0.f, 0.f, 0.f, 0.f};
        cur = nxt; cA = nA; cB = nB; ++ui;
        if (wr == 1) PG8_BAR;
    }
    PG8_WAIT_V(0);
    PG8_BAR;
#undef PG8_SA
#undef PG8_SB
#undef PG8_STAGE
#undef PG8_LDA
#undef PG8_LDB
#undef PG8_MMA
#undef PG8_WAIT_V
#undef PG8_WAIT_L
#undef PG8_BAR
#undef PG8_SCHED
}
}
#define GAS __attribute__((address_space(1)))
#define LAS __attribute__((address_space(3)))
typedef unsigned short bf16;
typedef float f32x4 __attribute__((ext_vector_type(4)));
typedef float f32x2 __attribute__((ext_vector_type(2)));
typedef float f32x16 __attribute__((ext_vector_type(16)));
typedef short bf16x8 __attribute__((ext_vector_type(8)));
typedef unsigned u32x4 __attribute__((ext_vector_type(4)));
typedef unsigned u32x2 __attribute__((ext_vector_type(2)));

constexpr int NB = 4, SEQ = 4096, T = NB * SEQ, D = 1024, NL = 2;
constexpr int NH = 8, HD = 64, HW = 512;
constexpr int N_IN = 7344, FFD = 2816, FFE = 3584, NE = 8, PLE = 256;
constexpr int N1 = 4352, NZR = 1792, NZQ = 1536, NZG = 512, NZM = 512, NGATE = 3072;
constexpr int K2 = 512, N2 = 1792, K3 = 384, N3 = 2048;
constexpr int QKD = 96;
constexpr int NBLK_MAX = 136, HALF_BLK = 68;
constexpr float NORM_EPS = 1e-6f;
constexpr int NTH = 512, NWV = 8;

constexpr size_t MiB = 1u << 20;
constexpr size_t WS_CTL = 0;
constexpr size_t WS_W = 2 * MiB;
constexpr size_t WS_HB = 73 * MiB;
constexpr size_t WS_PB = 105 * MiB;
constexpr size_t WS_VF = 121 * MiB;
constexpr size_t WS_S = 137 * MiB;
constexpr size_t WS_END = 553 * MiB;
constexpr size_t S_ZR = WS_S + 0 * MiB, S_ZQ = WS_S + 56 * MiB, S_ZG = WS_S + 104 * MiB, S_ZM = WS_S + 120 * MiB;
constexpr size_t S_A2 = WS_S + 136 * MiB, S_L2 = WS_S + 148 * MiB;
constexpr size_t S_QRAW = WS_S + 212 * MiB, S_KVRAW = WS_S + 236 * MiB, S_Q = WS_S + 268 * MiB, S_K = WS_S + 292 * MiB, S_VT = WS_S + 316 * MiB, S_OB = WS_S + 332 * MiB;
constexpr size_t S_RR = WS_S + 212 * MiB, S_RK = WS_S + 228 * MiB, S_RV = WS_S + 244 * MiB, S_RA = WS_S + 260 * MiB, S_RB = WS_S + 276 * MiB, S_RW = WS_S + 292 * MiB, S_RG = WS_S + 348 * MiB;
constexpr size_t S_GQ = WS_S + 364 * MiB, S_GK = WS_S + 380 * MiB, S_GV = WS_S + 396 * MiB, S_GAL = WS_S + 412 * MiB, S_GBE = WS_S + 412 * MiB + 524288;
constexpr size_t S_YA = WS_S + 148 * MiB, S_YC = WS_S + 164 * MiB, S_OA = WS_S + 212 * MiB, S_OC = WS_S + 228 * MiB;
constexpr size_t S_ZS = WS_S + 0 * MiB, S_M = WS_S + 348 * MiB;
constexpr size_t S_CMR = WS_S + 0 * MiB, S_S0R = WS_S + 64 * MiB, S_CMG = WS_S + 120 * MiB, S_S0G = WS_S + 184 * MiB;
constexpr size_t S_ACT = WS_S + 0 * MiB;
constexpr size_t S_MWGU = WS_S + 0 * MiB;
constexpr size_t S_MWD = WS_S + 112 * MiB;
constexpr size_t S_XG = WS_S + 168 * MiB;
constexpr size_t S_MACT = WS_S + 237 * MiB;
constexpr size_t S_E = WS_S + 358 * MiB;
constexpr size_t S_SSP0 = WS_S + 413 * MiB, S_SSP1 = WS_S + 414 * MiB, S_SSP2 = WS_S + 415 * MiB;
static_assert(S_SSP2 + MiB <= WS_END, "ws map");
static_assert(S_E + 32 * MiB <= WS_END, "ws map");
static_assert(S_MACT + (size_t)HALF_BLK * 256 * FFE * 2 <= S_E, "ws map");
static_assert(S_XG + (size_t)NBLK_MAX * 256 * D * 2 <= S_MACT, "ws map");
static_assert(S_GBE + 524288 <= WS_END, "ws map");

constexpr size_t WL = 41 * MiB;
constexpr size_t W_IN = 0, W_GATE = 9 * MiB, W_2 = 15 * MiB, W_3 = 17 * MiB, W_BRA = 19 * MiB, W_BRB = 20 * MiB, W_BRC = 21 * MiB, W_OUT = 22 * MiB;
constexpr size_t W_FGU = 24 * MiB, W_FD = 35 * MiB;
constexpr size_t W_PLE = 65 * MiB, WPL = 2 * MiB + 524288, W_PP = 0, W_PG = 524288;
static_assert(W_FD + (size_t)D * FFD * 2 <= WL && W_PLE + 2 * WPL <= 71 * MiB, "w map");
constexpr size_t WS_HB2 = WS_W;
constexpr size_t CTL_ZERO = 512 * 1024;
constexpr size_t C_BAR = 0;
constexpr size_t C_MOE = 16384;
constexpr size_t C_SS = 65536;
constexpr size_t C_RSQ = 512 * 1024, C_RSKV = C_RSQ + 65536;
constexpr size_t C_SEL = C_RSKV + 65536;
constexpr size_t C_WTS = C_SEL + 131072;
constexpr size_t C_RANK = C_WTS + 131072;
constexpr size_t C_DEST = C_RANK + 131072;
constexpr size_t C_RSX = C_DEST + 131072;
constexpr size_t C_BLKE = C_RSX + 139264;
constexpr size_t C_RS1 = C_BLKE + 1024;
constexpr size_t C_BSC = C_RS1 + 65536;
static_assert(C_BSC + 524288 <= 2 * MiB, "ctl map");

__device__ __forceinline__ float bf2f(unsigned v) { return __uint_as_float(v << 16); }
__device__ __forceinline__ unsigned f2bf(float f) { return pg8::cvt_pk_bf16(f, f) & 0xffffu; }
__device__ __forceinline__ unsigned pk2(float lo, float hi) { return pg8::cvt_pk_bf16(lo, hi); }
__device__ __forceinline__ float wave_sum(float v) {
#pragma unroll
    for (int o = 1; o < 64; o <<= 1) v += __shfl_xor(v, o);
    return v;
}
__device__ __forceinline__ float sigmoidf_(float x) { return __builtin_amdgcn_rcpf(1.f + __builtin_amdgcn_exp2f(-1.4426950408889634f * x)); }
__device__ __forceinline__ float sigmoid_fast_(float x) { return __builtin_amdgcn_rcpf(1.f + __builtin_amdgcn_exp2f(-1.4426950408889634f * x)); }
__device__ __forceinline__ float siluf_(float x) { return x * __builtin_amdgcn_rcpf(1.f + __builtin_amdgcn_exp2f(-1.4426950408889634f * x)); }
__device__ __forceinline__ float softplusf_(float x) { return fmaxf(x, 0.f) + log1pf(__expf(-fabsf(x))); }

struct Args { const void* in[45]; float* out; unsigned char* ws; int layer; int pad; };
typedef const void* gptr_t;
typedef const __attribute__((address_space(4))) gptr_t* kin_t;
struct PArgs { kin_t in; float* out; unsigned char* ws; };
__device__ __forceinline__ PArgs make_pargs(const Args& a) {
    PArgs p; p.in = (kin_t)__builtin_amdgcn_kernarg_segment_ptr();
    GAS float* o1 = (GAS float*)a.out; GAS unsigned char* w1 = (GAS unsigned char*)a.ws;
    asm volatile("" : "+s"(p.in), "+s"(o1), "+s"(w1)); p.out = (float*)o1; p.ws = (unsigned char*)w1; return p; }
#define INF(i) ((const float*)(const GAS float*)a.in[i])
#define EPI_ARGS const pg8::f32x4 (&acc)[2][2][4][2], const pg8::Unit& u, int wr, int wc, int fr, int fq
#define EPI_ROWS _Pragma("unroll") for (int ai = 0; ai < 2; ++ai) _Pragma("unroll") for (int m = 0; m < 4; ++m)
__device__ __forceinline__ u32x4 pack8(const f32x4 v0, const f32x4 v1) { u32x4 w; w.x = pg8::cvt_pk_bf16(v0[0], v0[1]); w.y = pg8::cvt_pk_bf16(v0[2], v0[3]); w.z = pg8::cvt_pk_bf16(v1[0], v1[1]); w.w = pg8::cvt_pk_bf16(v1[2], v1[3]); return w; }
__device__ __forceinline__ void unpack8(const u32x4 w, float (&f)[8]) { f[0] = bf2f(w.x & 0xffffu); f[1] = bf2f(w.x >> 16); f[2] = bf2f(w.y & 0xffffu); f[3] = bf2f(w.y >> 16); f[4] = bf2f(w.z & 0xffffu); f[5] = bf2f(w.z >> 16); f[6] = bf2f(w.w & 0xffffu); f[7] = bf2f(w.w >> 16); }

__device__ __forceinline__ float rowscale16(const float* ssp, int r) { const f32x4* p = (const f32x4*)(ssp + (size_t)r * 16); const f32x4 a = p[0], b = p[1], c = p[2], d = p[3];
    const float s = ((a[0] + a[1]) + (a[2] + a[3])) + ((b[0] + b[1]) + (b[2] + b[3])) + ((c[0] + c[1]) + (c[2] + c[3])) + ((d[0] + d[1]) + (d[2] + d[3])); return rsqrtf(s * (1.f / D) + NORM_EPS); }
__device__ __forceinline__ void rowscales16(const float* ssp, int row0, float (&s)[2][4]) {
#pragma unroll
    for (int ai = 0; ai < 2; ++ai)
#pragma unroll
        for (int mp = 0; mp < 2; ++mp) { f32x4 p[2][4];
#pragma unroll
            for (int mm = 0; mm < 2; ++mm) { const f32x4* q = (const f32x4*)(ssp + (size_t)(row0 + ai * 128 + (2 * mp + mm) * 16) * 16); p[mm][0] = q[0]; p[mm][1] = q[1]; p[mm][2] = q[2]; p[mm][3] = q[3]; }
#pragma unroll
            for (int mm = 0; mm < 2; ++mm) { const float t = ((p[mm][0][0] + p[mm][0][1]) + (p[mm][0][2] + p[mm][0][3])) + ((p[mm][1][0] + p[mm][1][1]) + (p[mm][1][2] + p[mm][1][3])) + ((p[mm][2][0] + p[mm][2][1]) + (p[mm][2][2] + p[mm][2][3])) + ((p[mm][3][0] + p[mm][3][1]) + (p[mm][3][2] + p[mm][3][3]));
                s[ai][2 * mp + mm] = rsqrtf(t * (1.f / D) + NORM_EPS); } }
}
__device__ __forceinline__ void rowvals(const float* rs, int row0, float (&s)[2][4]) {
#pragma unroll
    for (int ai = 0; ai < 2; ++ai)
#pragma unroll
        for (int m = 0; m < 4; ++m) s[ai][m] = rs[row0 + ai * 128 + m * 16];
}
struct EpiInProj {
    static constexpr bool PERM = true;
    bf16 *zr, *zq, *zg, *zm; const float* ss;
    __device__ __forceinline__ void operator()(EPI_ARGS) const {
        bf16* O; int ld, ct; const int pn = u.pn;
        if (pn < 7) { O = zr; ld = NZR; ct = pn * 256; } else if (pn < 13) { O = zq; ld = NZQ; ct = (pn - 7) * 256; } else if (pn < 15) { O = zg; ld = NZG; ct = (pn - 13) * 256; } else { O = zm; ld = NZM; ct = (pn - 15) * 256; }
        const int row0 = u.pm * 256 + wr * 64 + fr, col0 = ct + wc * 32 + 8 * fq;
        float sv[2][4]; rowscales16(ss, row0, sv);
        EPI_ROWS { const int r = row0 + ai * 128 + m * 16; const float s = sv[ai][m]; bf16* rowp = O + (size_t)r * ld + col0;
#pragma unroll
            for (int bj = 0; bj < 2; ++bj) *(u32x4*)(rowp + bj * 128) = pack8(acc[ai][bj][m][0] * s, acc[ai][bj][m][1] * s); }
    }
};
struct EpiGate {
    static constexpr bool PERM = true;
    bf16* O; const float* ss;
    __device__ __forceinline__ void operator()(EPI_ARGS) const {
        const int row0 = u.pm * 256 + wr * 64 + fr, col0 = u.pn * 256 + wc * 32 + 8 * fq;
        float sv[2][4]; rowscales16(ss, row0, sv);
        EPI_ROWS { const int r = row0 + ai * 128 + m * 16; const float s = sv[ai][m]; bf16* rowp = O + (size_t)r * NGATE + col0;
#pragma unroll
            for (int bj = 0; bj < 2; ++bj) { f32x4 v0 = acc[ai][bj][m][0] * s, v1 = acc[ai][bj][m][1] * s;
#pragma unroll
                for (int j = 0; j < 4; ++j) { v0[j] = sigmoid_fast_(v0[j]); v1[j] = sigmoid_fast_(v1[j]); }
                *(u32x4*)(rowp + bj * 128) = pack8(v0, v1); } }
    }
};
struct EpiMla {
    static constexpr bool PERM = true;
    bf16 *qraw, *kvraw; const float *rsq, *rskv;
    __device__ __forceinline__ void operator()(EPI_ARGS) const {
        const bool isq = u.pn < 3; bf16* O = isq ? qraw : kvraw; const int ld = isq ? 768 : 1024, ct = isq ? u.pn * 256 : (u.pn - 3) * 256; const float* rs = isq ? rsq : rskv;
        const int row0 = u.pm * 256 + wr * 64 + fr, col0 = ct + wc * 32 + 8 * fq;
        float sv[2][4]; rowvals(rs, row0, sv);
        EPI_ROWS { const int r = row0 + ai * 128 + m * 16; const float s = sv[ai][m]; bf16* rowp = O + (size_t)r * ld + col0;
#pragma unroll
            for (int bj = 0; bj < 2; ++bj) *(u32x4*)(rowp + bj * 128) = pack8(acc[ai][bj][m][0] * s, acc[ai][bj][m][1] * s); }
    }
};
struct EpiPlain {
    static constexpr bool PERM = true;
    bf16* O; int ld;
    __device__ __forceinline__ void operator()(EPI_ARGS) const {
        const int row0 = u.pm * 256 + wr * 64 + fr, col0 = u.pn * 256 + wc * 32 + 8 * fq;
        EPI_ROWS { const int r = row0 + ai * 128 + m * 16; bf16* rowp = O + (size_t)r * ld + col0;
#pragma unroll
            for (int bj = 0; bj < 2; ++bj) *(u32x4*)(rowp + bj * 128) = pack8(acc[ai][bj][m][0], acc[ai][bj][m][1]); }
    }
};
template <bool FIRST> struct EpiMerge {
    static constexpr bool PERM = true;
    bf16* M; const bf16* zs; int br;
    __device__ __forceinline__ void operator()(EPI_ARGS) const {
        const int row0 = u.pm * 256 + wr * 64 + fr, col0 = u.pn * 256 + wc * 32 + 8 * fq;
#pragma unroll
        for (int ai = 0; ai < 2; ++ai) { u32x4 gv[4][2], mv[4][2];
#pragma unroll
            for (int m = 0; m < 4; ++m)
#pragma unroll
                for (int bj = 0; bj < 2; ++bj) { const int r = row0 + ai * 128 + m * 16, c = col0 + bj * 128; gv[m][bj] = *(const u32x4*)(zs + (size_t)r * NGATE + br * 1024 + c); if (!FIRST) mv[m][bj] = *(const u32x4*)(M + (size_t)r * D + c); }
#pragma unroll
            for (int m = 0; m < 4; ++m)
#pragma unroll
                for (int bj = 0; bj < 2; ++bj) { const int r = row0 + ai * 128 + m * 16, c = col0 + bj * 128; float g[8], o[8]; unpack8(gv[m][bj], g); if (!FIRST) unpack8(mv[m][bj], o);
                    f32x4 v0, v1;
#pragma unroll
                    for (int j = 0; j < 4; ++j) { v0[j] = g[j] * acc[ai][bj][m][0][j] + (FIRST ? 0.f : o[j]); v1[j] = g[4 + j] * acc[ai][bj][m][1][j] + (FIRST ? 0.f : o[4 + j]); }
                    *(u32x4*)(M + (size_t)r * D + c) = pack8(v0, v1); }
            asm volatile("" ::: "memory"); }
    }
};
struct EpiResid {
    static constexpr bool PERM = false;
    const float* basef; const bf16* baseb; bf16* hb; float* ss;
    __device__ __forceinline__ void operator()(EPI_ARGS) const {
        const int row0 = u.pm * 256 + wr * 64 + fr, col0 = u.pn * 256 + wc * 32 + 4 * fq;
#pragma unroll
        for (int ai = 0; ai < 2; ++ai) { f32x4 bv[4][2][2];
#pragma unroll
            for (int m = 0; m < 4; ++m)
#pragma unroll
                for (int bj = 0; bj < 2; ++bj)
#pragma unroll
                    for (int n = 0; n < 2; ++n) { const size_t off = (size_t)(row0 + ai * 128 + m * 16) * D + col0 + bj * 128 + n * 16;
                        if (basef) bv[m][bj][n] = *(const f32x4*)(basef + off);
                        else { const u32x2 w = *(const u32x2*)(baseb + off); bv[m][bj][n] = (f32x4){bf2f(w.x & 0xffffu), bf2f(w.x >> 16), bf2f(w.y & 0xffffu), bf2f(w.y >> 16)}; } }
#pragma unroll
            for (int m = 0; m < 4; ++m) { const int r = row0 + ai * 128 + m * 16; float sq = 0.f;
#pragma unroll
                for (int bj = 0; bj < 2; ++bj)
#pragma unroll
                    for (int n = 0; n < 2; ++n) { const size_t off = (size_t)r * D + col0 + bj * 128 + n * 16; f32x4 h = bv[m][bj][n]; h += acc[ai][bj][m][n];
                        u32x2 w; w.x = pg8::cvt_pk_bf16(h[0], h[1]); w.y = pg8::cvt_pk_bf16(h[2], h[3]); *(u32x2*)(hb + off) = w; sq += (h[0] * h[0] + h[1] * h[1]) + (h[2] * h[2] + h[3] * h[3]); }
                if (ss) { sq += __shfl_xor(sq, 16); sq += __shfl_xor(sq, 32); if (fq == 0) ss[(size_t)r * 16 + u.pn * 4 + wc] = sq; } }
            asm volatile("" ::: "memory"); }
    }
};
template <bool MOE> struct EpiSwiglu {
    static constexpr bool PERM = true;
    bf16* O; int ld; const float* rs;
    __device__ __forceinline__ void operator()(EPI_ARGS) const {
        const int row0 = u.pm * 256 + wr * 64 + fr, col0 = u.pn * 128 + wc * 32 + 8 * fq;
        float sv[2][4]; if (MOE) rowvals(rs, row0, sv); else rowscales16(rs, row0, sv);
        EPI_ROWS { const int r = row0 + ai * 128 + m * 16; const float s = sv[ai][m];
            f32x4 v0, v1;
#pragma unroll
            for (int j = 0; j < 4; ++j) { v0[j] = siluf_(acc[ai][0][m][0][j] * s) * (acc[ai][1][m][0][j] * s); v1[j] = siluf_(acc[ai][0][m][1][j] * s) * (acc[ai][1][m][1][j] * s); }
            *(u32x4*)(O + (size_t)r * ld + col0) = pack8(v0, v1); }
    }
};
struct EpiPleProj {
    static constexpr bool PERM = true;
    bf16* O; float* sse;
    __device__ __forceinline__ void operator()(EPI_ARGS) const {
        const int row0 = u.pm * 256 + wr * 64 + fr, col0 = u.pn * 256 + wc * 32 + 8 * fq;
        EPI_ROWS { const int r = row0 + ai * 128 + m * 16; float sq = 0.f;
#pragma unroll
            for (int bj = 0; bj < 2; ++bj) { const f32x4 v0 = acc[ai][bj][m][0], v1 = acc[ai][bj][m][1]; *(u32x4*)(O + (size_t)r * D + col0 + bj * 128) = pack8(v0, v1);
                sq += (v0[0] * v0[0] + v0[1] * v0[1]) + (v0[2] * v0[2] + v0[3] * v0[3]) + (v1[0] * v1[0] + v1[1] * v1[1]) + (v1[2] * v1[2] + v1[3] * v1[3]); }
            sq += __shfl_xor(sq, 16); sq += __shfl_xor(sq, 32); if (fq == 0) sse[(size_t)r * 16 + u.pn * 4 + wc] = sq; }
    }
};
struct EpiPleGate {
    static constexpr bool PERM = false;
    float* out; const bf16* hin; bf16* hbn; const bf16* E; const float* sse; const float* png; float* ssn;
    __device__ __forceinline__ void operator()(EPI_ARGS) const {
        const int row0 = u.pm * 256 + wr * 64 + fr, col0 = u.pn * 256 + wc * 32 + 4 * fq;
        EPI_ROWS { const int r = row0 + ai * 128 + m * 16; float sq = 0.f; const float se = rowscale16(sse, r);
#pragma unroll
            for (int bj = 0; bj < 2; ++bj)
#pragma unroll
                for (int n = 0; n < 2; ++n) { const int c = col0 + bj * 128 + n * 16; const size_t off = (size_t)r * D + c; const u32x2 hw = *(const u32x2*)(hin + off);
                    f32x4 h = (f32x4){bf2f(hw.x & 0xffffu), bf2f(hw.x >> 16), bf2f(hw.y & 0xffffu), bf2f(hw.y >> 16)};
                    const u32x2 ew = *(const u32x2*)(E + off); const f32x4 g = *(const f32x4*)(png + c);
                    const float e0 = bf2f(ew.x & 0xffffu), e1 = bf2f(ew.x >> 16), e2 = bf2f(ew.y & 0xffffu), e3 = bf2f(ew.y >> 16);
                    const f32x4 a4 = acc[ai][bj][m][n];
                    h[0] += sigmoidf_(a4[0]) * (e0 * se * g[0]); h[1] += sigmoidf_(a4[1]) * (e1 * se * g[1]); h[2] += sigmoidf_(a4[2]) * (e2 * se * g[2]); h[3] += sigmoidf_(a4[3]) * (e3 * se * g[3]);
                    if (out) *(f32x4*)(out + off) = h;
                    if (hbn) { u32x2 w; w.x = pg8::cvt_pk_bf16(h[0], h[1]); w.y = pg8::cvt_pk_bf16(h[2], h[3]); *(u32x2*)(hbn + off) = w; }
                    sq += (h[0] * h[0] + h[1] * h[1]) + (h[2] * h[2] + h[3] * h[3]); }
            if (ssn) { sq += __shfl_xor(sq, 16); sq += __shfl_xor(sq, 32); if (fq == 0) ssn[(size_t)r * 16 + u.pn * 4 + wc] = sq; } }
    }
};
struct TJob { int src, src_off, K, ldn, n0, ncnt; int dst_off, dst_ld, dst_k0, dst_row0, rowmode; int gain, gain_off, gain2, gain2_off, g2mode; };
#define WOFF(l, o) ((int)((l) * WL + (o)))
#define LAYER_JOBS(l) \
    {4, (l) * D * N_IN, D, N_IN, 0, 1792, WOFF(l, W_IN), D, 0, 0, 0, 3, (l) * D, -1, 0, 0}, \
    {4, (l) * D * N_IN, D, N_IN, 2208, 1536, WOFF(l, W_IN), D, 0, 1792, 0, 3, (l) * D, -1, 0, 0}, \
    {4, (l) * D * N_IN, D, N_IN, 3760, 512, WOFF(l, W_IN), D, 0, 3328, 0, 3, (l) * D, -1, 0, 0}, \
    {4, (l) * D * N_IN, D, N_IN, 1792, 416, WOFF(l, W_IN), D, 0, 3840, 0, 3, (l) * D, -1, 0, 0}, \
    {4, (l) * D * N_IN, D, N_IN, 3744, 16, WOFF(l, W_IN), D, 0, 3840 + 416, 0, 3, (l) * D, -1, 0, 0}, \
    {4, (l) * D * N_IN, D, N_IN, 4272, 3072, WOFF(l, W_GATE), D, 0, 0, 0, 3, (l) * D, -1, 0, 0}, \
    {7, (l) * 64 * 512, 64, 512, 0, 512, WOFF(l, W_3), K3, 0, 0, 0, -1, 0, -1, 0, 0}, \
    {9, (l) * 64 * 512, 64, 512, 0, 512, WOFF(l, W_3), K3, 64, 512, 0, -1, 0, -1, 0, 0}, \
    {10, (l) * 128 * 512, 128, 512, 0, 512, WOFF(l, W_3), K3, 128, 1024, 0, -1, 0, -1, 0, 0}, \
    {22, (l) * 256 * 768, 256, 768, 0, 768, WOFF(l, W_2), K2, 0, 0, 0, 20, (l) * 256, -1, 0, 0}, \
    {23, (l) * 128 * 1024, 128, 1024, 0, 1024, WOFF(l, W_2), K2, 256, 768, 0, 21, (l) * 128, -1, 0, 0}, \
    {30, (l) * 512 * 1024, 512, 1024, 0, 1024, WOFF(l, W_BRA), 512, 0, 0, 0, -1, 0, -1, 0, 0}, \
    {31, (l) * 512 * 1024, 512, 1024, 0, 1024, WOFF(l, W_BRB), 512, 0, 0, 0, -1, 0, -1, 0, 0}, \
    {32, (l) * 512 * 1024, 512, 1024, 0, 1024, WOFF(l, W_BRC), 512, 0, 0, 0, -1, 0, -1, 0, 0}, \
    {33, (l) * D * D, D, D, 0, D, WOFF(l, W_OUT), D, 0, 0, 0, -1, 0, -1, 0, 0}, \
    {42, (l) * PLE * D, PLE, D, 0, D, (int)(W_PLE + (l) * WPL + W_PP), PLE, 0, 0, 0, -1, 0, -1, 0, 0}, \
    {43, (l) * D * D, D, D, 0, D, (int)(W_PLE + (l) * WPL + W_PG), D, 0, 0, 0, -1, 0, -1, 0, 0}
__constant__ TJob g_jobs[] = {
    LAYER_JOBS(0), LAYER_JOBS(1),
    {17, 0, D, 32, 0, 32, WOFF(1, W_IN), D, 0, 3840 + 432, 0, 3, 1 * D, 16, 0, 1},
    {17, 0, D, 32, 0, 32, WOFF(1, W_IN), D, 0, 3840 + 464, 0, 3, 1 * D, 16, 0, 2},
    {18, 0, 32, 512, 0, 512, WOFF(1, W_3), K3, 256, 1536, 0, -1, 0, -1, 0, 0},
    {35, 0, D, FFD, 0, FFD, (int)W_FGU, D, 0, 0, 1, 34, 0, -1, 0, 0},
    {36, 0, D, FFD, 0, FFD, (int)W_FGU, D, 0, 0, 2, 34, 0, -1, 0, 0},
    {37, 0, FFD, D, 0, D, (int)W_FD, FFD, 0, 0, 0, -1, 0, -1, 0, 0},
};
constexpr int NJOBS = sizeof(g_jobs) / sizeof(TJob);

__device__ __forceinline__ void tr_load(const PArgs& a, const TJob& j, int item, int lane, float (&v)[32], float (&gn)[8]) {
    const float* W = INF(j.src) + j.src_off;
    const int nblk = (j.ncnt + 31) / 32, kb = item / nblk, nb = item % nblk, k0 = 64 * kb, nl0 = 32 * nb;
    const int nl = nl0 + (lane & 31);
#pragma unroll
    for (int i = 0; i < 32; ++i) { const int k = k0 + 2 * i + (lane >> 5); v[i] = (k < j.K && nl < j.ncnt) ? W[(size_t)k * j.ldn + j.n0 + nl] : 0.f; }
    const int c = lane & 7;
#pragma unroll
    for (int e = 0; e < 8; ++e) gn[e] = 1.f;
    if (k0 + 8 * c < j.K) {
        if (j.gain >= 0) { const float* G1 = INF(j.gain) + j.gain_off + k0 + 8 * c; const f32x4 g0 = *(const f32x4*)G1, g1 = *(const f32x4*)(G1 + 4);
#pragma unroll
            for (int e = 0; e < 4; ++e) { gn[e] = g0[e]; gn[4 + e] = g1[e]; } }
        if (j.gain2 >= 0) { const float* G2 = INF(j.gain2) + j.gain2_off + k0 + 8 * c; const f32x4 g0 = *(const f32x4*)G2, g1 = *(const f32x4*)(G2 + 4);
#pragma unroll
            for (int e = 0; e < 4; ++e) { gn[e] *= (j.g2mode == 1) ? (1.f - g0[e]) : g0[e]; gn[4 + e] *= (j.g2mode == 1) ? (1.f - g1[e]) : g1[e]; } } }
}
__device__ __forceinline__ void tr_finish(const TJob& j, bf16* dstbase, LAS float* scr, int item, int lane, const float (&v)[32], const float (&gn)[8]) {
    const int nblk = (j.ncnt + 31) / 32, kb = item / nblk, nb = item % nblk, k0 = 64 * kb, nl0 = 32 * nb, c = lane & 7;
#pragma unroll
    for (int i = 0; i < 32; ++i) scr[(2 * i + (lane >> 5)) * 33 + (lane & 31)] = v[i];
    asm volatile("s_waitcnt lgkmcnt(0)" ::: "memory");
    if (k0 + 8 * c < j.K) {
#pragma unroll
        for (int q = 0; q < 4; ++q) { const int nloc = (lane >> 3) + 8 * q, n = nl0 + nloc; if (n < j.ncnt) { const LAS float* s = scr + (8 * c) * 33 + nloc;
            u32x4 o; o.x = pk2(s[0 * 33] * gn[0], s[1 * 33] * gn[1]); o.y = pk2(s[2 * 33] * gn[2], s[3 * 33] * gn[3]); o.z = pk2(s[4 * 33] * gn[4], s[5 * 33] * gn[5]); o.w = pk2(s[6 * 33] * gn[6], s[7 * 33] * gn[7]);
            const int row = j.dst_row0 + (j.rowmode == 0 ? n : (n / 128) * 256 + (n % 128) + (j.rowmode == 2 ? 128 : 0));
            *(u32x4*)(dstbase + (size_t)row * j.dst_ld + j.dst_k0 + k0 + 8 * c) = o; } }
    }
    asm volatile("s_waitcnt lgkmcnt(0)" ::: "memory");
}

__device__ __forceinline__ void phase_prologue(const PArgs& a, LAS unsigned char* lds) {
    const int bidx_ = obid();
    const int tid = otid(), lane = tid & 63, wave = __builtin_amdgcn_readfirstlane(tid >> 6), G = ogrid();
    const int gw = bidx_ * NWV + wave, NGW = G * NWV;
    LAS float* scr = (LAS float*)(lds + wave * 16384);
    { int ji = 0, base = 0, nit = ((g_jobs[0].K + 63) / 64) * ((g_jobs[0].ncnt + 31) / 32);
#define PJ_FIND(it_) do { while (ji < NJOBS && (it_) >= base + nit) { base += nit; ++ji; if (ji < NJOBS) nit = ((g_jobs[ji].K + 63) / 64) * ((g_jobs[ji].ncnt + 31) / 32); } } while (0)
      float v[32], gn[8]; int it = gw; PJ_FIND(it); bool have = ji < NJOBS; TJob jc; int ic = 0;
      if (have) { jc = g_jobs[ji]; ic = it - base; tr_load(a, jc, ic, lane, v, gn); }
      while (have) { const int itn = it + NGW; PJ_FIND(itn); const bool hn = ji < NJOBS; TJob jn; int in_ = 0; float vn[32], gnn[8];
          if (hn) { jn = g_jobs[ji]; in_ = itn - base; tr_load(a, jn, in_, lane, vn, gnn); }
          tr_finish(jc, (bf16*)(a.ws + WS_W + jc.dst_off), scr, ic, lane, v, gn);
          if (hn) { jc = jn; ic = in_;
#pragma unroll
              for (int i = 0; i < 32; ++i) v[i] = vn[i];
#pragma unroll
              for (int e = 0; e < 8; ++e) gn[e] = gnn[e]; }
          have = hn; it = itn; }
#undef PJ_FIND
    }
    const float* x = INF(0); bf16* hb = (bf16*)(a.ws + WS_HB); float* ss0 = (float*)(a.ws + S_SSP0);
    for (int m = gw; m < T; m += NGW) { const f32x4* xr = (const f32x4*)(x + (size_t)m * D) + lane; u32x2* hrow = (u32x2*)(hb + (size_t)m * D) + lane;
        float s = 0.f;
#pragma unroll
        for (int q = 0; q < 4; ++q) { const f32x4 v = xr[64 * q]; u32x2 w; w.x = pk2(v[0], v[1]); w.y = pk2(v[2], v[3]); hrow[64 * q] = w; s += (v[0] * v[0] + v[1] * v[1]) + (v[2] * v[2] + v[3] * v[3]); }
        s = wave_sum(s); if (lane < 16) ss0[(size_t)m * 16 + lane] = lane == 0 ? s : 0.f; }
    const f32x4* p4 = (const f32x4*)INF(1); u32x2* pb = (u32x2*)(a.ws + WS_PB);
    for (size_t i = (size_t)bidx_ * NTH + tid; i < (size_t)NL * T * PLE / 4; i += (size_t)G * NTH) { const f32x4 v = p4[i]; u32x2 w; w.x = pk2(v[0], v[1]); w.y = pk2(v[2], v[3]); pb[i] = w; }
}

__device__ __forceinline__ void phase_moe_cvt(const PArgs& a, LAS unsigned char* lds) {
    const int bidx_ = obid();
    const int tid = otid(), lane = tid & 63, wave = __builtin_amdgcn_readfirstlane(tid >> 6), G = ogrid();
    const int gw = bidx_ * NWV + wave, NGW = G * NWV;
    LAS float* scr = (LAS float*)(lds + wave * 16384);
    constexpr int IT_GU = (D / 64) * (FFE / 32), IT_D = (FFE / 64) * (D / 32);
    constexpr int PER_E = 2 * IT_GU + IT_D;
#define MJ_MAKE(it_, j, item_, dst_) do { const int e_ = (it_) / PER_E; int r_ = (it_) % PER_E; j.gain2 = -1; j.gain2_off = 0; j.g2mode = 0; j.n0 = 0; j.dst_k0 = 0; j.dst_off = 0; \
        if (r_ < 2 * IT_GU) { const int up_ = r_ >= IT_GU; if (up_) r_ -= IT_GU; j.src = up_ ? 40 : 39; j.src_off = e_ * D * FFE; j.K = D; j.ldn = FFE; j.ncnt = FFE; j.dst_ld = D; j.dst_row0 = e_ * 2 * FFE; j.rowmode = up_ ? 2 : 1; j.gain = 34; j.gain_off = D; dst_ = (bf16*)(a.ws + S_MWGU); } \
        else { r_ -= 2 * IT_GU; j.src = 41; j.src_off = e_ * FFE * D; j.K = FFE; j.ldn = D; j.ncnt = D; j.dst_ld = FFE; j.dst_row0 = e_ * D; j.rowmode = 0; j.gain = -1; j.gain_off = 0; dst_ = (bf16*)(a.ws + S_MWD); } item_ = r_; } while (0)
    { float v[32], gn[8]; TJob jc; int ic = 0; bf16* dc = nullptr; int it = gw; bool have = it < NE * PER_E;
      if (have) { MJ_MAKE(it, jc, ic, dc); tr_load(a, jc, ic, lane, v, gn); }
      while (have) { const int itn = it + NGW; const bool hn = itn < NE * PER_E; TJob jn; int in_ = 0; bf16* dn = nullptr; float vn[32], gnn[8];
          if (hn) { MJ_MAKE(itn, jn, in_, dn); tr_load(a, jn, in_, lane, vn, gnn); }
          tr_finish(jc, dc, scr, ic, lane, v, gn);
          if (hn) { jc = jn; ic = in_; dc = dn;
#pragma unroll
              for (int i = 0; i < 32; ++i) v[i] = vn[i];
#pragma unroll
              for (int e = 0; e < 8; ++e) gn[e] = gnn[e]; }
          have = hn; it = itn; } }
#undef MJ_MAKE
}
__device__ __forceinline__ void phase_pre(const PArgs& a, int l) {
    const int bidx_ = obid();
    const int tid = otid(), lane = tid & 63, wave = tid >> 6, G = ogrid();
    const bf16* zr = (const bf16*)(a.ws + S_ZR); const bf16* zm = (const bf16*)(a.ws + S_ZM); bf16* A2 = (bf16*)(a.ws + S_A2);
    float* rsq = (float*)(a.ws + WS_CTL + C_RSQ); float* rskv = (float*)(a.ws + WS_CTL + C_RSKV);
    constexpr int TT = 8;
    const float mu = tid < 256 ? INF(5)[l * 1792 + 1536 + tid] : 0.f;
    for (int g = bidx_; g < T / TT; g += G) { const int t0 = g * TT;
        if (tid < 256) { const int col = 1536 + tid; float v[TT + 1];
            v[0] = (t0 % SEQ == 0) ? 0.f : bf2f(zr[(size_t)(t0 - 1) * NZR + col]);
#pragma unroll
            for (int i = 0; i < TT; ++i) v[i + 1] = bf2f(zr[(size_t)(t0 + i) * NZR + col]);
#pragma unroll
            for (int i = 0; i < TT; ++i) { float x = v[i + 1] + (v[i] - v[i + 1]) * mu; if (tid < 64) x = tanhf(x); else if (tid >= 128) x = sigmoidf_(x); A2[(size_t)(t0 + i) * K3 + tid] = (bf16)f2bf(x); }
        } else if (tid < 288) { const int jx = tid - 256; float c1[TT], c2[TT + 1];
            c2[0] = (t0 % SEQ == 0) ? 0.f : bf2f(zm[(size_t)(t0 - 1) * NZM + 464 + jx]);
#pragma unroll
            for (int i = 0; i < TT; ++i) { c1[i] = bf2f(zm[(size_t)(t0 + i) * NZM + 432 + jx]); c2[i + 1] = bf2f(zm[(size_t)(t0 + i) * NZM + 464 + jx]); }
#pragma unroll
            for (int i = 0; i < TT; ++i) A2[(size_t)(t0 + i) * K3 + tid] = (bf16)f2bf(c1[i] + c2[i]);
        } else if (tid < 384) {
#pragma unroll
            for (int i = 0; i < TT; ++i) A2[(size_t)(t0 + i) * K3 + tid] = 0;
        } else if (wave == 6) { float s[TT];
#pragma unroll
            for (int i = 0; i < TT; ++i) { const u32x2 w = *(const u32x2*)(zm + (size_t)(t0 + i) * NZM + lane * 4); const float f0 = bf2f(w.x & 0xffffu), f1 = bf2f(w.x >> 16), f2 = bf2f(w.y & 0xffffu), f3 = bf2f(w.y >> 16); s[i] = f0 * f0 + f1 * f1 + f2 * f2 + f3 * f3; }
#pragma unroll
            for (int i = 0; i < TT; ++i) { const float q = wave_sum(s[i]); if (lane == 0) rsq[t0 + i] = rsqrtf(q * (1.f / 256.f) + NORM_EPS); }
        } else { float s[TT];
#pragma unroll
            for (int i = 0; i < TT; ++i) { const unsigned w = *(const unsigned*)(zm + (size_t)(t0 + i) * NZM + 256 + lane * 2); const float f0 = bf2f(w & 0xffffu), f1 = bf2f(w >> 16); s[i] = f0 * f0 + f1 * f1; }
#pragma unroll
            for (int i = 0; i < TT; ++i) { const float q = wave_sum(s[i]); if (lane == 0) rskv[t0 + i] = rsqrtf(q * (1.f / 128.f) + NORM_EPS); }
        }
    }
}

__device__ __forceinline__ void ld8(const bf16* p, float (&f)[8]) { unpack8(*(const u32x4*)p, f); }
__device__ __forceinline__ void st8(bf16* p, const float (&f)[8]) { *(u32x4*)p = (u32x4){pk2(f[0], f[1]), pk2(f[2], f[3]), pk2(f[4], f[5]), pk2(f[6], f[7])}; }
__device__ __forceinline__ void ldf8(const float* p, float (&f)[8]) { const f32x4 a = *(const f32x4*)p, b = *(const f32x4*)(p + 4); f[0] = a[0]; f[1] = a[1]; f[2] = a[2]; f[3] = a[3]; f[4] = b[0]; f[5] = b[1]; f[6] = b[2]; f[7] = b[3]; }
__device__ __forceinline__ float sum8lanes(float v) { v += __shfl_xor(v, 1); v += __shfl_xor(v, 2); v += __shfl_xor(v, 4); return v; }
__device__ __forceinline__ void phase_mla_post(const PArgs& a, int l, LAS unsigned char* lds) {
    const int bidx_ = obid();
    const int tid = otid(), lane = tid & 63, wave = __builtin_amdgcn_readfirstlane(tid >> 6), G = ogrid(), h = lane >> 3, sub = lane & 7;
    const bf16* qraw = (const bf16*)(a.ws + S_QRAW); const bf16* kvraw = (const bf16*)(a.ws + S_KVRAW); const bf16* zm = (const bf16*)(a.ws + S_ZM);
    bf16* Q = (bf16*)(a.ws + S_Q); bf16* Kk = (bf16*)(a.ws + S_K); bf16* Vt = (bf16*)(a.ws + S_VT);
    const int* pos = (const int*)(const GAS int*)a.in[2];
    const bool rp = sub < 4;
    float gq0[8], gk0[8], gq1[8], gk1[8], invf[8];
    ldf8(INF(24) + l * QKD + 8 * sub, gq0); ldf8(INF(25) + l * QKD + 8 * sub, gk0);
    ldf8(INF(24) + l * QKD + 64 + 8 * (sub & 3), gq1); ldf8(INF(25) + l * QKD + 64 + 8 * (sub & 3), gk1);
#pragma unroll
    for (int e = 0; e < 8; ++e) invf[e] = exp2f(-(float)(8 * (sub & 1) + e) * (13.287712379549449f / 16.f));
    const float qscale = 0.10206207261596577f * 1.4426950408889634f;
    for (int g = bidx_ * NWV + wave; g < T / 8; g += G * NWV) { const int t0 = g * 8, b = t0 / SEQ, s0 = t0 % SEQ;
        unsigned vtr[8][4];
        u32x4 nq0, nk0, nvw, nq1 = (u32x4){0u, 0u, 0u, 0u}, nk1 = (u32x4){0u, 0u, 0u, 0u}; int npos;
#define ML_LOAD(tt) do { const size_t t_ = (tt); nq0 = *(const u32x4*)(qraw + t_ * 768 + h * 96 + 8 * sub); nk0 = *(const u32x4*)(kvraw + t_ * 1024 + h * 128 + 8 * sub); nvw = *(const u32x4*)(kvraw + t_ * 1024 + h * 128 + 64 + 8 * sub); \
            if (rp) { nq1 = *(const u32x4*)(qraw + t_ * 768 + h * 96 + 64 + 8 * sub); nk1 = *(const u32x4*)(zm + t_ * NZM + 384 + 8 * sub); } npos = pos[t_]; } while (0)
        ML_LOAD(t0);
        for (int i = 0; i < 8; ++i) { const size_t t = t0 + i; float q0[8], q1[8], k0[8], k1[8];
            unpack8(nq0, q0); unpack8(nk0, k0); unpack8(nq1, q1); unpack8(nk1, k1); const u32x4 vw = nvw; const float ps = (float)npos;
            if (i + 1 < 8) ML_LOAD(t + 1);
            float sq = 0.f, sk = 0.f;
#pragma unroll
            for (int e = 0; e < 8; ++e) { sq += q0[e] * q0[e] + q1[e] * q1[e]; sk += k0[e] * k0[e] + k1[e] * k1[e]; }
            sq = sum8lanes(sq); sk = sum8lanes(sk);
            const float rq = rsqrtf(sq * (1.f / QKD) + NORM_EPS), rk = rsqrtf(sk * (1.f / QKD) + NORM_EPS);
            float qo[8], ko[8], qr[8], kr[8];
#pragma unroll
            for (int e = 0; e < 8; ++e) { qo[e] = q0[e] * rq * gq0[e] * qscale; ko[e] = k0[e] * rk * gk0[e]; q1[e] = q1[e] * rq * gq1[e]; k1[e] = k1[e] * rk * gk1[e]; }
#pragma unroll
            for (int e = 0; e < 8; ++e) { const float qp = __shfl_xor(q1[e], 2), kp = __shfl_xor(k1[e], 2);
                const double rev = (double)(ps * invf[e]) * 0.15915494309189535; const float fr = (float)(rev - rint(rev));
                const float sn = __builtin_amdgcn_sinf(fr), cs = __builtin_amdgcn_cosf(fr);
                qr[e] = ((sub & 2) ? (q1[e] * cs + qp * sn) : (q1[e] * cs - qp * sn)) * qscale; kr[e] = (sub & 2) ? (k1[e] * cs + kp * sn) : (k1[e] * cs - kp * sn); }
            const size_t ro = ((size_t)(b * NH + h) * SEQ + s0 + i) * QKD;
            st8(Q + ro + 8 * sub, qo); st8(Kk + ro + 8 * sub, ko);
            if (rp) { st8(Q + ro + 64 + 8 * sub, qr); st8(Kk + ro + 64 + 8 * sub, kr); }
            vtr[i][0] = vw.x; vtr[i][1] = vw.y; vtr[i][2] = vw.z; vtr[i][3] = vw.w; }
#undef ML_LOAD
#pragma unroll
        for (int e = 0; e < 8; ++e) { u32x4 o;
            const unsigned x0 = (e & 1) ? (vtr[0][e >> 1] >> 16) : (vtr[0][e >> 1] & 0xffffu), x1 = (e & 1) ? (vtr[1][e >> 1] >> 16) : (vtr[1][e >> 1] & 0xffffu);
            const unsigned x2 = (e & 1) ? (vtr[2][e >> 1] >> 16) : (vtr[2][e >> 1] & 0xffffu), x3 = (e & 1) ? (vtr[3][e >> 1] >> 16) : (vtr[3][e >> 1] & 0xffffu);
            const unsigned x4 = (e & 1) ? (vtr[4][e >> 1] >> 16) : (vtr[4][e >> 1] & 0xffffu), x5 = (e & 1) ? (vtr[5][e >> 1] >> 16) : (vtr[5][e >> 1] & 0xffffu);
            const unsigned x6 = (e & 1) ? (vtr[6][e >> 1] >> 16) : (vtr[6][e >> 1] & 0xffffu), x7 = (e & 1) ? (vtr[7][e >> 1] >> 16) : (vtr[7][e >> 1] & 0xffffu);
            o.x = x0 | (x1 << 16); o.y = x2 | (x3 << 16); o.z = x4 | (x5 << 16); o.w = x6 | (x7 << 16);
            *(u32x4*)(Vt + ((size_t)(b * NH + h) * 64 + 8 * sub + e) * SEQ + s0) = o; }
    }
}

__device__ __forceinline__ void phase_rwkv_post(const PArgs& a, int l) {
    const int bidx_ = obid();
    const int tid = otid(), lane = tid & 63, wave = __builtin_amdgcn_readfirstlane(tid >> 6), G = ogrid(), c0 = lane * 8, h = lane >> 3;
    const bf16* zr = (const bf16*)(a.ws + S_ZR); const bf16* L2 = (const bf16*)(a.ws + S_L2); bf16* vf = (bf16*)(a.ws + WS_VF);
    bf16* RR = (bf16*)(a.ws + S_RR); bf16* RK = (bf16*)(a.ws + S_RK); bf16* RV = (bf16*)(a.ws + S_RV); bf16* RA = (bf16*)(a.ws + S_RA); bf16* RB = (bf16*)(a.ws + S_RB); float* RW = (float*)(a.ws + S_RW); bf16* RG = (bf16*)(a.ws + S_RG);
    float* bscA = (float*)(a.ws + WS_CTL + C_BSC);
    float mur[8], muk[8], muv[8], w0[8], a0[8], kkc[8], kac[8], rkc[8], vb[8];
    ldf8(INF(5) + l * 1792 + c0, mur); ldf8(INF(5) + l * 1792 + 512 + c0, muk); ldf8(INF(5) + l * 1792 + 1024 + c0, muv);
    ldf8(INF(6) + l * 512 + c0, w0); ldf8(INF(8) + l * 512 + c0, a0); ldf8(INF(11) + l * 512 + c0, kkc); ldf8(INF(12) + l * 512 + c0, kac); ldf8(INF(13) + l * 512 + c0, rkc);
    if (l > 0) ldf8(INF(19) + (l - 1) * 512 + c0, vb);
    for (int g = bidx_ * NWV + wave; g < T / 8; g += G * NWV) { const int t0 = g * 8;
        float pr[8], pk[8], pv[8];
        if (t0 % SEQ == 0) {
#pragma unroll
            for (int e = 0; e < 8; ++e) { pr[e] = 0.f; pk[e] = 0.f; pv[e] = 0.f; } }
        else { ld8(zr + (size_t)(t0 - 1) * NZR + c0, pr); ld8(zr + (size_t)(t0 - 1) * NZR + 512 + c0, pk); ld8(zr + (size_t)(t0 - 1) * NZR + 1024 + c0, pv); }
        u32x4 nzr, nzk, nzv, nlw, nla, nlg, nlv, nvf;
#define RW_LOAD(tt) do { const size_t t_ = (tt); nzr = *(const u32x4*)(zr + t_ * NZR + c0); nzk = *(const u32x4*)(zr + t_ * NZR + 512 + c0); nzv = *(const u32x4*)(zr + t_ * NZR + 1024 + c0); \
            nlw = *(const u32x4*)(L2 + t_ * N3 + c0); nla = *(const u32x4*)(L2 + t_ * N3 + 512 + c0); nlg = *(const u32x4*)(L2 + t_ * N3 + 1024 + c0); \
            if (l > 0) { nlv = *(const u32x4*)(L2 + t_ * N3 + 1536 + c0); nvf = *(const u32x4*)(vf + t_ * HW + c0); } } while (0)
        RW_LOAD(t0);
        for (int i = 0; i < 8; ++i) { const size_t t = t0 + i; float zr_[8], zk_[8], zv_[8], lw[8], la[8], lg[8], lv[8], vfi[8];
            unpack8(nzr, zr_); unpack8(nzk, zk_); unpack8(nzv, zv_); unpack8(nlw, lw); unpack8(nla, la); unpack8(nlg, lg);
            if (l > 0) { unpack8(nlv, lv); unpack8(nvf, vfi); }
            if (i + 1 < 8) RW_LOAD(t + 1);
            float r[8], kp[8], v[8], av[8], bv[8], dw[8]; float ssq = 0.f, bs = 0.f;
#pragma unroll
            for (int e = 0; e < 8; ++e) { r[e] = zr_[e] + (pr[e] - zr_[e]) * mur[e]; const float k = zk_[e] + (pk[e] - zk_[e]) * muk[e]; v[e] = zv_[e] + (pv[e] - zv_[e]) * muv[e];
                pr[e] = zr_[e]; pk[e] = zk_[e]; pv[e] = zv_[e];
                const float logw = -softplusf_(-(w0[e] + lw[e])) - 0.5f; dw[e] = -__expf(logw);
                const float iclr = sigmoidf_(a0[e] + la[e]);
                if (l > 0) v[e] = v[e] + (vfi[e] - v[e]) * sigmoidf_(vb[e] + lv[e]);
                const float kkr = k * kkc[e]; ssq += kkr * kkr; av[e] = kkr; bv[e] = iclr;
                kp[e] = k * (1.f + (iclr - 1.f) * kac[e]); bs += r[e] * kp[e] * rkc[e]; }
            ssq = sum8lanes(ssq); bs = sum8lanes(bs); const float rn = rsqrtf(ssq + 1e-12f);
#pragma unroll
            for (int e = 0; e < 8; ++e) { const float kk = av[e] * rn; av[e] = -kk; bv[e] = kk * bv[e]; }
            if (l == 0) st8(vf + t * HW + c0, v);
            st8(RR + t * HW + c0, r); st8(RK + t * HW + c0, kp); st8(RV + t * HW + c0, v); st8(RA + t * HW + c0, av); st8(RB + t * HW + c0, bv); st8(RG + t * HW + c0, lg);
            *(f32x4*)(RW + t * HW + c0) = (f32x4){dw[0], dw[1], dw[2], dw[3]}; *(f32x4*)(RW + t * HW + c0 + 4) = (f32x4){dw[4], dw[5], dw[6], dw[7]};
            if ((lane & 7) == 0) bscA[t * 8 + h] = bs; }
#undef RW_LOAD
    }
}

__device__ __forceinline__ void phase_gdn_prep(const PArgs& a, int l) {
    const int bidx_ = obid();
    const int tid = otid(), lane = tid & 63, wave = __builtin_amdgcn_readfirstlane(tid >> 6), G = ogrid(), c0 = lane * 8, h = lane >> 3;
    const bf16* zq = (const bf16*)(a.ws + S_ZQ); const bf16* zm = (const bf16*)(a.ws + S_ZM);
    float* GAL = (float*)(a.ws + S_GAL); float* GBE = (float*)(a.ws + S_GBE);
    const float* cw = INF(26) + l * 4 * NZQ;
    for (int u = bidx_ * NWV + wave; u < 3 * (T / 8); u += G * NWV) { const int which = u / (T / 8), t0 = (u % (T / 8)) * 8;
        const int cc = which * 512 + c0; bf16* O = (bf16*)(a.ws + (which == 0 ? S_GQ : which == 1 ? S_GK : S_GV));
        float w[4][8];
#pragma unroll
        for (int j = 0; j < 4; ++j) ldf8(cw + j * NZQ + cc, w[j]);
        float x0[8], x1[8], x2[8];
        if (t0 % SEQ == 0) {
#pragma unroll
            for (int e = 0; e < 8; ++e) { x0[e] = 0.f; x1[e] = 0.f; x2[e] = 0.f; } }
        else { ld8(zq + (size_t)(t0 - 3) * NZQ + cc, x0); ld8(zq + (size_t)(t0 - 2) * NZQ + cc, x1); ld8(zq + (size_t)(t0 - 1) * NZQ + cc, x2); }
        float alog = 0.f, dtb = 0.f; if (which == 0 && lane < 8) { alog = INF(27)[l * 8 + lane]; dtb = INF(28)[l * 8 + lane]; }
        u32x4 nx3 = *(const u32x4*)(zq + (size_t)t0 * NZQ + cc); float nbl = 0.f, nal = 0.f; if (which == 0 && lane < 8) { nbl = bf2f(zm[(size_t)t0 * NZM + 416 + lane]); nal = bf2f(zm[(size_t)t0 * NZM + 424 + lane]); }
        for (int i = 0; i < 8; ++i) { const size_t t = t0 + i; float x3[8], y[8]; unpack8(nx3, x3); const float bl = nbl, al = nal;
            if (i + 1 < 8) { nx3 = *(const u32x4*)(zq + (t + 1) * NZQ + cc); if (which == 0 && lane < 8) { nbl = bf2f(zm[(t + 1) * NZM + 416 + lane]); nal = bf2f(zm[(t + 1) * NZM + 424 + lane]); } }
            float ss = 0.f;
#pragma unroll
            for (int e = 0; e < 8; ++e) { const float c = w[0][e] * x0[e] + w[1][e] * x1[e] + w[2][e] * x2[e] + w[3][e] * x3[e]; y[e] = siluf_(c); ss += y[e] * y[e]; x0[e] = x1[e]; x1[e] = x2[e]; x2[e] = x3[e]; }
            if (which < 2) { ss = sum8lanes(ss); const float rn = rsqrtf(ss + 1e-12f) * (which == 0 ? 0.125f : 1.f);
#pragma unroll
                for (int e = 0; e < 8; ++e) y[e] *= rn; }
            st8(O + t * HW + c0, y);
            if (which == 0 && lane < 8) { GBE[t * 8 + lane] = sigmoidf_(bl); GAL[t * 8 + lane] = -__expf(alog) * softplusf_(al + dtb); } }
    }
}

__device__ __forceinline__ void phase_finish(const PArgs& a, int l) {
    const int bidx_ = obid();
    const int tid = otid(), lane = tid & 63, h = tid >> 6, G = ogrid(), c = tid;
    const bf16* YA = (const bf16*)(a.ws + S_YA); const bf16* YC = (const bf16*)(a.ws + S_YC); const bf16* RR = (const bf16*)(a.ws + S_RR); const bf16* RK = (const bf16*)(a.ws + S_RK); const bf16* RV = (const bf16*)(a.ws + S_RV); const bf16* RG = (const bf16*)(a.ws + S_RG);
    const bf16* zg = (const bf16*)(a.ws + S_ZG); bf16* OA = (bf16*)(a.ws + S_OA); bf16* OC = (bf16*)(a.ws + S_OC);
    const float rkc = INF(13)[l * 512 + c], lng = INF(14)[l * 512 + c], lnb = INF(15)[l * 512 + c], gng = INF(29)[l * 64 + lane];
    constexpr int TT = 4;
    for (int g = bidx_; g < T / TT; g += G) { const int t0 = g * TT; float ya[TT], yc[TT], r[TT], k[TT], v[TT], gt[TT], gg[TT];
#pragma unroll
        for (int i = 0; i < TT; ++i) { const size_t o = (size_t)(t0 + i) * HW + c; ya[i] = bf2f(YA[o]); yc[i] = bf2f(YC[o]); r[i] = bf2f(RR[o]); k[i] = bf2f(RK[o]); v[i] = bf2f(RV[o]); gt[i] = bf2f(RG[o]); gg[i] = bf2f(zg[o]); }
#pragma unroll
        for (int i = 0; i < TT; ++i) { const size_t o = (size_t)(t0 + i) * HW + c;
            const float mean = wave_sum(ya[i]) * (1.f / 64.f); const float d = ya[i] - mean; const float var = wave_sum(d * d) * (1.f / 64.f);
            const float bon = wave_sum(r[i] * k[i] * rkc) * v[i];
            const float y = d * rsqrtf(var + 64e-5f) * lng + lnb + bon;
            OA[o] = (bf16)f2bf(y * gt[i]);
            const float ms = wave_sum(yc[i] * yc[i]) * (1.f / 64.f);
            OC[o] = (bf16)f2bf(yc[i] * rsqrtf(ms + NORM_EPS) * gng * siluf_(gg[i])); }
    }
}
constexpr int AT_KP = 208, AT_VP = 136, AT_KB = 64 * AT_KP, AT_VB = 64 * AT_VP;
constexpr int AT_K0 = 0, AT_V0 = 2 * AT_KB;
template <int AV> __device__ __forceinline__ void attn_unit(const bf16* Q, const bf16* K, const bf16* Vt, bf16* OB, LAS unsigned char* lds, int b, int h, int qb) {
    const int tid = otid(), lane = tid & 63, wave = __builtin_amdgcn_readfirstlane(tid >> 6), ql = lane & 31, hh = lane >> 5;
    const int qrow0 = qb * 256 + wave * 32;
    const size_t bh = (size_t)(b * NH + h);
    bf16x8 qf[6];
    { const bf16* qp = Q + (bh * SEQ + qrow0 + ql) * QKD + 8 * hh;
#pragma unroll
      for (int s = 0; s < 6; ++s) qf[s] = *(const bf16x8*)(qp + 16 * s); }
    f32x16 o0, o1;
#pragma unroll
    for (int r = 0; r < 16; ++r) { o0[r] = 0.f; o1[r] = 0.f; }
    float mrun = -1e30f, lsum = 0.f;
    const int nkt = 4 * qb + 4;
    const unsigned char* Kb = (const unsigned char*)(K + bh * SEQ * QKD);
    const unsigned char* Vb = (const unsigned char*)(Vt + bh * 64 * SEQ);
    const int kr0 = tid / 12, kc0 = tid % 12, id1 = tid + 512, kr1 = id1 / 12, kc1 = id1 % 12; const bool k1v = id1 < 768;
    const int vr = tid >> 3, vc = tid & 7;
    u32x4 rk0, rk1, rv;
#define AT_LOADK(kt) do { const size_t key0 = (size_t)(kt) * 64; rk0 = *(const u32x4*)(Kb + (key0 + kr0) * (QKD * 2) + kc0 * 16); if (k1v) rk1 = *(const u32x4*)(Kb + (key0 + kr1) * (QKD * 2) + kc1 * 16); } while (0)
#define AT_LOADV(kt) do { rv = *(const u32x4*)(Vb + ((size_t)vr * SEQ + (size_t)(kt) * 64) * 2 + vc * 16); } while (0)
#define AT_STOREK(buf) do { LAS unsigned char* bp = lds + AT_K0 + (buf) * AT_KB; *(LAS u32x4*)(bp + kr0 * AT_KP + kc0 * 16) = rk0; if (k1v) *(LAS u32x4*)(bp + kr1 * AT_KP + kc1 * 16) = rk1; } while (0)
#define AT_STOREV(buf) do { LAS u32x2* vp = (LAS u32x2*)(lds + AT_V0 + (buf) * AT_VB + vr * AT_VP + vc * 16); vp[0] = (u32x2){rv.x, rv.y}; vp[1] = (u32x2){rv.z, rv.w}; } while (0)
#define AT_KFR(buf) do { const LAS unsigned char* kb = lds + AT_K0 + (buf) * AT_KB; \
        _Pragma("unroll") for (int s = 0; s < 6; ++s) { kfr[2 * s] = *(const LAS bf16x8*)(kb + ql * AT_KP + (16 * s + 8 * hh) * 2); kfr[2 * s + 1] = *(const LAS bf16x8*)(kb + (32 + ql) * AT_KP + (16 * s + 8 * hh) * 2); } } while (0)
#define AT_QK(dst0, dst1) do { \
        _Pragma("unroll") for (int r = 0; r < 16; ++r) { dst0[r] = 0.f; dst1[r] = 0.f; } \
        _Pragma("unroll") for (int s = 0; s < 6; ++s) { dst0 = __builtin_amdgcn_mfma_f32_32x32x16_bf16(kfr[2 * s], qf[s], dst0, 0, 0, 0); dst1 = __builtin_amdgcn_mfma_f32_32x32x16_bf16(kfr[2 * s + 1], qf[s], dst1, 0, 0, 0); } } while (0)
    bf16x8 kfr[12]; union VF { u32x4 u; bf16x8 v; } vfa[4], vfb[4];
    AT_LOADK(0); AT_LOADV(0); AT_STOREK(0); AT_STOREV(0); AT_LOADK(1); AT_STOREK(1);
    __syncthreads();
    f32x16 s0, s1;
    AT_KFR(0); AT_QK(s0, s1);
    for (int kt = 0; kt < nkt; ++kt) {
        const bool nx = kt + 1 < nkt;
        if (AV != 2) { if (kt + 2 < nkt) AT_LOADK(kt + 2);
        if (nx) AT_LOADV(kt + 1); }
        { const LAS unsigned char* vb = lds + AT_V0 + (kt & 1) * AT_VB;
#pragma unroll
          for (int q = 0; q < 4; ++q) { const int kofs = ((q >> 1) * 32 + 16 * (q & 1) + 4 * hh) * 2;
              { const u32x2 lo = *(const LAS u32x2*)(vb + ql * AT_VP + kofs), hi = *(const LAS u32x2*)(vb + ql * AT_VP + kofs + 16); vfa[q].u = (u32x4){lo.x, lo.y, hi.x, hi.y}; }
              { const u32x2 lo = *(const LAS u32x2*)(vb + (32 + ql) * AT_VP + kofs), hi = *(const LAS u32x2*)(vb + (32 + ql) * AT_VP + kofs + 16); vfb[q].u = (u32x4){lo.x, lo.y, hi.x, hi.y}; } } }
        f32x16 n0, n1;
        if (nx && wave < 4) { AT_KFR((kt + 1) & 1); AT_QK(n0, n1); }
        if (64 * kt + 63 > qrow0) { const int qi = qrow0 + ql, kbase = 64 * kt + 4 * hh;
#pragma unroll
            for (int r = 0; r < 16; ++r) { const int key = kbase + (r & 3) + 8 * (r >> 2); if (key > qi) s0[r] = -1e30f; if (key + 32 > qi) s1[r] = -1e30f; } }
        float mx = s0[0];
#pragma unroll
        for (int r = 1; r < 16; ++r) mx = fmaxf(mx, s0[r]);
#pragma unroll
        for (int r = 0; r < 16; ++r) mx = fmaxf(mx, s1[r]);
        mx = fmaxf(mx, __shfl_xor(mx, 32));
        const float mnew = fmaxf(mrun, mx), alpha = __builtin_amdgcn_exp2f(mrun - mnew); mrun = mnew;
        float ps = 0.f;
#pragma unroll
        for (int r = 0; r < 16; ++r) { if (AV == 1) { s0[r] = (s0[r] - mnew) * 1e-3f; s1[r] = (s1[r] - mnew) * 1e-3f; } else { s0[r] = __builtin_amdgcn_exp2f(s0[r] - mnew); s1[r] = __builtin_amdgcn_exp2f(s1[r] - mnew); } ps += s0[r] + s1[r]; }
        lsum = lsum * alpha + ps;
#pragma unroll
        for (int r = 0; r < 16; ++r) { o0[r] *= alpha; o1[r] *= alpha; }
#pragma unroll
        for (int q = 0; q < 4; ++q) { union { u32x4 u; bf16x8 v; } pf; const int s2 = q & 1;
            if (q < 2) { pf.u.x = pg8::cvt_pk_bf16(s0[8 * s2 + 0], s0[8 * s2 + 1]); pf.u.y = pg8::cvt_pk_bf16(s0[8 * s2 + 2], s0[8 * s2 + 3]); pf.u.z = pg8::cvt_pk_bf16(s0[8 * s2 + 4], s0[8 * s2 + 5]); pf.u.w = pg8::cvt_pk_bf16(s0[8 * s2 + 6], s0[8 * s2 + 7]); }
            else { pf.u.x = pg8::cvt_pk_bf16(s1[8 * s2 + 0], s1[8 * s2 + 1]); pf.u.y = pg8::cvt_pk_bf16(s1[8 * s2 + 2], s1[8 * s2 + 3]); pf.u.z = pg8::cvt_pk_bf16(s1[8 * s2 + 4], s1[8 * s2 + 5]); pf.u.w = pg8::cvt_pk_bf16(s1[8 * s2 + 6], s1[8 * s2 + 7]); }
            if (AV == 3) { o0[q] += bf2f(pf.u.x & 0xffffu) + bf2f(vfa[q].u.x); o1[q] += bf2f(pf.u.y >> 16) + bf2f(vfb[q].u.y); } else {
            o0 = __builtin_amdgcn_mfma_f32_32x32x16_bf16(vfa[q].v, pf.v, o0, 0, 0, 0); o1 = __builtin_amdgcn_mfma_f32_32x32x16_bf16(vfb[q].v, pf.v, o1, 0, 0, 0); } }
        if (nx && wave >= 4) { AT_KFR((kt + 1) & 1); AT_QK(n0, n1); }
        if (AV != 2) { if (kt + 2 < nkt) AT_STOREK(kt & 1);
        if (nx) AT_STOREV((kt + 1) & 1); }
        __syncthreads();
        if (nx) { s0 = n0; s1 = n1; }
    }
#undef AT_LOADK
#undef AT_LOADV
#undef AT_STOREK
#undef AT_STOREV
#undef AT_QK
#undef AT_KFR
    const float ltot = lsum + __shfl_xor(lsum, 32), inv = 1.f / ltot;
    bf16* op = OB + ((size_t)b * SEQ + qrow0 + ql) * HW + h * 64 + 4 * hh;
#pragma unroll
    for (int g = 0; g < 4; ++g) { u32x2 w0, w1; w0.x = pg8::cvt_pk_bf16(o0[4 * g] * inv, o0[4 * g + 1] * inv); w0.y = pg8::cvt_pk_bf16(o0[4 * g + 2] * inv, o0[4 * g + 3] * inv);
        w1.x = pg8::cvt_pk_bf16(o1[4 * g] * inv, o1[4 * g + 1] * inv); w1.y = pg8::cvt_pk_bf16(o1[4 * g + 2] * inv, o1[4 * g + 3] * inv);
        *(u32x2*)(op + 8 * g) = w0; *(u32x2*)(op + 32 + 8 * g) = w1; }
}
template <int AV> __device__ __forceinline__ void phase_attn(const PArgs& a, LAS unsigned char* lds) {
    const int bidx_ = obid();
    const bf16* Q = (const bf16*)(a.ws + S_Q); const bf16* K = (const bf16*)(a.ws + S_K); const bf16* Vt = (const bf16*)(a.ws + S_VT); bf16* OB = (bf16*)(a.ws + (AV == 0 ? S_OB : S_RG));
    for (int pi0 = bidx_; pi0 < NB * NH * 8; pi0 += ogrid()) { const int xg = pi0 & 7, ix = pi0 >> 3; const int pi = (ogrid() % 8 == 0 && pi0 < 256) ? ((xg * 4 + (ix >> 3)) * 8 + (ix & 7)) : pi0; const int bh = pi >> 3, j = pi & 7;
        attn_unit<AV>(Q, K, Vt, OB, lds, bh >> 3, bh & 7, 15 - j);
        attn_unit<AV>(Q, K, Vt, OB, lds, bh >> 3, bh & 7, j); }
}

constexpr int SC_STEPS = 16, SC_ROW = 5 * 64 + 16, SC_BUF = SC_STEPS * SC_ROW * 4;
__device__ __forceinline__ void scan_task(const PArgs& a, int task, LAS unsigned char* wlds) {
    const int lane = otid() & 63, i = lane >> 2, jq = lane & 3;
    const bool gdn = task >= 128; const int tt = gdn ? task - 128 : task; const int b = tt >> 5, h = (tt >> 2) & 7, rg = tt & 3;
    const bf16 *PR, *PK, *PV, *PA, *PB; const float* PW; const float *PAL, *PBE; bf16* Y;
    if (!gdn) { PR = (const bf16*)(a.ws + S_RR); PK = (const bf16*)(a.ws + S_RK); PV = (const bf16*)(a.ws + S_RV); PA = (const bf16*)(a.ws + S_RA); PB = (const bf16*)(a.ws + S_RB); PW = (const float*)(a.ws + S_RW); PAL = nullptr; PBE = nullptr; Y = (bf16*)(a.ws + S_YA); }
    else { PR = (const bf16*)(a.ws + S_GQ); PK = (const bf16*)(a.ws + S_GK); PV = (const bf16*)(a.ws + S_GV); PA = nullptr; PB = nullptr; PW = nullptr; PAL = (const float*)(a.ws + S_GAL); PBE = (const float*)(a.ws + S_GBE); Y = (bf16*)(a.ws + S_YC); }
    const size_t row0 = (size_t)b * SEQ; const int col0 = h * 64;
    const int bs = lane >> 3, be = 8 * (lane & 7);
    u32x4 gr[2], gk[2], ga[2], gb[2], gv; f32x4 gw[4]; float gal[2], gbe[2];
#define SC_LOAD(c) do { const size_t t0_ = row0 + (size_t)(c) * SC_STEPS; \
        _Pragma("unroll") for (int q = 0; q < 2; ++q) { const size_t o_ = (t0_ + bs + 8 * q) * HW + col0 + be; gr[q] = *(const u32x4*)(PR + o_); gk[q] = *(const u32x4*)(PK + o_); \
            if (!gdn) { ga[q] = *(const u32x4*)(PA + o_); gb[q] = *(const u32x4*)(PB + o_); } else { gal[q] = PAL[(t0_ + bs + 8 * q) * 8 + h]; gbe[q] = PBE[(t0_ + bs + 8 * q) * 8 + h]; } } \
        if (!gdn) { _Pragma("unroll") for (int q = 0; q < 4; ++q) gw[q] = *(const f32x4*)(PW + (t0_ + (lane >> 4) + 4 * q) * HW + col0 + 4 * (lane & 15)); } \
        if (lane < 32) gv = *(const u32x4*)(PV + (t0_ + (lane >> 1)) * HW + col0 + rg * 16 + (lane & 1) * 8); } while (0)
#define SC_STORE(buf) do { LAS float* B_ = (LAS float*)(wlds + (buf) * SC_BUF); \
        _Pragma("unroll") for (int q = 0; q < 2; ++q) { LAS float* R_ = B_ + (bs + 8 * q) * SC_ROW; float fr_[8], fk_[8]; unpack8(gr[q], fr_); unpack8(gk[q], fk_); \
            if (!gdn) { float fa_[8], fb_[8]; unpack8(ga[q], fa_); unpack8(gb[q], fb_); \
                *(LAS f32x4*)(R_ + 0 + be) = (f32x4){fa_[0], fa_[1], fa_[2], fa_[3]}; *(LAS f32x4*)(R_ + 0 + be + 4) = (f32x4){fa_[4], fa_[5], fa_[6], fa_[7]}; \
                *(LAS f32x4*)(R_ + 128 + be) = (f32x4){fb_[0], fb_[1], fb_[2], fb_[3]}; *(LAS f32x4*)(R_ + 128 + be + 4) = (f32x4){fb_[4], fb_[5], fb_[6], fb_[7]}; \
                *(LAS f32x4*)(R_ + 192 + be) = (f32x4){fk_[0], fk_[1], fk_[2], fk_[3]}; *(LAS f32x4*)(R_ + 192 + be + 4) = (f32x4){fk_[4], fk_[5], fk_[6], fk_[7]}; } \
            else { const float al_ = gal[q], be_ = gbe[q], nab_ = -al_ * be_; \
                *(LAS f32x4*)(R_ + 0 + be) = (f32x4){fk_[0], fk_[1], fk_[2], fk_[3]}; *(LAS f32x4*)(R_ + 0 + be + 4) = (f32x4){fk_[4], fk_[5], fk_[6], fk_[7]}; \
                *(LAS f32x4*)(R_ + 64 + be) = (f32x4){al_, al_, al_, al_}; *(LAS f32x4*)(R_ + 64 + be + 4) = (f32x4){al_, al_, al_, al_}; \
                *(LAS f32x4*)(R_ + 128 + be) = (f32x4){fk_[0] * nab_, fk_[1] * nab_, fk_[2] * nab_, fk_[3] * nab_}; *(LAS f32x4*)(R_ + 128 + be + 4) = (f32x4){fk_[4] * nab_, fk_[5] * nab_, fk_[6] * nab_, fk_[7] * nab_}; \
                *(LAS f32x4*)(R_ + 192 + be) = (f32x4){fk_[0] * be_, fk_[1] * be_, fk_[2] * be_, fk_[3] * be_}; *(LAS f32x4*)(R_ + 192 + be + 4) = (f32x4){fk_[4] * be_, fk_[5] * be_, fk_[6] * be_, fk_[7] * be_}; } \
            *(LAS f32x4*)(R_ + 256 + be) = (f32x4){fr_[0], fr_[1], fr_[2], fr_[3]}; *(LAS f32x4*)(R_ + 256 + be + 4) = (f32x4){fr_[4], fr_[5], fr_[6], fr_[7]}; } \
        if (!gdn) { _Pragma("unroll") for (int q = 0; q < 4; ++q) *(LAS f32x4*)(B_ + ((lane >> 4) + 4 * q) * SC_ROW + 64 + 4 * (lane & 15)) = gw[q]; } \
        if (lane < 32) { float fv_[8]; unpack8(gv, fv_); LAS float* V_ = B_ + (lane >> 1) * SC_ROW + 320 + (lane & 1) * 8; *(LAS f32x4*)(V_) = (f32x4){fv_[0], fv_[1], fv_[2], fv_[3]}; *(LAS f32x4*)(V_ + 4) = (f32x4){fv_[4], fv_[5], fv_[6], fv_[7]}; } } while (0)
    float st[16];
#pragma unroll
    for (int q = 0; q < 16; ++q) st[q] = 0.f;
    SC_LOAD(0); SC_STORE(0);
    constexpr int NCH = SEQ / SC_STEPS;
    for (int c = 0; c < NCH; ++c) {
        if (c + 1 < NCH) SC_LOAD(c + 1);
        const LAS float* B_ = (const LAS float*)(wlds + (c & 1) * SC_BUF);
        for (int s = 0; s < SC_STEPS; ++s) { const LAS float* R_ = B_ + s * SC_ROW + 16 * jq;
            float va[16], vw[16], vb[16], vk[16], vr[16];
#pragma unroll
            for (int q = 0; q < 4; ++q) { const f32x4 x0 = *(const LAS f32x4*)(R_ + 4 * q), x1 = *(const LAS f32x4*)(R_ + 64 + 4 * q), x2 = *(const LAS f32x4*)(R_ + 128 + 4 * q), x3 = *(const LAS f32x4*)(R_ + 192 + 4 * q), x4 = *(const LAS f32x4*)(R_ + 256 + 4 * q);
#pragma unroll
                for (int e = 0; e < 4; ++e) { va[4 * q + e] = x0[e]; vw[4 * q + e] = x1[e]; vb[4 * q + e] = x2[e]; vk[4 * q + e] = x3[e]; vr[4 * q + e] = x4[e]; } }
            const float vi = B_[s * SC_ROW + 320 + i];
            float sa = 0.f;
#pragma unroll
            for (int q = 0; q < 16; ++q) sa += st[q] * va[q];
            sa += __shfl_xor(sa, 1); sa += __shfl_xor(sa, 2);
            float y = 0.f;
#pragma unroll
            for (int q = 0; q < 16; ++q) { st[q] = st[q] * vw[q] + sa * vb[q] + vi * vk[q]; y += st[q] * vr[q]; }
            y += __shfl_xor(y, 1); y += __shfl_xor(y, 2);
            if (jq == 0) Y[(row0 + (size_t)c * SC_STEPS + s) * HW + col0 + rg * 16 + i] = (bf16)f2bf(y);
        }
        if (c + 1 < NCH) SC_STORE((c + 1) & 1);
    }
#undef SC_LOAD
#undef SC_STORE
}
__device__ __forceinline__ void phase_scan(const PArgs& a, LAS unsigned char* lds) {
    const int bidx_ = obid();
    const int wave = __builtin_amdgcn_readfirstlane(otid() >> 6), G = ogrid();
    if (wave < 3) for (int task = bidx_ + wave * G; task < 256; task += 3 * G) scan_task(a, task, lds + wave * (2 * SC_BUF));
}
constexpr int CK_TP = 144;
constexpr int CK_AT = 0, CK_BT = 9216, CK_KT = 18432, CK_RT = 27648, CK_BW = 36864, CK_KW = 46080, CK_V = 55296, CK_N = 64512, CK_LAK = 73728, CK_LRB = 82944, CK_LRK = 92160,
              CK_AW = 101376, CK_W1 = 110592, CK_AH = 119808, CK_LVT = 129024, CK_DD = 138240;
constexpr int CK_CUM = 147456, CK_CUMP = 147712, CK_PC = 147968, CK_WTOT = 148224;
constexpr int CM_ITEM = 32768;
typedef short s16x4 __attribute__((ext_vector_type(4)));
__device__ __forceinline__ bf16x8 ck_frag(const LAS unsigned char* tile, int row, int ks, int hh) { return *(const LAS bf16x8*)(tile + row * CK_TP + (16 * ks + 8 * hh) * 2); }
__device__ __forceinline__ int crow_(int r, int hh) { return (r & 3) + 8 * (r >> 2) + 4 * hh; }
#define DPP_ADD(v, ctrl, rmask) v += __builtin_bit_cast(float, __builtin_amdgcn_update_dpp(0, __builtin_bit_cast(int, v), ctrl, rmask, 0xf, true))
__device__ __forceinline__ float wave_scan_incl(float v) {
    DPP_ADD(v, 0x111, 0xf);
    DPP_ADD(v, 0x112, 0xf);
    DPP_ADD(v, 0x114, 0xf);
    DPP_ADD(v, 0x118, 0xf);
    DPP_ADD(v, 0x142, 0xa);
    DPP_ADD(v, 0x143, 0xc);
    return v;
}
struct CkIn { u32x4 r, k, v, a, b; f32x4 w0, w1; float g, be; };
__device__ __forceinline__ void ck_load(const PArgs& a, int item, int t, int j0, CkIn& o) {
    const bool gdn = item >= 2048; const int it = item & 2047, bh = it >> 6, ch = it & 63, b = bh >> 3, h = bh & 7;
    const size_t row = (size_t)b * SEQ + ch * 64 + t; const size_t eo = row * HW + h * 64 + j0;
    const bf16* pr = (const bf16*)(a.ws + (gdn ? S_GQ : S_RR)); const bf16* pk = (const bf16*)(a.ws + (gdn ? S_GK : S_RK)); const bf16* pv = (const bf16*)(a.ws + (gdn ? S_GV : S_RV));
    const bf16* pa = (const bf16*)(a.ws + (gdn ? S_GK : S_RA)); const bf16* pb = (const bf16*)(a.ws + (gdn ? S_GK : S_RB));
    o.r = *(const u32x4*)(pr + eo); o.k = *(const u32x4*)(pk + eo); o.v = *(const u32x4*)(pv + eo); o.a = *(const u32x4*)(pa + eo); o.b = *(const u32x4*)(pb + eo);
    o.w0 = *(const f32x4*)((const float*)(a.ws + S_RW) + eo); o.w1 = *(const f32x4*)((const float*)(a.ws + S_RW) + eo + 4);
    o.g = ((const float*)(a.ws + S_GAL))[row * 8 + h]; o.be = ((const float*)(a.ws + S_GBE))[row * 8 + h];
}
__device__ __forceinline__ void phase_cprep(const PArgs& a, LAS unsigned char* lds) {
    const int bidx_ = obid();
    const int tid = otid(), lane = tid & 63, wave = __builtin_amdgcn_readfirstlane(tid >> 6), G = ogrid(), ql = lane & 31, hh = lane >> 5;
    const int t = lane, j0 = wave * 8;
    LAS float* cumA = (LAS float*)(lds + CK_CUM); LAS float* cumpA = (LAS float*)(lds + CK_CUMP); LAS float* pcA = (LAS float*)(lds + CK_PC);
    CkIn in; if (bidx_ < 4096) ck_load(a, bidx_, t, j0, in);
#if PROBE_SUB >= 10
    volatile LAS unsigned* tmisc = (volatile LAS unsigned*)(lds + (163840 - 1024)) + 40; unsigned long long tprev = __builtin_amdgcn_s_memrealtime();
#define CKSTAMP(k) do { if (PROBE_SUB - 10 == (k)) { const unsigned long long tn_ = __builtin_amdgcn_s_memrealtime(); if (tid == 0) tmisc[0] += (unsigned)(tn_ - tprev); } tprev = __builtin_amdgcn_s_memrealtime(); } while (0)
#else
#define CKSTAMP(k) do { } while (0)
#endif
    for (int item = bidx_; item < 4096; item += G) {
        CKSTAMP(6);
        const bool gdn = item >= 2048; const int it = item & 2047;
        float fr[8], fk[8], fv[8], fa[8], fb[8], lw[8];
        unpack8(in.v, fv);
        if (!gdn) { unpack8(in.r, fr); unpack8(in.k, fk); unpack8(in.a, fa); unpack8(in.b, fb);
#pragma unroll
            for (int e = 0; e < 4; ++e) { lw[e] = in.w0[e]; lw[4 + e] = in.w1[e]; } }
        else { float fkk[8]; unpack8(in.r, fr); unpack8(in.k, fkk); const float g = in.g, be = in.be, al = __expf(g);
#pragma unroll
            for (int e = 0; e < 8; ++e) { fa[e] = fkk[e]; fb[e] = -al * be * fkk[e]; fk[e] = be * fkk[e]; lw[e] = g; } }
        CKSTAMP(7);
        if (item + G < 4096) ck_load(a, item + G, t, j0, in);
        float cum[8], pc[8];
#pragma unroll
        for (int e = 0; e < 8; ++e) { cum[e] = wave_scan_incl(lw[e]); pc[e] = __builtin_bit_cast(float, __builtin_amdgcn_readlane(__builtin_bit_cast(int, cum[e]), 63)); }
        CKSTAMP(8);
        if (wave == 0) { cumA[t] = gdn ? cum[0] : 0.f; cumpA[t] = gdn ? cum[0] - lw[0] : 0.f; }
        if (lane == 0) {
#pragma unroll
            for (int e = 0; e < 8; ++e) pcA[j0 + e] = pc[e]; }
        { float xa[8], xr[8], xb[8], xk[8], yb[8], yk[8], ya[8];
#pragma unroll
          for (int e = 0; e < 8; ++e) { const float ecp_true = __expf(cum[e] - lw[e]); const float ec = gdn ? 1.f : __expf(cum[e]), ecp = gdn ? 1.f : ecp_true, eci = gdn ? 1.f : __expf(-cum[e]), et = __expf(pc[e] - cum[e]);
              xa[e] = fa[e] * ecp; xr[e] = fr[e] * ec; xb[e] = fb[e] * eci; xk[e] = fk[e] * eci; yb[e] = fb[e] * et; yk[e] = fk[e] * et; ya[e] = fa[e] * ecp_true; }
          const int ro = t * CK_TP + j0 * 2;
          *(LAS u32x4*)(lds + CK_AT + ro) = (u32x4){pk2(xa[0], xa[1]), pk2(xa[2], xa[3]), pk2(xa[4], xa[5]), pk2(xa[6], xa[7])};
          *(LAS u32x4*)(lds + CK_RT + ro) = (u32x4){pk2(xr[0], xr[1]), pk2(xr[2], xr[3]), pk2(xr[4], xr[5]), pk2(xr[6], xr[7])};
          *(LAS u32x4*)(lds + CK_BT + ro) = (u32x4){pk2(xb[0], xb[1]), pk2(xb[2], xb[3]), pk2(xb[4], xb[5]), pk2(xb[6], xb[7])};
          *(LAS u32x4*)(lds + CK_KT + ro) = (u32x4){pk2(xk[0], xk[1]), pk2(xk[2], xk[3]), pk2(xk[4], xk[5]), pk2(xk[6], xk[7])};
#pragma unroll
          for (int e = 0; e < 8; ++e) { const int to = (j0 + e) * CK_TP + t * 2; *(LAS unsigned short*)(lds + CK_BW + to) = (unsigned short)f2bf(yb[e]); *(LAS unsigned short*)(lds + CK_KW + to) = (unsigned short)f2bf(yk[e]);
              *(LAS unsigned short*)(lds + CK_V + to) = (unsigned short)f2bf(fv[e]); *(LAS unsigned short*)(lds + CK_AH + to) = (unsigned short)f2bf(ya[e]); } }
        CKSTAMP(9);
        __syncthreads();
        CKSTAMP(0);
#ifndef PROBE_CK
#define PROBE_CK 1
#endif
        for (int rep_ = 0; rep_ < PROBE_CK; ++rep_) {
        { const int p = wave >> 1, hf = wave & 1; const LAS unsigned char* At = lds + (p < 2 ? CK_AT : CK_RT); const LAS unsigned char* Bt = lds + ((p & 1) ? CK_KT : CK_BT);
          const LAS float* dA = (p < 2) ? cumpA : cumA; LAS unsigned char* Ot = lds + (p == 0 ? CK_N : p == 1 ? CK_LAK : p == 2 ? CK_LRB : CK_LRK); const int incl = (p >= 2) ? 1 : 0;
#pragma unroll
          for (int sq = 0; sq < 2; ++sq) { f32x16 acc;
#pragma unroll
              for (int r = 0; r < 16; ++r) acc[r] = 0.f;
              if (!(sq == 1 && hf == 0)) {
#pragma unroll
                  for (int ks = 0; ks < 4; ++ks) acc = __builtin_amdgcn_mfma_f32_32x32x16_bf16(ck_frag(At, 32 * hf + ql, ks, hh), ck_frag(Bt, 32 * sq + ql, ks, hh), acc, 0, 0, 0); }
              const int s = 32 * sq + ql; const float dBs = cumA[s];
#pragma unroll
              for (int r = 0; r < 16; ++r) { const int tt = 32 * hf + crow_(r, hh); const bool keep = s < tt + incl; const float val = keep ? (gdn ? acc[r] * __expf(dA[tt] - dBs) : acc[r]) : 0.f;
                  *(LAS unsigned short*)(Ot + tt * CK_TP + s * 2) = (unsigned short)f2bf(val); } } }
        __syncthreads();
        CKSTAMP(1);
        if (wave >= 1 && wave <= 4) { const int w4 = wave - 1, tq = w4 >> 1, iq = w4 & 1; f32x16 acc;
#pragma unroll
            for (int r = 0; r < 16; ++r) acc[r] = 0.f;
#pragma unroll
            for (int ks = 0; ks < 4; ++ks) acc = __builtin_amdgcn_mfma_f32_32x32x16_bf16(ck_frag(lds + CK_LAK, 32 * tq + ql, ks, hh), ck_frag(lds + CK_V, 32 * iq + ql, ks, hh), acc, 0, 0, 0);
#pragma unroll
            for (int g4 = 0; g4 < 4; ++g4) *(LAS u32x2*)(lds + CK_LVT + (32 * iq + ql) * CK_TP + (32 * tq + 8 * g4 + 4 * hh) * 2) = (u32x2){pk2(acc[4 * g4], acc[4 * g4 + 1]), pk2(acc[4 * g4 + 2], acc[4 * g4 + 3])}; }
        else if (wave == 0) { const int I = lane >> 4, c = lane & 15; float d[16];
#pragma unroll
            for (int r = 0; r < 16; ++r) { float nr[16]; { float lo8[8], hi8[8]; unpack8(*(const LAS u32x4*)(lds + CK_N + (16 * I + r) * CK_TP + (16 * I) * 2), lo8); unpack8(*(const LAS u32x4*)(lds + CK_N + (16 * I + r) * CK_TP + (16 * I + 8) * 2), hi8);
#pragma unroll
                    for (int e = 0; e < 8; ++e) { nr[e] = lo8[e]; nr[8 + e] = hi8[e]; } }
                float v = (r == c) ? 1.f : 0.f;
#pragma unroll
                for (int s2 = 0; s2 < r; ++s2) v += nr[s2] * d[s2];
                d[r] = v; *(LAS unsigned short*)(lds + CK_DD + (16 * I + r) * CK_TP + (16 * I + c) * 2) = (unsigned short)f2bf(v); } }
        __syncthreads();
        CKSTAMP(2);
        { const int col = lane & 15, g = lane >> 4; const int rb = (wave < 4) ? (16 * wave + col) : (16 * (wave - 4) + col);
          const LAS unsigned char* RTt = lds + (wave < 4 ? CK_AH : CK_LVT) + rb * CK_TP; LAS unsigned char* XTt = lds + (wave < 4 ? CK_AW : CK_W1) + rb * CK_TP;
          s16x4 xb[4];
#pragma unroll
          for (int I = 0; I < 4; ++I) { f32x4 acc; { const u32x2 w = *(const LAS u32x2*)(RTt + (16 * I + 4 * g) * 2); acc[0] = bf2f(w.x & 0xffffu); acc[1] = bf2f(w.x >> 16); acc[2] = bf2f(w.y & 0xffffu); acc[3] = bf2f(w.y >> 16); }
#pragma unroll
              for (int J = 0; J < I; ++J) acc = __builtin_amdgcn_mfma_f32_16x16x16bf16_1k(*(const LAS s16x4*)(lds + CK_N + (16 * I + col) * CK_TP + (16 * J + 4 * g) * 2), xb[J], acc, 0, 0, 0);
              union { u32x2 u; s16x4 v; } zb; zb.u = (u32x2){pk2(acc[0], acc[1]), pk2(acc[2], acc[3])};
              f32x4 x = (f32x4){0.f, 0.f, 0.f, 0.f};
              x = __builtin_amdgcn_mfma_f32_16x16x16bf16_1k(*(const LAS s16x4*)(lds + CK_DD + (16 * I + col) * CK_TP + (16 * I + 4 * g) * 2), zb.v, x, 0, 0, 0);
              union { u32x2 u; s16x4 v; } xo; xo.u = (u32x2){pk2(x[0], x[1]), pk2(x[2], x[3])}; xb[I] = xo.v;
              *(LAS u32x2*)(XTt + (16 * I + 4 * g) * 2) = xo.u; } }
        __syncthreads();
        }
        CKSTAMP(3);
        { const int quad = wave & 3, rq = quad >> 1, cq = quad & 1; const bool lo = wave < 4;
          bf16* cm = (bf16*)(a.ws + (gdn ? S_CMG : S_CMR) + (size_t)it * CM_ITEM);
          const LAS unsigned char* A1 = lds + (lo ? CK_BW : CK_LRB); const LAS unsigned char* A2 = lds + (lo ? CK_KW : CK_LRK);
          f32x16 g1, g2;
#pragma unroll
          for (int r = 0; r < 16; ++r) { g1[r] = 0.f; g2[r] = 0.f; }
#pragma unroll
          for (int ks = 0; ks < 4; ++ks) { const bf16x8 af = ck_frag(A1, 32 * rq + ql, ks, hh);
              g1 = __builtin_amdgcn_mfma_f32_32x32x16_bf16(af, ck_frag(lds + CK_AW, 32 * cq + ql, ks, hh), g1, 0, 0, 0);
              g2 = __builtin_amdgcn_mfma_f32_32x32x16_bf16(af, ck_frag(lds + CK_W1, 32 * cq + ql, ks, hh), g2, 0, 0, 0); }
#pragma unroll
          for (int ks = 0; ks < 4; ++ks) g2 = __builtin_amdgcn_mfma_f32_32x32x16_bf16(ck_frag(A2, 32 * rq + ql, ks, hh), ck_frag(lds + CK_V, 32 * cq + ql, ks, hh), g2, 0, 0, 0);
          const int col = 32 * cq + ql;
          if (lo) { const float dg = __expf(pcA[col]);
#pragma unroll
              for (int r = 0; r < 16; ++r) { const int rw = 32 * rq + crow_(r, hh); *(LAS unsigned short*)(lds + CK_AT + rw * CK_TP + col * 2) = (unsigned short)f2bf(g1[r] + (rw == col ? dg : 0.f)); }
#pragma unroll
              for (int g4 = 0; g4 < 4; ++g4) *(LAS u32x2*)(lds + CK_BT + col * CK_TP + (32 * rq + 8 * g4 + 4 * hh) * 2) = (u32x2){pk2(g2[4 * g4], g2[4 * g4 + 1]), pk2(g2[4 * g4 + 2], g2[4 * g4 + 3])}; }
          else {
#pragma unroll
              for (int r = 0; r < 16; ++r) { const int rw = 32 * rq + crow_(r, hh); const float rh = bf2f(*(const LAS unsigned short*)(lds + CK_RT + rw * CK_TP + col * 2)) * (gdn ? __expf(cumA[rw]) : 1.f);
                  *(LAS unsigned short*)(lds + CK_KT + rw * CK_TP + col * 2) = (unsigned short)f2bf(g1[r] + rh); *(LAS unsigned short*)(lds + CK_N + rw * CK_TP + col * 2) = (unsigned short)f2bf(g2[r]); } }
          __syncthreads();
          CKSTAMP(4);
          { const int rr = tid >> 3, cc = (tid & 7) * 16; unsigned char* o = (unsigned char*)cm + rr * 128 + cc;
            *(u32x4*)(o) = *(const LAS u32x4*)(lds + CK_AT + rr * CK_TP + cc); *(u32x4*)(o + 8192) = *(const LAS u32x4*)(lds + CK_BT + rr * CK_TP + cc);
            *(u32x4*)(o + 16384) = *(const LAS u32x4*)(lds + CK_KT + rr * CK_TP + cc); *(u32x4*)(o + 24576) = *(const LAS u32x4*)(lds + CK_N + rr * CK_TP + cc); } }
        __syncthreads();
        CKSTAMP(5);
    }
}

__device__ __forceinline__ void phase_cscan(const PArgs& a, LAS unsigned char* lds) {
    const int bidx_ = obid();
    const int tid = otid(), lane = tid & 63, wave = __builtin_amdgcn_readfirstlane(tid >> 6), G = ogrid(), ql = lane & 31, hh = lane >> 5;
    for (int task = bidx_; task < 64; task += G) { const bool gdn = task >= 32; const int bh = task & 31;
        const bf16* cm = (const bf16*)(a.ws + (gdn ? S_CMG : S_CMR)) + (size_t)bh * 64 * (CM_ITEM / 2); bf16* s0 = (bf16*)(a.ws + (gdn ? S_S0G : S_S0R)) + (size_t)bh * 64 * 4096;
        const int rq = (wave >> 1) & 1, cq = wave & 1;
        for (int q = tid; q < 64 * CK_TP / 4; q += NTH) ((LAS unsigned*)lds)[q] = 0u;
        __syncthreads();
        bf16x8 ga[4][4]; u32x2 hc[4][4];
        if (wave < 4) {
#pragma unroll
            for (int u = 0; u < 4; ++u) { const bf16* cn = cm + (size_t)u * (CM_ITEM / 2);
#pragma unroll
                for (int ks = 0; ks < 4; ++ks) ga[u][ks] = *(const bf16x8*)(cn + (32 * rq + ql) * 64 + 16 * ks + 8 * hh);
#pragma unroll
                for (int g4 = 0; g4 < 4; ++g4) hc[u][g4] = *(const u32x2*)(cn + 4096 + (32 * cq + ql) * 64 + 32 * rq + 8 * g4 + 4 * hh); } }
        for (int c0 = 0; c0 < 64; c0 += 4) {
#pragma unroll
            for (int u = 0; u < 4; ++u) { const int c = c0 + u; const LAS unsigned char* sc = lds + (u & 1) * (64 * CK_TP); LAS unsigned char* sn = lds + ((u + 1) & 1) * (64 * CK_TP);
                { const int rr = tid >> 3, cc = (tid & 7) * 16; *(u32x4*)((unsigned char*)(s0 + (size_t)c * 4096) + rr * 128 + cc) = *(const LAS u32x4*)(sc + rr * CK_TP + cc); }
                if (wave < 4) { f32x16 acc;
#pragma unroll
                    for (int g4 = 0; g4 < 4; ++g4) { acc[4 * g4] = bf2f(hc[u][g4].x & 0xffffu); acc[4 * g4 + 1] = bf2f(hc[u][g4].x >> 16); acc[4 * g4 + 2] = bf2f(hc[u][g4].y & 0xffffu); acc[4 * g4 + 3] = bf2f(hc[u][g4].y >> 16); }
#pragma unroll
                    for (int ks = 0; ks < 4; ++ks) acc = __builtin_amdgcn_mfma_f32_32x32x16_bf16(ga[u][ks], ck_frag(sc, 32 * cq + ql, ks, hh), acc, 0, 0, 0);
                    if (c + 4 < 64) { const bf16* cn = cm + (size_t)(c + 4) * (CM_ITEM / 2);
#pragma unroll
                        for (int ks = 0; ks < 4; ++ks) ga[u][ks] = *(const bf16x8*)(cn + (32 * rq + ql) * 64 + 16 * ks + 8 * hh);
#pragma unroll
                        for (int g4 = 0; g4 < 4; ++g4) hc[u][g4] = *(const u32x2*)(cn + 4096 + (32 * cq + ql) * 64 + 32 * rq + 8 * g4 + 4 * hh); }
#pragma unroll
                    for (int g4 = 0; g4 < 4; ++g4) *(LAS u32x2*)(sn + (32 * cq + ql) * CK_TP + (32 * rq + 8 * g4 + 4 * hh) * 2) = (u32x2){pk2(acc[4 * g4], acc[4 * g4 + 1]), pk2(acc[4 * g4 + 2], acc[4 * g4 + 3])}; }
                __syncthreads();
            }
        }
    }
}

struct CoIn { bf16x8 sa[4], sb[4], qf[4]; u32x2 ya[4], yb[4]; };
__device__ __forceinline__ void co_load(const PArgs& a, int wt, int ql, int hh, CoIn& o) {
    const int item = wt >> 1, th = wt & 1; const bool gdn = item >= 2048; const int it = item & 2047;
    const bf16* cm = (const bf16*)(a.ws + (gdn ? S_CMG : S_CMR) + (size_t)it * CM_ITEM); const bf16* s0 = (const bf16*)(a.ws + (gdn ? S_S0G : S_S0R)) + (size_t)it * 4096;
    const bf16* yy = cm + 12288 + (32 * th + ql) * 64 + 4 * hh;
#pragma unroll
    for (int g4 = 0; g4 < 4; ++g4) { o.ya[g4] = *(const u32x2*)(yy + 8 * g4); o.yb[g4] = *(const u32x2*)(yy + 32 + 8 * g4); }
#pragma unroll
    for (int ks = 0; ks < 4; ++ks) { o.qf[ks] = *(const bf16x8*)(cm + 8192 + (32 * th + ql) * 64 + 16 * ks + 8 * hh); o.sa[ks] = *(const bf16x8*)(s0 + ql * 64 + 16 * ks + 8 * hh); o.sb[ks] = *(const bf16x8*)(s0 + (32 + ql) * 64 + 16 * ks + 8 * hh); }
}
__device__ __forceinline__ void phase_cout(const PArgs& a, int l) {
    const int bidx_ = obid();
    const int tid = otid(), lane = tid & 63, wave = __builtin_amdgcn_readfirstlane(tid >> 6), G = ogrid(), ql = lane & 31, hh = lane >> 5;
    CoIn in; { const int w0 = bidx_ * NWV + wave; if (w0 < 8192) co_load(a, w0, ql, hh, in); }
    for (int wt = bidx_ * NWV + wave; wt < 8192; wt += G * NWV) { const int item = wt >> 1, th = wt & 1; const bool gdn = item >= 2048; const int it = item & 2047, bh = it >> 6, ch = it & 63, b = bh >> 3, h = bh & 7;
        f32x16 y0, y1;
#pragma unroll
        for (int g4 = 0; g4 < 4; ++g4) { const u32x2 w0 = in.ya[g4], w1 = in.yb[g4];
            y0[4 * g4] = bf2f(w0.x & 0xffffu); y0[4 * g4 + 1] = bf2f(w0.x >> 16); y0[4 * g4 + 2] = bf2f(w0.y & 0xffffu); y0[4 * g4 + 3] = bf2f(w0.y >> 16);
            y1[4 * g4] = bf2f(w1.x & 0xffffu); y1[4 * g4 + 1] = bf2f(w1.x >> 16); y1[4 * g4 + 2] = bf2f(w1.y & 0xffffu); y1[4 * g4 + 3] = bf2f(w1.y >> 16); }
#pragma unroll
        for (int ks = 0; ks < 4; ++ks) { y0 = __builtin_amdgcn_mfma_f32_32x32x16_bf16(in.sa[ks], in.qf[ks], y0, 0, 0, 0); y1 = __builtin_amdgcn_mfma_f32_32x32x16_bf16(in.sb[ks], in.qf[ks], y1, 0, 0, 0); }
        if (wt + G * NWV < 8192) co_load(a, wt + G * NWV, ql, hh, in);
        const size_t tok = (size_t)b * SEQ + ch * 64 + 32 * th + ql; const size_t base = tok * HW + h * 64 + 4 * hh;
        float s1 = 0.f;
#pragma unroll
        for (int r = 0; r < 16; ++r) s1 += y0[r] + y1[r];
        if (!gdn) { s1 += __shfl_xor(s1, 32); const float mean = s1 * (1.f / 64.f); float s2 = 0.f;
#pragma unroll
            for (int r = 0; r < 16; ++r) { const float d0 = y0[r] - mean, d1 = y1[r] - mean; s2 += d0 * d0 + d1 * d1; }
            s2 += __shfl_xor(s2, 32); const float rstd = rsqrtf(s2 * (1.f / 64.f) + 64e-5f); const float bsc = ((const float*)(a.ws + WS_CTL + C_BSC))[tok * 8 + h];
            const bf16* RV = (const bf16*)(a.ws + S_RV) + base; const bf16* RG = (const bf16*)(a.ws + S_RG) + base; bf16* OA = (bf16*)(a.ws + S_OA) + base;
            const float* lng = INF(14) + l * 512 + h * 64 + 4 * hh; const float* lnb = INF(15) + l * 512 + h * 64 + 4 * hh;
#pragma unroll
            for (int half = 0; half < 2; ++half)
#pragma unroll
                for (int g4 = 0; g4 < 4; ++g4) { const int co = 32 * half + 8 * g4; const u32x2 vw = *(const u32x2*)(RV + co), gw = *(const u32x2*)(RG + co); const f32x4 lg = *(const f32x4*)(lng + co), lb = *(const f32x4*)(lnb + co);
                    const float vv[4] = {bf2f(vw.x & 0xffffu), bf2f(vw.x >> 16), bf2f(vw.y & 0xffffu), bf2f(vw.y >> 16)}, gg[4] = {bf2f(gw.x & 0xffffu), bf2f(gw.x >> 16), bf2f(gw.y & 0xffffu), bf2f(gw.y >> 16)}; float o[4];
#pragma unroll
                    for (int e = 0; e < 4; ++e) { const float yv = half ? y1[4 * g4 + e] : y0[4 * g4 + e]; o[e] = ((yv - mean) * rstd * lg[e] + lb[e] + bsc * vv[e]) * gg[e]; }
                    *(u32x2*)(OA + co) = (u32x2){pk2(o[0], o[1]), pk2(o[2], o[3])}; } }
        else { float s2 = 0.f;
#pragma unroll
            for (int r = 0; r < 16; ++r) s2 += y0[r] * y0[r] + y1[r] * y1[r];
            s2 += __shfl_xor(s2, 32); const float rstd = rsqrtf(s2 * (1.f / 64.f) + NORM_EPS);
            const bf16* ZG = (const bf16*)(a.ws + S_ZG) + base; bf16* OC = (bf16*)(a.ws + S_OC) + base; const float* gng = INF(29) + l * 64 + 4 * hh;
#pragma unroll
            for (int half = 0; half < 2; ++half)
#pragma unroll
                for (int g4 = 0; g4 < 4; ++g4) { const int co = 32 * half + 8 * g4; const u32x2 gw = *(const u32x2*)(ZG + co); const f32x4 ng = *(const f32x4*)(gng + co);
                    const float gg[4] = {bf2f(gw.x & 0xffffu), bf2f(gw.x >> 16), bf2f(gw.y & 0xffffu), bf2f(gw.y >> 16)}; float o[4];
#pragma unroll
                    for (int e = 0; e < 4; ++e) { const float yv = half ? y1[4 * g4 + e] : y0[4 * g4 + e]; o[e] = yv * rstd * ng[e] * siluf_(gg[e]); }
                    *(u32x2*)(OC + co) = (u32x2){pk2(o[0], o[1]), pk2(o[2], o[3])}; } }
    }
}
__device__ __forceinline__ void phase_router(const PArgs& a, LAS unsigned char* lds) {
    const int bidx_ = obid();
    const int tid = otid(), lane = tid & 63, wave = __builtin_amdgcn_readfirstlane(tid >> 6), G = ogrid();
    const int gw = bidx_ * NWV + wave, NGW = G * NWV;
    const float* gf = INF(34) + D; const float* wr = INF(38);
    int* sel = (int*)(a.ws + WS_CTL + C_SEL); float* wts = (float*)(a.ws + WS_CTL + C_WTS); int* rank = (int*)(a.ws + WS_CTL + C_RANK); float* rs1 = (float*)(a.ws + WS_CTL + C_RS1);
    unsigned* cnt = (unsigned*)(a.ws + WS_CTL + C_MOE);
    LAS float* wl = (LAS float*)lds;
    __syncthreads();
    for (int k = tid; k < D; k += NTH) { const float g = gf[k]; const f32x4 w0 = *(const f32x4*)(wr + (size_t)k * 8), w1 = *(const f32x4*)(wr + (size_t)k * 8 + 4);
        wl[0 * D + k] = w0[0] * g; wl[1 * D + k] = w0[1] * g; wl[2 * D + k] = w0[2] * g; wl[3 * D + k] = w0[3] * g; wl[4 * D + k] = w1[0] * g; wl[5 * D + k] = w1[1] * g; wl[6 * D + k] = w1[2] * g; wl[7 * D + k] = w1[3] * g; }
    __syncthreads();
    LAS unsigned* lcnt = (LAS unsigned*)(lds + 32768); LAS unsigned* gbase = lcnt + 8;
    for (int b0 = bidx_ * NWV; b0 < T / 8; b0 += G * NWV) { const int bi = b0 + wave; const bool act = bi < T / 8; int my_e0 = -1, my_e1 = -1;
        if (tid < 8) lcnt[tid] = 0u;
        if (act) {
        u32x2 xn[4]; const bf16* hbp = (const bf16*)(a.ws + WS_HB);
        { const u32x2* hr = (const u32x2*)(hbp + (size_t)(bi * 8) * D) + lane;
#pragma unroll
          for (int q = 0; q < 4; ++q) xn[q] = hr[64 * q]; }
        for (int i = 0; i < 8; ++i) { const int t = bi * 8 + i;
            f32x4 x[4];
#pragma unroll
            for (int q = 0; q < 4; ++q) x[q] = (f32x4){bf2f(xn[q].x & 0xffffu), bf2f(xn[q].x >> 16), bf2f(xn[q].y & 0xffffu), bf2f(xn[q].y >> 16)};
            if (i + 1 < 8) { const u32x2* hr = (const u32x2*)(hbp + (size_t)(t + 1) * D) + lane;
#pragma unroll
                for (int q = 0; q < 4; ++q) xn[q] = hr[64 * q]; }
            float ssq = 0.f; float lg[8];
#pragma unroll
            for (int e = 0; e < 8; ++e) lg[e] = 0.f;
#pragma unroll
            for (int q = 0; q < 4; ++q) { ssq += (x[q][0] * x[q][0] + x[q][1] * x[q][1]) + (x[q][2] * x[q][2] + x[q][3] * x[q][3]);
#pragma unroll
                for (int e = 0; e < 8; ++e) { const f32x4 w = *(const LAS f32x4*)(wl + e * D + (lane + 64 * q) * 4); lg[e] += (x[q][0] * w[0] + x[q][1] * w[1]) + (x[q][2] * w[2] + x[q][3] * w[3]); } }
            ssq = wave_sum(ssq); const float rs = rsqrtf(ssq * (1.f / D) + NORM_EPS);
#pragma unroll
            for (int e = 0; e < 8; ++e) lg[e] = wave_sum(lg[e]) * rs;
            int e0 = 0; float l0 = lg[0];
#pragma unroll
            for (int e = 1; e < 8; ++e) if (lg[e] > l0) { l0 = lg[e]; e0 = e; }
            int e1 = -1; float l1 = -3.4e38f;
#pragma unroll
            for (int e = 0; e < 8; ++e) if (e != e0 && lg[e] > l1) { l1 = lg[e]; e1 = e; }
            const float wa = 1.f / (1.f + __expf(l1 - l0));
            if (lane == i) { my_e0 = e0; my_e1 = e1; sel[t * 2] = e0; sel[t * 2 + 1] = e1; wts[t * 2] = wa; wts[t * 2 + 1] = 1.f - wa; rs1[t] = rs; } } }
        __syncthreads();
        unsigned woff[2][8];
#pragma unroll
        for (int s = 0; s < 2; ++s) { const int me = s ? my_e1 : my_e0;
#pragma unroll
            for (int e = 0; e < 8; ++e) { const unsigned long long m = __ballot(me == e); const int n = __popcll(m); unsigned o = 0;
                if (n != 0 && lane == 0) o = __hip_atomic_fetch_add(lcnt + e, (unsigned)n, __ATOMIC_RELAXED, __HIP_MEMORY_SCOPE_WORKGROUP);
                woff[s][e] = __builtin_amdgcn_readfirstlane(o); } }
        __syncthreads();
        if (tid < 8) gbase[tid] = atomicAdd(cnt + tid, lcnt[tid]);
        __syncthreads();
        if (act && lane < 8) {
#pragma unroll
            for (int s = 0; s < 2; ++s) { const int me = s ? my_e1 : my_e0; unsigned r = 0;
#pragma unroll
                for (int e = 0; e < 8; ++e) { const unsigned long long m = __ballot(me == e); if (me == e) r = gbase[e] + woff[s][e] + (unsigned)__popcll(m & ((1ull << lane) - 1ull)); }
                rank[(bi * 8 + lane) * 2 + s] = (int)r; } }
        __syncthreads();
    }
    __syncthreads();
}
__device__ __forceinline__ void phase_assign(const PArgs& a) {
    const int bidx_ = obid();
    const int tid = otid(), lane = tid & 63, wave = __builtin_amdgcn_readfirstlane(tid >> 6), G = ogrid();
    const int gw = bidx_ * NWV + wave, NGW = G * NWV;
    const unsigned* cnt = (const unsigned*)(a.ws + WS_CTL + C_MOE);
    const int* sel = (const int*)(a.ws + WS_CTL + C_SEL); const int* rank = (const int*)(a.ws + WS_CTL + C_RANK); const float* rs1 = (const float*)(a.ws + WS_CTL + C_RS1);
    int* dest = (int*)(a.ws + WS_CTL + C_DEST); float* rsx = (float*)(a.ws + WS_CTL + C_RSX); int* blke = (int*)(a.ws + WS_CTL + C_BLKE);
    const bf16* hb = (const bf16*)(a.ws + WS_HB); bf16* xg = (bf16*)(a.ws + S_XG);
    int pstart[9]; pstart[0] = 0;
#pragma unroll
    for (int e = 0; e < 8; ++e) pstart[e + 1] = pstart[e] + (int)((cnt[e] + 255u) / 256u) * 256;
    if (bidx_ == 0 && tid < NBLK_MAX + 1) { if (tid == NBLK_MAX) blke[NBLK_MAX] = pstart[8] / 256; else { int e = 0;
#pragma unroll
            for (int q = 1; q < 8; ++q) if (tid * 256 >= pstart[q]) e = q;
            blke[tid] = e; } }
    u32x4 nr0 = (u32x4){0u, 0u, 0u, 0u}, nr1 = nr0; int ne = 0, nrk = 0; float nrs = 0.f;
#define AS_LOAD(aa) do { const int as_ = (aa), t_ = as_ >> 1; ne = sel[as_]; nrk = rank[as_]; nrs = rs1[t_]; const u32x4* src_ = (const u32x4*)(hb + (size_t)t_ * D); nr0 = src_[lane]; nr1 = src_[lane + 64]; } while (0)
    if (gw < T * 2) AS_LOAD(gw);
    for (int as = gw; as < T * 2; as += NGW) { const int e = ne, rk = nrk; const float rsv = nrs; const u32x4 r0 = nr0, r1 = nr1;
        if (as + NGW < T * 2) AS_LOAD(as + NGW);
        int ps = 0;
#pragma unroll
        for (int q = 0; q < 8; ++q) if (e == q) ps = pstart[q];
        const int d = ps + rk;
        if (lane == 0) { dest[as] = d; rsx[d] = rsv; }
        u32x4* dst = (u32x4*)(xg + (size_t)d * D);
        dst[lane] = r0; dst[lane + 64] = r1; }
#undef AS_LOAD
}
__device__ __forceinline__ void phase_combine(const PArgs& a) {
    const int bidx_ = obid();
    const int tid = otid(), lane = tid & 63, wave = __builtin_amdgcn_readfirstlane(tid >> 6), G = ogrid();
    const int gw = bidx_ * NWV + wave, NGW = G * NWV;
    const int* dest = (const int*)(a.ws + WS_CTL + C_DEST); const float* wts = (const float*)(a.ws + WS_CTL + C_WTS);
    const bf16* y = (const bf16*)(a.ws + S_XG); bf16* hb = (bf16*)(a.ws + WS_HB);
    u32x2 nh[4], na[4], nb[4]; float nw0 = 0.f, nw1 = 0.f;
#define CB_LOAD(tt) do { const int t_ = (tt); const int d0_ = dest[t_ * 2], d1_ = dest[t_ * 2 + 1]; nw0 = wts[t_ * 2]; nw1 = wts[t_ * 2 + 1]; \
        const u32x2* hr_ = (const u32x2*)(hb + (size_t)t_ * D); const u32x2* y0_ = (const u32x2*)(y + (size_t)d0_ * D); const u32x2* y1_ = (const u32x2*)(y + (size_t)d1_ * D); \
        _Pragma("unroll") for (int q = 0; q < 4; ++q) { nh[q] = hr_[lane + 64 * q]; na[q] = y0_[lane + 64 * q]; nb[q] = y1_[lane + 64 * q]; } } while (0)
    if (gw < T) CB_LOAD(gw);
    for (int t = gw; t < T; t += NGW) { u32x2 ch[4], ca[4], cb2[4]; const float w0 = nw0, w1 = nw1;
#pragma unroll
        for (int q = 0; q < 4; ++q) { ch[q] = nh[q]; ca[q] = na[q]; cb2[q] = nb[q]; }
        if (t + NGW < T) CB_LOAD(t + NGW);
        u32x2* hbr = (u32x2*)(hb + (size_t)t * D);
#pragma unroll
        for (int q = 0; q < 4; ++q) { const int ix = lane + 64 * q; const u32x2 hw = ch[q], a0 = ca[q], a1 = cb2[q];
            const float h0 = bf2f(hw.x & 0xffffu) + w0 * bf2f(a0.x & 0xffffu) + w1 * bf2f(a1.x & 0xffffu), h1 = bf2f(hw.x >> 16) + w0 * bf2f(a0.x >> 16) + w1 * bf2f(a1.x >> 16);
            const float h2 = bf2f(hw.y & 0xffffu) + w0 * bf2f(a0.y & 0xffffu) + w1 * bf2f(a1.y & 0xffffu), h3 = bf2f(hw.y >> 16) + w0 * bf2f(a0.y >> 16) + w1 * bf2f(a1.y >> 16);
            u32x2 w; w.x = pk2(h0, h1); w.y = pk2(h2, h3); hbr[ix] = w; } }
#undef CB_LOAD
}
#ifndef PROBE_X
#define PROBE_X 0
#endif
#ifndef MK_ONE_LAUNCH
#define MK_ONE_LAUNCH 1
#endif
#define XB_TMO      128
#define XB_XCNT(j)  (256  + 64 * (j))
#define XB_XSUB(j)  (1280 + 64 * (j))
#define XB_XGEN(j)  (2304 + 64 * (j))
#define XB_TOP      3328
#define XB_TOPGEN   3392
#define XCD_BAR_WORDS 3456
#define XB_SPIN_CAP (1u << 22)
__device__ __forceinline__ unsigned xb_ld(unsigned* p)              { return __hip_atomic_load(p, __ATOMIC_RELAXED, __HIP_MEMORY_SCOPE_AGENT); }
__device__ __forceinline__ unsigned xb_add(unsigned* p, unsigned v) { return __hip_atomic_fetch_add(p, v, __ATOMIC_RELAXED, __HIP_MEMORY_SCOPE_AGENT); }
__device__ __forceinline__ unsigned xb_xcc_id() { return (unsigned)__builtin_amdgcn_s_getreg((3 << 11) | 20) & 0xFu; }
#define XB_SPIN(cond, bar) do { unsigned _sp = 0; while (cond) { __builtin_amdgcn_s_sleep(1); \
    if ((++_sp & 255u) == 0u) { if (xb_ld(&(bar)[XB_TMO])) break; if (_sp > XB_SPIN_CAP) { atomicAdd(&(bar)[XB_TMO], 1u); break; } } } } while (0)
struct XcdBarrier { unsigned* bar; unsigned x; volatile LAS unsigned* st; };
__device__ __forceinline__ XcdBarrier xcd_barrier_post(unsigned* bar, volatile LAS unsigned* st) {
    XcdBarrier b; b.bar = bar; b.x = xb_xcc_id(); b.st = st;
    if (threadIdx.x == 0) (void)xb_add(&bar[XB_XCNT(b.x)], 1u);
    return b;
}
__device__ __forceinline__ void xcd_barrier_complete(unsigned* bar, unsigned x, unsigned& nloc, unsigned& nx) {
    const unsigned G = gridDim.x * gridDim.y * gridDim.z;
    unsigned sum, cnt, mine, sp = 0u;
    for (;;) {
        sum = 0u; cnt = 0u; mine = 0u;
#pragma unroll
        for (unsigned j = 0; j < 16; ++j) { const unsigned c = xb_ld(&bar[XB_XCNT(j)]); sum += c; cnt += (c > 0u) ? 1u : 0u; mine = (j == x) ? c : mine; }
        if (sum == G) break;
        __builtin_amdgcn_s_sleep(1);
        if ((++sp & 255u) == 0u) { if (xb_ld(&bar[XB_TMO])) break; if (sp > XB_SPIN_CAP) { atomicAdd(&bar[XB_TMO], 1u); break; } }
    }
    nloc = mine > 0u ? mine : 1u; nx = cnt > 0u ? cnt : 1u;
}
__device__ __forceinline__ void xcd_barrier(const XcdBarrier& b_) {
    asm volatile("s_waitcnt vmcnt(0)" ::: "memory");
    __syncthreads();
    if (otid() == 0) {
        XcdBarrier b = b_; asm volatile("" : "+s"(b.bar)); b.x = xb_xcc_id();
        unsigned* bar = b.bar;
        __builtin_amdgcn_s_waitcnt(0);
        unsigned nloc = b.st[0], nx = b.st[1];
        if (nloc == 0u) { xcd_barrier_complete(bar, b.x, nloc, nx); b.st[0] = nloc; b.st[1] = nx; }
        const unsigned old = xb_add(&bar[XB_XSUB(b.x)], 1u);
        const unsigned gen = old / nloc;
        if (old + 1u == (gen + 1u) * nloc) {
            __builtin_amdgcn_fence(__ATOMIC_RELEASE, "agent");
            asm volatile("s_waitcnt vmcnt(0)" ::: "memory");
            const unsigned og = xb_add(&bar[XB_TOP], 1u);
            const unsigned tg = og / nx;
            if (og + 1u == (tg + 1u) * nx) xb_add(&bar[XB_TOPGEN], 1u);
            else XB_SPIN(xb_ld(&bar[XB_TOPGEN]) == tg, bar);
            __builtin_amdgcn_fence(__ATOMIC_ACQUIRE, "agent");
            xb_add(&bar[XB_XGEN(b.x)], 1u);
            asm volatile("s_waitcnt vmcnt(0)" ::: "memory");
        } else {
            XB_SPIN(xb_ld(&bar[XB_XGEN(b.x)]) == gen, bar);
            __builtin_amdgcn_fence(__ATOMIC_ACQUIRE, "agent");
            asm volatile("s_waitcnt vmcnt(0)" ::: "memory");
        }
    }
    __syncthreads();
}

enum PhaseKind { PK_PRO = 0, PK_G1A, PK_PRE, PK_G23, PK_MLAPOST, PK_ATT, PK_RGPREP, PK_SCAN, PK_FIN, PK_G1B, PK_MRG, PK_OUT, PK_FGU, PK_FD, PK_MOEA, PK_MOEB, PK_MGU0, PK_MD0, PK_MGU1, PK_MD1, PK_COMB, PK_PP, PK_PG, PK_COUT };
struct PhaseEnt { int kind, layer; };
__constant__ PhaseEnt g_prog[] = {
    {PK_PRO, 0},
    {PK_G1A, 0}, {PK_PRE, 0}, {PK_G23, 0}, {PK_MLAPOST, 0}, {PK_ATT, 0}, {PK_RGPREP, 0}, {PK_SCAN, 0}, {PK_FIN, 0}, {PK_COUT, 0}, {PK_G1B, 0}, {PK_MRG, 0}, {PK_OUT, 0}, {PK_FGU, 0}, {PK_FD, 0}, {PK_PP, 0}, {PK_PG, 0},
    {PK_G1A, 1}, {PK_PRE, 1}, {PK_G23, 1}, {PK_MLAPOST, 1}, {PK_ATT, 1}, {PK_RGPREP, 1}, {PK_SCAN, 1}, {PK_FIN, 1}, {PK_COUT, 1}, {PK_G1B, 1}, {PK_MRG, 1}, {PK_OUT, 1},
    {PK_MOEA, 1}, {PK_MOEB, 1}, {PK_MGU0, 1}, {PK_MD0, 1}, {PK_MGU1, 1}, {PK_MD1, 1}, {PK_COMB, 1}, {PK_PP, 1}, {PK_PG, 1},
};
constexpr int NPHASE = sizeof(g_prog) / sizeof(PhaseEnt);

constexpr int LDS_BYTES = 163840;
constexpr int LDS_MISC = 163840 - 1024;

template <int KINDT> __device__ __forceinline__ void run_phase(const Args& a_, int kind_rt, int l, LAS unsigned char* lds) {
    const int kind = KINDT >= 0 ? KINDT : kind_rt; const PArgs a = make_pargs(a_);
    const int G = ogrid(), c = obid();
    unsigned char* ws = a.ws;
    const bf16* Wl = (const bf16*)(ws + WS_W + (size_t)l * WL);
    float* SS0 = (float*)(ws + S_SSP0); float* SS1 = (float*)(ws + S_SSP1); float* SSE = (float*)(ws + S_SSP2);
    bf16* HB = (bf16*)(ws + WS_HB); const bf16* HBin = (const bf16*)(ws + (l == 0 ? WS_HB : WS_HB2));
    const bf16* Wp = (const bf16*)(ws + WS_W + W_PLE + (size_t)l * WPL);
    switch (kind) {
    case PK_PRO: phase_prologue(a, lds); break;
    case PK_G1A: { pg8::Gemm g{HBin, Wl + W_IN / 2, D, D, D}; pg8::StaticOrder S; S.init(T / 256, N1 / 256, G, c);
        EpiInProj E{(bf16*)(ws + S_ZR), (bf16*)(ws + S_ZQ), (bf16*)(ws + S_ZG), (bf16*)(ws + S_ZM), SS0}; pg8::gemm_phase(lds, g, S, E); } break;
    case PK_PRE: phase_pre(a, l); break;
    case PK_G23: { { pg8::Gemm g{(const bf16*)(ws + S_ZM), Wl + W_2 / 2, K2, NZM, K2}; pg8::StaticOrder S; S.init(T / 256, N2 / 256, G, c);
            EpiMla E{(bf16*)(ws + S_QRAW), (bf16*)(ws + S_KVRAW), (const float*)(ws + WS_CTL + C_RSQ), (const float*)(ws + WS_CTL + C_RSKV)}; pg8::gemm_phase(lds, g, S, E); }
        { pg8::Gemm g{(const bf16*)(ws + S_A2), Wl + W_3 / 2, K3, K3, K3}; pg8::StaticOrder S; S.init(T / 256, N3 / 256, G, c);
            EpiPlain E{(bf16*)(ws + S_L2), N3}; pg8::gemm_phase(lds, g, S, E); } } break;
    case PK_MLAPOST: phase_mla_post(a, l, lds); break;
    case PK_ATT: phase_attn<0>(a, lds);
#if PROBE_X >= 10
        phase_attn<PROBE_X - 10>(a, lds);
#endif
        break;
    case PK_RGPREP: phase_rwkv_post(a, l); phase_gdn_prep(a, l); break;
    case PK_SCAN: phase_cprep(a, lds); break;
    case PK_FIN: phase_cscan(a, lds); break;
    case PK_COUT: phase_cout(a, l); break;
    case PK_G1B: { pg8::Gemm g{HBin, Wl + W_GATE / 2, D, D, D}; pg8::StaticOrder S; S.init(T / 256, NGATE / 256, G, c);
        EpiGate E{(bf16*)(ws + S_ZS), SS0}; pg8::gemm_phase(lds, g, S, E); } break;
    case PK_MRG: { pg8::StaticOrder S; S.init(T / 256, D / 256, G, c);
        { pg8::Gemm g{(const bf16*)(ws + S_OA), Wl + W_BRA / 2, HW, HW, HW}; EpiMerge<true> E{(bf16*)(ws + S_M), (const bf16*)(ws + S_ZS), 0}; pg8::gemm_phase(lds, g, S, E); }
        { pg8::Gemm g{(const bf16*)(ws + S_OB), Wl + W_BRB / 2, HW, HW, HW}; EpiMerge<false> E{(bf16*)(ws + S_M), (const bf16*)(ws + S_ZS), 1}; pg8::gemm_phase(lds, g, S, E); }
        { pg8::Gemm g{(const bf16*)(ws + S_OC), Wl + W_BRC / 2, HW, HW, HW}; EpiMerge<false> E{(bf16*)(ws + S_M), (const bf16*)(ws + S_ZS), 2}; pg8::gemm_phase(lds, g, S, E); } } break;
    case PK_OUT: { pg8::Gemm g{(const bf16*)(ws + S_M), Wl + W_OUT / 2, D, D, D}; pg8::StaticOrder S; S.init(T / 256, D / 256, G, c);
#if PROBE_X == 1
        { EpiPlain E2{(bf16*)(ws + S_ZR), D}; pg8::gemm_phase(lds, g, S, E2); }
#endif
        EpiResid E{l == 0 ? INF(0) : nullptr, HBin, HB, SS1}; pg8::gemm_phase(lds, g, S, E); } break;
    case PK_FGU: { pg8::Gemm g{HB, (const bf16*)(ws + WS_W + W_FGU), D, D, D}; pg8::StaticOrder S; S.init(T / 256, 2 * FFD / 256, G, c);
        EpiSwiglu<false> E{(bf16*)(ws + S_ACT), FFD, SS1}; pg8::gemm_phase(lds, g, S, E); } break;
    case PK_FD: { pg8::Gemm g{(const bf16*)(ws + S_ACT), (const bf16*)(ws + WS_W + W_FD), FFD, FFD, FFD}; pg8::StaticOrder S; S.init(T / 256, D / 256, G, c);
#if PROBE_X == 2
        { EpiPlain E2{(bf16*)(ws + WS_S + 100 * MiB), D}; pg8::gemm_phase(lds, g, S, E2); }
#endif
        EpiResid E{nullptr, HB, HB, nullptr}; pg8::gemm_phase(lds, g, S, E); } break;
    case PK_MOEA: {
#if PROBE_SUB
        __syncthreads(); const unsigned long long ts0 = __builtin_amdgcn_s_memrealtime();
#endif
        phase_moe_cvt(a, lds);
#if PROBE_SUB
        __syncthreads(); const unsigned long long ts1 = __builtin_amdgcn_s_memrealtime();
#endif
        phase_router(a, lds);
#if PROBE_SUB
        __syncthreads(); const unsigned long long ts2 = __builtin_amdgcn_s_memrealtime();
        if (threadIdx.x == 0) ((volatile LAS unsigned*)(lds + LDS_MISC))[32] = (unsigned)((PROBE_SUB == 1) ? (ts1 - ts0) : (ts2 - ts1));
#endif
        } break;
    case PK_MOEB: phase_assign(a); break;
    case PK_MGU0: case PK_MGU1: { const int half = (kind == PK_MGU1); const int* blke = (const int*)(ws + WS_CTL + C_BLKE); const int nblk = __builtin_amdgcn_readfirstlane(blke[NBLK_MAX]);
        const int lo = half * HALF_BLK, hi = nblk < lo + HALF_BLK ? nblk : lo + HALF_BLK, nM = hi > lo ? hi - lo : 0;
        pg8::Gemm g{(const bf16*)(ws + S_XG), (const bf16*)(ws + S_MWGU), D, D, D}; pg8::StaticOrder S; S.init(nM, 2 * FFE / 256, G, c, lo, blke);
        EpiSwiglu<true> E{(bf16*)(ws + S_MACT) - (size_t)lo * 256 * FFE, FFE, (const float*)(ws + WS_CTL + C_RSX)}; pg8::gemm_phase(lds, g, S, E); } break;
    case PK_MD0: case PK_MD1: { const int half = (kind == PK_MD1); const int* blke = (const int*)(ws + WS_CTL + C_BLKE); const int nblk = __builtin_amdgcn_readfirstlane(blke[NBLK_MAX]);
        const int lo = half * HALF_BLK, hi = nblk < lo + HALF_BLK ? nblk : lo + HALF_BLK, nM = hi > lo ? hi - lo : 0;
        pg8::Gemm g{(const bf16*)(ws + S_MACT) - (size_t)lo * 256 * FFE, (const bf16*)(ws + S_MWD), FFE, FFE, FFE}; pg8::StaticOrder S; S.init(nM, D / 256, G, c, lo, blke);
        EpiPlain E{(bf16*)(ws + S_XG), D}; pg8::gemm_phase(lds, g, S, E); } break;
    case PK_COMB: phase_combine(a); break;
    case PK_PP: { pg8::Gemm g{(const bf16*)(ws + WS_PB) + (size_t)l * T * PLE, Wp + W_PP / 2, PLE, PLE, PLE}; pg8::StaticOrder S; S.init(T / 256, D / 256, G, c);
        EpiPleProj E{(bf16*)(ws + S_E), SSE}; pg8::gemm_phase(lds, g, S, E); } break;
    case PK_PG: { pg8::Gemm g{HB, Wp + W_PG / 2, D, D, D}; pg8::StaticOrder S; S.init(T / 256, D / 256, G, c);
#if PROBE_X == 3
        { EpiPlain E2{(bf16*)(ws + WS_S + 100 * MiB), D}; pg8::gemm_phase(lds, g, S, E2); }
#endif
        EpiPleGate E{l + 1 < NL ? nullptr : a.out, HB, l + 1 < NL ? (bf16*)(ws + WS_HB2) : nullptr, (const bf16*)(ws + S_E), SSE, INF(44) + l * D, l + 1 < NL ? SS0 : nullptr}; pg8::gemm_phase(lds, g, S, E); } break;
    default: break;
    }
}

template <int KINDT> __global__ void __launch_bounds__(NTH, 2) k_one(Args a, int l) {
    extern __shared__ __attribute__((aligned(16))) unsigned char lds_raw[];
    run_phase<KINDT>(a, KINDT, l, (LAS unsigned char*)lds_raw);
}
#if MK_ONE_LAUNCH
__global__ void __launch_bounds__(NTH, 2) k_fwd(Args a) {
    extern __shared__ __attribute__((aligned(16))) unsigned char lds_raw[];
    LAS unsigned char* lds = (LAS unsigned char*)lds_raw;
    volatile LAS unsigned* misc = (volatile LAS unsigned*)(lds + LDS_MISC);
    if (threadIdx.x < 64) misc[threadIdx.x] = 0u;
    __syncthreads();
    const XcdBarrier bar = xcd_barrier_post((unsigned*)(a.ws + WS_CTL + C_BAR), misc + 8);
#ifndef PROBE_MASK
#define PROBE_MASK 0u
#endif
#define BAR() xcd_barrier(bar)
#ifndef PROBE_T
#define PROBE_T 0u
#endif
#ifndef PROBE_TDIV
#define PROBE_TDIV 1000
#endif
#define RUN(K, l) do { if ((PROBE_MASK >> K) & 1u) { run_phase<K>(a, K, l, lds); BAR(); } \
    unsigned long long t0_ = 0; if ((PROBE_T >> K) & 1u) { BAR(); t0_ = __builtin_amdgcn_s_memrealtime(); } run_phase<K>(a, K, l, lds); if ((PROBE_T >> K) & 1u) { BAR(); tacc_ += __builtin_amdgcn_s_memrealtime() - t0_; } } while (0)
#ifdef PROBE_BARS
    for (int q = 0; q < PROBE_BARS; ++q) BAR();
#endif
    unsigned long long tacc_ = 0;
    RUN(PK_PRO, 0); BAR();
#define MIXER(l) RUN(PK_G1A, l); BAR(); RUN(PK_PRE, l); BAR(); RUN(PK_G23, l); BAR(); RUN(PK_MLAPOST, l); BAR(); RUN(PK_ATT, l); BAR(); RUN(PK_RGPREP, l); BAR(); \
        RUN(PK_SCAN, l); BAR(); RUN(PK_FIN, l); BAR(); RUN(PK_COUT, l); BAR(); RUN(PK_G1B, l); BAR(); RUN(PK_MRG, l); BAR(); RUN(PK_OUT, l); BAR();
    MIXER(0)
    RUN(PK_FGU, 0); BAR(); RUN(PK_FD, 0); RUN(PK_PP, 0); BAR();
    RUN(PK_PG, 0); BAR();
    MIXER(1)
    RUN(PK_MOEA, 1); BAR(); RUN(PK_MOEB, 1); BAR(); RUN(PK_MGU0, 1); BAR(); RUN(PK_MD0, 1); BAR(); RUN(PK_MGU1, 1); BAR(); RUN(PK_MD1, 1); RUN(PK_PP, 1); BAR(); RUN(PK_COMB, 1); BAR();
    RUN(PK_PG, 1);
#undef MIXER
    if (PROBE_T != 0u) { BAR(); if (blockIdx.x == 0 && threadIdx.x == 0) a.out[0] = (float)(tacc_ / PROBE_TDIV); }
#if PROBE_SUB
    BAR(); if (blockIdx.x == 0 && threadIdx.x == 0) a.out[0] = (float)(misc[PROBE_SUB >= 10 ? 40 : 32] / PROBE_TDIV);
#endif
#undef RUN
#undef BAR
}
#endif

#ifndef MK_ONE_LAUNCH
#define MK_ONE_LAUNCH 1
#endif
extern "C" void kernel_launch(void* const* d_in, const int* in_sizes, int n_in, void* d_out, int out_size, void* d_ws, size_t ws_size, hipStream_t stream) {
    static int grid = 0;
    if (grid == 0) {
        if (n_in != 45 || out_size != T * D || ws_size < WS_END) { fprintf(stderr, "kernel_launch: unexpected shapes: n_in %d out %d ws %zu (need %zu)\n", n_in, out_size, ws_size, (size_t)WS_END); grid = -1; return; }
        int dev = 0, cus = 0;
        if (hipGetDevice(&dev) != hipSuccess || hipDeviceGetAttribute(&cus, hipDeviceAttributeMultiprocessorCount, dev) != hipSuccess) { grid = -1; return; }
#if MK_ONE_LAUNCH
        if (hipFuncSetAttribute((const void*)k_fwd, hipFuncAttributeMaxDynamicSharedMemorySize, LDS_BYTES) != hipSuccess) { fprintf(stderr, "kernel_launch: hipFuncSetAttribute failed\n"); grid = -1; return; }
#else
#define SA(K) (void)hipFuncSetAttribute((const void*)k_one<K>, hipFuncAttributeMaxDynamicSharedMemorySize, LDS_BYTES);
        SA(PK_PRO) SA(PK_G1A) SA(PK_PRE) SA(PK_G23) SA(PK_MLAPOST) SA(PK_ATT) SA(PK_RGPREP) SA(PK_SCAN) SA(PK_FIN) SA(PK_G1B) SA(PK_MRG) SA(PK_OUT) SA(PK_FGU) SA(PK_FD) SA(PK_MOEA) SA(PK_MOEB) SA(PK_MGU0) SA(PK_MD0) SA(PK_MGU1) SA(PK_MD1) SA(PK_COMB) SA(PK_PP) SA(PK_PG) SA(PK_COUT)
#undef SA
#endif
        int per_cu = 0;
#if MK_ONE_LAUNCH
        if (hipOccupancyMaxActiveBlocksPerMultiprocessor(&per_cu, (const void*)k_fwd, NTH, LDS_BYTES) != hipSuccess || per_cu < 1) { fprintf(stderr, "kernel_launch: occupancy query says %d blocks/CU\n", per_cu); }
#endif
        (void)hipGetLastError();
        grid = cus;
    }
    if (grid < 0) return;
    (void)hipMemsetAsync((char*)d_ws + WS_CTL, 0, CTL_ZERO, stream);
    (void)hipMemsetAsync((char*)d_ws + WS_W, 0, 71 * MiB, stream);
    Args a{};
    for (int i = 0; i < 45; ++i) a.in[i] = d_in[i];
    a.out = (float*)d_out; a.ws = (unsigned char*)d_ws; a.layer = 0; a.pad = 0;
#if MK_ONE_LAUNCH
    hipLaunchKernelGGL(k_fwd, dim3(grid), dim3(NTH), LDS_BYTES, stream, a);
#else
    static const PhaseEnt prog_h[] = {
        {PK_PRO, 0},
        {PK_G1A, 0}, {PK_PRE, 0}, {PK_G23, 0}, {PK_MLAPOST, 0}, {PK_ATT, 0}, {PK_RGPREP, 0}, {PK_SCAN, 0}, {PK_FIN, 0}, {PK_COUT, 0}, {PK_G1B, 0}, {PK_MRG, 0}, {PK_OUT, 0}, {PK_FGU, 0}, {PK_FD, 0}, {PK_PP, 0}, {PK_PG, 0},
        {PK_G1A, 1}, {PK_PRE, 1}, {PK_G23, 1}, {PK_MLAPOST, 1}, {PK_ATT, 1}, {PK_RGPREP, 1}, {PK_SCAN, 1}, {PK_FIN, 1}, {PK_COUT, 1}, {PK_G1B, 1}, {PK_MRG, 1}, {PK_OUT, 1},
        {PK_MOEA, 1}, {PK_MOEB, 1}, {PK_MGU0, 1}, {PK_MD0, 1}, {PK_MGU1, 1}, {PK_MD1, 1}, {PK_COMB, 1}, {PK_PP, 1}, {PK_PG, 1} };
    for (int p = 0; p < (int)(sizeof(prog_h) / sizeof(prog_h[0])); ++p) { const int l = prog_h[p].layer;
#define LK(K) case K: hipLaunchKernelGGL(k_one<K>, dim3(grid), dim3(NTH), LDS_BYTES, stream, a, l); break;
        switch (prog_h[p].kind) { LK(PK_PRO) LK(PK_G1A) LK(PK_PRE) LK(PK_G23) LK(PK_MLAPOST) LK(PK_ATT) LK(PK_RGPREP) LK(PK_SCAN) LK(PK_FIN) LK(PK_G1B) LK(PK_MRG) LK(PK_OUT) LK(PK_FGU) LK(PK_FD) LK(PK_MOEA) LK(PK_MOEB) LK(PK_MGU0) LK(PK_MD0) LK(PK_MGU1) LK(PK_MD1) LK(PK_COMB) LK(PK_PP) LK(PK_PG) LK(PK_COUT) default: break; }
#undef LK
    }
#endif
}
```

```cpp
#include <hip/hip_runtime.h>
#include <cstdio>
#include <cstdint>
#ifndef PROBE_SUB
#define PROBE_SUB 0
#endif
__device__ __forceinline__ int otid() { int t = threadIdx.x; asm volatile("" : "+v"(t)); return t; }
__device__ __forceinline__ int obid() { int t = blockIdx.x; asm volatile("" : "+s"(t)); return t; }
__device__ __forceinline__ int ogrid() { int t = gridDim.x; asm volatile("" : "+s"(t)); return t; }
namespace pg8 {
#define PG8_LAS __attribute__((address_space(3)))
typedef unsigned short bf16_t;
typedef short bf16x8 __attribute__((ext_vector_type(8)));
typedef float f32x4 __attribute__((ext_vector_type(4)));
typedef unsigned u32x4 __attribute__((ext_vector_type(4)));
typedef unsigned u32x2 __attribute__((ext_vector_type(2)));
constexpr int BM = 256, BK = 64, HALF = 128, HTB = HALF * BK * 2, STAGE_BYTES = 8 * HTB, NXCD = 8, WGM = 8;

__host__ __device__ __forceinline__ int lds_byte(int r, int c) { const int st = (r >> 4) * 2 + (c >> 5), rr = r & 15, cc = c & 31, ob = rr * 64 + cc * 2; return st * 1024 + (ob ^ (((ob >> 9) & 1) << 5)); }
__host__ __device__ __forceinline__ void stage_rc(int b, int& R, int& C) { const int st = b / 1024, sb = b % 1024, swz = sb ^ (((sb >> 9) & 1) << 5); R = (st >> 1) * 16 + swz / 64; C = (st & 1) * 32 + (swz % 64) / 2; }
__host__ __device__ __forceinline__ int perm32(int rho) { const int n = rho >> 4, i = rho & 15; return 8 * (i >> 2) + 4 * n + (i & 3); }

struct Unit { int pm, pn, pb; };
struct Gemm { const bf16_t* A; const bf16_t* Bt; int K, lda, ldb; };

struct StaticOrder {
    int nM, nN, nwg, G, c, pm0; const int* blk_e;
    __device__ void init(int nM_, int nN_, int G_, int c_, int pm0_ = 0, const int* blk_e_ = nullptr) { nM = nM_; nN = nN_; nwg = nM * nN; G = G_; c = c_; pm0 = pm0_; blk_e = blk_e_; }
    __device__ bool next(int i, Unit& u) const {
        const long L = (long)i * G + c; if (L >= nwg) return false;
        int wgid = (int)L; { const int q = nwg / NXCD, r = nwg % NXCD, xcd = wgid % NXCD, off = wgid / NXCD; wgid = (xcd < r ? xcd * (q + 1) : r * (q + 1) + (xcd - r) * q) + off; }
        const int nig = WGM * nN, gid = wgid / nig, fm = gid * WGM, gsz = (nM - fm) < WGM ? (nM - fm) : WGM;
        u.pm = pm0 + fm + ((wgid % nig) % gsz); u.pn = (wgid % nig) / gsz;
        u.pb = blk_e ? (__builtin_amdgcn_readfirstlane(blk_e[u.pm]) * nN + u.pn) : u.pn;
        return true;
    }
};

typedef float cvt_f32x2 __attribute__((ext_vector_type(2)));
typedef __bf16 cvt_bf16x2 __attribute__((ext_vector_type(2)));
__device__ __forceinline__ unsigned cvt_pk_bf16(float lo, float hi) { const cvt_f32x2 v = {lo, hi}; return __builtin_bit_cast(unsigned, __builtin_convertvector(v, cvt_bf16x2)); }

template <class Epi, class Sched>
__device__ __forceinline__ void gemm_phase(PG8_LAS unsigned char* lds, const Gemm g, const Sched& S, const Epi& E) {
    const int tid = otid(), wid = __builtin_amdgcn_readfirstlane(tid >> 6), lane = tid & 63, wr = wid >> 2, wc = wid & 3, fr = lane & 15, fq = lane >> 4;
    const int K = g.K, nt = K / BK;
    unsigned voffA[2], voffB[2];
#pragma unroll
    for (int i = 0; i < 2; ++i) { int R, C; stage_rc(tid * 16 + i * 8192, R, C); const int Rb = Epi::PERM ? ((R & ~31) + perm32(R & 31)) : R;
        voffA[i] = (unsigned)(R * g.lda + C) * 2u; voffB[i] = (unsigned)(Rb * g.ldb + C) * 2u; }
    const size_t kstep = (size_t)(BK * 2);
    const size_t hA = (size_t)HALF * g.lda * 2, hB = (size_t)HALF * g.ldb * 2;
    const size_t tA = 2 * hA, tB = 2 * hB;
    const unsigned ldsw = (unsigned)wid * 1024u;
    const int aoff = lds_byte(wr * 64 + fr, fq * 8), boff = lds_byte(wc * 32 + fr, fq * 8);
#define PG8_SA(b, h) (((b) * 2 + (h)) * HTB)
#define PG8_SB(b, h) ((4 + (b) * 2 + (h)) * HTB)
#define PG8_STAGE(bufoff, gbase, voff) do { _Pragma("unroll") for (int _i = 0; _i < 2; ++_i) \
        __builtin_amdgcn_global_load_lds((const unsigned*)((const char*)(gbase) + (voff)[_i]), (PG8_LAS unsigned*)(lds + (bufoff) + ldsw + _i * 8192), 16, 0, 0); } while (0)
#define PG8_LDA(dst, b, h) do { _Pragma("unroll") for (int m = 0; m < 4; ++m) _Pragma("unroll") for (int k = 0; k < 2; ++k) dst[m][k] = *(const PG8_LAS bf16x8*)(lds + PG8_SA(b, h) + aoff + m * 2048 + k * 1024); } while (0)
#define PG8_LDB(dst, b, h) do { _Pragma("unroll") for (int n = 0; n < 2; ++n) _Pragma("unroll") for (int k = 0; k < 2; ++k) dst[n][k] = *(const PG8_LAS bf16x8*)(lds + PG8_SB(b, h) + boff + n * 2048 + k * 1024); } while (0)
#define PG8_MMA(ai, bj, At, Bt) do { __builtin_amdgcn_s_setprio(1); _Pragma("unroll") for (int m = 0; m < 4; ++m) _Pragma("unroll") for (int n = 0; n < 2; ++n) _Pragma("unroll") for (int k = 0; k < 2; ++k) \
        acc[ai][bj][m][n] = __builtin_amdgcn_mfma_f32_16x16x32_bf16(Bt[n][k], At[m][k], acc[ai][bj][m][n], 0, 0, 0); __builtin_amdgcn_s_setprio(0); } while (0)
#define PG8_WAIT_V(n) asm volatile("s_waitcnt vmcnt(" #n ")" ::: "memory")
#define PG8_WAIT_L(n) asm volatile("s_waitcnt lgkmcnt(" #n ")" ::: "memory")
#define PG8_BAR __builtin_amdgcn_s_barrier()
#define PG8_SCHED __builtin_amdgcn_sched_barrier(0)
    Unit cur, nxt; int ui = 0;
    if (!S.next(0, cur)) return;
    f32x4 acc[2][2][4][2];
#pragma unroll
    for (int a = 0; a < 2; ++a)
#pragma unroll
        for (int b = 0; b < 2; ++b)
#pragma unroll
            for (int m = 0; m < 4; ++m)
#pragma unroll
                for (int n = 0; n < 2; ++n) acc[a][b][m][n] = (f32x4){0.f, 0.f, 0.f, 0.f};
    bf16x8 At[4][2], B0[2][2], B1[2][2];
    const char* cA = (const char*)g.A + (size_t)cur.pm * tA; const char* cB = (const char*)g.Bt + (size_t)cur.pb * tB;
    PG8_STAGE(PG8_SB(0, 0), cB, voffB); PG8_STAGE(PG8_SB(0, 1), cB + hB, voffB); PG8_STAGE(PG8_SA(0, 0), cA, voffA); PG8_STAGE(PG8_SA(0, 1), cA + hA, voffA);
    if (wr == 1) PG8_BAR;
    PG8_WAIT_V(2); PG8_BAR;
    PG8_STAGE(PG8_SB(1, 0), cB + kstep, voffB); PG8_STAGE(PG8_SA(1, 0), cA + kstep, voffA); PG8_STAGE(PG8_SB(1, 1), cB + hB + kstep, voffB);
    PG8_WAIT_V(6); PG8_BAR;
    for (;;) {
        const bool has_next = S.next(ui + 1, nxt);
        const char* nA = has_next ? (const char*)g.A + (size_t)nxt.pm * tA : cA; const char* nB = has_next ? (const char*)g.Bt + (size_t)nxt.pb * tB : cB;
        for (int t = 0; t < nt; t += 2) {
            const bool last = (t == nt - 2);
            const char* a1 = cA + (size_t)(t + 1) * kstep;
            const char* a2 = last ? nA : cA + (size_t)(t + 2) * kstep; const char* b2 = last ? nB : cB + (size_t)(t + 2) * kstep;
            const char* a3 = a2 + kstep; const char* b3 = b2 + kstep;
            PG8_LDB(B0, 0, 0); PG8_LDB(B1, 0, 1); PG8_SCHED; PG8_LDA(At, 0, 0); PG8_STAGE(PG8_SA(1, 1), a1 + hA, voffA);
            PG8_WAIT_V(8); PG8_WAIT_L(0); PG8_BAR; PG8_MMA(0, 0, At, B0); PG8_MMA(0, 1, At, B1); PG8_BAR; PG8_SCHED;
            PG8_LDA(At, 0, 1); PG8_STAGE(PG8_SB(0, 0), b2, voffB); PG8_STAGE(PG8_SB(0, 1), b2 + hB, voffB); PG8_STAGE(PG8_SA(0, 0), a2, voffA);
            PG8_WAIT_V(8); PG8_WAIT_L(0); PG8_BAR; PG8_MMA(1, 0, At, B0); PG8_MMA(1, 1, At, B1); PG8_BAR; PG8_SCHED;
            PG8_LDB(B0, 1, 0); PG8_LDB(B1, 1, 1); PG8_SCHED; PG8_LDA(At, 1, 0); PG8_STAGE(PG8_SA(0, 1), a2 + hA, voffA);
            PG8_WAIT_V(8); PG8_WAIT_L(0); PG8_BAR; PG8_MMA(0, 0, At, B0); PG8_MMA(0, 1, At, B1); PG8_BAR; PG8_SCHED;
            PG8_LDA(At, 1, 1); PG8_STAGE(PG8_SB(1, 0), b3, voffB); PG8_STAGE(PG8_SB(1, 1), b3 + hB, voffB); PG8_STAGE(PG8_SA(1, 0), a3, voffA);
            PG8_WAIT_V(8); PG8_WAIT_L(0); PG8_BAR; PG8_MMA(1, 0, At, B0); PG8_MMA(1, 1, At, B1); PG8_BAR; PG8_SCHED;
        }
        if (wr == 0) PG8_BAR;
        E(acc, cur, wr, wc, fr, fq);
        if (!has_next) break;
#pragma unroll
        for (int a = 0; a < 2; ++a)
#pragma unroll
            for (int b = 0; b < 2; ++b)
#pragma unroll
                for (int m = 0; m < 4; ++m)
#pragma unroll
                    for (int n = 0; n < 2; ++n) acc[a][b][m][n] = (f32x4){0.f, 0.f, 0.f, 0.f};
        cur = nxt; cA = nA; cB = nB; ++ui;
        if (wr == 1) PG8_BAR;
    }
    PG8_WAIT_V(0);
    PG8_BAR;
#undef PG8_SA
#undef PG8_SB
#undef PG8_STAGE
#undef PG8_LDA
#undef PG8_LDB
#undef PG8_MMA
#undef PG8_WAIT_V
#undef PG8_WAIT_L
#undef PG8_BAR
#undef PG8_SCHED
}
}
#define GAS __attribute__((address_space(1)))
#define LAS __attribute__((address_space(3)))
typedef unsigned short bf16;
typedef float f32x4 __attribute__((ext_vector_type(4)));
typedef float f32x2 __attribute__((ext_vector_type(2)));
typedef float f32x16 __attribute__((ext_vector_type(16)));
typedef short bf16x8 __attribute__((ext_vector_type(8)));
typedef unsigned u32x4 __attribute__((ext_vector_type(4)));
typedef unsigned u32x2 __attribute__((ext_vector_type(2)));

constexpr int NB = 4, SEQ = 4096, T = NB * SEQ, D = 1024, NL = 2;
constexpr int NH = 8, HD = 64, HW = 512;
constexpr int N_IN = 7344, FFD = 2816, FFE = 3584, NE = 8, PLE = 256;
constexpr int N1 = 4352, NZR = 1792, NZQ = 1536, NZG = 512, NZM = 512, NGATE = 3072;
constexpr int K2 = 512, N2 = 1792, K3 = 384, N3 = 2048;
constexpr int QKD = 96;
constexpr int NBLK_MAX = 136, HALF_BLK = 64;
constexpr float NORM_EPS = 1e-6f;
constexpr int NTH = 512, NWV = 8;

constexpr size_t MiB = 1u << 20;
constexpr size_t WS_CTL = 0;
constexpr size_t WS_W = 2 * MiB;
constexpr size_t WS_HB = 73 * MiB;
constexpr size_t WS_PB = 105 * MiB;
constexpr size_t WS_VF = 121 * MiB;
constexpr size_t WS_S = 137 * MiB;
constexpr size_t WS_END = 553 * MiB;
constexpr size_t S_ZR = WS_S + 0 * MiB, S_ZQ = WS_S + 56 * MiB, S_ZG = WS_S + 104 * MiB, S_ZM = WS_S + 120 * MiB;
constexpr size_t S_A2 = WS_S + 136 * MiB, S_L2 = WS_S + 148 * MiB;
constexpr size_t S_QRAW = WS_S + 212 * MiB, S_KVRAW = WS_S + 236 * MiB, S_Q = WS_S + 268 * MiB, S_K = WS_S + 292 * MiB, S_VT = WS_S + 316 * MiB, S_OB = WS_S + 332 * MiB;
constexpr size_t S_RR = WS_S + 212 * MiB, S_RK = WS_S + 228 * MiB, S_RV = WS_S + 244 * MiB, S_RA = WS_S + 260 * MiB, S_RB = WS_S + 276 * MiB, S_RW = WS_S + 292 * MiB, S_RG = WS_S + 348 * MiB;
constexpr size_t S_GQ = WS_S + 364 * MiB, S_GK = WS_S + 380 * MiB, S_GV = WS_S + 396 * MiB, S_GAL = WS_S + 412 * MiB, S_GBE = WS_S + 412 * MiB + 524288;
constexpr size_t S_YA = WS_S + 148 * MiB, S_YC = WS_S + 164 * MiB, S_OA = WS_S + 212 * MiB, S_OC = WS_S + 228 * MiB;
constexpr size_t S_ZSH = WS_S + 260 * MiB, S_M = WS_S + 348 * MiB;
constexpr int G1A_GT = 3;
constexpr size_t S_CMR = WS_S + 0 * MiB, S_S0R = WS_S + 64 * MiB, S_CMG = WS_S + 120 * MiB, S_S0G = WS_S + 184 * MiB;
constexpr size_t S_ACT = WS_S + 0 * MiB;
constexpr size_t S_MWGU = WS_S + 0 * MiB;
constexpr size_t S_MWD = WS_S + 112 * MiB;
constexpr size_t S_XG = WS_S + 168 * MiB;
constexpr size_t S_MACT = WS_S + 237 * MiB;
constexpr size_t S_E = WS_S + 380 * MiB;
constexpr size_t S_SSP0 = WS_S + 413 * MiB, S_SSP1 = WS_S + 414 * MiB, S_SSP2 = WS_S + 415 * MiB;
static_assert(S_SSP2 + MiB <= WS_END, "ws map");
static_assert(S_E + 32 * MiB <= WS_END, "ws map");
static_assert(S_MACT + (size_t)(NBLK_MAX - HALF_BLK) * 256 * FFE * 2 <= S_E && S_E + 32 * MiB <= S_SSP0, "ws map");
static_assert(S_XG + (size_t)NBLK_MAX * 256 * D * 2 <= S_MACT, "ws map");
static_assert(S_GBE + 524288 <= WS_END, "ws map");

constexpr size_t WL = 41 * MiB;
constexpr size_t W_IN = 0, W_GATE = 8 * MiB + 524288, W_2 = 15 * MiB, W_3 = 17 * MiB, W_BRA = 19 * MiB, W_BRB = 20 * MiB, W_BRC = 21 * MiB, W_OUT = 22 * MiB;
constexpr size_t W_FGU = 24 * MiB, W_FD = 35 * MiB;
constexpr size_t W_PLE = 65 * MiB, WPL = 2 * MiB + 524288, W_PP = 0, W_PG = 524288;
static_assert(W_FD + (size_t)D * FFD * 2 <= WL && W_PLE + 2 * WPL <= 71 * MiB, "w map");
constexpr size_t WS_HB2 = WS_W;
constexpr size_t CTL_ZERO = 512 * 1024;
constexpr size_t C_BAR = 0;
constexpr size_t C_MOE = 16384;
constexpr size_t C_SS = 65536;
constexpr size_t C_RSQ = 512 * 1024, C_RSKV = C_RSQ + 65536;
constexpr size_t C_SEL = C_RSKV + 65536;
constexpr size_t C_WTS = C_SEL + 131072;
constexpr size_t C_RANK = C_WTS + 131072;
constexpr size_t C_DEST = C_RANK + 131072;
constexpr size_t C_RSX = C_DEST + 131072;
constexpr size_t C_BLKE = C_RSX + 139264;
constexpr size_t C_RS1 = C_BLKE + 1024;
constexpr size_t C_BSC = C_RS1 + 65536;
static_assert(C_BSC + 524288 <= 2 * MiB, "ctl map");

__device__ __forceinline__ float bf2f(unsigned v) { return __uint_as_float(v << 16); }
__device__ __forceinline__ unsigned f2bf(float f) { return pg8::cvt_pk_bf16(f, f) & 0xffffu; }
__device__ __forceinline__ unsigned pk2(float lo, float hi) { return pg8::cvt_pk_bf16(lo, hi); }
__device__ __forceinline__ float wave_sum(float v) {
#pragma unroll
    for (int o = 1; o < 64; o <<= 1) v += __shfl_xor(v, o);
    return v;
}
__device__ __forceinline__ float sigmoidf_(float x) { return __builtin_amdgcn_rcpf(1.f + __builtin_amdgcn_exp2f(-1.4426950408889634f * x)); }
__device__ __forceinline__ float sigmoid_fast_(float x) { return __builtin_amdgcn_rcpf(1.f + __builtin_amdgcn_exp2f(-1.4426950408889634f * x)); }
__device__ __forceinline__ float siluf_(float x) { return x * __builtin_amdgcn_rcpf(1.f + __builtin_amdgcn_exp2f(-1.4426950408889634f * x)); }
__device__ __forceinline__ float softplusf_(float x) { return fmaxf(x, 0.f) + log1pf(__expf(-fabsf(x))); }

struct Args { const void* in[45]; float* out; unsigned char* ws; int layer; int pad; };
typedef const void* gptr_t;
typedef const __attribute__((address_space(4))) gptr_t* kin_t;
struct PArgs { kin_t in; float* out; unsigned char* ws; };
__device__ __forceinline__ PArgs make_pargs(const Args& a) {
    PArgs p; p.in = (kin_t)__builtin_amdgcn_kernarg_segment_ptr();
    GAS float* o1 = (GAS float*)a.out; GAS unsigned char* w1 = (GAS unsigned char*)a.ws;
    asm volatile("" : "+s"(p.in), "+s"(o1), "+s"(w1)); p.out = (float*)o1; p.ws = (unsigned char*)w1; return p; }
#define INF(i) ((const float*)(const GAS float*)a.in[i])
#define EPI_ARGS const pg8::f32x4 (&acc)[2][2][4][2], const pg8::Unit& u, int wr, int wc, int fr, int fq
#define EPI_ROWS _Pragma("unroll") for (int ai = 0; ai < 2; ++ai) _Pragma("unroll") for (int m = 0; m < 4; ++m)
__device__ __forceinline__ u32x4 pack8(const f32x4 v0, const f32x4 v1) { u32x4 w; w.x = pg8::cvt_pk_bf16(v0[0], v0[1]); w.y = pg8::cvt_pk_bf16(v0[2], v0[3]); w.z = pg8::cvt_pk_bf16(v1[0], v1[1]); w.w = pg8::cvt_pk_bf16(v1[2], v1[3]); return w; }
__device__ __forceinline__ void unpack8(const u32x4 w, float (&f)[8]) { f[0] = bf2f(w.x & 0xffffu); f[1] = bf2f(w.x >> 16); f[2] = bf2f(w.y & 0xffffu); f[3] = bf2f(w.y >> 16); f[4] = bf2f(w.z & 0xffffu); f[5] = bf2f(w.z >> 16); f[6] = bf2f(w.w & 0xffffu); f[7] = bf2f(w.w >> 16); }

__device__ __forceinline__ float rowscale16(const float* ssp, int r) { const f32x4* p = (const f32x4*)(ssp + (size_t)r * 16); const f32x4 a = p[0], b = p[1], c = p[2], d = p[3];
    const float s = ((a[0] + a[1]) + (a[2] + a[3])) + ((b[0] + b[1]) + (b[2] + b[3])) + ((c[0] + c[1]) + (c[2] + c[3])) + ((d[0] + d[1]) + (d[2] + d[3])); return rsqrtf(s * (1.f / D) + NORM_EPS); }
__device__ __forceinline__ void rowscales16(const float* ssp, int row0, float (&s)[2][4]) {
    const int fq = (otid() >> 4) & 3; f32x4 p[2][4];
#pragma unroll
    for (int ai = 0; ai < 2; ++ai)
#pragma unroll
        for (int m = 0; m < 4; ++m) p[ai][m] = *(const f32x4*)(ssp + (size_t)(row0 + ai * 128 + m * 16) * 16 + 4 * fq);
#pragma unroll
    for (int ai = 0; ai < 2; ++ai)
#pragma unroll
        for (int m = 0; m < 4; ++m) { float t = (p[ai][m][0] + p[ai][m][1]) + (p[ai][m][2] + p[ai][m][3]); t += __shfl_xor(t, 16); t += __shfl_xor(t, 32);
            s[ai][m] = rsqrtf(t * (1.f / D) + NORM_EPS); }
}
__device__ __forceinline__ void rowvals(const float* rs, int row0, float (&s)[2][4]) {
#pragma unroll
    for (int ai = 0; ai < 2; ++ai)
#pragma unroll
        for (int m = 0; m < 4; ++m) s[ai][m] = rs[row0 + ai * 128 + m * 16];
}
__device__ __forceinline__ bf16* zs_slab(bf16* zlo, bf16* zhi, int gt) { return gt < 8 ? zlo + (size_t)gt * ((size_t)4 << 20) : zhi + (size_t)(gt - 8) * ((size_t)4 << 20); }
struct EpiInProj {
    static constexpr bool PERM = true;
    bf16 *zr, *zq, *zg, *zm; const float* ss; bf16 *zlo, *zhi;
    __device__ __forceinline__ void operator()(EPI_ARGS) const {
        bf16* O; int ld, ct; const int pn = u.pn; const bool gate = pn >= 17;
        if (pn < 7) { O = zr; ld = NZR; ct = pn * 256; } else if (pn < 13) { O = zq; ld = NZQ; ct = (pn - 7) * 256; } else if (pn < 15) { O = zg; ld = NZG; ct = (pn - 13) * 256; } else if (pn < 17) { O = zm; ld = NZM; ct = (pn - 15) * 256; } else { O = zs_slab(zlo, zhi, pn - 17); ld = 256; ct = 0; }
        const int row0 = u.pm * 256 + wr * 64 + fr, col0 = ct + wc * 32 + 8 * fq;
        float sv[2][4]; rowscales16(ss, row0, sv);
        if (!gate) {
            EPI_ROWS { const int r = row0 + ai * 128 + m * 16; const float s = sv[ai][m]; bf16* rowp = O + (size_t)r * ld + col0;
#pragma unroll
                for (int bj = 0; bj < 2; ++bj) *(u32x4*)(rowp + bj * 128) = pack8(acc[ai][bj][m][0] * s, acc[ai][bj][m][1] * s); }
        } else {
            EPI_ROWS { const int r = row0 + ai * 128 + m * 16; const float s = sv[ai][m]; bf16* rowp = O + (size_t)r * ld + col0;
#pragma unroll
                for (int bj = 0; bj < 2; ++bj) { f32x4 v0 = acc[ai][bj][m][0] * s, v1 = acc[ai][bj][m][1] * s;
#pragma unroll
                    for (int j = 0; j < 4; ++j) { v0[j] = sigmoid_fast_(v0[j]); v1[j] = sigmoid_fast_(v1[j]); }
                    *(u32x4*)(rowp + bj * 128) = pack8(v0, v1); } }
        }
    }
};
struct EpiGate {
    static constexpr bool PERM = true;
    bf16 *zlo, *zhi; const float* ss; int pn0;
    __device__ __forceinline__ void operator()(EPI_ARGS) const {
        bf16* O = zs_slab(zlo, zhi, u.pn + pn0);
        const int row0 = u.pm * 256 + wr * 64 + fr, col0 = wc * 32 + 8 * fq;
        float sv[2][4]; rowscales16(ss, row0, sv);
        EPI_ROWS { const int r = row0 + ai * 128 + m * 16; const float s = sv[ai][m]; bf16* rowp = O + (size_t)r * 256 + col0;
#pragma unroll
            for (int bj = 0; bj < 2; ++bj) { f32x4 v0 = acc[ai][bj][m][0] * s, v1 = acc[ai][bj][m][1] * s;
#pragma unroll
                for (int j = 0; j < 4; ++j) { v0[j] = sigmoid_fast_(v0[j]); v1[j] = sigmoid_fast_(v1[j]); }
                *(u32x4*)(rowp + bj * 128) = pack8(v0, v1); } }
    }
};
struct EpiMla {
    static constexpr bool PERM = true;
    bf16 *qraw, *kvraw; const float *rsq, *rskv; int pn0;
    __device__ __forceinline__ void operator()(EPI_ARGS) const {
        const int pnn = u.pn + pn0; const bool isq = pnn < 3; bf16* O = isq ? qraw : kvraw; const int ld = isq ? 768 : 1024, ct = isq ? pnn * 256 : (pnn - 3) * 256; const float* rs = isq ? rsq : rskv;
        const int row0 = u.pm * 256 + wr * 64 + fr, col0 = ct + wc * 32 + 8 * fq;
        float sv[2][4]; rowvals(rs, row0, sv);
        EPI_ROWS { const int r = row0 + ai * 128 + m * 16; const float s = sv[ai][m]; bf16* rowp = O + (size_t)r * ld + col0;
#pragma unroll
            for (int bj = 0; bj < 2; ++bj) *(u32x4*)(rowp + bj * 128) = pack8(acc[ai][bj][m][0] * s, acc[ai][bj][m][1] * s); }
    }
};
struct EpiPlain {
    static constexpr bool PERM = true;
    bf16* O; int ld; int c0;
    __device__ __forceinline__ void operator()(EPI_ARGS) const {
        const int row0 = u.pm * 256 + wr * 64 + fr, col0 = c0 + u.pn * 256 + wc * 32 + 8 * fq;
        EPI_ROWS { const int r = row0 + ai * 128 + m * 16; bf16* rowp = O + (size_t)r * ld + col0;
#pragma unroll
            for (int bj = 0; bj < 2; ++bj) *(u32x4*)(rowp + bj * 128) = pack8(acc[ai][bj][m][0], acc[ai][bj][m][1]); }
    }
};
template <bool FIRST> struct EpiMerge {
    static constexpr bool PERM = true;
    bf16* M; bf16 *zlo, *zhi; int br;
    __device__ __forceinline__ void operator()(EPI_ARGS) const {
        const int row0 = u.pm * 256 + wr * 64 + fr, col0 = u.pn * 256 + wc * 32 + 8 * fq; const bf16* zs = zs_slab(zlo, zhi, 4 * br + u.pn) + wc * 32 + 8 * fq;
#pragma unroll
        for (int ai = 0; ai < 2; ++ai) { u32x4 gv[4][2], mv[4][2];
#pragma unroll
            for (int m = 0; m < 4; ++m)
#pragma unroll
                for (int bj = 0; bj < 2; ++bj) { const int r = row0 + ai * 128 + m * 16, c = col0 + bj * 128; gv[m][bj] = *(const u32x4*)(zs + (size_t)r * 256 + bj * 128); if (!FIRST) mv[m][bj] = *(const u32x4*)(M + (size_t)r * D + c); }
#pragma unroll
            for (int m = 0; m < 4; ++m)
#pragma unroll
                for (int bj = 0; bj < 2; ++bj) { const int r = row0 + ai * 128 + m * 16, c = col0 + bj * 128; float g[8], o[8]; unpack8(gv[m][bj], g); if (!FIRST) unpack8(mv[m][bj], o);
                    f32x4 v0, v1;
#pragma unroll
                    for (int j = 0; j < 4; ++j) { v0[j] = g[j] * acc[ai][bj][m][0][j] + (FIRST ? 0.f : o[j]); v1[j] = g[4 + j] * acc[ai][bj][m][1][j] + (FIRST ? 0.f : o[4 + j]); }
                    *(u32x4*)(M + (size_t)r * D + c) = pack8(v0, v1); }
            asm volatile("" ::: "memory"); }
    }
};
struct EpiResid {
    static constexpr bool PERM = false;
    const float* basef; const bf16* baseb; bf16* hb; float* ss;
    __device__ __forceinline__ void operator()(EPI_ARGS) const {
        const int row0 = u.pm * 256 + wr * 64 + fr, col0 = u.pn * 256 + wc * 32 + 4 * fq;
#pragma unroll
        for (int ai = 0; ai < 2; ++ai) { f32x4 bv[4][2][2];
#pragma unroll
            for (int m = 0; m < 4; ++m)
#pragma unroll
                for (int bj = 0; bj < 2; ++bj)
#pragma unroll
                    for (int n = 0; n < 2; ++n) { const size_t off = (size_t)(row0 + ai * 128 + m * 16) * D + col0 + bj * 128 + n * 16;
                        if (basef) bv[m][bj][n] = *(const f32x4*)(basef + off);
                        else { const u32x2 w = *(const u32x2*)(baseb + off); bv[m][bj][n] = (f32x4){bf2f(w.x & 0xffffu), bf2f(w.x >> 16), bf2f(w.y & 0xffffu), bf2f(w.y >> 16)}; } }
#pragma unroll
            for (int m = 0; m < 4; ++m) { const int r = row0 + ai * 128 + m * 16; float sq = 0.f;
#pragma unroll
                for (int bj = 0; bj < 2; ++bj)
#pragma unroll
                    for (int n = 0; n < 2; ++n) { const size_t off = (size_t)r * D + col0 + bj * 128 + n * 16; f32x4 h = bv[m][bj][n]; h += acc[ai][bj][m][n];
                        u32x2 w; w.x = pg8::cvt_pk_bf16(h[0], h[1]); w.y = pg8::cvt_pk_bf16(h[2], h[3]); *(u32x2*)(hb + off) = w; sq += (h[0] * h[0] + h[1] * h[1]) + (h[2] * h[2] + h[3] * h[3]); }
                if (ss) { sq += __shfl_xor(sq, 16); sq += __shfl_xor(sq, 32); if (fq == 0) ss[(size_t)r * 16 + u.pn * 4 + wc] = sq; } }
            asm volatile("" ::: "memory"); }
    }
};
template <bool MOE> struct EpiSwiglu {
    static constexpr bool PERM = true;
    bf16* O; int ld; const float* rs;
    __device__ __forceinline__ void operator()(EPI_ARGS) const {
        const int row0 = u.pm * 256 + wr * 64 + fr, col0 = u.pn * 128 + wc * 32 + 8 * fq;
        float sv[2][4]; if (MOE) rowvals(rs, row0, sv); else rowscales16(rs, row0, sv);
        EPI_ROWS { const int r = row0 + ai * 128 + m * 16; const float s = sv[ai][m];
            f32x4 v0, v1;
#pragma unroll
            for (int j = 0; j < 4; ++j) { v0[j] = siluf_(acc[ai][0][m][0][j] * s) * (acc[ai][1][m][0][j] * s); v1[j] = siluf_(acc[ai][0][m][1][j] * s) * (acc[ai][1][m][1][j] * s); }
            *(u32x4*)(O + (size_t)r * ld + col0) = pack8(v0, v1); }
    }
};
struct EpiPleProj {
    static constexpr bool PERM = true;
    bf16* O; float* sse;
    __device__ __forceinline__ void operator()(EPI_ARGS) const {
        const int row0 = u.pm * 256 + wr * 64 + fr, col0 = u.pn * 256 + wc * 32 + 8 * fq;
        EPI_ROWS { const int r = row0 + ai * 128 + m * 16; float sq = 0.f;
#pragma unroll
            for (int bj = 0; bj < 2; ++bj) { const f32x4 v0 = acc[ai][bj][m][0], v1 = acc[ai][bj][m][1]; *(u32x4*)(O + (size_t)r * D + col0 + bj * 128) = pack8(v0, v1);
                sq += (v0[0] * v0[0] + v0[1] * v0[1]) + (v0[2] * v0[2] + v0[3] * v0[3]) + (v1[0] * v1[0] + v1[1] * v1[1]) + (v1[2] * v1[2] + v1[3] * v1[3]); }
            sq += __shfl_xor(sq, 16); sq += __shfl_xor(sq, 32); if (fq == 0) sse[(size_t)r * 16 + u.pn * 4 + wc] = sq; }
    }
};
struct EpiPleGate {
    static constexpr bool PERM = false;
    float* out; const bf16* hin; bf16* hbn; const bf16* E; const float* sse; const float* png; float* ssn;
    __device__ __forceinline__ void operator()(EPI_ARGS) const {
        const int row0 = u.pm * 256 + wr * 64 + fr, col0 = u.pn * 256 + wc * 32 + 4 * fq;
        float sv[2][4]; rowscales16(sse, row0, sv);
        f32x4 gq[2][2];
#pragma unroll
        for (int bj = 0; bj < 2; ++bj)
#pragma unroll
            for (int n = 0; n < 2; ++n) gq[bj][n] = *(const f32x4*)(png + col0 + bj * 128 + n * 16);
#pragma unroll
        for (int ai = 0; ai < 2; ++ai)
#pragma unroll
        for (int mp = 0; mp < 2; ++mp) { u32x2 hwv[2][2][2], ewv[2][2][2];
#pragma unroll
            for (int mm = 0; mm < 2; ++mm)
#pragma unroll
                for (int bj = 0; bj < 2; ++bj)
#pragma unroll
                    for (int n = 0; n < 2; ++n) { const size_t off = (size_t)(row0 + ai * 128 + (2 * mp + mm) * 16) * D + col0 + bj * 128 + n * 16; hwv[mm][bj][n] = *(const u32x2*)(hin + off); ewv[mm][bj][n] = *(const u32x2*)(E + off); }
#pragma unroll
            for (int mm = 0; mm < 2; ++mm) { const int m = 2 * mp + mm; const int r = row0 + ai * 128 + m * 16; float sq = 0.f; const float se = sv[ai][m];
#pragma unroll
                for (int bj = 0; bj < 2; ++bj)
#pragma unroll
                    for (int n = 0; n < 2; ++n) { const int c = col0 + bj * 128 + n * 16; const size_t off = (size_t)r * D + c; const u32x2 hw = hwv[mm][bj][n];
                        f32x4 h = (f32x4){bf2f(hw.x & 0xffffu), bf2f(hw.x >> 16), bf2f(hw.y & 0xffffu), bf2f(hw.y >> 16)};
                        const u32x2 ew = ewv[mm][bj][n]; const f32x4 g = gq[bj][n];
                        const float e0 = bf2f(ew.x & 0xffffu), e1 = bf2f(ew.x >> 16), e2 = bf2f(ew.y & 0xffffu), e3 = bf2f(ew.y >> 16);
                        const f32x4 a4 = acc[ai][bj][m][n];
                        h[0] += sigmoidf_(a4[0]) * (e0 * se * g[0]); h[1] += sigmoidf_(a4[1]) * (e1 * se * g[1]); h[2] += sigmoidf_(a4[2]) * (e2 * se * g[2]); h[3] += sigmoidf_(a4[3]) * (e3 * se * g[3]);
                        if (out) *(f32x4*)(out + off) = h;
                        if (hbn) { u32x2 w; w.x = pg8::cvt_pk_bf16(h[0], h[1]); w.y = pg8::cvt_pk_bf16(h[2], h[3]); *(u32x2*)(hbn + off) = w; }
                        sq += (h[0] * h[0] + h[1] * h[1]) + (h[2] * h[2] + h[3] * h[3]); }
                if (ssn) { sq += __shfl_xor(sq, 16); sq += __shfl_xor(sq, 32); if (fq == 0) ssn[(size_t)r * 16 + u.pn * 4 + wc] = sq; } }
            asm volatile("" ::: "memory"); }
    }
};
struct TJob { int src, src_off, K, ldn, n0, ncnt; int dst_off, dst_ld, dst_k0, dst_row0, rowmode; int gain, gain_off, gain2, gain2_off, g2mode; };
#define WOFF(l, o) ((int)((l) * WL + (o)))
#define LAYER_JOBS(l) \
    {4, (l) * D * N_IN, D, N_IN, 0, 1792, WOFF(l, W_IN), D, 0, 0, 0, 3, (l) * D, -1, 0, 0}, \
    {4, (l) * D * N_IN, D, N_IN, 2208, 1536, WOFF(l, W_IN), D, 0, 1792, 0, 3, (l) * D, -1, 0, 0}, \
    {4, (l) * D * N_IN, D, N_IN, 3760, 512, WOFF(l, W_IN), D, 0, 3328, 0, 3, (l) * D, -1, 0, 0}, \
    {4, (l) * D * N_IN, D, N_IN, 1792, 416, WOFF(l, W_IN), D, 0, 3840, 0, 3, (l) * D, -1, 0, 0}, \
    {4, (l) * D * N_IN, D, N_IN, 3744, 16, WOFF(l, W_IN), D, 0, 3840 + 416, 0, 3, (l) * D, -1, 0, 0}, \
    {4, (l) * D * N_IN, D, N_IN, 4272, 3072, WOFF(l, W_GATE), D, 0, 0, 0, 3, (l) * D, -1, 0, 0}, \
    {7, (l) * 64 * 512, 64, 512, 0, 512, WOFF(l, W_3), K3, 0, 0, 0, -1, 0, -1, 0, 0}, \
    {9, (l) * 64 * 512, 64, 512, 0, 512, WOFF(l, W_3), K3, 64, 512, 0, -1, 0, -1, 0, 0}, \
    {10, (l) * 128 * 512, 128, 512, 0, 512, WOFF(l, W_3), K3, 128, 1024, 0, -1, 0, -1, 0, 0}, \
    {22, (l) * 256 * 768, 256, 768, 0, 768, WOFF(l, W_2), K2, 0, 0, 0, 20, (l) * 256, -1, 0, 0}, \
    {23, (l) * 128 * 1024, 128, 1024, 0, 1024, WOFF(l, W_2), K2, 256, 768, 0, 21, (l) * 128, -1, 0, 0}, \
    {30, (l) * 512 * 1024, 512, 1024, 0, 1024, WOFF(l, W_BRA), 512, 0, 0, 0, -1, 0, -1, 0, 0}, \
    {31, (l) * 512 * 1024, 512, 1024, 0, 1024, WOFF(l, W_BRB), 512, 0, 0, 0, -1, 0, -1, 0, 0}, \
    {32, (l) * 512 * 1024, 512, 1024, 0, 1024, WOFF(l, W_BRC), 512, 0, 0, 0, -1, 0, -1, 0, 0}, \
    {33, (l) * D * D, D, D, 0, D, WOFF(l, W_OUT), D, 0, 0, 0, -1, 0, -1, 0, 0}, \
    {42, (l) * PLE * D, PLE, D, 0, D, (int)(W_PLE + (l) * WPL + W_PP), PLE, 0, 0, 0, -1, 0, -1, 0, 0}, \
    {43, (l) * D * D, D, D, 0, D, (int)(W_PLE + (l) * WPL + W_PG), D, 0, 0, 0, -1, 0, -1, 0, 0}
__constant__ TJob g_jobs[] = {
    LAYER_JOBS(0), LAYER_JOBS(1),
    {17, 0, D, 32, 0, 32, WOFF(1, W_IN), D, 0, 3840 + 432, 0, 3, 1 * D, 16, 0, 1},
    {17, 0, D, 32, 0, 32, WOFF(1, W_IN), D, 0, 3840 + 464, 0, 3, 1 * D, 16, 0, 2},
    {18, 0, 32, 512, 0, 512, WOFF(1, W_3), K3, 256, 1536, 0, -1, 0, -1, 0, 0},
    {35, 0, D, FFD, 0, FFD, (int)W_FGU, D, 0, 0, 1, 34, 0, -1, 0, 0},
    {36, 0, D, FFD, 0, FFD, (int)W_FGU, D, 0, 0, 2, 34, 0, -1, 0, 0},
    {37, 0, FFD, D, 0, D, (int)W_FD, FFD, 0, 0, 0, -1, 0, -1, 0, 0},
};
constexpr int NJOBS = sizeof(g_jobs) / sizeof(TJob);

__device__ __forceinline__ void tr_load(const PArgs& a, const TJob& j, int item, int lane, float (&v)[32], float (&gn)[8]) {
    const float* W = INF(j.src) + j.src_off;
    const int nblk = (j.ncnt + 31) / 32, kb = item / nblk, nb = item % nblk, k0 = 64 * kb, nl0 = 32 * nb;
    const int nl = nl0 + (lane & 31);
#pragma unroll
    for (int i = 0; i < 32; ++i) { const int k = k0 + 2 * i + (lane >> 5); v[i] = (k < j.K && nl < j.ncnt) ? W[(size_t)k * j.ldn + j.n0 + nl] : 0.f; }
    const int c = lane & 7;
#pragma unroll
    for (int e = 0; e < 8; ++e) gn[e] = 1.f;
    if (k0 + 8 * c < j.K) {
        if (j.gain >= 0) { const float* G1 = INF(j.gain) + j.gain_off + k0 + 8 * c; const f32x4 g0 = *(const f32x4*)G1, g1 = *(const f32x4*)(G1 + 4);
#pragma unroll
            for (int e = 0; e < 4; ++e) { gn[e] = g0[e]; gn[4 + e] = g1[e]; } }
        if (j.gain2 >= 0) { const float* G2 = INF(j.gain2) + j.gain2_off + k0 + 8 * c; const f32x4 g0 = *(const f32x4*)G2, g1 = *(const f32x4*)(G2 + 4);
#pragma unroll
            for (int e = 0; e < 4; ++e) { gn[e] *= (j.g2mode == 1) ? (1.f - g0[e]) : g0[e]; gn[4 + e] *= (j.g2mode == 1) ? (1.f - g1[e]) : g1[e]; } } }
}
__device__ __forceinline__ void tr_finish(const TJob& j, bf16* dstbase, LAS float* scr, int item, int lane, const float (&v)[32], const float (&gn)[8]) {
    const int nblk = (j.ncnt + 31) / 32, kb = item / nblk, nb = item % nblk, k0 = 64 * kb, nl0 = 32 * nb, c = lane & 7;
#pragma unroll
    for (int i = 0; i < 32; ++i) scr[(2 * i + (lane >> 5)) * 33 + (lane & 31)] = v[i];
    asm volatile("s_waitcnt lgkmcnt(0)" ::: "memory");
    if (k0 + 8 * c < j.K) {
#pragma unroll
        for (int q = 0; q < 4; ++q) { const int nloc = (lane >> 3) + 8 * q, n = nl0 + nloc; if (n < j.ncnt) { const LAS float* s = scr + (8 * c) * 33 + nloc;
            u32x4 o; o.x = pk2(s[0 * 33] * gn[0], s[1 * 33] * gn[1]); o.y = pk2(s[2 * 33] * gn[2], s[3 * 33] * gn[3]); o.z = pk2(s[4 * 33] * gn[4], s[5 * 33] * gn[5]); o.w = pk2(s[6 * 33] * gn[6], s[7 * 33] * gn[7]);
            const int row = j.dst_row0 + (j.rowmode == 0 ? n : (n / 128) * 256 + (n % 128) + (j.rowmode == 2 ? 128 : 0));
            *(u32x4*)(dstbase + (size_t)row * j.dst_ld + j.dst_k0 + k0 + 8 * c) = o; } }
    }
    asm volatile("s_waitcnt lgkmcnt(0)" ::: "memory");
}

__device__ __forceinline__ void phase_prologue(const PArgs& a, LAS unsigned char* lds) {
    const int bidx_ = obid();
    const int tid = otid(), lane = tid & 63, wave = __builtin_amdgcn_readfirstlane(tid >> 6), G = ogrid();
    const int gw = bidx_ * NWV + wave, NGW = G * NWV;
    LAS float* scr = (LAS float*)(lds + wave * 16384);
    { int ji = 0, base = 0, nit = ((g_jobs[0].K + 63) / 64) * ((g_jobs[0].ncnt + 31) / 32);
#define PJ_FIND(it_) do { while (ji < NJOBS && (it_) >= base + nit) { base += nit; ++ji; if (ji < NJOBS) nit = ((g_jobs[ji].K + 63) / 64) * ((g_jobs[ji].ncnt + 31) / 32); } } while (0)
      float v[32], gn[8]; int it = gw; PJ_FIND(it); bool have = ji < NJOBS; TJob jc; int ic = 0;
      if (have) { jc = g_jobs[ji]; ic = it - base; tr_load(a, jc, ic, lane, v, gn); }
      while (have) { const int itn = it + NGW; PJ_FIND(itn); const bool hn = ji < NJOBS; TJob jn; int in_ = 0; float vn[32], gnn[8];
          if (hn) { jn = g_jobs[ji]; in_ = itn - base; tr_load(a, jn, in_, lane, vn, gnn); }
          tr_finish(jc, (bf16*)(a.ws + WS_W + jc.dst_off), scr, ic, lane, v, gn);
          if (hn) { jc = jn; ic = in_;
#pragma unroll
              for (int i = 0; i < 32; ++i) v[i] = vn[i];
#pragma unroll
              for (int e = 0; e < 8; ++e) gn[e] = gnn[e]; }
          have = hn; it = itn; }
#undef PJ_FIND
    }
    { const int gt = bidx_ * NTH + tid, GT = G * NTH; const u32x4 z4 = (u32x4){0u, 0u, 0u, 0u};
      for (int l = 0; l < NL; ++l) { bf16* W3 = (bf16*)(a.ws + WS_W + (size_t)l * WL + W_3);
          for (int i = gt; i < 1024 * 8; i += GT) { const int r = i >> 3, q = i & 7; *(u32x4*)(W3 + (size_t)r * K3 + (r < 512 ? 64 : 0) + 8 * q) = z4; }
          if (l > 0) for (int i = gt; i < 512 * 12; i += GT) { const int r = 1536 + i / 12, q = i % 12; *(u32x4*)(W3 + (size_t)r * K3 + 288 + 8 * q) = z4; } } }
    const float* x = INF(0); bf16* hb = (bf16*)(a.ws + WS_HB); float* ss0 = (float*)(a.ws + S_SSP0);
    for (int m0 = gw; m0 < T; m0 += 4 * NGW) { f32x4 v[4][4];
#pragma unroll
        for (int r = 0; r < 4; ++r) { const int m = m0 + r * NGW; if (m < T) { const f32x4* xr = (const f32x4*)(x + (size_t)m * D) + lane;
#pragma unroll
            for (int q = 0; q < 4; ++q) v[r][q] = xr[64 * q]; } }
#pragma unroll
        for (int r = 0; r < 4; ++r) { const int m = m0 + r * NGW; if (m < T) { u32x2* hrow = (u32x2*)(hb + (size_t)m * D) + lane; float s = 0.f;
#pragma unroll
            for (int q = 0; q < 4; ++q) { const f32x4 w4 = v[r][q]; u32x2 w; w.x = pk2(w4[0], w4[1]); w.y = pk2(w4[2], w4[3]); hrow[64 * q] = w; s += (w4[0] * w4[0] + w4[1] * w4[1]) + (w4[2] * w4[2] + w4[3] * w4[3]); }
            s = wave_sum(s); if (lane < 16) ss0[(size_t)m * 16 + lane] = lane == 0 ? s : 0.f; } } }
    const f32x4* p4 = (const f32x4*)INF(1); u32x2* pb = (u32x2*)(a.ws + WS_PB);
    { const size_t N4 = (size_t)NL * T * PLE / 4, st = (size_t)G * NTH;
      for (size_t i = (size_t)bidx_ * NTH + tid; i < N4; i += 4 * st) { f32x4 v[4];
#pragma unroll
          for (int q = 0; q < 4; ++q) if (i + q * st < N4) v[q] = p4[i + q * st];
#pragma unroll
          for (int q = 0; q < 4; ++q) if (i + q * st < N4) { u32x2 w; w.x = pk2(v[q][0], v[q][1]); w.y = pk2(v[q][2], v[q][3]); pb[i + q * st] = w; } } }
}

__device__ __forceinline__ void phase_moe_cvt(const PArgs& a, LAS unsigned char* lds) {
    const int bidx_ = obid();
    const int tid = otid(), lane = tid & 63, wave = __builtin_amdgcn_readfirstlane(tid >> 6), G = ogrid();
    const int gw = bidx_ * NWV + wave, NGW = G * NWV;
    LAS float* scr = (LAS float*)(lds + wave * 16384);
    constexpr int IT_GU = (D / 64) * (FFE / 32), IT_D = (FFE / 64) * (D / 32);
    constexpr int PER_E = 2 * IT_GU + IT_D;
#define MJ_MAKE(it_, j, item_, dst_) do { const int e_ = (it_) / PER_E; int r_ = (it_) % PER_E; j.gain2 = -1; j.gain2_off = 0; j.g2mode = 0; j.n0 = 0; j.dst_k0 = 0; j.dst_off = 0; \
        if (r_ < 2 * IT_GU) { const int up_ = r_ >= IT_GU; if (up_) r_ -= IT_GU; j.src = up_ ? 40 : 39; j.src_off = e_ * D * FFE; j.K = D; j.ldn = FFE; j.ncnt = FFE; j.dst_ld = D; j.dst_row0 = e_ * 2 * FFE; j.rowmode = up_ ? 2 : 1; j.gain = 34; j.gain_off = D; dst_ = (bf16*)(a.ws + S_MWGU); } \
        else { r_ -= 2 * IT_GU; j.src = 41; j.src_off = e_ * FFE * D; j.K = FFE; j.ldn = D; j.ncnt = D; j.dst_ld = FFE; j.dst_row0 = e_ * D; j.rowmode = 0; j.gain = -1; j.gain_off = 0; dst_ = (bf16*)(a.ws + S_MWD); } item_ = r_; } while (0)
    { float v[32], gn[8]; TJob jc; int ic = 0; bf16* dc = nullptr; int it = gw; bool have = it < NE * PER_E;
      if (have) { MJ_MAKE(it, jc, ic, dc); tr_load(a, jc, ic, lane, v, gn); }
      while (have) { const int itn = it + NGW; const bool hn = itn < NE * PER_E; TJob jn; int in_ = 0; bf16* dn = nullptr; float vn[32], gnn[8];
          if (hn) { MJ_MAKE(itn, jn, in_, dn); tr_load(a, jn, in_, lane, vn, gnn); }
          tr_finish(jc, dc, scr, ic, lane, v, gn);
          if (hn) { jc = jn; ic = in_; dc = dn;
#pragma unroll
              for (int i = 0; i < 32; ++i) v[i] = vn[i];
#pragma unroll
              for (int e = 0; e < 8; ++e) gn[e] = gnn[e]; }
          have = hn; it = itn; } }
#undef MJ_MAKE
}
__device__ __forceinline__ void ld8(const bf16* p, float (&f)[8]);
__device__ __forceinline__ void st8(bf16* p, const float (&f)[8]);
__device__ __forceinline__ void ldf8(const float* p, float (&f)[8]);
__device__ __forceinline__ float sum8lanes(float v);
__device__ __forceinline__ void phase_pre(const PArgs& a, int l) {
    const int bidx_ = obid();
    const int tid = otid(), lane = tid & 63, wave = __builtin_amdgcn_readfirstlane(tid >> 6), G = ogrid(), ti = lane >> 3, part = lane & 7;
    const bf16* zr = (const bf16*)(a.ws + S_ZR); const bf16* zm = (const bf16*)(a.ws + S_ZM); bf16* A2 = (bf16*)(a.ws + S_A2);
    float* rsq = (float*)(a.ws + WS_CTL + C_RSQ); float* rskv = (float*)(a.ws + WS_CTL + C_RSKV);
    float mu[4][8];
#pragma unroll
    for (int q = 0; q < 4; ++q) ldf8(INF(5) + l * 1792 + 1536 + 32 * part + 8 * q, mu[q]);
    for (int g = bidx_ * NWV + wave; g < T / 8; g += G * NWV) { const size_t t = (size_t)g * 8 + ti; const bool first = (t % SEQ) == 0; const size_t tp = first ? t : t - 1;
        u32x4 cur[4], prv[4], cq[4], ckv[2], v1 = (u32x4){0u, 0u, 0u, 0u}, v2 = v1;
#pragma unroll
        for (int q = 0; q < 4; ++q) { cur[q] = *(const u32x4*)(zr + t * NZR + 1536 + 32 * part + 8 * q); prv[q] = *(const u32x4*)(zr + tp * NZR + 1536 + 32 * part + 8 * q); cq[q] = *(const u32x4*)(zm + t * NZM + 32 * part + 8 * q); }
        ckv[0] = *(const u32x4*)(zm + t * NZM + 256 + 16 * part); ckv[1] = *(const u32x4*)(zm + t * NZM + 256 + 16 * part + 8);
        if (part < 4) { v1 = *(const u32x4*)(zm + t * NZM + 432 + 8 * part); v2 = *(const u32x4*)(zm + tp * NZM + 464 + 8 * part); }
        float sq = 0.f, skv = 0.f;
#pragma unroll
        for (int q = 0; q < 4; ++q) { float c[8], p[8], o[8], f[8]; unpack8(cur[q], c); unpack8(prv[q], p); unpack8(cq[q], f);
#pragma unroll
            for (int e = 0; e < 8; ++e) { const float pv = first ? 0.f : p[e]; float x = c[e] + (pv - c[e]) * mu[q][e]; if (part < 2) x = tanhf(x); else if (part >= 4) x = sigmoidf_(x); o[e] = x; sq += f[e] * f[e]; }
            st8(A2 + t * K3 + 32 * part + 8 * q, o); }
#pragma unroll
        for (int q = 0; q < 2; ++q) { float f[8]; unpack8(ckv[q], f);
#pragma unroll
            for (int e = 0; e < 8; ++e) skv += f[e] * f[e]; }
        if (part < 4) { float x1[8], x2[8], o[8]; unpack8(v1, x1); unpack8(v2, x2);
#pragma unroll
            for (int e = 0; e < 8; ++e) o[e] = x1[e] + (first ? 0.f : x2[e]);
            st8(A2 + t * K3 + 256 + 8 * part, o); }
        { u32x2* z8 = (u32x2*)(A2 + t * K3 + 288 + 12 * part); z8[0] = (u32x2){0u, 0u}; z8[1] = (u32x2){0u, 0u}; z8[2] = (u32x2){0u, 0u}; }
        sq = sum8lanes(sq); skv = sum8lanes(skv);
        if (part == 0) { rsq[t] = rsqrtf(sq * (1.f / 256.f) + NORM_EPS); rskv[t] = rsqrtf(skv * (1.f / 128.f) + NORM_EPS); }
    }
}

__device__ __forceinline__ void ld8(const bf16* p, float (&f)[8]) { unpack8(*(const u32x4*)p, f); }
__device__ __forceinline__ void st8(bf16* p, const float (&f)[8]) { *(u32x4*)p = (u32x4){pk2(f[0], f[1]), pk2(f[2], f[3]), pk2(f[4], f[5]), pk2(f[6], f[7])}; }
__device__ __forceinline__ void ldf8(const float* p, float (&f)[8]) { const f32x4 a = *(const f32x4*)p, b = *(const f32x4*)(p + 4); f[0] = a[0]; f[1] = a[1]; f[2] = a[2]; f[3] = a[3]; f[4] = b[0]; f[5] = b[1]; f[6] = b[2]; f[7] = b[3]; }
__device__ __forceinline__ float sum8lanes(float v) { v += __shfl_xor(v, 1); v += __shfl_xor(v, 2); v += __shfl_xor(v, 4); return v; }
__device__ __forceinline__ void phase_mla_post(const PArgs& a, int l, LAS unsigned char* lds) {
    const int bidx_ = obid();
    const int tid = otid(), lane = tid & 63, wave = __builtin_amdgcn_readfirstlane(tid >> 6), G = ogrid(), h = lane >> 3, sub = lane & 7;
    const bf16* qraw = (const bf16*)(a.ws + S_QRAW); const bf16* kvraw = (const bf16*)(a.ws + S_KVRAW); const bf16* zm = (const bf16*)(a.ws + S_ZM);
    bf16* Q = (bf16*)(a.ws + S_Q); bf16* Kk = (bf16*)(a.ws + S_K); bf16* Vt = (bf16*)(a.ws + S_VT);
    const int* pos = (const int*)(const GAS int*)a.in[2];
    const bool rp = sub < 4;
    float gq0[8], gk0[8], gq1[8], gk1[8], invf[8];
    ldf8(INF(24) + l * QKD + 8 * sub, gq0); ldf8(INF(25) + l * QKD + 8 * sub, gk0);
    ldf8(INF(24) + l * QKD + 64 + 8 * (sub & 3), gq1); ldf8(INF(25) + l * QKD + 64 + 8 * (sub & 3), gk1);
#pragma unroll
    for (int e = 0; e < 8; ++e) invf[e] = exp2f(-(float)(8 * (sub & 1) + e) * (13.287712379549449f / 16.f));
    const float qscale = 0.10206207261596577f * 1.4426950408889634f;
    for (int g = bidx_ * NWV + wave; g < T / 8; g += G * NWV) { const int t0 = g * 8, b = t0 / SEQ, s0 = t0 % SEQ;
        unsigned vtr[8][4];
        u32x4 nq0, nk0, nvw, nq1 = (u32x4){0u, 0u, 0u, 0u}, nk1 = (u32x4){0u, 0u, 0u, 0u}; int npos;
#define ML_LOAD(tt) do { const size_t t_ = (tt); nq0 = *(const u32x4*)(qraw + t_ * 768 + h * 96 + 8 * sub); nk0 = *(const u32x4*)(kvraw + t_ * 1024 + h * 128 + 8 * sub); nvw = *(const u32x4*)(kvraw + t_ * 1024 + h * 128 + 64 + 8 * sub); \
            if (rp) { nq1 = *(const u32x4*)(qraw + t_ * 768 + h * 96 + 64 + 8 * sub); nk1 = *(const u32x4*)(zm + t_ * NZM + 384 + 8 * sub); } npos = pos[t_]; } while (0)
        ML_LOAD(t0);
        for (int i = 0; i < 8; ++i) { const size_t t = t0 + i; float q0[8], q1[8], k0[8], k1[8];
            unpack8(nq0, q0); unpack8(nk0, k0); unpack8(nq1, q1); unpack8(nk1, k1); const u32x4 vw = nvw; const float ps = (float)npos;
            if (i + 1 < 8) ML_LOAD(t + 1);
            float sq = 0.f, sk = 0.f;
#pragma unroll
            for (int e = 0; e < 8; ++e) { sq += q0[e] * q0[e] + q1[e] * q1[e]; sk += k0[e] * k0[e] + k1[e] * k1[e]; }
            sq = sum8lanes(sq); sk = sum8lanes(sk);
            const float rq = rsqrtf(sq * (1.f / QKD) + NORM_EPS), rk = rsqrtf(sk * (1.f / QKD) + NORM_EPS);
            float qo[8], ko[8], qr[8], kr[8];
#pragma unroll
            for (int e = 0; e < 8; ++e) { qo[e] = q0[e] * rq * gq0[e] * qscale; ko[e] = k0[e] * rk * gk0[e]; q1[e] = q1[e] * rq * gq1[e]; k1[e] = k1[e] * rk * gk1[e]; }
#pragma unroll
            for (int e = 0; e < 8; ++e) { const float qp = __shfl_xor(q1[e], 2), kp = __shfl_xor(k1[e], 2);
                const double rev = (double)(ps * invf[e]) * 0.15915494309189535; const float fr = (float)(rev - rint(rev));
                const float sn = __builtin_amdgcn_sinf(fr), cs = __builtin_amdgcn_cosf(fr);
                qr[e] = ((sub & 2) ? (q1[e] * cs + qp * sn) : (q1[e] * cs - qp * sn)) * qscale; kr[e] = (sub & 2) ? (k1[e] * cs + kp * sn) : (k1[e] * cs - kp * sn); }
            const size_t ro = ((size_t)(b * NH + h) * SEQ + s0 + i) * QKD;
            st8(Q + ro + 8 * sub, qo); st8(Kk + ro + 8 * sub, ko);
            if (rp) { st8(Q + ro + 64 + 8 * sub, qr); st8(Kk + ro + 64 + 8 * sub, kr); }
            vtr[i][0] = vw.x; vtr[i][1] = vw.y; vtr[i][2] = vw.z; vtr[i][3] = vw.w; }
#undef ML_LOAD
#pragma unroll
        for (int e = 0; e < 8; ++e) { u32x4 o;
            const unsigned x0 = (e & 1) ? (vtr[0][e >> 1] >> 16) : (vtr[0][e >> 1] & 0xffffu), x1 = (e & 1) ? (vtr[1][e >> 1] >> 16) : (vtr[1][e >> 1] & 0xffffu);
            const unsigned x2 = (e & 1) ? (vtr[2][e >> 1] >> 16) : (vtr[2][e >> 1] & 0xffffu), x3 = (e & 1) ? (vtr[3][e >> 1] >> 16) : (vtr[3][e >> 1] & 0xffffu);
            const unsigned x4 = (e & 1) ? (vtr[4][e >> 1] >> 16) : (vtr[4][e >> 1] & 0xffffu), x5 = (e & 1) ? (vtr[5][e >> 1] >> 16) : (vtr[5][e >> 1] & 0xffffu);
            const unsigned x6 = (e & 1) ? (vtr[6][e >> 1] >> 16) : (vtr[6][e >> 1] & 0xffffu), x7 = (e & 1) ? (vtr[7][e >> 1] >> 16) : (vtr[7][e >> 1] & 0xffffu);
            o.x = x0 | (x1 << 16); o.y = x2 | (x3 << 16); o.z = x4 | (x5 << 16); o.w = x6 | (x7 << 16);
            *(u32x4*)(Vt + ((size_t)(b * NH + h) * 64 + 8 * sub + e) * SEQ + s0) = o; }
    }
}

__device__ __forceinline__ void phase_rwkv_post(const PArgs& a, int l) {
    const int bidx_ = obid();
    const int tid = otid(), lane = tid & 63, wave = __builtin_amdgcn_readfirstlane(tid >> 6), G = ogrid(), c0 = lane * 8, h = lane >> 3;
    const bf16* zr = (const bf16*)(a.ws + S_ZR); const bf16* L2 = (const bf16*)(a.ws + S_L2); bf16* vf = (bf16*)(a.ws + WS_VF);
    bf16* RR = (bf16*)(a.ws + S_RR); bf16* RK = (bf16*)(a.ws + S_RK); bf16* RV = (bf16*)(a.ws + S_RV); bf16* RA = (bf16*)(a.ws + S_RA); bf16* RB = (bf16*)(a.ws + S_RB); float* RW = (float*)(a.ws + S_RW); bf16* RG = (bf16*)(a.ws + S_RG);
    float* bscA = (float*)(a.ws + WS_CTL + C_BSC);
    float mur[8], muk[8], muv[8], w0[8], a0[8], kkc[8], kac[8], rkc[8], vb[8];
    ldf8(INF(5) + l * 1792 + c0, mur); ldf8(INF(5) + l * 1792 + 512 + c0, muk); ldf8(INF(5) + l * 1792 + 1024 + c0, muv);
    ldf8(INF(6) + l * 512 + c0, w0); ldf8(INF(8) + l * 512 + c0, a0); ldf8(INF(11) + l * 512 + c0, kkc); ldf8(INF(12) + l * 512 + c0, kac); ldf8(INF(13) + l * 512 + c0, rkc);
    if (l > 0) ldf8(INF(19) + (l - 1) * 512 + c0, vb);
    for (int g = bidx_ * NWV + wave; g < T / 8; g += G * NWV) { const int t0 = g * 8;
        float pr[8], pk[8], pv[8];
        if (t0 % SEQ == 0) {
#pragma unroll
            for (int e = 0; e < 8; ++e) { pr[e] = 0.f; pk[e] = 0.f; pv[e] = 0.f; } }
        else { ld8(zr + (size_t)(t0 - 1) * NZR + c0, pr); ld8(zr + (size_t)(t0 - 1) * NZR + 512 + c0, pk); ld8(zr + (size_t)(t0 - 1) * NZR + 1024 + c0, pv); }
        u32x4 nzr, nzk, nzv, nlw, nla, nlv, nvf;
#define RW_LOAD(tt) do { const size_t t_ = (tt); nzr = *(const u32x4*)(zr + t_ * NZR + c0); nzk = *(const u32x4*)(zr + t_ * NZR + 512 + c0); nzv = *(const u32x4*)(zr + t_ * NZR + 1024 + c0); \
            nlw = *(const u32x4*)(L2 + t_ * N3 + c0); nla = *(const u32x4*)(L2 + t_ * N3 + 512 + c0); \
            if (l > 0) { nlv = *(const u32x4*)(L2 + t_ * N3 + 1536 + c0); nvf = *(const u32x4*)(vf + t_ * HW + c0); } } while (0)
        RW_LOAD(t0);
        for (int i = 0; i < 8; ++i) { const size_t t = t0 + i; float zr_[8], zk_[8], zv_[8], lw[8], la[8], lv[8], vfi[8];
            unpack8(nzr, zr_); unpack8(nzk, zk_); unpack8(nzv, zv_); unpack8(nlw, lw); unpack8(nla, la);
            if (l > 0) { unpack8(nlv, lv); unpack8(nvf, vfi); }
            if (i + 1 < 8) RW_LOAD(t + 1);
            float r[8], kp[8], v[8], av[8], bv[8], dw[8]; float ssq = 0.f, bs = 0.f;
#pragma unroll
            for (int e = 0; e < 8; ++e) { r[e] = zr_[e] + (pr[e] - zr_[e]) * mur[e]; const float k = zk_[e] + (pk[e] - zk_[e]) * muk[e]; v[e] = zv_[e] + (pv[e] - zv_[e]) * muv[e];
                pr[e] = zr_[e]; pk[e] = zk_[e]; pv[e] = zv_[e];
                const float logw = -softplusf_(-(w0[e] + lw[e])) - 0.5f; dw[e] = -__expf(logw);
                const float iclr = sigmoidf_(a0[e] + la[e]);
                if (l > 0) v[e] = v[e] + (vfi[e] - v[e]) * sigmoidf_(vb[e] + lv[e]);
                const float kkr = k * kkc[e]; ssq += kkr * kkr; av[e] = kkr; bv[e] = iclr;
                kp[e] = k * (1.f + (iclr - 1.f) * kac[e]); bs += r[e] * kp[e] * rkc[e]; }
            ssq = sum8lanes(ssq); bs = sum8lanes(bs); const float rn = rsqrtf(ssq + 1e-12f);
#pragma unroll
            for (int e = 0; e < 8; ++e) { const float kk = av[e] * rn; av[e] = -kk; bv[e] = kk * bv[e]; }
            if (l == 0) st8(vf + t * HW + c0, v);
            st8(RR + t * HW + c0, r); st8(RK + t * HW + c0, kp); st8(RV + t * HW + c0, v); st8(RA + t * HW + c0, av); st8(RB + t * HW + c0, bv);
            *(f32x4*)(RW + t * HW + c0) = (f32x4){dw[0], dw[1], dw[2], dw[3]}; *(f32x4*)(RW + t * HW + c0 + 4) = (f32x4){dw[4], dw[5], dw[6], dw[7]};
            if ((lane & 7) == 0) bscA[t * 8 + h] = bs; }
#undef RW_LOAD
    }
}

__device__ __forceinline__ void phase_gdn_prep(const PArgs& a, int l) {
    const int bidx_ = obid();
    const int tid = otid(), lane = tid & 63, wave = __builtin_amdgcn_readfirstlane(tid >> 6), G = ogrid(), c0 = lane * 8, h = lane >> 3;
    const bf16* zq = (const bf16*)(a.ws + S_ZQ); const bf16* zm = (const bf16*)(a.ws + S_ZM);
    float* GAL = (float*)(a.ws + S_GAL); float* GBE = (float*)(a.ws + S_GBE);
    const float* cw = INF(26) + l * 4 * NZQ;
    for (int u = bidx_ * NWV + wave; u < 3 * (T / 8); u += G * NWV) { const int which = u / (T / 8), t0 = (u % (T / 8)) * 8;
        const int cc = which * 512 + c0; bf16* O = (bf16*)(a.ws + (which == 0 ? S_GQ : which == 1 ? S_GK : S_GV));
        float w[4][8];
#pragma unroll
        for (int j = 0; j < 4; ++j) ldf8(cw + j * NZQ + cc, w[j]);
        float x0[8], x1[8], x2[8];
        if (t0 % SEQ == 0) {
#pragma unroll
            for (int e = 0; e < 8; ++e) { x0[e] = 0.f; x1[e] = 0.f; x2[e] = 0.f; } }
        else { ld8(zq + (size_t)(t0 - 3) * NZQ + cc, x0); ld8(zq + (size_t)(t0 - 2) * NZQ + cc, x1); ld8(zq + (size_t)(t0 - 1) * NZQ + cc, x2); }
        float alog = 0.f, dtb = 0.f; if (which == 0 && lane < 8) { alog = INF(27)[l * 8 + lane]; dtb = INF(28)[l * 8 + lane]; }
        u32x4 nx3 = *(const u32x4*)(zq + (size_t)t0 * NZQ + cc); float nbl = 0.f, nal = 0.f; if (which == 0 && lane < 8) { nbl = bf2f(zm[(size_t)t0 * NZM + 416 + lane]); nal = bf2f(zm[(size_t)t0 * NZM + 424 + lane]); }
        for (int i = 0; i < 8; ++i) { const size_t t = t0 + i; float x3[8], y[8]; unpack8(nx3, x3); const float bl = nbl, al = nal;
            if (i + 1 < 8) { nx3 = *(const u32x4*)(zq + (t + 1) * NZQ + cc); if (which == 0 && lane < 8) { nbl = bf2f(zm[(t + 1) * NZM + 416 + lane]); nal = bf2f(zm[(t + 1) * NZM + 424 + lane]); } }
            float ss = 0.f;
#pragma unroll
            for (int e = 0; e < 8; ++e) { const float c = w[0][e] * x0[e] + w[1][e] * x1[e] + w[2][e] * x2[e] + w[3][e] * x3[e]; y[e] = siluf_(c); ss += y[e] * y[e]; x0[e] = x1[e]; x1[e] = x2[e]; x2[e] = x3[e]; }
            if (which < 2) { ss = sum8lanes(ss); const float rn = rsqrtf(ss + 1e-12f) * (which == 0 ? 0.125f : 1.f);
#pragma unroll
                for (int e = 0; e < 8; ++e) y[e] *= rn; }
            st8(O + t * HW + c0, y);
            if (which == 0 && lane < 8) { GBE[t * 8 + lane] = sigmoidf_(bl); GAL[t * 8 + lane] = -__expf(alog) * softplusf_(al + dtb); } }
    }
}

__device__ __forceinline__ void phase_finish(const PArgs& a, int l) {
    const int bidx_ = obid();
    const int tid = otid(), lane = tid & 63, h = tid >> 6, G = ogrid(), c = tid;
    const bf16* YA = (const bf16*)(a.ws + S_YA); const bf16* YC = (const bf16*)(a.ws + S_YC); const bf16* RR = (const bf16*)(a.ws + S_RR); const bf16* RK = (const bf16*)(a.ws + S_RK); const bf16* RV = (const bf16*)(a.ws + S_RV); const bf16* RG = (const bf16*)(a.ws + S_RG);
    const bf16* zg = (const bf16*)(a.ws + S_ZG); bf16* OA = (bf16*)(a.ws + S_OA); bf16* OC = (bf16*)(a.ws + S_OC);
    const float rkc = INF(13)[l * 512 + c], lng = INF(14)[l * 512 + c], lnb = INF(15)[l * 512 + c], gng = INF(29)[l * 64 + lane];
    constexpr int TT = 4;
    for (int g = bidx_; g < T / TT; g += G) { const int t0 = g * TT; float ya[TT], yc[TT], r[TT], k[TT], v[TT], gt[TT], gg[TT];
#pragma unroll
        for (int i = 0; i < TT; ++i) { const size_t o = (size_t)(t0 + i) * HW + c; ya[i] = bf2f(YA[o]); yc[i] = bf2f(YC[o]); r[i] = bf2f(RR[o]); k[i] = bf2f(RK[o]); v[i] = bf2f(RV[o]); gt[i] = bf2f(RG[o]); gg[i] = bf2f(zg[o]); }
#pragma unroll
        for (int i = 0; i < TT; ++i) { const size_t o = (size_t)(t0 + i) * HW + c;
            const float mean = wave_sum(ya[i]) * (1.f / 64.f); const float d = ya[i] - mean; const float var = wave_sum(d * d) * (1.f / 64.f);
            const float bon = wave_sum(r[i] * k[i] * rkc) * v[i];
            const float y = d * rsqrtf(var + 64e-5f) * lng + lnb + bon;
            OA[o] = (bf16)f2bf(y * gt[i]);
            const float ms = wave_sum(yc[i] * yc[i]) * (1.f / 64.f);
            OC[o] = (bf16)f2bf(yc[i] * rsqrtf(ms + NORM_EPS) * gng * siluf_(gg[i])); }
    }
}
constexpr int AT_KP = 208, AT_VP = 136, AT_KB = 64 * AT_KP, AT_VB = 64 * AT_VP;
constexpr int AT_K0 = 0, AT_V0 = 2 * AT_KB;
template <int AV> __device__ __forceinline__ void attn_unit(const bf16* Q, const bf16* K, const bf16* Vt, bf16* OB, LAS unsigned char* lds, int b, int h, int qb) {
    const int tid = otid(), lane = tid & 63, wave = __builtin_amdgcn_readfirstlane(tid >> 6), ql = lane & 31, hh = lane >> 5;
    const int qrow0 = qb * 256 + wave * 32;
    const size_t bh = (size_t)(b * NH + h);
    bf16x8 qf[6];
    { const bf16* qp = Q + (bh * SEQ + qrow0 + ql) * QKD + 8 * hh;
#pragma unroll
      for (int s = 0; s < 6; ++s) qf[s] = *(const bf16x8*)(qp + 16 * s); }
    f32x16 o0, o1;
#pragma unroll
    for (int r = 0; r < 16; ++r) { o0[r] = 0.f; o1[r] = 0.f; }
    float mrun = -1e30f, lsum = 0.f;
    const int nkt = 4 * qb + 4;
    const unsigned char* Kb = (const unsigned char*)(K + bh * SEQ * QKD);
    const unsigned char* Vb = (const unsigned char*)(Vt + bh * 64 * SEQ);
    const int kr0 = tid / 12, kc0 = tid % 12, id1 = tid + 512, kr1 = id1 / 12, kc1 = id1 % 12; const bool k1v = id1 < 768;
    const int vr = tid >> 3, vc = tid & 7;
    u32x4 rk0, rk1, rv;
#define AT_LOADK(kt) do { const size_t key0 = (size_t)(kt) * 64; rk0 = *(const u32x4*)(Kb + (key0 + kr0) * (QKD * 2) + kc0 * 16); if (k1v) rk1 = *(const u32x4*)(Kb + (key0 + kr1) * (QKD * 2) + kc1 * 16); } while (0)
#define AT_LOADV(kt) do { rv = *(const u32x4*)(Vb + ((size_t)vr * SEQ + (size_t)(kt) * 64) * 2 + vc * 16); } while (0)
#define AT_STOREK(buf) do { LAS unsigned char* bp = lds + AT_K0 + (buf) * AT_KB; *(LAS u32x4*)(bp + kr0 * AT_KP + kc0 * 16) = rk0; if (k1v) *(LAS u32x4*)(bp + kr1 * AT_KP + kc1 * 16) = rk1; } while (0)
#define AT_STOREV(buf) do { LAS u32x2* vp = (LAS u32x2*)(lds + AT_V0 + (buf) * AT_VB + vr * AT_VP + vc * 16); vp[0] = (u32x2){rv.x, rv.y}; vp[1] = (u32x2){rv.z, rv.w}; } while (0)
#define AT_KFR(buf) do { const LAS unsigned char* kb = lds + AT_K0 + (buf) * AT_KB; \
        _Pragma("unroll") for (int s = 0; s < 6; ++s) { kfr[2 * s] = *(const LAS bf16x8*)(kb + ql * AT_KP + (16 * s + 8 * hh) * 2); kfr[2 * s + 1] = *(const LAS bf16x8*)(kb + (32 + ql) * AT_KP + (16 * s + 8 * hh) * 2); } } while (0)
#define AT_QK(dst0, dst1) do { \
        _Pragma("unroll") for (int r = 0; r < 16; ++r) { dst0[r] = 0.f; dst1[r] = 0.f; } \
        _Pragma("unroll") for (int s = 0; s < 6; ++s) { dst0 = __builtin_amdgcn_mfma_f32_32x32x16_bf16(kfr[2 * s], qf[s], dst0, 0, 0, 0); dst1 = __builtin_amdgcn_mfma_f32_32x32x16_bf16(kfr[2 * s + 1], qf[s], dst1, 0, 0, 0); } } while (0)
    bf16x8 kfr[12]; union VF { u32x4 u; bf16x8 v; } vfa[4], vfb[4];
    AT_LOADK(0); AT_LOADV(0); AT_STOREK(0); AT_STOREV(0); AT_LOADK(1); AT_STOREK(1);
    __syncthreads();
    f32x16 s0, s1;
    AT_KFR(0); AT_QK(s0, s1);
    for (int kt = 0; kt < nkt; ++kt) {
        const bool nx = kt + 1 < nkt;
        if (AV != 2) { if (kt + 2 < nkt) AT_LOADK(kt + 2);
        if (nx) AT_LOADV(kt + 1); }
        { const LAS unsigned char* vb = lds + AT_V0 + (kt & 1) * AT_VB;
#pragma unroll
          for (int q = 0; q < 4; ++q) { const int kofs = ((q >> 1) * 32 + 16 * (q & 1) + 4 * hh) * 2;
              { const u32x2 lo = *(const LAS u32x2*)(vb + ql * AT_VP + kofs), hi = *(const LAS u32x2*)(vb + ql * AT_VP + kofs + 16); vfa[q].u = (u32x4){lo.x, lo.y, hi.x, hi.y}; }
              { const u32x2 lo = *(const LAS u32x2*)(vb + (32 + ql) * AT_VP + kofs), hi = *(const LAS u32x2*)(vb + (32 + ql) * AT_VP + kofs + 16); vfb[q].u = (u32x4){lo.x, lo.y, hi.x, hi.y}; } } }
        f32x16 n0, n1;
        if (nx && wave < 4) { AT_KFR((kt + 1) & 1); AT_QK(n0, n1); }
        if (64 * kt + 63 > qrow0) { const int qi = qrow0 + ql, kbase = 64 * kt + 4 * hh;
#pragma unroll
            for (int r = 0; r < 16; ++r) { const int key = kbase + (r & 3) + 8 * (r >> 2); if (key > qi) s0[r] = -1e30f; if (key + 32 > qi) s1[r] = -1e30f; } }
        float mx = s0[0];
#pragma unroll
        for (int r = 1; r < 16; ++r) mx = fmaxf(mx, s0[r]);
#pragma unroll
        for (int r = 0; r < 16; ++r) mx = fmaxf(mx, s1[r]);
        mx = fmaxf(mx, __shfl_xor(mx, 32));
        const float mnew = fmaxf(mrun, mx), alpha = __builtin_amdgcn_exp2f(mrun - mnew); mrun = mnew;
        float ps = 0.f;
#pragma unroll
        for (int r = 0; r < 16; ++r) { if (AV == 1) { s0[r] = (s0[r] - mnew) * 1e-3f; s1[r] = (s1[r] - mnew) * 1e-3f; } else { s0[r] = __builtin_amdgcn_exp2f(s0[r] - mnew); s1[r] = __builtin_amdgcn_exp2f(s1[r] - mnew); } ps += s0[r] + s1[r]; }
        lsum = lsum * alpha + ps;
#pragma unroll
        for (int r = 0; r < 16; ++r) { o0[r] *= alpha; o1[r] *= alpha; }
#pragma unroll
        for (int q = 0; q < 4; ++q) { union { u32x4 u; bf16x8 v; } pf; const int s2 = q & 1;
            if (q < 2) { pf.u.x = pg8::cvt_pk_bf16(s0[8 * s2 + 0], s0[8 * s2 + 1]); pf.u.y = pg8::cvt_pk_bf16(s0[8 * s2 + 2], s0[8 * s2 + 3]); pf.u.z = pg8::cvt_pk_bf16(s0[8 * s2 + 4], s0[8 * s2 + 5]); pf.u.w = pg8::cvt_pk_bf16(s0[8 * s2 + 6], s0[8 * s2 + 7]); }
            else { pf.u.x = pg8::cvt_pk_bf16(s1[8 * s2 + 0], s1[8 * s2 + 1]); pf.u.y = pg8::cvt_pk_bf16(s1[8 * s2 + 2], s1[8 * s2 + 3]); pf.u.z = pg8::cvt_pk_bf16(s1[8 * s2 + 4], s1[8 * s2 + 5]); pf.u.w = pg8::cvt_pk_bf16(s1[8 * s2 + 6], s1[8 * s2 + 7]); }
            if (AV == 3) { o0[q] += bf2f(pf.u.x & 0xffffu) + bf2f(vfa[q].u.x); o1[q] += bf2f(pf.u.y >> 16) + bf2f(vfb[q].u.y); } else {
            o0 = __builtin_amdgcn_mfma_f32_32x32x16_bf16(vfa[q].v, pf.v, o0, 0, 0, 0); o1 = __builtin_amdgcn_mfma_f32_32x32x16_bf16(vfb[q].v, pf.v, o1, 0, 0, 0); } }
        if (nx && wave >= 4) { AT_KFR((kt + 1) & 1); AT_QK(n0, n1); }
        if (AV != 2) { if (kt + 2 < nkt) AT_STOREK(kt & 1);
        if (nx) AT_STOREV((kt + 1) & 1); }
        __syncthreads();
        if (nx) { s0 = n0; s1 = n1; }
    }
#undef AT_LOADK
#undef AT_LOADV
#undef AT_STOREK
#undef AT_STOREV
#undef AT_QK
#undef AT_KFR
    const float ltot = lsum + __shfl_xor(lsum, 32), inv = 1.f / ltot;
    bf16* op = OB + ((size_t)b * SEQ + qrow0 + ql) * HW + h * 64 + 4 * hh;
#pragma unroll
    for (int g = 0; g < 4; ++g) { u32x2 w0, w1; w0.x = pg8::cvt_pk_bf16(o0[4 * g] * inv, o0[4 * g + 1] * inv); w0.y = pg8::cvt_pk_bf16(o0[4 * g + 2] * inv, o0[4 * g + 3] * inv);
        w1.x = pg8::cvt_pk_bf16(o1[4 * g] * inv, o1[4 * g + 1] * inv); w1.y = pg8::cvt_pk_bf16(o1[4 * g + 2] * inv, o1[4 * g + 3] * inv);
        *(u32x2*)(op + 8 * g) = w0; *(u32x2*)(op + 32 + 8 * g) = w1; }
}
template <int AV> __device__ __forceinline__ void phase_attn(const PArgs& a, LAS unsigned char* lds) {
    const int bidx_ = obid();
    const bf16* Q = (const bf16*)(a.ws + S_Q); const bf16* K = (const bf16*)(a.ws + S_K); const bf16* Vt = (const bf16*)(a.ws + S_VT); bf16* OB = (bf16*)(a.ws + (AV == 0 ? S_OB : S_RG));
    for (int pi0 = bidx_; pi0 < NB * NH * 8; pi0 += ogrid()) { const int xg = pi0 & 7, ix = pi0 >> 3; const int pi = (ogrid() % 8 == 0 && pi0 < 256) ? ((xg * 4 + (ix >> 3)) * 8 + (ix & 7)) : pi0; const int bh = pi >> 3, j = pi & 7;
        attn_unit<AV>(Q, K, Vt, OB, lds, bh >> 3, bh & 7, 15 - j);
        attn_unit<AV>(Q, K, Vt, OB, lds, bh >> 3, bh & 7, j); }
}

constexpr int SC_STEPS = 16, SC_ROW = 5 * 64 + 16, SC_BUF = SC_STEPS * SC_ROW * 4;
__device__ __forceinline__ void scan_task(const PArgs& a, int task, LAS unsigned char* wlds) {
    const int lane = otid() & 63, i = lane >> 2, jq = lane & 3;
    const bool gdn = task >= 128; const int tt = gdn ? task - 128 : task; const int b = tt >> 5, h = (tt >> 2) & 7, rg = tt & 3;
    const bf16 *PR, *PK, *PV, *PA, *PB; const float* PW; const float *PAL, *PBE; bf16* Y;
    if (!gdn) { PR = (const bf16*)(a.ws + S_RR); PK = (const bf16*)(a.ws + S_RK); PV = (const bf16*)(a.ws + S_RV); PA = (const bf16*)(a.ws + S_RA); PB = (const bf16*)(a.ws + S_RB); PW = (const float*)(a.ws + S_RW); PAL = nullptr; PBE = nullptr; Y = (bf16*)(a.ws + S_YA); }
    else { PR = (const bf16*)(a.ws + S_GQ); PK = (const bf16*)(a.ws + S_GK); PV = (const bf16*)(a.ws + S_GV); PA = nullptr; PB = nullptr; PW = nullptr; PAL = (const float*)(a.ws + S_GAL); PBE = (const float*)(a.ws + S_GBE); Y = (bf16*)(a.ws + S_YC); }
    const size_t row0 = (size_t)b * SEQ; const int col0 = h * 64;
    const int bs = lane >> 3, be = 8 * (lane & 7);
    u32x4 gr[2], gk[2], ga[2], gb[2], gv; f32x4 gw[4]; float gal[2], gbe[2];
#define SC_LOAD(c) do { const size_t t0_ = row0 + (size_t)(c) * SC_STEPS; \
        _Pragma("unroll") for (int q = 0; q < 2; ++q) { const size_t o_ = (t0_ + bs + 8 * q) * HW + col0 + be; gr[q] = *(const u32x4*)(PR + o_); gk[q] = *(const u32x4*)(PK + o_); \
            if (!gdn) { ga[q] = *(const u32x4*)(PA + o_); gb[q] = *(const u32x4*)(PB + o_); } else { gal[q] = PAL[(t0_ + bs + 8 * q) * 8 + h]; gbe[q] = PBE[(t0_ + bs + 8 * q) * 8 + h]; } } \
        if (!gdn) { _Pragma("unroll") for (int q = 0; q < 4; ++q) gw[q] = *(const f32x4*)(PW + (t0_ + (lane >> 4) + 4 * q) * HW + col0 + 4 * (lane & 15)); } \
        if (lane < 32) gv = *(const u32x4*)(PV + (t0_ + (lane >> 1)) * HW + col0 + rg * 16 + (lane & 1) * 8); } while (0)
#define SC_STORE(buf) do { LAS float* B_ = (LAS float*)(wlds + (buf) * SC_BUF); \
        _Pragma("unroll") for (int q = 0; q < 2; ++q) { LAS float* R_ = B_ + (bs + 8 * q) * SC_ROW; float fr_[8], fk_[8]; unpack8(gr[q], fr_); unpack8(gk[q], fk_); \
            if (!gdn) { float fa_[8], fb_[8]; unpack8(ga[q], fa_); unpack8(gb[q], fb_); \
                *(LAS f32x4*)(R_ + 0 + be) = (f32x4){fa_[0], fa_[1], fa_[2], fa_[3]}; *(LAS f32x4*)(R_ + 0 + be + 4) = (f32x4){fa_[4], fa_[5], fa_[6], fa_[7]}; \
                *(LAS f32x4*)(R_ + 128 + be) = (f32x4){fb_[0], fb_[1], fb_[2], fb_[3]}; *(LAS f32x4*)(R_ + 128 + be + 4) = (f32x4){fb_[4], fb_[5], fb_[6], fb_[7]}; \
                *(LAS f32x4*)(R_ + 192 + be) = (f32x4){fk_[0], fk_[1], fk_[2], fk_[3]}; *(LAS f32x4*)(R_ + 192 + be + 4) = (f32x4){fk_[4], fk_[5], fk_[6], fk_[7]}; } \
            else { const float al_ = gal[q], be_ = gbe[q], nab_ = -al_ * be_; \
                *(LAS f32x4*)(R_ + 0 + be) = (f32x4){fk_[0], fk_[1], fk_[2], fk_[3]}; *(LAS f32x4*)(R_ + 0 + be + 4) = (f32x4){fk_[4], fk_[5], fk_[6], fk_[7]}; \
                *(LAS f32x4*)(R_ + 64 + be) = (f32x4){al_, al_, al_, al_}; *(LAS f32x4*)(R_ + 64 + be + 4) = (f32x4){al_, al_, al_, al_}; \
                *(LAS f32x4*)(R_ + 128 + be) = (f32x4){fk_[0] * nab_, fk_[1] * nab_, fk_[2] * nab_, fk_[3] * nab_}; *(LAS f32x4*)(R_ + 128 + be + 4) = (f32x4){fk_[4] * nab_, fk_[5] * nab_, fk_[6] * nab_, fk_[7] * nab_}; \
                *(LAS f32x4*)(R_ + 192 + be) = (f32x4){fk_[0] * be_, fk_[1] * be_, fk_[2] * be_, fk_[3] * be_}; *(LAS f32x4*)(R_ + 192 + be + 4) = (f32x4){fk_[4] * be_, fk_[5] * be_, fk_[6] * be_, fk_[7] * be_}; } \
            *(LAS f32x4*)(R_ + 256 + be) = (f32x4){fr_[0], fr_[1], fr_[2], fr_[3]}; *(LAS f32x4*)(R_ + 256 + be + 4) = (f32x4){fr_[4], fr_[5], fr_[6], fr_[7]}; } \
        if (!gdn) { _Pragma("unroll") for (int q = 0; q < 4; ++q) *(LAS f32x4*)(B_ + ((lane >> 4) + 4 * q) * SC_ROW + 64 + 4 * (lane & 15)) = gw[q]; } \
        if (lane < 32) { float fv_[8]; unpack8(gv, fv_); LAS float* V_ = B_ + (lane >> 1) * SC_ROW + 320 + (lane & 1) * 8; *(LAS f32x4*)(V_) = (f32x4){fv_[0], fv_[1], fv_[2], fv_[3]}; *(LAS f32x4*)(V_ + 4) = (f32x4){fv_[4], fv_[5], fv_[6], fv_[7]}; } } while (0)
    float st[16];
#pragma unroll
    for (int q = 0; q < 16; ++q) st[q] = 0.f;
    SC_LOAD(0); SC_STORE(0);
    constexpr int NCH = SEQ / SC_STEPS;
    for (int c = 0; c < NCH; ++c) {
        if (c + 1 < NCH) SC_LOAD(c + 1);
        const LAS float* B_ = (const LAS float*)(wlds + (c & 1) * SC_BUF);
        for (int s = 0; s < SC_STEPS; ++s) { const LAS float* R_ = B_ + s * SC_ROW + 16 * jq;
            float va[16], vw[16], vb[16], vk[16], vr[16];
#pragma unroll
            for (int q = 0; q < 4; ++q) { const f32x4 x0 = *(const LAS f32x4*)(R_ + 4 * q), x1 = *(const LAS f32x4*)(R_ + 64 + 4 * q), x2 = *(const LAS f32x4*)(R_ + 128 + 4 * q), x3 = *(const LAS f32x4*)(R_ + 192 + 4 * q), x4 = *(const LAS f32x4*)(R_ + 256 + 4 * q);
#pragma unroll
                for (int e = 0; e < 4; ++e) { va[4 * q + e] = x0[e]; vw[4 * q + e] = x1[e]; vb[4 * q + e] = x2[e]; vk[4 * q + e] = x3[e]; vr[4 * q + e] = x4[e]; } }
            const float vi = B_[s * SC_ROW + 320 + i];
            float sa = 0.f;
#pragma unroll
            for (int q = 0; q < 16; ++q) sa += st[q] * va[q];
            sa += __shfl_xor(sa, 1); sa += __shfl_xor(sa, 2);
            float y = 0.f;
#pragma unroll
            for (int q = 0; q < 16; ++q) { st[q] = st[q] * vw[q] + sa * vb[q] + vi * vk[q]; y += st[q] * vr[q]; }
            y += __shfl_xor(y, 1); y += __shfl_xor(y, 2);
            if (jq == 0) Y[(row0 + (size_t)c * SC_STEPS + s) * HW + col0 + rg * 16 + i] = (bf16)f2bf(y);
        }
        if (c + 1 < NCH) SC_STORE((c + 1) & 1);
    }
#undef SC_LOAD
#undef SC_STORE
}
__device__ __forceinline__ void phase_scan(const PArgs& a, LAS unsigned char* lds) {
    const int bidx_ = obid();
    const int wave = __builtin_amdgcn_readfirstlane(otid() >> 6), G = ogrid();
    if (wave < 3) for (int task = bidx_ + wave * G; task < 256; task += 3 * G) scan_task(a, task, lds + wave * (2 * SC_BUF));
}
constexpr int CK_TP = 144;
constexpr int CK_AT = 0, CK_BT = 9216, CK_KT = 18432, CK_RT = 27648, CK_BW = 36864, CK_KW = 46080, CK_V = 55296, CK_N = 64512, CK_LAK = 73728, CK_LRB = 82944, CK_LRK = 92160,
              CK_AW = 101376, CK_W1 = 110592, CK_AH = 119808, CK_LVT = 129024, CK_DD = 138240;
constexpr int CK_CUM = 147456, CK_CUMP = 147712, CK_PC = 147968, CK_WTOT = 148224;
constexpr int CM_ITEM = 32768;
typedef short s16x4 __attribute__((ext_vector_type(4)));
__device__ __forceinline__ bf16x8 ck_frag(const LAS unsigned char* tile, int row, int ks, int hh) { return *(const LAS bf16x8*)(tile + row * CK_TP + (16 * ks + 8 * hh) * 2); }
__device__ __forceinline__ int crow_(int r, int hh) { return (r & 3) + 8 * (r >> 2) + 4 * hh; }
#define DPP_ADD(v, ctrl, rmask) v += __builtin_bit_cast(float, __builtin_amdgcn_update_dpp(0, __builtin_bit_cast(int, v), ctrl, rmask, 0xf, true))
__device__ __forceinline__ float wave_scan_incl(float v) {
    DPP_ADD(v, 0x111, 0xf);
    DPP_ADD(v, 0x112, 0xf);
    DPP_ADD(v, 0x114, 0xf);
    DPP_ADD(v, 0x118, 0xf);
    DPP_ADD(v, 0x142, 0xa);
    DPP_ADD(v, 0x143, 0xc);
    return v;
}
struct CkIn { u32x4 r, k, v, a, b; f32x4 w0, w1; float g, be; };
__device__ __forceinline__ void ck_load(const PArgs& a, int item, int t, int j0, CkIn& o) {
    const bool gdn = item >= 2048; const int it = item & 2047, bh = it >> 6, ch = it & 63, b = bh >> 3, h = bh & 7;
    const size_t row = (size_t)b * SEQ + ch * 64 + t; const size_t eo = row * HW + h * 64 + j0;
    const bf16* pr = (const bf16*)(a.ws + (gdn ? S_GQ : S_RR)); const bf16* pk = (const bf16*)(a.ws + (gdn ? S_GK : S_RK)); const bf16* pv = (const bf16*)(a.ws + (gdn ? S_GV : S_RV));
    const bf16* pa = (const bf16*)(a.ws + (gdn ? S_GK : S_RA)); const bf16* pb = (const bf16*)(a.ws + (gdn ? S_GK : S_RB));
    o.r = *(const u32x4*)(pr + eo); o.k = *(const u32x4*)(pk + eo); o.v = *(const u32x4*)(pv + eo); o.a = *(const u32x4*)(pa + eo); o.b = *(const u32x4*)(pb + eo);
    const size_t wo = gdn ? (size_t)(j0) : eo;
    o.w0 = *(const f32x4*)((const float*)(a.ws + S_RW) + wo); o.w1 = *(const f32x4*)((const float*)(a.ws + S_RW) + wo + 4);
    o.g = ((const float*)(a.ws + S_GAL))[row * 8 + h]; o.be = ((const float*)(a.ws + S_GBE))[row * 8 + h];
}
__device__ __forceinline__ void phase_cprep(const PArgs& a, LAS unsigned char* lds) {
    const int bidx_ = obid();
    const int tid = otid(), lane = tid & 63, wave = __builtin_amdgcn_readfirstlane(tid >> 6), G = ogrid(), ql = lane & 31, hh = lane >> 5;
    const int t = lane, j0 = wave * 8;
    LAS float* cumA = (LAS float*)(lds + CK_CUM); LAS float* cumpA = (LAS float*)(lds + CK_CUMP); LAS float* pcA = (LAS float*)(lds + CK_PC);
    CkIn in; if (bidx_ < 4096) ck_load(a, bidx_, t, j0, in);
#if PROBE_SUB >= 10
    volatile LAS unsigned* tmisc = (volatile LAS unsigned*)(lds + (163840 - 1024)) + 40; unsigned long long tprev = __builtin_amdgcn_s_memrealtime();
#define CKSTAMP(k) do { if (PROBE_SUB - 10 == (k)) { const unsigned long long tn_ = __builtin_amdgcn_s_memrealtime(); if (tid == 0) tmisc[0] += (unsigned)(tn_ - tprev); } tprev = __builtin_amdgcn_s_memrealtime(); } while (0)
#else
#define CKSTAMP(k) do { } while (0)
#endif
    for (int item = bidx_; item < 4096; item += G) {
        CKSTAMP(6);
        const bool gdn = item >= 2048; const int it = item & 2047;
        float fr[8], fk[8], fv[8], fa[8], fb[8], lw[8];
        unpack8(in.v, fv);
        if (!gdn) { unpack8(in.r, fr); unpack8(in.k, fk); unpack8(in.a, fa); unpack8(in.b, fb);
#pragma unroll
            for (int e = 0; e < 4; ++e) { lw[e] = in.w0[e]; lw[4 + e] = in.w1[e]; } }
        else { float fkk[8]; unpack8(in.r, fr); unpack8(in.k, fkk); const float g = in.g, be = in.be, al = __expf(g);
#pragma unroll
            for (int e = 0; e < 8; ++e) { fa[e] = fkk[e]; fb[e] = -al * be * fkk[e]; fk[e] = be * fkk[e]; lw[e] = g; } }
        CKSTAMP(7);
        if (item + G < 4096) ck_load(a, item + G, t, j0, in);
        float cum[8], pc[8];
        if (!gdn) {
#pragma unroll
            for (int e = 0; e < 8; ++e) { cum[e] = wave_scan_incl(lw[e]); pc[e] = __builtin_bit_cast(float, __builtin_amdgcn_readlane(__builtin_bit_cast(int, cum[e]), 63)); } }
        else { const float c0 = wave_scan_incl(lw[0]); const float p0 = __builtin_bit_cast(float, __builtin_amdgcn_readlane(__builtin_bit_cast(int, c0), 63));
#pragma unroll
            for (int e = 0; e < 8; ++e) { cum[e] = c0; pc[e] = p0; } }
        CKSTAMP(8);
        if (wave == 0) { cumA[t] = gdn ? cum[0] : 0.f; cumpA[t] = gdn ? cum[0] - lw[0] : 0.f; }
        if (lane == 0) {
#pragma unroll
            for (int e = 0; e < 8; ++e) pcA[j0 + e] = pc[e]; }
        { float xa[8], xr[8], xb[8], xk[8], yb[8], yk[8], ya[8];
          if (!gdn) {
#pragma unroll
              for (int e = 0; e < 8; ++e) { const float ecp = __expf(cum[e] - lw[e]), ec = __expf(cum[e]), eci = __expf(-cum[e]), et = __expf(pc[e] - cum[e]);
                  xa[e] = fa[e] * ecp; xr[e] = fr[e] * ec; xb[e] = fb[e] * eci; xk[e] = fk[e] * eci; yb[e] = fb[e] * et; yk[e] = fk[e] * et; ya[e] = fa[e] * ecp; } }
          else { const float ecp_true = __expf(cum[0] - lw[0]), et = __expf(pc[0] - cum[0]);
#pragma unroll
              for (int e = 0; e < 8; ++e) { xa[e] = fa[e]; xr[e] = fr[e]; xb[e] = fb[e]; xk[e] = fk[e]; yb[e] = fb[e] * et; yk[e] = fk[e] * et; ya[e] = fa[e] * ecp_true; } }
          const int ro = t * CK_TP + j0 * 2;
          *(LAS u32x4*)(lds + CK_AT + ro) = (u32x4){pk2(xa[0], xa[1]), pk2(xa[2], xa[3]), pk2(xa[4], xa[5]), pk2(xa[6], xa[7])};
          *(LAS u32x4*)(lds + CK_RT + ro) = (u32x4){pk2(xr[0], xr[1]), pk2(xr[2], xr[3]), pk2(xr[4], xr[5]), pk2(xr[6], xr[7])};
          *(LAS u32x4*)(lds + CK_BT + ro) = (u32x4){pk2(xb[0], xb[1]), pk2(xb[2], xb[3]), pk2(xb[4], xb[5]), pk2(xb[6], xb[7])};
          *(LAS u32x4*)(lds + CK_KT + ro) = (u32x4){pk2(xk[0], xk[1]), pk2(xk[2], xk[3]), pk2(xk[4], xk[5]), pk2(xk[6], xk[7])};
#pragma unroll
          for (int e = 0; e < 8; ++e) { const int to = (j0 + e) * CK_TP + t * 2; *(LAS unsigned short*)(lds + CK_BW + to) = (unsigned short)f2bf(yb[e]); *(LAS unsigned short*)(lds + CK_KW + to) = (unsigned short)f2bf(yk[e]);
              *(LAS unsigned short*)(lds + CK_V + to) = (unsigned short)f2bf(fv[e]); *(LAS unsigned short*)(lds + CK_AH + to) = (unsigned short)f2bf(ya[e]); } }
        CKSTAMP(9);
        __syncthreads();
        CKSTAMP(0);
#ifndef PROBE_CK
#define PROBE_CK 1
#endif
        for (int rep_ = 0; rep_ < PROBE_CK; ++rep_) {
        { const int p = wave >> 1, hf = wave & 1; const LAS unsigned char* At = lds + (p < 2 ? CK_AT : CK_RT); const LAS unsigned char* Bt = lds + ((p & 1) ? CK_KT : CK_BT);
          const LAS float* dA = (p < 2) ? cumpA : cumA; LAS unsigned char* Ot = lds + (p == 0 ? CK_N : p == 1 ? CK_LAK : p == 2 ? CK_LRB : CK_LRK); const int incl = (p >= 2) ? 1 : 0;
#pragma unroll
          for (int sq = 0; sq < 2; ++sq) { f32x16 acc;
#pragma unroll
              for (int r = 0; r < 16; ++r) acc[r] = 0.f;
              if (!(sq == 1 && hf == 0)) {
#pragma unroll
                  for (int ks = 0; ks < 4; ++ks) acc = __builtin_amdgcn_mfma_f32_32x32x16_bf16(ck_frag(Bt, 32 * sq + ql, ks, hh), ck_frag(At, 32 * hf + ql, ks, hh), acc, 0, 0, 0); }
              const int tt = 32 * hf + ql; LAS unsigned char* orow = Ot + tt * CK_TP + (32 * sq + 4 * hh) * 2;
              if (gdn) { const float dAt = dA[tt];
#pragma unroll
                  for (int g4 = 0; g4 < 4; ++g4) { const f32x4 dB4 = *(const LAS f32x4*)(cumA + 32 * sq + 8 * g4 + 4 * hh); float v[4];
#pragma unroll
                      for (int q = 0; q < 4; ++q) { const int s = 32 * sq + 8 * g4 + 4 * hh + q; v[q] = (s < tt + incl) ? acc[4 * g4 + q] * __expf(dAt - dB4[q]) : 0.f; }
                      *(LAS u32x2*)(orow + 16 * g4) = (u32x2){pk2(v[0], v[1]), pk2(v[2], v[3])}; } }
              else {
#pragma unroll
                  for (int g4 = 0; g4 < 4; ++g4) { float v[4];
#pragma unroll
                      for (int q = 0; q < 4; ++q) { const int s = 32 * sq + 8 * g4 + 4 * hh + q; v[q] = (s < tt + incl) ? acc[4 * g4 + q] : 0.f; }
                      *(LAS u32x2*)(orow + 16 * g4) = (u32x2){pk2(v[0], v[1]), pk2(v[2], v[3])}; } } } }
        __syncthreads();
        CKSTAMP(1);
        if (wave >= 1 && wave <= 4) { const int w4 = wave - 1, tq = w4 >> 1, iq = w4 & 1; f32x16 acc;
#pragma unroll
            for (int r = 0; r < 16; ++r) acc[r] = 0.f;
#pragma unroll
            for (int ks = 0; ks < 4; ++ks) acc = __builtin_amdgcn_mfma_f32_32x32x16_bf16(ck_frag(lds + CK_LAK, 32 * tq + ql, ks, hh), ck_frag(lds + CK_V, 32 * iq + ql, ks, hh), acc, 0, 0, 0);
#pragma unroll
            for (int g4 = 0; g4 < 4; ++g4) *(LAS u32x2*)(lds + CK_LVT + (32 * iq + ql) * CK_TP + (32 * tq + 8 * g4 + 4 * hh) * 2) = (u32x2){pk2(acc[4 * g4], acc[4 * g4 + 1]), pk2(acc[4 * g4 + 2], acc[4 * g4 + 3])}; }
        else if (wave == 0) { const int I = lane >> 4, c = lane & 15; float d[16];
#pragma unroll
            for (int r = 0; r < 16; ++r) { float nr[16]; { float lo8[8], hi8[8]; unpack8(*(const LAS u32x4*)(lds + CK_N + (16 * I + r) * CK_TP + (16 * I) * 2), lo8); unpack8(*(const LAS u32x4*)(lds + CK_N + (16 * I + r) * CK_TP + (16 * I + 8) * 2), hi8);
#pragma unroll
                    for (int e = 0; e < 8; ++e) { nr[e] = lo8[e]; nr[8 + e] = hi8[e]; } }
                float v = (r == c) ? 1.f : 0.f;
#pragma unroll
                for (int s2 = 0; s2 < r; ++s2) v += nr[s2] * d[s2];
                d[r] = v; }
#pragma unroll
            for (int r = 0; r < 16; ++r) *(LAS unsigned short*)(lds + CK_DD + (16 * I + r) * CK_TP + (16 * I + c) * 2) = (unsigned short)f2bf(d[r]); }
        __syncthreads();
        CKSTAMP(2);
        { const int col = lane & 15, g = lane >> 4; const int rb = (wave < 4) ? (16 * wave + col) : (16 * (wave - 4) + col);
          const LAS unsigned char* RTt = lds + (wave < 4 ? CK_AH : CK_LVT) + rb * CK_TP; LAS unsigned char* XTt = lds + (wave < 4 ? CK_AW : CK_W1) + rb * CK_TP;
          s16x4 xb[4], nf[4][3], dd[4]; u32x2 rt[4];
#pragma unroll
          for (int I = 0; I < 4; ++I) { rt[I] = *(const LAS u32x2*)(RTt + (16 * I + 4 * g) * 2); dd[I] = *(const LAS s16x4*)(lds + CK_DD + (16 * I + col) * CK_TP + (16 * I + 4 * g) * 2);
#pragma unroll
              for (int J = 0; J < 3; ++J) if (J < I) nf[I][J] = *(const LAS s16x4*)(lds + CK_N + (16 * I + col) * CK_TP + (16 * J + 4 * g) * 2); }
#pragma unroll
          for (int I = 0; I < 4; ++I) { f32x4 acc; { const u32x2 w = rt[I]; acc[0] = bf2f(w.x & 0xffffu); acc[1] = bf2f(w.x >> 16); acc[2] = bf2f(w.y & 0xffffu); acc[3] = bf2f(w.y >> 16); }
#pragma unroll
              for (int J = 0; J < 3; ++J) if (J < I) acc = __builtin_amdgcn_mfma_f32_16x16x16bf16_1k(nf[I][J], xb[J], acc, 0, 0, 0);
              union { u32x2 u; s16x4 v; } zb; zb.u = (u32x2){pk2(acc[0], acc[1]), pk2(acc[2], acc[3])};
              f32x4 x = (f32x4){0.f, 0.f, 0.f, 0.f};
              x = __builtin_amdgcn_mfma_f32_16x16x16bf16_1k(dd[I], zb.v, x, 0, 0, 0);
              union { u32x2 u; s16x4 v; } xo; xo.u = (u32x2){pk2(x[0], x[1]), pk2(x[2], x[3])}; xb[I] = xo.v;
              *(LAS u32x2*)(XTt + (16 * I + 4 * g) * 2) = xo.u; } }
        __syncthreads();
        }
        CKSTAMP(3);
        { const int quad = wave & 3, rq = quad >> 1, cq = quad & 1; const bool lo = wave < 4;
          bf16* cm = (bf16*)(a.ws + (gdn ? S_CMG : S_CMR) + (size_t)it * CM_ITEM);
          const LAS unsigned char* A1 = lds + (lo ? CK_BW : CK_LRB); const LAS unsigned char* A2 = lds + (lo ? CK_KW : CK_LRK);
          f32x16 g1, g2;
#pragma unroll
          for (int r = 0; r < 16; ++r) { g1[r] = 0.f; g2[r] = 0.f; }
          if (lo) {
#pragma unroll
              for (int ks = 0; ks < 4; ++ks) { const bf16x8 af = ck_frag(A1, 32 * rq + ql, ks, hh);
                  g1 = __builtin_amdgcn_mfma_f32_32x32x16_bf16(ck_frag(lds + CK_AW, 32 * cq + ql, ks, hh), af, g1, 0, 0, 0);
                  g2 = __builtin_amdgcn_mfma_f32_32x32x16_bf16(af, ck_frag(lds + CK_W1, 32 * cq + ql, ks, hh), g2, 0, 0, 0); }
#pragma unroll
              for (int ks = 0; ks < 4; ++ks) g2 = __builtin_amdgcn_mfma_f32_32x32x16_bf16(ck_frag(A2, 32 * rq + ql, ks, hh), ck_frag(lds + CK_V, 32 * cq + ql, ks, hh), g2, 0, 0, 0); }
          else {
#pragma unroll
              for (int ks = 0; ks < 4; ++ks) { const bf16x8 af = ck_frag(A1, 32 * rq + ql, ks, hh);
                  g1 = __builtin_amdgcn_mfma_f32_32x32x16_bf16(ck_frag(lds + CK_AW, 32 * cq + ql, ks, hh), af, g1, 0, 0, 0);
                  g2 = __builtin_amdgcn_mfma_f32_32x32x16_bf16(ck_frag(lds + CK_W1, 32 * cq + ql, ks, hh), af, g2, 0, 0, 0); }
#pragma unroll
              for (int ks = 0; ks < 4; ++ks) g2 = __builtin_amdgcn_mfma_f32_32x32x16_bf16(ck_frag(lds + CK_V, 32 * cq + ql, ks, hh), ck_frag(A2, 32 * rq + ql, ks, hh), g2, 0, 0, 0); }
          const int col = 32 * cq + ql, ln = 32 * rq + ql, cb = 32 * cq + 4 * hh;
          if (lo) { const float dg = __expf(pcA[ln]);
#pragma unroll
              for (int g4 = 0; g4 < 4; ++g4) { float v[4];
#pragma unroll
                  for (int q = 0; q < 4; ++q) v[q] = g1[4 * g4 + q] + ((cb + 8 * g4 + q) == ln ? dg : 0.f);
                  *(LAS u32x2*)(lds + CK_AT + ln * CK_TP + (cb + 8 * g4) * 2) = (u32x2){pk2(v[0], v[1]), pk2(v[2], v[3])}; }
#pragma unroll
              for (int g4 = 0; g4 < 4; ++g4) *(LAS u32x2*)(lds + CK_BT + col * CK_TP + (32 * rq + 8 * g4 + 4 * hh) * 2) = (u32x2){pk2(g2[4 * g4], g2[4 * g4 + 1]), pk2(g2[4 * g4 + 2], g2[4 * g4 + 3])}; }
          else { const float sc = gdn ? __expf(cumA[ln]) : 1.f;
#pragma unroll
              for (int g4 = 0; g4 < 4; ++g4) { const u32x2 rw_ = *(const LAS u32x2*)(lds + CK_RT + ln * CK_TP + (cb + 8 * g4) * 2);
                  const float r0 = bf2f(rw_.x & 0xffffu) * sc, r1 = bf2f(rw_.x >> 16) * sc, r2 = bf2f(rw_.y & 0xffffu) * sc, r3 = bf2f(rw_.y >> 16) * sc;
                  *(LAS u32x2*)(lds + CK_KT + ln * CK_TP + (cb + 8 * g4) * 2) = (u32x2){pk2(g1[4 * g4] + r0, g1[4 * g4 + 1] + r1), pk2(g1[4 * g4 + 2] + r2, g1[4 * g4 + 3] + r3)};
                  *(LAS u32x2*)(lds + CK_N + ln * CK_TP + (cb + 8 * g4) * 2) = (u32x2){pk2(g2[4 * g4], g2[4 * g4 + 1]), pk2(g2[4 * g4 + 2], g2[4 * g4 + 3])}; } }
          __syncthreads();
          CKSTAMP(4);
          { const int rr = tid >> 3, cc = (tid & 7) * 16; unsigned char* o = (unsigned char*)cm + rr * 128 + cc;
            *(u32x4*)(o) = *(const LAS u32x4*)(lds + CK_AT + rr * CK_TP + cc); *(u32x4*)(o + 8192) = *(const LAS u32x4*)(lds + CK_BT + rr * CK_TP + cc);
            *(u32x4*)(o + 16384) = *(const LAS u32x4*)(lds + CK_KT + rr * CK_TP + cc); *(u32x4*)(o + 24576) = *(const LAS u32x4*)(lds + CK_N + rr * CK_TP + cc); } }
        __syncthreads();
        CKSTAMP(5);
    }
}

__device__ __forceinline__ void phase_cscan(const PArgs& a, LAS unsigned char* lds) {
    const int bidx_ = obid();
    const int tid = otid(), lane = tid & 63, wave = __builtin_amdgcn_readfirstlane(tid >> 6), G = ogrid(), ql = lane & 31, hh = lane >> 5;
    for (int task = bidx_; task < 64; task += G) { const bool gdn = task >= 32; const int bh = task & 31;
        const bf16* cm = (const bf16*)(a.ws + (gdn ? S_CMG : S_CMR)) + (size_t)bh * 64 * (CM_ITEM / 2); bf16* s0 = (bf16*)(a.ws + (gdn ? S_S0G : S_S0R)) + (size_t)bh * 64 * 4096;
        const int rq = (wave >> 1) & 1, cq = wave & 1;
        for (int q = tid; q < 64 * CK_TP / 4; q += NTH) ((LAS unsigned*)lds)[q] = 0u;
        __syncthreads();
        bf16x8 ga[4][4]; u32x2 hc[4][4];
        if (wave < 4) {
#pragma unroll
            for (int u = 0; u < 4; ++u) { const bf16* cn = cm + (size_t)u * (CM_ITEM / 2);
#pragma unroll
                for (int ks = 0; ks < 4; ++ks) ga[u][ks] = *(const bf16x8*)(cn + (32 * rq + ql) * 64 + 16 * ks + 8 * hh);
#pragma unroll
                for (int g4 = 0; g4 < 4; ++g4) hc[u][g4] = *(const u32x2*)(cn + 4096 + (32 * cq + ql) * 64 + 32 * rq + 8 * g4 + 4 * hh); } }
        for (int c0 = 0; c0 < 64; c0 += 4) {
#pragma unroll
            for (int u = 0; u < 4; ++u) { const int c = c0 + u; const LAS unsigned char* sc = lds + (u & 1) * (64 * CK_TP); LAS unsigned char* sn = lds + ((u + 1) & 1) * (64 * CK_TP);
                { const int rr = tid >> 3, cc = (tid & 7) * 16; *(u32x4*)((unsigned char*)(s0 + (size_t)c * 4096) + rr * 128 + cc) = *(const LAS u32x4*)(sc + rr * CK_TP + cc); }
                if (wave < 4) { f32x16 acc;
#pragma unroll
                    for (int g4 = 0; g4 < 4; ++g4) { acc[4 * g4] = bf2f(hc[u][g4].x & 0xffffu); acc[4 * g4 + 1] = bf2f(hc[u][g4].x >> 16); acc[4 * g4 + 2] = bf2f(hc[u][g4].y & 0xffffu); acc[4 * g4 + 3] = bf2f(hc[u][g4].y >> 16); }
#pragma unroll
                    for (int ks = 0; ks < 4; ++ks) acc = __builtin_amdgcn_mfma_f32_32x32x16_bf16(ga[u][ks], ck_frag(sc, 32 * cq + ql, ks, hh), acc, 0, 0, 0);
                    if (c + 4 < 64) { const bf16* cn = cm + (size_t)(c + 4) * (CM_ITEM / 2);
#pragma unroll
                        for (int ks = 0; ks < 4; ++ks) ga[u][ks] = *(const bf16x8*)(cn + (32 * rq + ql) * 64 + 16 * ks + 8 * hh);
#pragma unroll
                        for (int g4 = 0; g4 < 4; ++g4) hc[u][g4] = *(const u32x2*)(cn + 4096 + (32 * cq + ql) * 64 + 32 * rq + 8 * g4 + 4 * hh); }
#pragma unroll
                    for (int g4 = 0; g4 < 4; ++g4) *(LAS u32x2*)(sn + (32 * cq + ql) * CK_TP + (32 * rq + 8 * g4 + 4 * hh) * 2) = (u32x2){pk2(acc[4 * g4], acc[4 * g4 + 1]), pk2(acc[4 * g4 + 2], acc[4 * g4 + 3])}; }
                __syncthreads();
            }
        }
    }
}

struct CoIn { bf16x8 sa[4], sb[4], qf[4]; u32x2 ya[4], yb[4]; };
__device__ __forceinline__ void co_load(const PArgs& a, int wt, int ql, int hh, CoIn& o) {
    const int item = wt >> 1, th = wt & 1; const bool gdn = item >= 2048; const int it = item & 2047;
    const bf16* cm = (const bf16*)(a.ws + (gdn ? S_CMG : S_CMR) + (size_t)it * CM_ITEM); const bf16* s0 = (const bf16*)(a.ws + (gdn ? S_S0G : S_S0R)) + (size_t)it * 4096;
    const bf16* yy = cm + 12288 + (32 * th + ql) * 64 + 4 * hh;
#pragma unroll
    for (int g4 = 0; g4 < 4; ++g4) { o.ya[g4] = *(const u32x2*)(yy + 8 * g4); o.yb[g4] = *(const u32x2*)(yy + 32 + 8 * g4); }
#pragma unroll
    for (int ks = 0; ks < 4; ++ks) { o.qf[ks] = *(const bf16x8*)(cm + 8192 + (32 * th + ql) * 64 + 16 * ks + 8 * hh); o.sa[ks] = *(const bf16x8*)(s0 + ql * 64 + 16 * ks + 8 * hh); o.sb[ks] = *(const bf16x8*)(s0 + (32 + ql) * 64 + 16 * ks + 8 * hh); }
}
__device__ __forceinline__ void phase_cout(const PArgs& a, int l, LAS unsigned char* lds) {
    const int bidx_ = obid();
    const int tid = otid(), lane = tid & 63, wave = __builtin_amdgcn_readfirstlane(tid >> 6), G = ogrid(), ql = lane & 31, hh = lane >> 5;
    LAS float* plg = (LAS float*)lds; LAS float* plb = plg + 512; LAS float* png_ = plb + 512;
    __syncthreads();
    plg[tid] = INF(14)[l * 512 + tid]; plb[tid] = INF(15)[l * 512 + tid]; if (tid < 64) png_[tid] = INF(29)[l * 64 + tid];
    __syncthreads();
    CoIn in; { const int w0 = bidx_ * NWV + wave; if (w0 < 8192) co_load(a, w0, ql, hh, in); }
    for (int wt = bidx_ * NWV + wave; wt < 8192; wt += G * NWV) { const int item = wt >> 1, th = wt & 1; const bool gdn = item >= 2048; const int it = item & 2047, bh = it >> 6, ch = it & 63, b = bh >> 3, h = bh & 7;
        f32x16 y0, y1;
#pragma unroll
        for (int g4 = 0; g4 < 4; ++g4) { const u32x2 w0 = in.ya[g4], w1 = in.yb[g4];
            y0[4 * g4] = bf2f(w0.x & 0xffffu); y0[4 * g4 + 1] = bf2f(w0.x >> 16); y0[4 * g4 + 2] = bf2f(w0.y & 0xffffu); y0[4 * g4 + 3] = bf2f(w0.y >> 16);
            y1[4 * g4] = bf2f(w1.x & 0xffffu); y1[4 * g4 + 1] = bf2f(w1.x >> 16); y1[4 * g4 + 2] = bf2f(w1.y & 0xffffu); y1[4 * g4 + 3] = bf2f(w1.y >> 16); }
#pragma unroll
        for (int ks = 0; ks < 4; ++ks) { y0 = __builtin_amdgcn_mfma_f32_32x32x16_bf16(in.sa[ks], in.qf[ks], y0, 0, 0, 0); y1 = __builtin_amdgcn_mfma_f32_32x32x16_bf16(in.sb[ks], in.qf[ks], y1, 0, 0, 0); }
        if (wt + G * NWV < 8192) co_load(a, wt + G * NWV, ql, hh, in);
        const size_t tok = (size_t)b * SEQ + ch * 64 + 32 * th + ql; const size_t base = tok * HW + h * 64 + 4 * hh;
        u32x2 pv_[8], pg_[8]; float bsc = 0.f;
        if (!gdn) { const bf16* RV = (const bf16*)(a.ws + S_RV) + base; const bf16* RG = (const bf16*)(a.ws + S_RG) + base; bsc = ((const float*)(a.ws + WS_CTL + C_BSC))[tok * 8 + h];
#pragma unroll
            for (int q = 0; q < 8; ++q) { const int co = 32 * (q >> 2) + 8 * (q & 3); pv_[q] = *(const u32x2*)(RV + co); pg_[q] = *(const u32x2*)(RG + co); } }
        else { const bf16* ZG = (const bf16*)(a.ws + S_ZG) + base;
#pragma unroll
            for (int q = 0; q < 8; ++q) { const int co = 32 * (q >> 2) + 8 * (q & 3); pg_[q] = *(const u32x2*)(ZG + co); } }
        float s1 = 0.f;
#pragma unroll
        for (int r = 0; r < 16; ++r) s1 += y0[r] + y1[r];
        if (!gdn) { s1 += __shfl_xor(s1, 32); const float mean = s1 * (1.f / 64.f); float s2 = 0.f;
#pragma unroll
            for (int r = 0; r < 16; ++r) { const float d0 = y0[r] - mean, d1 = y1[r] - mean; s2 += d0 * d0 + d1 * d1; }
            s2 += __shfl_xor(s2, 32); const float rstd = rsqrtf(s2 * (1.f / 64.f) + 64e-5f);
            bf16* OA = (bf16*)(a.ws + S_OA) + base;
#pragma unroll
            for (int q = 0; q < 8; ++q) { const int half = q >> 2, g4 = q & 3, co = 32 * half + 8 * g4; const u32x2 vw = pv_[q], gw = pg_[q]; const f32x4 lg = *(const LAS f32x4*)(plg + h * 64 + 4 * hh + co), lb = *(const LAS f32x4*)(plb + h * 64 + 4 * hh + co);
                const float vv[4] = {bf2f(vw.x & 0xffffu), bf2f(vw.x >> 16), bf2f(vw.y & 0xffffu), bf2f(vw.y >> 16)}, gg[4] = {bf2f(gw.x & 0xffffu), bf2f(gw.x >> 16), bf2f(gw.y & 0xffffu), bf2f(gw.y >> 16)}; float o[4];
#pragma unroll
                for (int e = 0; e < 4; ++e) { const float yv = half ? y1[4 * g4 + e] : y0[4 * g4 + e]; o[e] = ((yv - mean) * rstd * lg[e] + lb[e] + bsc * vv[e]) * gg[e]; }
                *(u32x2*)(OA + co) = (u32x2){pk2(o[0], o[1]), pk2(o[2], o[3])}; asm volatile("" ::: "memory"); } }
        else { float s2 = 0.f;
#pragma unroll
            for (int r = 0; r < 16; ++r) s2 += y0[r] * y0[r] + y1[r] * y1[r];
            s2 += __shfl_xor(s2, 32); const float rstd = rsqrtf(s2 * (1.f / 64.f) + NORM_EPS);
            bf16* OC = (bf16*)(a.ws + S_OC) + base;
#pragma unroll
            for (int q = 0; q < 8; ++q) { const int half = q >> 2, g4 = q & 3, co = 32 * half + 8 * g4; const u32x2 gw = pg_[q]; const f32x4 ng = *(const LAS f32x4*)(png_ + 4 * hh + co);
                const float gg[4] = {bf2f(gw.x & 0xffffu), bf2f(gw.x >> 16), bf2f(gw.y & 0xffffu), bf2f(gw.y >> 16)}; float o[4];
#pragma unroll
                for (int e = 0; e < 4; ++e) { const float yv = half ? y1[4 * g4 + e] : y0[4 * g4 + e]; o[e] = yv * rstd * ng[e] * siluf_(gg[e]); }
                *(u32x2*)(OC + co) = (u32x2){pk2(o[0], o[1]), pk2(o[2], o[3])}; asm volatile("" ::: "memory"); } }
    }
}
__device__ __forceinline__ void phase_router(const PArgs& a, LAS unsigned char* lds) {
    const int bidx_ = obid();
    const int tid = otid(), lane = tid & 63, wave = __builtin_amdgcn_readfirstlane(tid >> 6), G = ogrid();
    const int gw = bidx_ * NWV + wave, NGW = G * NWV;
    const float* gf = INF(34) + D; const float* wr = INF(38);
    int* sel = (int*)(a.ws + WS_CTL + C_SEL); float* wts = (float*)(a.ws + WS_CTL + C_WTS); int* rank = (int*)(a.ws + WS_CTL + C_RANK); float* rs1 = (float*)(a.ws + WS_CTL + C_RS1);
    unsigned* cnt = (unsigned*)(a.ws + WS_CTL + C_MOE);
    LAS float* wl = (LAS float*)lds;
    __syncthreads();
    for (int k = tid; k < D; k += NTH) { const float g = gf[k]; const f32x4 w0 = *(const f32x4*)(wr + (size_t)k * 8), w1 = *(const f32x4*)(wr + (size_t)k * 8 + 4);
        wl[0 * D + k] = w0[0] * g; wl[1 * D + k] = w0[1] * g; wl[2 * D + k] = w0[2] * g; wl[3 * D + k] = w0[3] * g; wl[4 * D + k] = w1[0] * g; wl[5 * D + k] = w1[1] * g; wl[6 * D + k] = w1[2] * g; wl[7 * D + k] = w1[3] * g; }
    __syncthreads();
    LAS unsigned* lcnt = (LAS unsigned*)(lds + 32768); LAS unsigned* gbase = lcnt + 8;
    for (int b0 = bidx_ * NWV; b0 < T / 8; b0 += G * NWV) { const int bi = b0 + wave; const bool act = bi < T / 8; int my_e0 = -1, my_e1 = -1;
        if (tid < 8) lcnt[tid] = 0u;
        if (act) {
        u32x2 xn[4]; const bf16* hbp = (const bf16*)(a.ws + WS_HB);
        { const u32x2* hr = (const u32x2*)(hbp + (size_t)(bi * 8) * D) + lane;
#pragma unroll
          for (int q = 0; q < 4; ++q) xn[q] = hr[64 * q]; }
        for (int i = 0; i < 8; ++i) { const int t = bi * 8 + i;
            f32x4 x[4];
#pragma unroll
            for (int q = 0; q < 4; ++q) x[q] = (f32x4){bf2f(xn[q].x & 0xffffu), bf2f(xn[q].x >> 16), bf2f(xn[q].y & 0xffffu), bf2f(xn[q].y >> 16)};
            if (i + 1 < 8) { const u32x2* hr = (const u32x2*)(hbp + (size_t)(t + 1) * D) + lane;
#pragma unroll
                for (int q = 0; q < 4; ++q) xn[q] = hr[64 * q]; }
            float ssq = 0.f; float lg[8];
#pragma unroll
            for (int e = 0; e < 8; ++e) lg[e] = 0.f;
#pragma unroll
            for (int q = 0; q < 4; ++q) { ssq += (x[q][0] * x[q][0] + x[q][1] * x[q][1]) + (x[q][2] * x[q][2] + x[q][3] * x[q][3]);
#pragma unroll
                for (int e = 0; e < 8; ++e) { const f32x4 w = *(const LAS f32x4*)(wl + e * D + (lane + 64 * q) * 4); lg[e] += (x[q][0] * w[0] + x[q][1] * w[1]) + (x[q][2] * w[2] + x[q][3] * w[3]); } }
            ssq = wave_sum(ssq); const float rs = rsqrtf(ssq * (1.f / D) + NORM_EPS);
#pragma unroll
            for (int e = 0; e < 8; ++e) lg[e] = wave_sum(lg[e]) * rs;
            int e0 = 0; float l0 = lg[0];
#pragma unroll
            for (int e = 1; e < 8; ++e) if (lg[e] > l0) { l0 = lg[e]; e0 = e; }
            int e1 = -1; float l1 = -3.4e38f;
#pragma unroll
            for (int e = 0; e < 8; ++e) if (e != e0 && lg[e] > l1) { l1 = lg[e]; e1 = e; }
            const float wa = 1.f / (1.f + __expf(l1 - l0));
            if (lane == i) { my_e0 = e0; my_e1 = e1; sel[t * 2] = e0; sel[t * 2 + 1] = e1; wts[t * 2] = wa; wts[t * 2 + 1] = 1.f - wa; rs1[t] = rs; } } }
        __syncthreads();
        unsigned woff[2][8];
#pragma unroll
        for (int s = 0; s < 2; ++s) { const int me = s ? my_e1 : my_e0;
#pragma unroll
            for (int e = 0; e < 8; ++e) { const unsigned long long m = __ballot(me == e); const int n = __popcll(m); unsigned o = 0;
                if (n != 0 && lane == 0) o = __hip_atomic_fetch_add(lcnt + e, (unsigned)n, __ATOMIC_RELAXED, __HIP_MEMORY_SCOPE_WORKGROUP);
                woff[s][e] = __builtin_amdgcn_readfirstlane(o); } }
        __syncthreads();
        if (tid < 8) gbase[tid] = atomicAdd(cnt + tid, lcnt[tid]);
        __syncthreads();
        if (act && lane < 8) {
#pragma unroll
            for (int s = 0; s < 2; ++s) { const int me = s ? my_e1 : my_e0; unsigned r = 0;
#pragma unroll
                for (int e = 0; e < 8; ++e) { const unsigned long long m = __ballot(me == e); if (me == e) r = gbase[e] + woff[s][e] + (unsigned)__popcll(m & ((1ull << lane) - 1ull)); }
                rank[(bi * 8 + lane) * 2 + s] = (int)r; } }
        __syncthreads();
    }
    __syncthreads();
}
__device__ __forceinline__ void phase_assign(const PArgs& a) {
    const int bidx_ = obid();
    const int tid = otid(), lane = tid & 63, wave = __builtin_amdgcn_readfirstlane(tid >> 6), G = ogrid();
    const int gw = bidx_ * NWV + wave, NGW = G * NWV;
    const unsigned* cnt = (const unsigned*)(a.ws + WS_CTL + C_MOE);
    const int* sel = (const int*)(a.ws + WS_CTL + C_SEL); const int* rank = (const int*)(a.ws + WS_CTL + C_RANK); const float* rs1 = (const float*)(a.ws + WS_CTL + C_RS1);
    int* dest = (int*)(a.ws + WS_CTL + C_DEST); float* rsx = (float*)(a.ws + WS_CTL + C_RSX); int* blke = (int*)(a.ws + WS_CTL + C_BLKE);
    const bf16* hb = (const bf16*)(a.ws + WS_HB); bf16* xg = (bf16*)(a.ws + S_XG);
    int pstart[9]; pstart[0] = 0;
#pragma unroll
    for (int e = 0; e < 8; ++e) pstart[e + 1] = pstart[e] + (int)((cnt[e] + 255u) / 256u) * 256;
    if (bidx_ == 0 && tid < NBLK_MAX + 1) { if (tid == NBLK_MAX) blke[NBLK_MAX] = pstart[8] / 256; else { int e = 0;
#pragma unroll
            for (int q = 1; q < 8; ++q) if (tid * 256 >= pstart[q]) e = q;
            blke[tid] = e; } }
    u32x4 nr0 = (u32x4){0u, 0u, 0u, 0u}, nr1 = nr0; int ne = 0, nrk = 0; float nrs = 0.f;
#define AS_LOAD(aa) do { const int as_ = (aa), t_ = as_ >> 1; ne = sel[as_]; nrk = rank[as_]; nrs = rs1[t_]; const u32x4* src_ = (const u32x4*)(hb + (size_t)t_ * D); nr0 = src_[lane]; nr1 = src_[lane + 64]; } while (0)
    if (gw < T * 2) AS_LOAD(gw);
    for (int as = gw; as < T * 2; as += NGW) { const int e = ne, rk = nrk; const float rsv = nrs; const u32x4 r0 = nr0, r1 = nr1;
        if (as + NGW < T * 2) AS_LOAD(as + NGW);
        int ps = 0;
#pragma unroll
        for (int q = 0; q < 8; ++q) if (e == q) ps = pstart[q];
        const int d = ps + rk;
        if (lane == 0) { dest[as] = d; rsx[d] = rsv; }
        u32x4* dst = (u32x4*)(xg + (size_t)d * D);
        dst[lane] = r0; dst[lane + 64] = r1; }
#undef AS_LOAD
}
__device__ __forceinline__ void phase_combine(const PArgs& a) {
    const int bidx_ = obid();
    const int tid = otid(), lane = tid & 63, wave = __builtin_amdgcn_readfirstlane(tid >> 6), G = ogrid();
    const int gw = bidx_ * NWV + wave, NGW = G * NWV;
    const int* dest = (const int*)(a.ws + WS_CTL + C_DEST); const float* wts = (const float*)(a.ws + WS_CTL + C_WTS);
    const bf16* y = (const bf16*)(a.ws + S_XG); bf16* hb = (bf16*)(a.ws + WS_HB);
    u32x2 nh[4], na[4], nb[4]; float nw0 = 0.f, nw1 = 0.f;
#define CB_LOAD(tt) do { const int t_ = (tt); const int d0_ = dest[t_ * 2], d1_ = dest[t_ * 2 + 1]; nw0 = wts[t_ * 2]; nw1 = wts[t_ * 2 + 1]; \
        const u32x2* hr_ = (const u32x2*)(hb + (size_t)t_ * D); const u32x2* y0_ = (const u32x2*)(y + (size_t)d0_ * D); const u32x2* y1_ = (const u32x2*)(y + (size_t)d1_ * D); \
        _Pragma("unroll") for (int q = 0; q < 4; ++q) { nh[q] = hr_[lane + 64 * q]; na[q] = y0_[lane + 64 * q]; nb[q] = y1_[lane + 64 * q]; } } while (0)
    if (gw < T) CB_LOAD(gw);
    for (int t = gw; t < T; t += NGW) { u32x2 ch[4], ca[4], cb2[4]; const float w0 = nw0, w1 = nw1;
#pragma unroll
        for (int q = 0; q < 4; ++q) { ch[q] = nh[q]; ca[q] = na[q]; cb2[q] = nb[q]; }
        if (t + NGW < T) CB_LOAD(t + NGW);
        u32x2* hbr = (u32x2*)(hb + (size_t)t * D);
#pragma unroll
        for (int q = 0; q < 4; ++q) { const int ix = lane + 64 * q; const u32x2 hw = ch[q], a0 = ca[q], a1 = cb2[q];
            const float h0 = bf2f(hw.x & 0xffffu) + w0 * bf2f(a0.x & 0xffffu) + w1 * bf2f(a1.x & 0xffffu), h1 = bf2f(hw.x >> 16) + w0 * bf2f(a0.x >> 16) + w1 * bf2f(a1.x >> 16);
            const float h2 = bf2f(hw.y & 0xffffu) + w0 * bf2f(a0.y & 0xffffu) + w1 * bf2f(a1.y & 0xffffu), h3 = bf2f(hw.y >> 16) + w0 * bf2f(a0.y >> 16) + w1 * bf2f(a1.y >> 16);
            u32x2 w; w.x = pk2(h0, h1); w.y = pk2(h2, h3); hbr[ix] = w; } }
#undef CB_LOAD
}
#ifndef PROBE_X
#define PROBE_X 0
#endif
#ifndef MK_ONE_LAUNCH
#define MK_ONE_LAUNCH 1
#endif
#define XB_TMO      128
#define XB_XCNT(j)  (256  + 64 * (j))
#define XB_XSUB(j)  (1280 + 64 * (j))
#define XB_XGEN(j)  (2304 + 64 * (j))
#define XB_TOP      3328
#define XB_TOPGEN   3392
#define XCD_BAR_WORDS 3456
#define XB_SPIN_CAP (1u << 22)
__device__ __forceinline__ unsigned xb_ld(unsigned* p)              { return __hip_atomic_load(p, __ATOMIC_RELAXED, __HIP_MEMORY_SCOPE_AGENT); }
__device__ __forceinline__ unsigned xb_add(unsigned* p, unsigned v) { return __hip_atomic_fetch_add(p, v, __ATOMIC_RELAXED, __HIP_MEMORY_SCOPE_AGENT); }
__device__ __forceinline__ unsigned xb_xcc_id() { return (unsigned)__builtin_amdgcn_s_getreg((3 << 11) | 20) & 0xFu; }
#define XB_SPIN(cond, bar) do { unsigned _sp = 0; while (cond) { __builtin_amdgcn_s_sleep(1); \
    if ((++_sp & 255u) == 0u) { if (xb_ld(&(bar)[XB_TMO])) break; if (_sp > XB_SPIN_CAP) { atomicAdd(&(bar)[XB_TMO], 1u); break; } } } } while (0)
struct XcdBarrier { unsigned* bar; unsigned x; volatile LAS unsigned* st; };
__device__ __forceinline__ XcdBarrier xcd_barrier_post(unsigned* bar, volatile LAS unsigned* st) {
    XcdBarrier b; b.bar = bar; b.x = xb_xcc_id(); b.st = st;
    if (threadIdx.x == 0) (void)xb_add(&bar[XB_XCNT(b.x)], 1u);
    return b;
}
__device__ __forceinline__ void xcd_barrier_complete(unsigned* bar, unsigned x, unsigned& nloc, unsigned& nx) {
    const unsigned G = gridDim.x * gridDim.y * gridDim.z;
    unsigned sum, cnt, mine, sp = 0u;
    for (;;) {
        sum = 0u; cnt = 0u; mine = 0u;
#pragma unroll
        for (unsigned j = 0; j < 16; ++j) { const unsigned c = xb_ld(&bar[XB_XCNT(j)]); sum += c; cnt += (c > 0u) ? 1u : 0u; mine = (j == x) ? c : mine; }
        if (sum == G) break;
        __builtin_amdgcn_s_sleep(1);
        if ((++sp & 255u) == 0u) { if (xb_ld(&bar[XB_TMO])) break; if (sp > XB_SPIN_CAP) { atomicAdd(&bar[XB_TMO], 1u); break; } }
    }
    nloc = mine > 0u ? mine : 1u; nx = cnt > 0u ? cnt : 1u;
}
__device__ __forceinline__ void xcd_barrier(const XcdBarrier& b_) {
    asm volatile("s_waitcnt vmcnt(0)" ::: "memory");
    __syncthreads();
    if (otid() == 0) {
        XcdBarrier b = b_; asm volatile("" : "+s"(b.bar)); b.x = xb_xcc_id();
        unsigned* bar = b.bar;
        __builtin_amdgcn_s_waitcnt(0);
        unsigned nloc = b.st[0], nx = b.st[1];
        if (nloc == 0u) { xcd_barrier_complete(bar, b.x, nloc, nx); b.st[0] = nloc; b.st[1] = nx; }
        const unsigned old = xb_add(&bar[XB_XSUB(b.x)], 1u);
        const unsigned gen = old / nloc;
        if (old + 1u == (gen + 1u) * nloc) {
            __builtin_amdgcn_fence(__ATOMIC_RELEASE, "agent");
            asm volatile("s_waitcnt vmcnt(0)" ::: "memory");
            const unsigned og = xb_add(&bar[XB_TOP], 1u);
            const unsigned tg = og / nx;
            if (og + 1u == (tg + 1u) * nx) xb_add(&bar[XB_TOPGEN], 1u);
            else XB_SPIN(xb_ld(&bar[XB_TOPGEN]) == tg, bar);
            __builtin_amdgcn_fence(__ATOMIC_ACQUIRE, "agent");
            xb_add(&bar[XB_XGEN(b.x)], 1u);
            asm volatile("s_waitcnt vmcnt(0)" ::: "memory");
        } else {
            XB_SPIN(xb_ld(&bar[XB_XGEN(b.x)]) == gen, bar);
            __builtin_amdgcn_fence(__ATOMIC_ACQUIRE, "agent");
            asm volatile("s_waitcnt vmcnt(0)" ::: "memory");
        }
    }
    __syncthreads();
}

enum PhaseKind { PK_PRO = 0, PK_G1A, PK_PRE, PK_G23, PK_MLAPOST, PK_ATT, PK_RGPREP, PK_SCAN, PK_FIN, PK_G1B, PK_MRG, PK_OUT, PK_FGU, PK_FD, PK_MOEA, PK_MOEB, PK_MGU0, PK_MD0, PK_MGU1, PK_MD1, PK_COMB, PK_PP, PK_PG, PK_COUT };
struct PhaseEnt { int kind, layer; };
__constant__ PhaseEnt g_prog[] = {
    {PK_PRO, 0},
    {PK_G1A, 0}, {PK_PRE, 0}, {PK_G23, 0}, {PK_MLAPOST, 0}, {PK_ATT, 0}, {PK_RGPREP, 0}, {PK_SCAN, 0}, {PK_FIN, 0}, {PK_COUT, 0}, {PK_G1B, 0}, {PK_MRG, 0}, {PK_OUT, 0}, {PK_FGU, 0}, {PK_FD, 0}, {PK_PP, 0}, {PK_PG, 0},
    {PK_G1A, 1}, {PK_PRE, 1}, {PK_G23, 1}, {PK_MLAPOST, 1}, {PK_ATT, 1}, {PK_RGPREP, 1}, {PK_SCAN, 1}, {PK_FIN, 1}, {PK_COUT, 1}, {PK_G1B, 1}, {PK_MRG, 1}, {PK_OUT, 1},
    {PK_MOEA, 1}, {PK_MOEB, 1}, {PK_MGU0, 1}, {PK_MD0, 1}, {PK_MGU1, 1}, {PK_MD1, 1}, {PK_COMB, 1}, {PK_PP, 1}, {PK_PG, 1},
};
constexpr int NPHASE = sizeof(g_prog) / sizeof(PhaseEnt);

constexpr int LDS_BYTES = 163840;
constexpr int LDS_MISC = 163840 - 1024;

#define RUN_PP_SLACK(nwg_main) do { const int nx_ = (nwg_main) % G; const bool sub_ = nx_ > 0 && G - nx_ >= G / 2; \
        if (!sub_ || c >= nx_) { pg8::Gemm g{(const bf16*)(ws + WS_PB) + (size_t)l * T * PLE, Wp + W_PP / 2, PLE, PLE, PLE}; pg8::StaticOrder S; S.init(T / 256, D / 256, sub_ ? G - nx_ : G, sub_ ? c - nx_ : c); \
            EpiPleProj E{(bf16*)(ws + S_E), SSE}; pg8::gemm_phase(lds, g, S, E); } } while (0)
template <int KINDT> __device__ __forceinline__ void run_phase(const Args& a_, int kind_rt, int l, LAS unsigned char* lds) {
    const int kind = KINDT >= 0 ? KINDT : kind_rt; const PArgs a = make_pargs(a_);
    const int G = ogrid(), c = obid();
    unsigned char* ws = a.ws;
    const bf16* Wl = (const bf16*)(ws + WS_W + (size_t)l * WL);
    float* SS0 = (float*)(ws + S_SSP0); float* SS1 = (float*)(ws + S_SSP1); float* SSE = (float*)(ws + S_SSP2);
    bf16* HB = (bf16*)(ws + WS_HB); const bf16* HBin = (const bf16*)(ws + (l == 0 ? WS_HB : WS_HB2));
    const bf16* Wp = (const bf16*)(ws + WS_W + W_PLE + (size_t)l * WPL);
    switch (kind) {
    case PK_PRO: phase_prologue(a, lds); break;
    case PK_G1A: { pg8::Gemm g{HBin, Wl + W_IN / 2, D, D, D}; pg8::StaticOrder S; S.init(T / 256, N1 / 256 + G1A_GT, G, c);
        EpiInProj E{(bf16*)(ws + S_ZR), (bf16*)(ws + S_ZQ), (bf16*)(ws + S_ZG), (bf16*)(ws + S_ZM), SS0, (bf16*)a.out, (bf16*)(ws + S_ZSH)}; pg8::gemm_phase(lds, g, S, E); } break;
    case PK_PRE: phase_pre(a, l); break;
    case PK_G23: {
        const bf16* ZMp = (const bf16*)(ws + S_ZM); const bf16* A2p = (const bf16*)(ws + S_A2); const bf16* W2p = Wl + W_2 / 2; const bf16* W3p = Wl + W_3 / 2;
        const float* rsq = (const float*)(ws + WS_CTL + C_RSQ); const float* rskv = (const float*)(ws + WS_CTL + C_RSKV);
        { pg8::Gemm g{ZMp, W2p, 256, NZM, K2}; pg8::StaticOrder S; S.init(T / 256, 3, G, G == 256 ? (c + 192) & 255 : c); EpiMla E{(bf16*)(ws + S_QRAW), (bf16*)(ws + S_KVRAW), rsq, rskv, 0}; pg8::gemm_phase(lds, g, S, E); }
        { pg8::Gemm g{ZMp + 256, W2p + (size_t)768 * K2 + 256, 128, NZM, K2}; pg8::StaticOrder S; S.init(T / 256, 4, G, c); EpiMla E{(bf16*)(ws + S_QRAW), (bf16*)(ws + S_KVRAW), rsq, rskv, 3}; pg8::gemm_phase(lds, g, S, E); }
        { pg8::Gemm g{A2p, W3p, 128, K3, K3}; pg8::StaticOrder S; S.init(T / 256, 4, G, c); EpiPlain E{(bf16*)(ws + S_L2), N3, 0}; pg8::gemm_phase(lds, g, S, E); }
        { pg8::Gemm g{A2p + 128, W3p + (size_t)1024 * K3 + 128, 128, K3, K3}; pg8::StaticOrder S; S.init(T / 256, 2, G, c); EpiPlain E{(bf16*)(ws + S_RG), HW, 0}; pg8::gemm_phase(lds, g, S, E); }
        if (l > 0) { pg8::Gemm g{A2p + 256, W3p + (size_t)1536 * K3 + 256, 128, K3, K3}; pg8::StaticOrder S; S.init(T / 256, 2, G, G == 256 ? (c + 128) & 255 : c); EpiPlain E{(bf16*)(ws + S_L2), N3, 1536}; pg8::gemm_phase(lds, g, S, E); }
        } break;
    case PK_MLAPOST: phase_mla_post(a, l, lds); break;
    case PK_ATT: phase_attn<0>(a, lds);
#if PROBE_X >= 10
        phase_attn<PROBE_X - 10>(a, lds);
#endif
        break;
    case PK_RGPREP: phase_rwkv_post(a, l); phase_gdn_prep(a, l); break;
    case PK_SCAN: phase_cprep(a, lds); break;
    case PK_FIN: {
        const bool split = G >= 128; const int NSC = 64;
        if (!split || c < NSC) phase_cscan(a, lds);
        if (!split || c >= NSC) { if (!split) __syncthreads();
            pg8::Gemm g{HBin, Wl + W_GATE / 2 + (size_t)G1A_GT * 256 * D, D, D, D}; pg8::StaticOrder S; S.init(T / 256, NGATE / 256 - G1A_GT, split ? G - NSC : G, split ? c - NSC : c);
            EpiGate E{(bf16*)a.out, (bf16*)(ws + S_ZSH), SS0, G1A_GT}; pg8::gemm_phase(lds, g, S, E); } } break;
    case PK_COUT: phase_cout(a, l, lds); break;
    case PK_G1B: break;
    case PK_MRG: { pg8::StaticOrder S; S.init(T / 256, D / 256, G, c);
        { pg8::Gemm g{(const bf16*)(ws + S_OA), Wl + W_BRA / 2, HW, HW, HW}; EpiMerge<true> E{(bf16*)(ws + S_M), (bf16*)a.out, (bf16*)(ws + S_ZSH), 0}; pg8::gemm_phase(lds, g, S, E); }
        { pg8::Gemm g{(const bf16*)(ws + S_OB), Wl + W_BRB / 2, HW, HW, HW}; EpiMerge<false> E{(bf16*)(ws + S_M), (bf16*)a.out, (bf16*)(ws + S_ZSH), 1}; pg8::gemm_phase(lds, g, S, E); }
        { pg8::Gemm g{(const bf16*)(ws + S_OC), Wl + W_BRC / 2, HW, HW, HW}; EpiMerge<false> E{(bf16*)(ws + S_M), (bf16*)a.out, (bf16*)(ws + S_ZSH), 2}; pg8::gemm_phase(lds, g, S, E); } } break;
    case PK_OUT: { pg8::Gemm g{(const bf16*)(ws + S_M), Wl + W_OUT / 2, D, D, D}; pg8::StaticOrder S; S.init(T / 256, D / 256, G, c);
#if PROBE_X == 1
        { EpiPlain E2{(bf16*)(ws + S_ZR), D, 0}; pg8::gemm_phase(lds, g, S, E2); }
#endif
        EpiResid E{l == 0 ? INF(0) : nullptr, HBin, HB, SS1}; pg8::gemm_phase(lds, g, S, E); } break;
    case PK_FGU: { pg8::Gemm g{HB, (const bf16*)(ws + WS_W + W_FGU), D, D, D}; pg8::StaticOrder S; S.init(T / 256, 2 * FFD / 256, G, c);
        EpiSwiglu<false> E{(bf16*)(ws + S_ACT), FFD, SS1}; pg8::gemm_phase(lds, g, S, E); }
        RUN_PP_SLACK((T / 256) * (2 * FFD / 256)); break;
    case PK_FD: { pg8::Gemm g{(const bf16*)(ws + S_ACT), (const bf16*)(ws + WS_W + W_FD), FFD, FFD, FFD}; pg8::StaticOrder S; S.init(T / 256, D / 256, G, c);
#if PROBE_X == 2
        { EpiPlain E2{(bf16*)(ws + WS_S + 100 * MiB), D, 0}; pg8::gemm_phase(lds, g, S, E2); }
#endif
        EpiResid E{nullptr, HB, HB, nullptr}; pg8::gemm_phase(lds, g, S, E); } break;
    case PK_MOEA: {
#if PROBE_SUB
        __syncthreads(); const unsigned long long ts0 = __builtin_amdgcn_s_memrealtime();
#endif
        phase_moe_cvt(a, lds);
#if PROBE_SUB
        __syncthreads(); const unsigned long long ts1 = __builtin_amdgcn_s_memrealtime();
#endif
        phase_router(a, lds);
#if PROBE_SUB
        __syncthreads(); const unsigned long long ts2 = __builtin_amdgcn_s_memrealtime();
        if (threadIdx.x == 0) ((volatile LAS unsigned*)(lds + LDS_MISC))[32] = (unsigned)((PROBE_SUB == 1) ? (ts1 - ts0) : (ts2 - ts1));
#endif
        } break;
    case PK_MOEB: phase_assign(a); break;
    case PK_MGU0: case PK_MGU1: { const int half = (kind == PK_MGU1); const int* blke = (const int*)(ws + WS_CTL + C_BLKE); const int nblk = __builtin_amdgcn_readfirstlane(blke[NBLK_MAX]);
        const int lo = half * HALF_BLK, hi = half ? nblk : (nblk < HALF_BLK ? nblk : HALF_BLK), nM = hi > lo ? hi - lo : 0;
        pg8::Gemm g{(const bf16*)(ws + S_XG), (const bf16*)(ws + S_MWGU), D, D, D}; pg8::StaticOrder S; S.init(nM, 2 * FFE / 256, G, c, lo, blke);
        EpiSwiglu<true> E{(bf16*)(ws + S_MACT) - (size_t)lo * 256 * FFE, FFE, (const float*)(ws + WS_CTL + C_RSX)}; pg8::gemm_phase(lds, g, S, E);
        if (half) RUN_PP_SLACK(nM * (2 * FFE / 256)); } break;
    case PK_MD0: case PK_MD1: { const int half = (kind == PK_MD1); const int* blke = (const int*)(ws + WS_CTL + C_BLKE); const int nblk = __builtin_amdgcn_readfirstlane(blke[NBLK_MAX]);
        const int lo = half * HALF_BLK, hi = half ? nblk : (nblk < HALF_BLK ? nblk : HALF_BLK), nM = hi > lo ? hi - lo : 0;
        pg8::Gemm g{(const bf16*)(ws + S_MACT) - (size_t)lo * 256 * FFE, (const bf16*)(ws + S_MWD), FFE, FFE, FFE}; pg8::StaticOrder S; S.init(nM, D / 256, G, c, lo, blke);
        EpiPlain E{(bf16*)(ws + S_XG), D, 0}; pg8::gemm_phase(lds, g, S, E); } break;
    case PK_COMB: phase_combine(a); break;
    case PK_PP: break;
    case PK_PG: { pg8::Gemm g{HB, Wp + W_PG / 2, D, D, D}; pg8::StaticOrder S; S.init(T / 256, D / 256, G, c);
#if PROBE_X == 3
        { EpiPlain E2{(bf16*)(ws + WS_S + 100 * MiB), D, 0}; pg8::gemm_phase(lds, g, S, E2); }
#endif
        EpiPleGate E{l + 1 < NL ? nullptr : a.out, HB, l + 1 < NL ? (bf16*)(ws + WS_HB2) : nullptr, (const bf16*)(ws + S_E), SSE, INF(44) + l * D, l + 1 < NL ? SS0 : nullptr}; pg8::gemm_phase(lds, g, S, E); } break;
    default: break;
    }
}

template <int KINDT> __global__ void __launch_bounds__(NTH, 2) k_one(Args a, int l) {
    extern __shared__ __attribute__((aligned(16))) unsigned char lds_raw[];
    run_phase<KINDT>(a, KINDT, l, (LAS unsigned char*)lds_raw);
}
#if MK_ONE_LAUNCH
__global__ void __launch_bounds__(NTH, 2) k_fwd(Args a) {
    extern __shared__ __attribute__((aligned(16))) unsigned char lds_raw[];
    LAS unsigned char* lds = (LAS unsigned char*)lds_raw;
    volatile LAS unsigned* misc = (volatile LAS unsigned*)(lds + LDS_MISC);
    if (threadIdx.x < 64) misc[threadIdx.x] = 0u;
    __syncthreads();
    const XcdBarrier bar = xcd_barrier_post((unsigned*)(a.ws + WS_CTL + C_BAR), misc + 8);
#ifndef PROBE_MASK
#define PROBE_MASK 0u
#endif
#define BAR() xcd_barrier(bar)
#ifndef PROBE_T
#define PROBE_T 0u
#endif
#ifndef PROBE_TDIV
#define PROBE_TDIV 1000
#endif
#define RUN(K, l) do { if ((PROBE_MASK >> K) & 1u) { run_phase<K>(a, K, l, lds); BAR(); } \
    unsigned long long t0_ = 0; if ((PROBE_T >> K) & 1u) { BAR(); t0_ = __builtin_amdgcn_s_memrealtime(); } run_phase<K>(a, K, l, lds); if ((PROBE_T >> K) & 1u) { BAR(); tacc_ += __builtin_amdgcn_s_memrealtime() - t0_; } } while (0)
#ifdef PROBE_BARS
    for (int q = 0; q < PROBE_BARS; ++q) BAR();
#endif
    unsigned long long tacc_ = 0;
    RUN(PK_PRO, 0); BAR();
#define MIXER(l) RUN(PK_G1A, l); BAR(); RUN(PK_PRE, l); BAR(); RUN(PK_G23, l); BAR(); RUN(PK_MLAPOST, l); BAR(); RUN(PK_ATT, l); BAR(); RUN(PK_RGPREP, l); BAR(); \
        RUN(PK_SCAN, l); BAR(); RUN(PK_FIN, l); BAR(); RUN(PK_COUT, l); BAR(); RUN(PK_MRG, l); BAR(); RUN(PK_OUT, l); BAR();
    MIXER(0)
    RUN(PK_FGU, 0); BAR(); RUN(PK_FD, 0); BAR();
    RUN(PK_PG, 0); BAR();
    MIXER(1)
    RUN(PK_MOEA, 1); BAR(); RUN(PK_MOEB, 1); BAR(); RUN(PK_MGU0, 1); BAR(); RUN(PK_MD0, 1); BAR(); RUN(PK_MGU1, 1); BAR(); RUN(PK_MD1, 1); BAR(); RUN(PK_COMB, 1); BAR();
    RUN(PK_PG, 1);
#undef MIXER
    if (PROBE_T != 0u) { BAR(); if (blockIdx.x == 0 && threadIdx.x == 0) a.out[0] = (float)(tacc_ / PROBE_TDIV); }
#if PROBE_SUB
    BAR(); if (blockIdx.x == 0 && threadIdx.x == 0) a.out[0] = (float)(misc[PROBE_SUB >= 10 ? 40 : 32] / PROBE_TDIV);
#endif
#undef RUN
#undef BAR
}
#endif

#ifndef MK_ONE_LAUNCH
#define MK_ONE_LAUNCH 1
#endif
extern "C" void kernel_launch(void* const* d_in, const int* in_sizes, int n_in, void* d_out, int out_size, void* d_ws, size_t ws_size, hipStream_t stream) {
    static int grid = 0;
    if (grid == 0) {
        if (n_in != 45 || out_size != T * D || ws_size < WS_END) { fprintf(stderr, "kernel_launch: unexpected shapes: n_in %d out %d ws %zu (need %zu)\n", n_in, out_size, ws_size, (size_t)WS_END); grid = -1; return; }
        int dev = 0, cus = 0;
        if (hipGetDevice(&dev) != hipSuccess || hipDeviceGetAttribute(&cus, hipDeviceAttributeMultiprocessorCount, dev) != hipSuccess) { grid = -1; return; }
#if MK_ONE_LAUNCH
        if (hipFuncSetAttribute((const void*)k_fwd, hipFuncAttributeMaxDynamicSharedMemorySize, LDS_BYTES) != hipSuccess) { fprintf(stderr, "kernel_launch: hipFuncSetAttribute failed\n"); grid = -1; return; }
#else
#define SA(K) (void)hipFuncSetAttribute((const void*)k_one<K>, hipFuncAttributeMaxDynamicSharedMemorySize, LDS_BYTES);
        SA(PK_PRO) SA(PK_G1A) SA(PK_PRE) SA(PK_G23) SA(PK_MLAPOST) SA(PK_ATT) SA(PK_RGPREP) SA(PK_SCAN) SA(PK_FIN) SA(PK_G1B) SA(PK_MRG) SA(PK_OUT) SA(PK_FGU) SA(PK_FD) SA(PK_MOEA) SA(PK_MOEB) SA(PK_MGU0) SA(PK_MD0) SA(PK_MGU1) SA(PK_MD1) SA(PK_COMB) SA(PK_PP) SA(PK_PG) SA(PK_COUT)
#undef SA
#endif
        int per_cu = 0;
#if MK_ONE_LAUNCH
        if (hipOccupancyMaxActiveBlocksPerMultiprocessor(&per_cu, (const void*)k_fwd, NTH, LDS_BYTES) != hipSuccess || per_cu < 1) { fprintf(stderr, "kernel_launch: occupancy query says %d blocks/CU\n", per_cu); }
#endif
        (void)hipGetLastError();
        grid = cus;
    }
    if (grid < 0) return;
    (void)hipMemsetAsync((char*)d_ws + WS_CTL, 0, CTL_ZERO, stream);
    Args a{};
    for (int i = 0; i < 45; ++i) a.in[i] = d_in[i];
    a.out = (float*)d_out; a.ws = (unsigned char*)d_ws; a.layer = 0; a.pad = 0;
#if MK_ONE_LAUNCH
    hipLaunchKernelGGL(k_fwd, dim3(grid), dim3(NTH), LDS_BYTES, stream, a);
#else
    static const PhaseEnt prog_h[] = {
        {PK_PRO, 0},
        {PK_G1A, 0}, {PK_PRE, 0}, {PK_G23, 0}, {PK_MLAPOST, 0}, {PK_ATT, 0}, {PK_RGPREP, 0}, {PK_SCAN, 0}, {PK_FIN, 0}, {PK_COUT, 0}, {PK_G1B, 0}, {PK_MRG, 0}, {PK_OUT, 0}, {PK_FGU, 0}, {PK_FD, 0}, {PK_PP, 0}, {PK_PG, 0},
        {PK_G1A, 1}, {PK_PRE, 1}, {PK_G23, 1}, {PK_MLAPOST, 1}, {PK_ATT, 1}, {PK_RGPREP, 1}, {PK_SCAN, 1}, {PK_FIN, 1}, {PK_COUT, 1}, {PK_G1B, 1}, {PK_MRG, 1}, {PK_OUT, 1},
        {PK_MOEA, 1}, {PK_MOEB, 1}, {PK_MGU0, 1}, {PK_MD0, 1}, {PK_MGU1, 1}, {PK_MD1, 1}, {PK_COMB, 1}, {PK_PP, 1}, {PK_PG, 1} };
    for (int p = 0; p < (int)(sizeof(prog_h) / sizeof(prog_h[0])); ++p) { const int l = prog_h[p].layer;
#define LK(K) case K: hipLaunchKernelGGL(k_one<K>, dim3(grid), dim3(NTH), LDS_BYTES, stream, a, l); break;
        switch (prog_h[p].kind) { LK(PK_PRO) LK(PK_G1A) LK(PK_PRE) LK(PK_G23) LK(PK_MLAPOST) LK(PK_ATT) LK(PK_RGPREP) LK(PK_SCAN) LK(PK_FIN) LK(PK_G1B) LK(PK_MRG) LK(PK_OUT) LK(PK_FGU) LK(PK_FD) LK(PK_MOEA) LK(PK_MOEB) LK(PK_MGU0) LK(PK_MD0) LK(PK_MGU1) LK(PK_MD1) LK(PK_COMB) LK(PK_PP) LK(PK_PG) LK(PK_COUT) default: break; }
#undef LK
    }
#endif
}
```
